# Optimizing an MI355X kernel written in HIP

```python
import math
import jax, jax.numpy as jnp
from jax import lax
import numpy as np

D_MODEL = 2048
BATCH = 4
SEQ = 4096
DEPTH = 1

GRID_W = 64
WIN_H = 8
WIN_W = 16
ATTN_WIDTH = D_MODEL // 2
SSM_WIDTH = D_MODEL - ATTN_WIDTH
MIX_WIDTH = ATTN_WIDTH + SSM_WIDTH
HEAD_DIM = 64
N_HEADS = ATTN_WIDTH // HEAD_DIM
SSM_GROUP_CH = 16
SSM_GROUPS = SSM_WIDTH // SSM_GROUP_CH
SSM_STATE = 64
N_DIRS = 2
D_FF = ((8 * D_MODEL + 3 * 256 - 1) // (3 * 256)) * 256
IN_WIDTH = 3 * ATTN_WIDTH + SSM_WIDTH
RMS_EPS = 1e-6
NEG_INF = -1e30

kernel_name = "hymba_natten_s5_encoder_block"


def rmsnorm(x, g):
    xf = x.astype(jnp.float32)
    y = xf * lax.rsqrt(jnp.mean(xf * xf, axis=-1, keepdims=True) + RMS_EPS)
    return (y * g.astype(jnp.float32)).astype(x.dtype)


def neighbourhood_attention(q, k, v, q_gain, k_gain, rpb):
    b, s, h, dh = q.shape
    rows = s // GRID_W
    kh = min(WIN_H, rows)
    q = rmsnorm(q, q_gain)
    k = rmsnorm(k, k_gain)
    qg = q.reshape(b, rows, GRID_W, h, dh)
    kg = k.reshape(b, rows, GRID_W, h, dh)
    vg = v.reshape(b, rows, GRID_W, h, dh)
    r_idx = jnp.arange(rows)
    row_start = jnp.clip(r_idx - kh // 2, 0, rows - kh)
    key_rows = row_start[:, None] + jnp.arange(kh)[None, :]
    k_blk = kg[:, key_rows]
    v_blk = vg[:, key_rows]
    c_idx = jnp.arange(GRID_W)
    col_start = jnp.clip(c_idx - WIN_W // 2, 0, GRID_W - WIN_W)
    col_in = (c_idx[None, :] >= col_start[:, None]) & (c_idx[None, :] < col_start[:, None] + WIN_W)
    dr_idx = key_rows - r_idx[:, None] + (WIN_H - 1)
    dc_idx = jnp.clip(c_idx[None, :] - c_idx[:, None], -(WIN_W - 1), WIN_W - 1) + (WIN_W - 1)
    bias = rpb[:, dr_idx[:, None, :, None], dc_idx[None, :, None, :]].astype(jnp.float32)
    scale = 1.0 / math.sqrt(dh)
    scores = jnp.einsum('brqhd,brikhd->bhrqik', qg, k_blk).astype(jnp.float32) * scale
    scores = jnp.where(col_in[None, None, None, :, None, :], scores + bias[None], NEG_INF)
    p = jax.nn.softmax(scores.reshape(b, h, rows, GRID_W, kh * GRID_W), axis=-1)
    p = p.reshape(b, h, rows, GRID_W, kh, GRID_W).astype(v.dtype)
    out = jnp.einsum('bhrqik,brikhd->brqhd', p, v_blk)
    return out.reshape(b, s, h * dh)


def _linear_recurrence(e1, e2):
    a1, b1 = e1
    a2, b2 = e2
    return a2 * a1, a2 * b1 + b2


def s5_bidirectional(u, a_re, a_im, b_re, b_im, c_re, c_im, log_step, d_skip, w_glu, b_glu):
    b, s, _ = u.shape
    ug = u.astype(jnp.float32).reshape(b, s, SSM_GROUPS, SSM_GROUP_CH)
    uc = lax.complex(ug, jnp.zeros_like(ug))
    y = jnp.zeros_like(ug)
    for d in range(N_DIRS):
        lam = lax.complex(jnp.minimum(a_re[d].astype(jnp.float32), -1e-4), a_im[d].astype(jnp.float32))
        dt = jnp.exp(log_step[d].astype(jnp.float32))[:, None]
        lam_bar = jnp.exp(lam * dt)
        b_mat = lax.complex(b_re[d].astype(jnp.float32), b_im[d].astype(jnp.float32))
        b_bar = ((lam_bar - 1.0) / lam)[:, :, None] * b_mat
        c_mat = lax.complex(c_re[d].astype(jnp.float32), c_im[d].astype(jnp.float32))
        bu = jnp.einsum('bsgc,gpc->bsgp', uc, b_bar)
        a_seq = jnp.broadcast_to(lam_bar[None, None], (1, s, SSM_GROUPS, SSM_STATE))
        _, states = lax.associative_scan(_linear_recurrence, (a_seq, bu), reverse=(d == 1), axis=1)
        y = y + jnp.real(jnp.einsum('bsgp,gcp->bsgc', states, c_mat))
    y = y.reshape(b, s, SSM_WIDTH) + d_skip.astype(jnp.float32) * ug.reshape(b, s, SSM_WIDTH)
    y = jax.nn.gelu(y.astype(u.dtype))
    return y * jax.nn.sigmoid(y @ w_glu + b_glu)


def setup_inputs(seed: int = 0) -> dict:
    key = jax.random.key(seed)
    ks = jax.random.split(key, 24)
    f32 = jnp.float32
    L, G, P, C = DEPTH, SSM_GROUPS, SSM_STATE, SSM_GROUP_CH
    nrm = lambda k, shp, sc: jax.random.normal(k, shp, f32) * sc
    a_im_base = jnp.pi * jnp.arange(P, dtype=f32)
    return {
        "x": jax.random.normal(ks[0], (BATCH, SEQ, D_MODEL), f32),
        "g_mix": 1.0 + nrm(ks[1], (L, D_MODEL), 0.05),
        "w_in": nrm(ks[2], (L, D_MODEL, IN_WIDTH), D_MODEL ** -0.5),
        "q_gain": 1.0 + nrm(ks[3], (L, HEAD_DIM), 0.05),
        "k_gain": 1.0 + nrm(ks[4], (L, HEAD_DIM), 0.05),
        "rpb": nrm(ks[5], (L, N_HEADS, 2 * WIN_H - 1, 2 * WIN_W - 1), 0.5),
        "ssm_a_re": -0.5 + nrm(ks[6], (L, N_DIRS, G, P), 0.01),
        "ssm_a_im": a_im_base + nrm(ks[7], (L, N_DIRS, G, P), 0.01),
        "ssm_b_re": nrm(ks[8], (L, N_DIRS, G, P, C), (2 * C) ** -0.5),
        "ssm_b_im": nrm(ks[9], (L, N_DIRS, G, P, C), (2 * C) ** -0.5),
        "ssm_c_re": nrm(ks[10], (L, N_DIRS, G, C, P), (2 * P) ** -0.5),
        "ssm_c_im": nrm(ks[11], (L, N_DIRS, G, C, P), (2 * P) ** -0.5),
        "ssm_log_step": jax.random.uniform(ks[12], (L, N_DIRS, G), f32, math.log(1e-3), math.log(1e-1)),
        "ssm_d": nrm(ks[13], (L, SSM_WIDTH), 1.0),
        "w_glu": nrm(ks[14], (L, SSM_WIDTH, SSM_WIDTH), SSM_WIDTH ** -0.5),
        "b_glu": nrm(ks[15], (L, SSM_WIDTH), 0.02),
        "g_out_attn": 1.0 + nrm(ks[16], (L, ATTN_WIDTH), 0.05),
        "g_out_ssm": 1.0 + nrm(ks[17], (L, SSM_WIDTH), 0.05),
        "w_out": nrm(ks[18], (L, MIX_WIDTH, D_MODEL), MIX_WIDTH ** -0.5),
        "g_ffn": 1.0 + nrm(ks[19], (L, D_MODEL), 0.05),
        "w_ffn_gate": nrm(ks[20], (L, D_MODEL, D_FF), D_MODEL ** -0.5),
        "w_ffn_up": nrm(ks[21], (L, D_MODEL, D_FF), D_MODEL ** -0.5),
        "w_ffn_down": nrm(ks[22], (L, D_FF, D_MODEL), D_FF ** -0.5),
    }


def reference(x, g_mix, w_in, q_gain, k_gain, rpb, ssm_a_re, ssm_a_im, ssm_b_re, ssm_b_im,
              ssm_c_re, ssm_c_im, ssm_log_step, ssm_d, w_glu, b_glu, g_out_attn, g_out_ssm,
              w_out, g_ffn, w_ffn_gate, w_ffn_up, w_ffn_down):
    b, s, _ = x.shape
    for l in range(DEPTH):
        h = rmsnorm(x, g_mix[l])
        z = h @ w_in[l]
        q, k, v, u = jnp.split(z, [ATTN_WIDTH, 2 * ATTN_WIDTH, 3 * ATTN_WIDTH], axis=-1)
        q = q.reshape(b, s, N_HEADS, HEAD_DIM)
        k = k.reshape(b, s, N_HEADS, HEAD_DIM)
        v = v.reshape(b, s, N_HEADS, HEAD_DIM)
        ya = neighbourhood_attention(q, k, v, q_gain[l], k_gain[l], rpb[l])
        ys = s5_bidirectional(u, ssm_a_re[l], ssm_a_im[l], ssm_b_re[l], ssm_b_im[l],
                              ssm_c_re[l], ssm_c_im[l], ssm_log_step[l], ssm_d[l],
                              w_glu[l], b_glu[l])
        y = jnp.concatenate([rmsnorm(ya, g_out_attn[l]), rmsnorm(ys, g_out_ssm[l])], axis=-1)
        x = x + y @ w_out[l]
        h = rmsnorm(x, g_ffn[l])
        x = x + (jax.nn.silu(h @ w_ffn_gate[l]) * (h @ w_ffn_up[l])) @ w_ffn_down[l]
    return x
```

```cpp
#include <hip/hip_runtime.h>
#include <cstdio>
#include <cstdint>

#ifndef MK_N_LAUNCHES
#define MK_N_LAUNCHES 1
#endif

#define GAS __attribute__((address_space(1)))
#define LAS __attribute__((address_space(3)))
typedef unsigned short bf16_t;
typedef short bf16x8 __attribute__((ext_vector_type(8)));
typedef short s16x4 __attribute__((ext_vector_type(4)));
typedef float f32x4 __attribute__((ext_vector_type(4)));
typedef float f32x2 __attribute__((ext_vector_type(2)));
typedef unsigned u32x4 __attribute__((ext_vector_type(4)));
typedef unsigned u32x2 __attribute__((ext_vector_type(2)));

constexpr int BATCH = 4, SEQ = 4096, DM = 2048, M = BATCH * SEQ;
constexpr int AW = 1024, SW = 1024, NH = 16, HD = 64, NQKV = 3 * AW, INW = 4096, DFF = 5632;
constexpr int GRIDW = 64, NROWS = SEQ / GRIDW;
constexpr int SG = 64, SC = 16, SP = 64;
constexpr int CL = 32, NCH = SEQ / CL, RCH = M / CL;
constexpr int KS5 = CL * SC + 256;
constexpr float RMS_EPS = 1e-6f;
constexpr int NPHASE = 9;

constexpr size_t MiB = 1u << 20;
constexpr size_t WS_CTL = 0, CTL_ZERO_BYTES = 1 * MiB;
constexpr size_t WS_WIN = 1 * MiB, WS_WGLU = 17 * MiB, WS_WOUT = 19 * MiB, WS_WGU = 27 * MiB, WS_WD = 71 * MiB;
constexpr size_t WS_WST = 93 * MiB, WS_TW = 109 * MiB, WS_LAML = 157 * MiB;
constexpr size_t WS_XN = 158 * MiB;
constexpr size_t WS_BIG = 222 * MiB;
constexpr size_t WS_A5 = WS_BIG + 96 * MiB, WS_E = WS_BIG + 144 * MiB;
constexpr size_t WS_YAYS = 398 * MiB, WS_END = 462 * MiB;
constexpr int CW_BAR = 4096;
constexpr int CW_SSQA = 65536, CW_SSQS = CW_SSQA + M, CW_SSQX = CW_SSQS + M;
static_assert((size_t)(CW_SSQX + M) * 4 <= CTL_ZERO_BYTES, "ctl");

constexpr int RING_BYTES = 131072;
constexpr int MISC_OFF = 143360;
constexpr int LDS_BYTES = 147456;

__device__ __forceinline__ unsigned cvt_pk_bf16(float lo, float hi) { unsigned r; asm volatile("v_cvt_pk_bf16_f32 %0, %1, %2" : "=v"(r) : "v"(lo), "v"(hi)); return r; }
__device__ __forceinline__ float bf_lo(unsigned w) { return __uint_as_float(w << 16); }
__device__ __forceinline__ float bf_hi(unsigned w) { return __uint_as_float(w & 0xffff0000u); }
__device__ __forceinline__ float fast_rcp(float x) { return __builtin_amdgcn_rcpf(x); }
__device__ __forceinline__ float fast_exp2(float x) { return __builtin_amdgcn_exp2f(x); }
__device__ __forceinline__ float sigmoidf_(float x) { return fast_rcp(1.0f + fast_exp2(-1.44269504089f * x)); }
__device__ __forceinline__ float gelu_tanh(float x) { const float t = x * (1.0f + 0.044715f * x * x); return x * fast_rcp(1.0f + fast_exp2(-2.30220818f * t)); }
__device__ __forceinline__ float wave_sum(float v) {
#pragma unroll
    for (int o = 1; o < 64; o <<= 1) v += __shfl_xor(v, o);
    return v;
}

namespace pg8 {
constexpr int BM = 256, BK = 64, HALF = 128, HTB = HALF * BK * 2, NXCD = 8, WGM = 8;
__host__ __device__ __forceinline__ int lds_byte(int r, int c) { const int st = (r >> 4) * 2 + (c >> 5), rr = r & 15, cc = c & 31, ob = rr * 64 + cc * 2; return st * 1024 + (ob ^ (((ob >> 9) & 1) << 5)); }
__host__ __device__ __forceinline__ void stage_rc(int b, int& R, int& C) { const int st = b / 1024, sb = b % 1024, swz = sb ^ (((sb >> 9) & 1) << 5); R = (st >> 1) * 16 + swz / 64; C = (st & 1) * 32 + (swz % 64) / 2; }
__host__ __device__ __forceinline__ int perm32(int rho) { const int n = rho >> 4, i = rho & 15; return 8 * (i >> 2) + 4 * n + (i & 3); }

struct Unit { int pm, pn, g, kh; };
struct Gemm { const bf16_t* A; const bf16_t* Bt; int lda, ldb, K; size_t sA, sB; };

struct StaticOrder {
    int nM, nN, nwg, G, c;
    __device__ void init(int M_, int N_, int G_, int c_) { nM = M_ / BM; nN = N_ / BM; nwg = nM * nN; G = G_; c = c_; }
    __device__ bool next(int i, Unit& u) const {
        const long L = (long)i * G + c; if (L >= nwg) return false;
        int wgid = (int)L; { const int q = nwg / NXCD, r = nwg % NXCD, xcd = wgid % NXCD, off = wgid / NXCD; wgid = (xcd < r ? xcd * (q + 1) : r * (q + 1) + (xcd - r) * q) + off; }
        const int nig = WGM * nN, gid = wgid / nig, fm = gid * WGM, gsz = (nM - fm) < WGM ? (nM - fm) : WGM;
        u.pm = fm + ((wgid % nig) % gsz); u.pn = (wgid % nig) / gsz; u.g = 0; u.kh = 0; return true;
    }
};
struct SplitKOrder {
    StaticOrder so;
    __device__ bool next(int i, Unit& u) const { if (!so.next(i >> 1, u)) return false; u.kh = i & 1; return true; }
};
struct BatchOrder {
    int nM, nN, nwg, G, c;
    __device__ void init(int nM_, int nN_, int nb, int G_, int c_) { nM = nM_; nN = nN_; nwg = nM * nN * nb; G = G_; c = c_; }
    __device__ bool next(int i, Unit& u) const {
        const long L = (long)i * G + c; if (L >= nwg) return false;
        const int l = (int)L; u.pn = l % nN; u.pm = (l / nN) % nM; u.g = l / (nN * nM); u.kh = 0; return true;
    }
};

template <class Epi, class Sched>
__device__ __forceinline__ void gemm_phase(LAS unsigned char* lds, const Gemm g, const Sched& S, const Epi& E) {
    const int tid = threadIdx.x, wid = __builtin_amdgcn_readfirstlane(tid >> 6), lane = tid & 63, wr = wid >> 2, wc = wid & 3, fr = lane & 15, fq = lane >> 4;
    const int K = g.K, nt = K / BK;
    unsigned voffA[2], voffB[2];
#pragma unroll
    for (int i = 0; i < 2; ++i) { int R, C; stage_rc(tid * 16 + i * 8192, R, C); const int Rb = Epi::PERM ? ((R & ~31) + perm32(R & 31)) : R;
        voffA[i] = (unsigned)(R * g.lda + C) * 2u; voffB[i] = (unsigned)(Rb * g.ldb + C) * 2u; }
    const size_t kstep = (size_t)(BK * 2);
    const size_t hstepA = (size_t)HALF * g.lda * 2, hstepB = (size_t)HALF * g.ldb * 2;
    const unsigned ldsw = (unsigned)wid * 1024u;
    const int aoff = lds_byte(wr * 64 + fr, fq * 8), boff = lds_byte(wc * 32 + fr, fq * 8);
#define PG8_SA(b, h) (((b) * 2 + (h)) * HTB)
#define PG8_SB(b, h) ((4 + (b) * 2 + (h)) * HTB)
#define PG8_STAGE(bufoff, gbase, voff) do { _Pragma("unroll") for (int _i = 0; _i < 2; ++_i) \
        __builtin_amdgcn_global_load_lds((const unsigned*)((const char*)(gbase) + (voff)[_i]), (LAS unsigned*)(lds + (bufoff) + ldsw + _i * 8192), 16, 0, 0); } while (0)
#define PG8_LDA(dst, b, h) do { _Pragma("unroll") for (int m = 0; m < 4; ++m) _Pragma("unroll") for (int k = 0; k < 2; ++k) dst[m][k] = *(const LAS bf16x8*)(lds + PG8_SA(b, h) + aoff + m * 2048 + k * 1024); } while (0)
#define PG8_LDB(dst, b, h) do { _Pragma("unroll") for (int n = 0; n < 2; ++n) _Pragma("unroll") for (int k = 0; k < 2; ++k) dst[n][k] = *(const LAS bf16x8*)(lds + PG8_SB(b, h) + boff + n * 2048 + k * 1024); } while (0)
#define PG8_MMA(ai, bj, At, Bt) do { __builtin_amdgcn_s_setprio(1); _Pragma("unroll") for (int m = 0; m < 4; ++m) _Pragma("unroll") for (int n = 0; n < 2; ++n) _Pragma("unroll") for (int k = 0; k < 2; ++k) \
        acc[ai][bj][m][n] = __builtin_amdgcn_mfma_f32_16x16x32_bf16(Bt[n][k], At[m][k], acc[ai][bj][m][n], 0, 0, 0); __builtin_amdgcn_s_setprio(0); } while (0)
#define PG8_WAIT_V(n) asm volatile("s_waitcnt vmcnt(" #n ")" ::: "memory")
#define PG8_WAIT_L(n) asm volatile("s_waitcnt lgkmcnt(" #n ")" ::: "memory")
#define PG8_BAR __builtin_amdgcn_s_barrier()
#define PG8_SCHED __builtin_amdgcn_sched_barrier(0)
    Unit cur, nxt; int ui = 0;
    if (!S.next(0, cur)) return;
    f32x4 acc[2][2][4][2];
#pragma unroll
    for (int a = 0; a < 2; ++a)
#pragma unroll
        for (int b = 0; b < 2; ++b)
#pragma unroll
            for (int m = 0; m < 4; ++m)
#pragma unroll
                for (int n = 0; n < 2; ++n) acc[a][b][m][n] = (f32x4){0.f, 0.f, 0.f, 0.f};
    bf16x8 At[4][2], B0[2][2], B1[2][2];
    const char* cA = (const char*)g.A + ((size_t)cur.g * g.sA + (size_t)cur.pm * BM * g.lda + (size_t)cur.kh * K) * 2;
    const char* cB = (const char*)g.Bt + ((size_t)cur.g * g.sB + (size_t)cur.pn * BM * g.ldb + (size_t)cur.kh * K) * 2;
    PG8_STAGE(PG8_SB(0, 0), cB, voffB); PG8_STAGE(PG8_SB(0, 1), cB + hstepB, voffB); PG8_STAGE(PG8_SA(0, 0), cA, voffA); PG8_STAGE(PG8_SA(0, 1), cA + hstepA, voffA);
    if (wr == 1) PG8_BAR;
    PG8_WAIT_V(2); PG8_BAR;
    PG8_STAGE(PG8_SB(1, 0), cB + kstep, voffB); PG8_STAGE(PG8_SA(1, 0), cA + kstep, voffA); PG8_STAGE(PG8_SB(1, 1), cB + hstepB + kstep, voffB);
    PG8_WAIT_V(6); PG8_BAR;
    for (;;) {
        const bool has_next = S.next(ui + 1, nxt);
        const char* nA = has_next ? (const char*)g.A + ((size_t)nxt.g * g.sA + (size_t)nxt.pm * BM * g.lda + (size_t)nxt.kh * K) * 2 : cA;
        const char* nB = has_next ? (const char*)g.Bt + ((size_t)nxt.g * g.sB + (size_t)nxt.pn * BM * g.ldb + (size_t)nxt.kh * K) * 2 : cB;
        for (int t = 0; t < nt; t += 2) {
            const bool last = (t == nt - 2);
            const char* a1 = cA + (size_t)(t + 1) * kstep;
            const char* a2 = last ? nA : cA + (size_t)(t + 2) * kstep; const char* b2 = last ? nB : cB + (size_t)(t + 2) * kstep;
            const char* a3 = a2 + kstep; const char* b3 = b2 + kstep;
            PG8_LDB(B0, 0, 0); PG8_LDB(B1, 0, 1); PG8_SCHED; PG8_LDA(At, 0, 0); PG8_STAGE(PG8_SA(1, 1), a1 + hstepA, voffA);
            PG8_WAIT_V(8); PG8_WAIT_L(0); PG8_BAR; PG8_MMA(0, 0, At, B0); PG8_MMA(0, 1, At, B1); PG8_BAR; PG8_SCHED;
            PG8_LDA(At, 0, 1); PG8_STAGE(PG8_SB(0, 0), b2, voffB); PG8_STAGE(PG8_SB(0, 1), b2 + hstepB, voffB); PG8_STAGE(PG8_SA(0, 0), a2, voffA);
            PG8_WAIT_V(8); PG8_WAIT_L(0); PG8_BAR; PG8_MMA(1, 0, At, B0); PG8_MMA(1, 1, At, B1); PG8_BAR; PG8_SCHED;
            PG8_LDB(B0, 1, 0); PG8_LDB(B1, 1, 1); PG8_SCHED; PG8_LDA(At, 1, 0); PG8_STAGE(PG8_SA(0, 1), a2 + hstepA, voffA);
            PG8_WAIT_V(8); PG8_WAIT_L(0); PG8_BAR; PG8_MMA(0, 0, At, B0); PG8_MMA(0, 1, At, B1); PG8_BAR; PG8_SCHED;
            PG8_LDA(At, 1, 1); PG8_STAGE(PG8_SB(1, 0), b3, voffB); PG8_STAGE(PG8_SB(1, 1), b3 + hstepB, voffB); PG8_STAGE(PG8_SA(1, 0), a3, voffA);
            PG8_WAIT_V(8); PG8_WAIT_L(0); PG8_BAR; PG8_MMA(1, 0, At, B0); PG8_MMA(1, 1, At, B1); PG8_BAR; PG8_SCHED;
        }
        if (wr == 0) PG8_BAR;
        E(acc, cur, wr, wc, fr, fq);
        if (!has_next) break;
        if (!(Epi::KSPLIT && cur.kh == 0)) {
#pragma unroll
        for (int a = 0; a < 2; ++a)
#pragma unroll
            for (int b = 0; b < 2; ++b)
#pragma unroll
                for (int m = 0; m < 4; ++m)
#pragma unroll
                    for (int n = 0; n < 2; ++n) acc[a][b][m][n] = (f32x4){0.f, 0.f, 0.f, 0.f};
        }
        cur = nxt; cA = nA; cB = nB; ++ui;
        if (wr == 1) PG8_BAR;
    }
    PG8_WAIT_V(0);
    PG8_BAR;
#undef PG8_SA
#undef PG8_SB
#undef PG8_STAGE
#undef PG8_LDA
#undef PG8_LDB
#undef PG8_MMA
#undef PG8_WAIT_V
#undef PG8_WAIT_L
#undef PG8_BAR
#undef PG8_SCHED
}

__device__ __forceinline__ u32x4 pack8(const f32x4 a, const f32x4 b) { u32x4 w; w.x = cvt_pk_bf16(a[0], a[1]); w.y = cvt_pk_bf16(a[2], a[3]); w.z = cvt_pk_bf16(b[0], b[1]); w.w = cvt_pk_bf16(b[2], b[3]); return w; }

struct EpiZ {
    static constexpr bool PERM = true, KSPLIT = false;
    bf16_t* QKV; bf16_t* A5;
    __device__ __forceinline__ void operator()(f32x4 (&acc)[2][2][4][2], const Unit& u, int wr, int wc, int fr, int fq) const {
#pragma unroll
        for (int ai = 0; ai < 2; ++ai)
#pragma unroll
            for (int m = 0; m < 4; ++m) { const int row = u.pm * BM + ai * HALF + wr * 64 + m * 16 + fr;
#pragma unroll
                for (int bj = 0; bj < 2; ++bj) { const int c8 = u.pn * BM + bj * HALF + wc * 32 + 8 * fq; const u32x4 w = pack8(acc[ai][bj][m][0], acc[ai][bj][m][1]);
                    if (u.pn < 12) *(u32x4*)(QKV + (size_t)row * NQKV + c8) = w;
                    else { const int ch = c8 - NQKV, gg = ch >> 4, c0 = ch & 15, R = row >> 5, s = row & 31; *(u32x4*)(A5 + ((size_t)gg * RCH + R) * KS5 + s * SC + c0) = w; } } }
    }
};
struct EpiE {
    static constexpr bool PERM = false, KSPLIT = false;
    float* E;
    __device__ __forceinline__ void operator()(f32x4 (&acc)[2][2][4][2], const Unit& u, int wr, int wc, int fr, int fq) const {
#pragma unroll
        for (int ai = 0; ai < 2; ++ai)
#pragma unroll
            for (int m = 0; m < 4; ++m) { const int R = u.pm * BM + ai * HALF + wr * 64 + m * 16 + fr; float* rowp = E + ((size_t)u.g * RCH + R) * 256 + wc * 32 + 4 * fq;
#pragma unroll
                for (int bj = 0; bj < 2; ++bj)
#pragma unroll
                    for (int n = 0; n < 2; ++n) *(f32x4*)(rowp + bj * HALF + n * 16) = acc[ai][bj][m][n]; }
    }
};
struct EpiS5Out {
    static constexpr bool PERM = true, KSPLIT = false;
    bf16_t* Yg;
    __device__ __forceinline__ void operator()(f32x4 (&acc)[2][2][4][2], const Unit& u, int wr, int wc, int fr, int fq) const {
#pragma unroll
        for (int ai = 0; ai < 2; ++ai)
#pragma unroll
            for (int m = 0; m < 4; ++m) { const int R = u.pm * BM + ai * HALF + wr * 64 + m * 16 + fr;
#pragma unroll
                for (int bj = 0; bj < 2; ++bj) { const int n8 = u.pn * BM + bj * HALF + wc * 32 + 8 * fq, s = n8 >> 4, c0 = n8 & 15;
                    f32x4 v0 = acc[ai][bj][m][0], v1 = acc[ai][bj][m][1];
#pragma unroll
                    for (int e = 0; e < 4; ++e) { v0[e] = gelu_tanh(v0[e]); v1[e] = gelu_tanh(v1[e]); }
                    *(u32x4*)(Yg + (size_t)(R * CL + s) * SW + u.g * SC + c0) = pack8(v0, v1); } }
    }
};
struct EpiGlu {
    static constexpr bool PERM = true, KSPLIT = false;
    const bf16_t* Yg; const float* bias; bf16_t* YAYS; float* ssq;
    __device__ __forceinline__ void operator()(f32x4 (&acc)[2][2][4][2], const Unit& u, int wr, int wc, int fr, int fq) const {
        const int c8b = u.pn * BM + wc * 32 + 8 * fq;
        f32x4 bv[2][2];
#pragma unroll
        for (int bj = 0; bj < 2; ++bj)
#pragma unroll
            for (int n = 0; n < 2; ++n) bv[bj][n] = *(const f32x4*)(bias + c8b + bj * HALF + 4 * n);
#pragma unroll
        for (int ai = 0; ai < 2; ++ai)
#pragma unroll
            for (int m = 0; m < 4; ++m) { const int row = u.pm * BM + ai * HALF + wr * 64 + m * 16 + fr; float ss = 0.f;
#pragma unroll
                for (int bj = 0; bj < 2; ++bj) { const int c8 = c8b + bj * HALF; const u32x4 y = *(const u32x4*)(Yg + (size_t)row * SW + c8);
                    const f32x4 a0 = acc[ai][bj][m][0] + bv[bj][0], a1 = acc[ai][bj][m][1] + bv[bj][1];
                    f32x4 v0, v1;
                    v0[0] = bf_lo(y.x) * sigmoidf_(a0[0]); v0[1] = bf_hi(y.x) * sigmoidf_(a0[1]); v0[2] = bf_lo(y.y) * sigmoidf_(a0[2]); v0[3] = bf_hi(y.y) * sigmoidf_(a0[3]);
                    v1[0] = bf_lo(y.z) * sigmoidf_(a1[0]); v1[1] = bf_hi(y.z) * sigmoidf_(a1[1]); v1[2] = bf_lo(y.w) * sigmoidf_(a1[2]); v1[3] = bf_hi(y.w) * sigmoidf_(a1[3]);
#pragma unroll
                    for (int e = 0; e < 4; ++e) ss += v0[e] * v0[e] + v1[e] * v1[e];
                    *(u32x4*)(YAYS + (size_t)row * DM + AW + c8) = pack8(v0, v1); }
                ss += __shfl_xor(ss, 16); ss += __shfl_xor(ss, 32);
                if (fq == 0) unsafeAtomicAdd(ssq + row, ss); }
    }
};
struct EpiRes1 {
    static constexpr bool PERM = true, KSPLIT = true;
    const float* x; float* out; bf16_t* XB; const float* ssqa; const float* ssqs; float* ssqx;
    __device__ __forceinline__ void operator()(f32x4 (&acc)[2][2][4][2], const Unit& u, int wr, int wc, int fr, int fq) const {
        if (u.kh == 0) {
#pragma unroll
        for (int ai = 0; ai < 2; ++ai)
#pragma unroll
            for (int m = 0; m < 4; ++m) { const int row = u.pm * BM + ai * HALF + wr * 64 + m * 16 + fr;
                const float ra = __builtin_amdgcn_rsqf(ssqa[row] * (1.0f / AW) + RMS_EPS), rs = __builtin_amdgcn_rsqf(ssqs[row] * (1.0f / SW) + RMS_EPS), f = ra * fast_rcp(rs);
#pragma unroll
                for (int bj = 0; bj < 2; ++bj)
#pragma unroll
                    for (int n = 0; n < 2; ++n) acc[ai][bj][m][n] *= f; }
        return; }
#pragma unroll
        for (int ai = 0; ai < 2; ++ai)
#pragma unroll
            for (int m = 0; m < 4; ++m) { const int row = u.pm * BM + ai * HALF + wr * 64 + m * 16 + fr; float ss = 0.f;
                const float rs = __builtin_amdgcn_rsqf(ssqs[row] * (1.0f / SW) + RMS_EPS);
#pragma unroll
                for (int bj = 0; bj < 2; ++bj) { const size_t off = (size_t)row * DM + u.pn * BM + bj * HALF + wc * 32 + 8 * fq;
                    const f32x4 x0 = *(const f32x4*)(x + off), x1 = *(const f32x4*)(x + off + 4);
                    const f32x4 v0 = x0 + acc[ai][bj][m][0] * rs, v1 = x1 + acc[ai][bj][m][1] * rs;
#pragma unroll
                    for (int e = 0; e < 4; ++e) ss += v0[e] * v0[e] + v1[e] * v1[e];
                    *(f32x4*)(out + off) = v0; *(f32x4*)(out + off + 4) = v1; *(u32x4*)(XB + off) = pack8(v0, v1); }
                ss += __shfl_xor(ss, 16); ss += __shfl_xor(ss, 32);
                if (fq == 0) unsafeAtomicAdd(ssqx + row, ss);
                asm volatile("" ::: "memory"); }
    }
};
struct EpiSwiGLU {
    static constexpr bool PERM = true, KSPLIT = false;
    bf16_t* H; const float* ssqx;
    __device__ __forceinline__ void operator()(f32x4 (&acc)[2][2][4][2], const Unit& u, int wr, int wc, int fr, int fq) const {
#pragma unroll
        for (int ai = 0; ai < 2; ++ai)
#pragma unroll
            for (int m = 0; m < 4; ++m) { const int row = u.pm * BM + ai * HALF + wr * 64 + m * 16 + fr;
                const float rs = __builtin_amdgcn_rsqf(ssqx[row] * (1.0f / DM) + RMS_EPS);
                f32x4 h0, h1;
#pragma unroll
                for (int e = 0; e < 4; ++e) { const float g0 = acc[ai][0][m][0][e] * rs, u0 = acc[ai][1][m][0][e] * rs, g1 = acc[ai][0][m][1][e] * rs, u1 = acc[ai][1][m][1][e] * rs;
                    h0[e] = g0 * sigmoidf_(g0) * u0; h1[e] = g1 * sigmoidf_(g1) * u1; }
                *(u32x4*)(H + (size_t)row * DFF + u.pn * HALF + wc * 32 + 8 * fq) = pack8(h0, h1); }
    }
};
struct EpiRes2 {
    static constexpr bool PERM = false, KSPLIT = false;
    float* out;
    __device__ __forceinline__ void operator()(f32x4 (&acc)[2][2][4][2], const Unit& u, int wr, int wc, int fr, int fq) const {
#pragma unroll
        for (int ai = 0; ai < 2; ++ai)
#pragma unroll
            for (int m = 0; m < 4; ++m) { float* rowp = out + (size_t)(u.pm * BM + ai * HALF + wr * 64 + m * 16 + fr) * DM + u.pn * BM + wc * 32 + 4 * fq;
#pragma unroll
                for (int bj = 0; bj < 2; ++bj)
#pragma unroll
                    for (int n = 0; n < 2; ++n) { float* p = rowp + bj * HALF + n * 16; *(f32x4*)p = *(const f32x4*)p + acc[ai][bj][m][n]; } }
    }
};
}

#define RLX_AGENT __ATOMIC_RELAXED, __HIP_MEMORY_SCOPE_AGENT
#define XB_TMO      128
#define XB_XCNT(j)  (256  + 64 * (j))
#define XB_XSUB(j)  (1280 + 64 * (j))
#define XB_XGEN(j)  (2304 + 64 * (j))
#define XB_TOP      3328
#define XB_TOPGEN   3392
#define XCD_BAR_WORDS 3456
#define XB_SPIN_CAP (1u << 24)
__device__ __forceinline__ unsigned xb_ld(unsigned* p)              { return __hip_atomic_load(p, __ATOMIC_RELAXED, __HIP_MEMORY_SCOPE_AGENT); }
__device__ __forceinline__ unsigned xb_add(unsigned* p, unsigned v) { return __hip_atomic_fetch_add(p, v, __ATOMIC_RELAXED, __HIP_MEMORY_SCOPE_AGENT); }
__device__ __forceinline__ unsigned xb_xcc_id() { return (unsigned)__builtin_amdgcn_s_getreg((3 << 11) | 20) & 0xFu; }
#define XB_SPIN(cond, bar) do { unsigned _sp = 0; while (cond) { __builtin_amdgcn_s_sleep(1); \
    if ((++_sp & 255u) == 0u) { if (xb_ld(&(bar)[XB_TMO])) break; if (_sp > XB_SPIN_CAP) { atomicAdd(&(bar)[XB_TMO], 1u); break; } } } } while (0)
struct XcdBarrier { unsigned* bar; unsigned x; volatile LAS unsigned* st; };
__device__ __forceinline__ XcdBarrier xcd_barrier_post(unsigned* bar, volatile LAS unsigned* st) {
    XcdBarrier b; b.bar = bar; b.x = xb_xcc_id(); b.st = st;
    if (threadIdx.x == 0) (void)xb_add(&bar[XB_XCNT(b.x)], 1u);
    return b;
}
__device__ __forceinline__ void xcd_barrier_complete(unsigned* bar, unsigned x, unsigned& nloc, unsigned& nx) {
    const unsigned G = gridDim.x * gridDim.y * gridDim.z;
    unsigned sum, cnt, mine, sp = 0u;
    for (;;) {
        sum = 0u; cnt = 0u; mine = 0u;
#pragma unroll
        for (unsigned j = 0; j < 16; ++j) { const unsigned c = xb_ld(&bar[XB_XCNT(j)]); sum += c; cnt += (c > 0u) ? 1u : 0u; mine = (j == x) ? c : mine; }
        if (sum == G) break;
        __builtin_amdgcn_s_sleep(1);
        if ((++sp & 255u) == 0u) { if (xb_ld(&bar[XB_TMO])) break; if (sp > XB_SPIN_CAP) { atomicAdd(&bar[XB_TMO], 1u); break; } }
    }
    nloc = mine > 0u ? mine : 1u; nx = cnt > 0u ? cnt : 1u;
}
__device__ __forceinline__ void xcd_barrier(const XcdBarrier& b) {
    asm volatile("s_waitcnt vmcnt(0)" ::: "memory");
    __syncthreads();
    if (threadIdx.x == 0) {
        unsigned* bar = b.bar;
        __builtin_amdgcn_s_waitcnt(0);
        unsigned nloc = b.st[0], nx = b.st[1];
        if (nloc == 0u) { xcd_barrier_complete(bar, b.x, nloc, nx); b.st[0] = nloc; b.st[1] = nx; }
        const unsigned old = xb_add(&bar[XB_XSUB(b.x)], 1u);
        const unsigned gen = old / nloc;
        if (old + 1u == (gen + 1u) * nloc) {
            __builtin_amdgcn_fence(__ATOMIC_RELEASE, "agent");
            asm volatile("s_waitcnt vmcnt(0)" ::: "memory");
            const unsigned og = xb_add(&bar[XB_TOP], 1u);
            const unsigned tg = og / nx;
            if (og + 1u == (tg + 1u) * nx) xb_add(&bar[XB_TOPGEN], 1u);
            else XB_SPIN(xb_ld(&bar[XB_TOPGEN]) == tg, bar);
            __builtin_amdgcn_fence(__ATOMIC_ACQUIRE, "agent");
            xb_add(&bar[XB_XGEN(b.x)], 1u);
            asm volatile("s_waitcnt vmcnt(0)" ::: "memory");
        } else {
            XB_SPIN(xb_ld(&bar[XB_XGEN(b.x)]) == gen, bar);
            __builtin_amdgcn_fence(__ATOMIC_ACQUIRE, "agent");
            asm volatile("s_waitcnt vmcnt(0)" ::: "memory");
        }
    }
    __syncthreads();
}

struct Args { const float* in[23]; float* out; unsigned char* ws; int ph_lo, ph_hi, li, pad; };
enum { I_X = 0, I_GMIX, I_WIN, I_QG, I_KG, I_RPB, I_ARE, I_AIM, I_BRE, I_BIM, I_CRE, I_CIM, I_LS, I_D, I_WGLU, I_BGLU, I_GOA, I_GOS, I_WOUT, I_GFFN, I_WG, I_WU, I_WD };

#define LDS_WAIT() asm volatile("s_waitcnt lgkmcnt(0)" ::: "memory")

__device__ __forceinline__ void p0_transpose_item(const float* W, int N, const float* kscale, bf16_t* WT, int ldd, int drow0, int k0, int n0, LAS float* scr, int lane) {
#pragma unroll 8
    for (int i = 0; i < 32; ++i) { const int kk = 2 * i + (lane >> 5); float v = W[(size_t)(k0 + kk) * N + n0 + (lane & 31)]; if (kscale) v *= kscale[k0 + kk]; scr[kk * 33 + (lane & 31)] = v; }
    LDS_WAIT(); asm volatile("" ::: "memory");
    const int c = lane & 7;
#pragma unroll
    for (int j = 0; j < 4; ++j) { const int n = (lane >> 3) + 8 * j; const LAS float* s = scr + (8 * c) * 33 + n;
        u32x4 o; o.x = cvt_pk_bf16(s[0 * 33], s[1 * 33]); o.y = cvt_pk_bf16(s[2 * 33], s[3 * 33]); o.z = cvt_pk_bf16(s[4 * 33], s[5 * 33]); o.w = cvt_pk_bf16(s[6 * 33], s[7 * 33]);
        *(u32x4*)(WT + (size_t)(drow0 + n) * ldd + k0 + 8 * c) = o; }
    LDS_WAIT(); asm volatile("" ::: "memory");
}

__device__ __forceinline__ void dsincos(double a, double& s, double& c) {
    const double k = __builtin_rint(a * 0.63661977236758134308);
    double r = __builtin_fma(-k, 1.57079632679489655800e+00, a);
    r = __builtin_fma(-k, 6.12323399573676603587e-17, r);
    const double r2 = r * r;
    double sp = -7.6471637318198164759e-13; sp = sp * r2 + 1.6059043836821614599e-10; sp = sp * r2 - 2.5052108385441718775e-08; sp = sp * r2 + 2.7557319223985890653e-06;
    sp = sp * r2 - 1.9841269841269841270e-04; sp = sp * r2 + 8.3333333333333333333e-03; sp = sp * r2 - 1.6666666666666666667e-01; sp = sp * r2 * r + r;
    double cp = 4.7794773323873852974e-14; cp = cp * r2 - 1.1470745597729724714e-11; cp = cp * r2 + 2.0876756987868098979e-09; cp = cp * r2 - 2.7557319223985890653e-07;
    cp = cp * r2 + 2.4801587301587301587e-05; cp = cp * r2 - 1.3888888888888888889e-03; cp = cp * r2 + 4.1666666666666666667e-02; cp = cp * r2 - 0.5; cp = cp * r2 + 1.0;
    const int q = (int)((long long)k) & 3;
    s = (q == 0) ? sp : (q == 1) ? cp : (q == 2) ? -sp : -cp;
    c = (q == 0) ? cp : (q == 1) ? -sp : (q == 2) ? -cp : sp;
}

__device__ __forceinline__ void p0_s5_tables(const Args& a, LAS unsigned char* lds, int g, int q, int tid) {
    LAS f32x2* LP = (LAS f32x2*)lds;
    LAS f32x2* Bb = (LAS f32x2*)(lds + 33792);
    LAS f32x2* Cm = (LAS f32x2*)(lds + 50176);
    LAS float* Kt = (LAS float*)(lds + 66560);
    const float* a_re = a.in[I_ARE]; const float* a_im = a.in[I_AIM]; const float* b_re = a.in[I_BRE]; const float* b_im = a.in[I_BIM];
    const float* c_re = a.in[I_CRE]; const float* c_im = a.in[I_CIM]; const float* lstep = a.in[I_LS]; const float* dsk = a.in[I_D];
    unsigned char* ws = a.ws;
    __syncthreads();
    for (int i = tid; i < 2 * 64 * 33; i += 512) { const int tau = i % 33, p = (i / 33) & 63, d = i / (33 * 64);
        const double lre = (double)fminf(a_re[(d * SG + g) * SP + p], -1e-4f), lim = (double)a_im[(d * SG + g) * SP + p], dt = exp((double)lstep[d * SG + g]);
        const double mag = exp(lre * dt * tau); double s, c; dsincos(lim * dt * tau, s, c);
        LP[i] = (f32x2){(float)(mag * c), (float)(mag * s)}; }
    for (int i = tid; i < 2 * 64 * 16; i += 512) { const int c = i & 15, p = (i >> 4) & 63, d = i >> 10;
        const double lre = (double)fminf(a_re[(d * SG + g) * SP + p], -1e-4f), lim = (double)a_im[(d * SG + g) * SP + p], dt = exp((double)lstep[d * SG + g]);
        const double mag = exp(lre * dt); double sn, cs; dsincos(lim * dt, sn, cs);
        const double nr = mag * cs - 1.0, ni = mag * sn, den = 1.0 / (lre * lre + lim * lim);
        const double fr = (nr * lre + ni * lim) * den, fi = (ni * lre - nr * lim) * den;
        const size_t bi = (((size_t)d * SG + g) * SP + p) * SC + c; const double br = b_re[bi], bim = b_im[bi];
        Bb[i] = (f32x2){(float)(fr * br - fi * bim), (float)(fr * bim + fi * br)};
        const size_t ci = (((size_t)d * SG + g) * SC + c) * SP + p;
        Cm[i] = (f32x2){c_re[ci], c_im[ci]}; }
    __syncthreads();
    if (q == 0 && tid < 128) { const int p = tid & 63, d = tid >> 6; ((f32x2*)(ws + WS_LAML))[(g * 2 + d) * SP + p] = LP[(d * 64 + p) * 33 + CL]; }
    { const int tau = tid >> 4, c = tid & 15;
      for (int d = 0; d < 2; ++d) { float kacc[16];
#pragma unroll
        for (int e = 0; e < 16; ++e) kacc[e] = 0.f;
        for (int p = 0; p < 64; ++p) { const f32x2 cm = Cm[(d * 64 + p) * 16 + c], lp = LP[(d * 64 + p) * 33 + tau];
            const float gr = cm.x * lp.x - cm.y * lp.y, gi = cm.x * lp.y + cm.y * lp.x;
#pragma unroll
            for (int e = 0; e < 16; ++e) { const f32x2 bb = Bb[(d * 64 + p) * 16 + e]; kacc[e] += gr * bb.x - gi * bb.y; } }
#pragma unroll
        for (int e = 0; e < 16; ++e) Kt[((d * 32 + tau) * 16 + c) * 16 + e] = kacc[e]; } }
    __syncthreads();
    { const int d = q >> 1, ri = q & 1, p = tid >> 3, s0 = (tid & 7) * 4;
      bf16_t* dst = (bf16_t*)(ws + WS_WST) + ((size_t)g * 256 + q * 64 + p) * 512 + s0 * 16;
#pragma unroll
      for (int sp = 0; sp < 4; ++sp) { const int pw = d == 0 ? (CL - 1 - (s0 + sp)) : (s0 + sp); const f32x2 lp = LP[(d * 64 + p) * 33 + pw]; float v[16];
#pragma unroll
          for (int e = 0; e < 16; ++e) { const f32x2 bb = Bb[(d * 64 + p) * 16 + e]; v[e] = ri == 0 ? (lp.x * bb.x - lp.y * bb.y) : (lp.x * bb.y + lp.y * bb.x); }
          u32x4 w0, w1; w0.x = cvt_pk_bf16(v[0], v[1]); w0.y = cvt_pk_bf16(v[2], v[3]); w0.z = cvt_pk_bf16(v[4], v[5]); w0.w = cvt_pk_bf16(v[6], v[7]);
          w1.x = cvt_pk_bf16(v[8], v[9]); w1.y = cvt_pk_bf16(v[10], v[11]); w1.z = cvt_pk_bf16(v[12], v[13]); w1.w = cvt_pk_bf16(v[14], v[15]);
          *(u32x4*)(dst + sp * 16) = w0; *(u32x4*)(dst + sp * 16 + 8) = w1; } }
    { const int rl = tid >> 2, s = 8 * q + (rl >> 4), c = rl & 15, part = tid & 3;
      bf16_t* dst = (bf16_t*)(ws + WS_TW) + ((size_t)g * 512 + s * 16 + c) * KS5;
      const float dsv = dsk[g * SC + c];
      for (int j = 0; j < 24; ++j) { const int k0 = part * 192 + j * 8; float v[8];
          if (k0 < 512) { const int sp = k0 >> 4, c0 = k0 & 15;
#pragma unroll
              for (int e = 0; e < 8; ++e) { float t = 0.f;
                  if (sp <= s) t += Kt[((0 * 32 + (s - sp)) * 16 + c) * 16 + c0 + e];
                  if (sp >= s) t += Kt[((1 * 32 + (sp - s)) * 16 + c) * 16 + c0 + e];
                  if (sp == s && c0 + e == c) t += dsv;
                  v[e] = t; }
          } else { const int kk = k0 - 512, d = kk >> 7, ri = (kk >> 6) & 1, p0 = kk & 63, pw = d == 0 ? (s + 1) : (CL - s);
#pragma unroll
              for (int e = 0; e < 8; ++e) { const f32x2 cm = Cm[(d * 64 + p0 + e) * 16 + c], lp = LP[(d * 64 + p0 + e) * 33 + pw];
                  v[e] = ri == 0 ? (cm.x * lp.x - cm.y * lp.y) : -(cm.x * lp.y + cm.y * lp.x); }
          }
          u32x4 w; w.x = cvt_pk_bf16(v[0], v[1]); w.y = cvt_pk_bf16(v[2], v[3]); w.z = cvt_pk_bf16(v[4], v[5]); w.w = cvt_pk_bf16(v[6], v[7]);
          *(u32x4*)(dst + k0) = w; } }
    __syncthreads();
}

__device__ __forceinline__ void p0_prologue(const Args& a, LAS unsigned char* lds, int vcu, int G, int tid) {
    const int wave = __builtin_amdgcn_readfirstlane(tid >> 6), lane = tid & 63;
    unsigned char* ws = a.ws;
    for (int it = vcu; it < SG * 4; it += G) p0_s5_tables(a, lds, it >> 2, it & 3, tid);
    __syncthreads();
    LAS float* scr = (LAS float*)(lds + wave * 16384);
    const int gw = vcu * 8 + wave, NGW = G * 8;
    constexpr int I_IN = (DM / 64) * (INW / 32), I_GL = (SW / 64) * (SW / 32), I_OUT = (DM / 64) * (DM / 32), I_GU = (DM / 64) * (DFF / 32), I_DN = (DFF / 64) * (DM / 32);
    constexpr int NITEMS = I_IN + I_GL + I_OUT + 2 * I_GU + I_DN;
    for (int it = gw; it < NITEMS; it += NGW) {
        int r = it;
        if (r < I_IN) { const int nb = INW / 32, kb = r / nb, n0 = (r % nb) * 32; p0_transpose_item(a.in[I_WIN], INW, nullptr, (bf16_t*)(ws + WS_WIN), DM, n0, kb * 64, n0, scr, lane); continue; } r -= I_IN;
        if (r < I_GL) { const int nb = SW / 32, kb = r / nb, n0 = (r % nb) * 32; p0_transpose_item(a.in[I_WGLU], SW, nullptr, (bf16_t*)(ws + WS_WGLU), SW, n0, kb * 64, n0, scr, lane); continue; } r -= I_GL;
        if (r < I_OUT) { const int nb = DM / 32, kb = r / nb, n0 = (r % nb) * 32, k0 = kb * 64;
            p0_transpose_item(a.in[I_WOUT], DM, k0 < AW ? a.in[I_GOA] : a.in[I_GOS] - AW, (bf16_t*)(ws + WS_WOUT), DM, n0, k0, n0, scr, lane); continue; } r -= I_OUT;
        if (r < 2 * I_GU) { const int up = r >= I_GU; if (up) r -= I_GU; const int nb = DFF / 32, kb = r / nb, n0 = (r % nb) * 32;
            p0_transpose_item(up ? a.in[I_WU] : a.in[I_WG], DFF, a.in[I_GFFN], (bf16_t*)(ws + WS_WGU), DM, 256 * (n0 >> 7) + (n0 & 127) + (up ? 128 : 0), kb * 64, n0, scr, lane); continue; } r -= 2 * I_GU;
        { const int nb = DM / 32, kb = r / nb, n0 = (r % nb) * 32; p0_transpose_item(a.in[I_WD], DM, nullptr, (bf16_t*)(ws + WS_WD), DFF, n0, kb * 64, n0, scr, lane); }
    }
    const float* x = a.in[I_X]; const float* gm = a.in[I_GMIX]; bf16_t* XN = (bf16_t*)(ws + WS_XN);
    for (int m = gw; m < M; m += NGW) { const f32x4* xr = (const f32x4*)(x + (size_t)m * DM) + lane; f32x4 v[8]; float s = 0.f;
#pragma unroll
        for (int j = 0; j < 8; ++j) { v[j] = xr[64 * j]; s += (v[j][0] * v[j][0] + v[j][1] * v[j][1]) + (v[j][2] * v[j][2] + v[j][3] * v[j][3]); }
        const float rstd = 1.0f / sqrtf(wave_sum(s) * (1.0f / DM) + RMS_EPS);
        u32x2* o8 = (u32x2*)(XN + (size_t)m * DM) + lane;
#pragma unroll
        for (int j = 0; j < 8; ++j) { const f32x4 gv = ((const f32x4*)gm)[64 * j + lane]; u32x2 w; w.x = cvt_pk_bf16(v[j][0] * rstd * gv[0], v[j][1] * rstd * gv[1]); w.y = cvt_pk_bf16(v[j][2] * rstd * gv[2], v[j][3] * rstd * gv[3]); o8[64 * j] = w; } }
}

constexpr int VROW = 160;
constexpr int VBUF = 32 * VROW;
constexpr int ATT_RPB_OFF = 8 * 2 * VBUF;
static_assert(ATT_RPB_OFF + 16 * 465 * 4 <= MISC_OFF, "attention LDS");

__device__ __forceinline__ void attn_phase(const Args& a, LAS unsigned char* lds, int vcu, int G, int tid) {
    const int wave = __builtin_amdgcn_readfirstlane(tid >> 6), lane = tid & 63, ql = lane & 15, g4 = lane >> 4;
    const bf16_t* QKV = (const bf16_t*)(a.ws + WS_BIG); bf16_t* YAYS = (bf16_t*)(a.ws + WS_YAYS); float* ssqa = (float*)(a.ws + WS_CTL) + CW_SSQA;
    LAS float* rpbL = (LAS float*)(lds + ATT_RPB_OFF);
    for (int i = tid; i < 16 * 465; i += 512) rpbL[i] = a.in[I_RPB][i];
    __syncthreads();
    LAS unsigned char* vb = lds + wave * 2 * VBUF;
    const int j = wave & 3, hsel = wave >> 2;
    const int cq = 16 * j + ql, cs = min(max(cq - 8, 0), GRIDW - 16), wb = (j == 0) ? 0 : (j == 1) ? 8 : (j == 2) ? 24 : 32;
    float gg[16];
#pragma unroll
    for (int ks = 0; ks < 2; ++ks)
#pragma unroll
        for (int e = 0; e < 8; ++e) { const int d = 32 * ks + 8 * g4 + e; gg[ks * 8 + e] = a.in[I_QG][d] * a.in[I_KG][d] * 0.125f; }
    for (int un = vcu; un < BATCH * NROWS; un += G) {
        const int b = un >> 6, r = un & 63, row_start = min(max(r - 4, 0), NROWS - 8);
        const size_t tq = (size_t)b * SEQ + 64 * r + cq;
        float ssq_acc = 0.f;
        for (int it = 0; it < 8; ++it) { const int h = 2 * it + hsel;
            bf16x8 Qf[2];
            { const u32x4* qp = (const u32x4*)(QKV + tq * NQKV + 64 * h + 8 * g4); const u32x4 q0 = qp[0], q1 = qp[4]; float qf[16];
              qf[0] = bf_lo(q0.x); qf[1] = bf_hi(q0.x); qf[2] = bf_lo(q0.y); qf[3] = bf_hi(q0.y); qf[4] = bf_lo(q0.z); qf[5] = bf_hi(q0.z); qf[6] = bf_lo(q0.w); qf[7] = bf_hi(q0.w);
              qf[8] = bf_lo(q1.x); qf[9] = bf_hi(q1.x); qf[10] = bf_lo(q1.y); qf[11] = bf_hi(q1.y); qf[12] = bf_lo(q1.z); qf[13] = bf_hi(q1.z); qf[14] = bf_lo(q1.w); qf[15] = bf_hi(q1.w);
              float ss = 0.f;
#pragma unroll
              for (int e = 0; e < 16; ++e) ss += qf[e] * qf[e];
              ss += __shfl_xor(ss, 16); ss += __shfl_xor(ss, 32);
              const float rq = __builtin_amdgcn_rsqf(ss * (1.0f / HD) + RMS_EPS);
#pragma unroll
              for (int e = 0; e < 16; ++e) qf[e] *= rq * gg[e];
              u32x4 w0, w1; w0.x = cvt_pk_bf16(qf[0], qf[1]); w0.y = cvt_pk_bf16(qf[2], qf[3]); w0.z = cvt_pk_bf16(qf[4], qf[5]); w0.w = cvt_pk_bf16(qf[6], qf[7]);
              w1.x = cvt_pk_bf16(qf[8], qf[9]); w1.y = cvt_pk_bf16(qf[10], qf[11]); w1.z = cvt_pk_bf16(qf[12], qf[13]); w1.w = cvt_pk_bf16(qf[14], qf[15]);
              Qf[0] = __builtin_bit_cast(bf16x8, w0); Qf[1] = __builtin_bit_cast(bf16x8, w1); }
            f32x4 S[8][2];
            const bf16_t* kbase = QKV + ((size_t)b * SEQ + 64 * row_start + wb + ql) * NQKV + AW + 64 * h + 8 * g4;
            const LAS float* bl = rpbL + h * 465 + (row_start - r + 7) * 31 + (wb + 4 * g4 - cq + 15);
#pragma unroll
            for (int kr = 0; kr < 8; ++kr)
#pragma unroll
                for (int t = 0; t < 2; ++t) {
                    const u32x4* kp = (const u32x4*)(kbase + (size_t)(64 * kr + 16 * t) * NQKV); const u32x4 k0 = kp[0], k1 = kp[4];
                    float ss = 0.f;
                    { const unsigned kw[8] = {k0.x, k0.y, k0.z, k0.w, k1.x, k1.y, k1.z, k1.w};
#pragma unroll
                      for (int e = 0; e < 8; ++e) { const float lo = bf_lo(kw[e]), hi = bf_hi(kw[e]); ss += lo * lo + hi * hi; } }
                    ss += __shfl_xor(ss, 16); ss += __shfl_xor(ss, 32);
                    const float rk = __builtin_amdgcn_rsqf(ss * (1.0f / HD) + RMS_EPS);
                    f32x4 acc = (f32x4){0.f, 0.f, 0.f, 0.f};
                    acc = __builtin_amdgcn_mfma_f32_16x16x32_bf16(__builtin_bit_cast(bf16x8, k0), Qf[0], acc, 0, 0, 0);
                    acc = __builtin_amdgcn_mfma_f32_16x16x32_bf16(__builtin_bit_cast(bf16x8, k1), Qf[1], acc, 0, 0, 0);
#pragma unroll
                    for (int e = 0; e < 4; ++e) { const float rkr = __shfl(rk, 4 * g4 + e); const int ck = wb + 16 * t + 4 * g4 + e;
                        const float bias = bl[kr * 31 + 16 * t + e];
                        acc[e] = (ck >= cs && ck < cs + 16) ? acc[e] * rkr + bias : -1e30f; }
                    S[kr][t] = acc; }
            float mx = -1e30f;
#pragma unroll
            for (int kr = 0; kr < 8; ++kr)
#pragma unroll
                for (int t = 0; t < 2; ++t)
#pragma unroll
                    for (int e = 0; e < 4; ++e) mx = fmaxf(mx, S[kr][t][e]);
            mx = fmaxf(mx, __shfl_xor(mx, 16)); mx = fmaxf(mx, __shfl_xor(mx, 32));
            float sum = 0.f; bf16x8 Pf[8];
#pragma unroll
            for (int kr = 0; kr < 8; ++kr) { f32x4 p0, p1;
#pragma unroll
                for (int e = 0; e < 4; ++e) { p0[e] = fast_exp2((S[kr][0][e] - mx) * 1.44269504089f); p1[e] = fast_exp2((S[kr][1][e] - mx) * 1.44269504089f); sum += p0[e] + p1[e]; }
                Pf[kr] = __builtin_bit_cast(bf16x8, pg8::pack8(p0, p1)); }
            sum += __shfl_xor(sum, 16); sum += __shfl_xor(sum, 32);
            f32x4 O[4];
#pragma unroll
            for (int dt = 0; dt < 4; ++dt) O[dt] = (f32x4){0.f, 0.f, 0.f, 0.f};
            const bf16_t* vbase = QKV + ((size_t)b * SEQ + 64 * row_start + wb + (lane >> 3)) * NQKV + 2 * AW + 64 * h + 8 * (lane & 7);
            u32x4 vr[3][4];
#pragma unroll
            for (int i = 0; i < 4; ++i) vr[0][i] = *(const u32x4*)(vbase + (size_t)(8 * i) * NQKV);
#pragma unroll
            for (int i = 0; i < 4; ++i) vr[1][i] = *(const u32x4*)(vbase + (size_t)(64 + 8 * i) * NQKV);
#pragma unroll
            for (int kr = 0; kr < 8; ++kr) {
                if (kr + 2 < 8) {
#pragma unroll
                    for (int i = 0; i < 4; ++i) vr[(kr + 2) % 3][i] = *(const u32x4*)(vbase + (size_t)(64 * (kr + 2) + 8 * i) * NQKV); }
                LAS unsigned char* vbuf = vb + (kr & 1) * VBUF;
#pragma unroll
                for (int i = 0; i < 4; ++i) *(LAS u32x4*)(vbuf + ((lane >> 3) + 8 * i) * VROW + (lane & 7) * 16) = vr[kr % 3][i];
                const LAS unsigned char* rp = vbuf + (4 * g4 + ((lane & 15) >> 2)) * VROW + (lane & 3) * 8;
#pragma unroll
                for (int dt = 0; dt < 4; ++dt) {
                    const s16x4 lo = __builtin_amdgcn_ds_read_tr16_b64_v4i16((LAS s16x4*)(rp + dt * 32));
                    const s16x4 hi = __builtin_amdgcn_ds_read_tr16_b64_v4i16((LAS s16x4*)(rp + 16 * VROW + dt * 32));
                    const bf16x8 av = (bf16x8){lo[0], lo[1], lo[2], lo[3], hi[0], hi[1], hi[2], hi[3]};
                    O[dt] = __builtin_amdgcn_mfma_f32_16x16x32_bf16(av, Pf[kr], O[dt], 0, 0, 0); }
            }
            const float inv = fast_rcp(sum);
            bf16_t* op = YAYS + tq * DM + 64 * h + 4 * g4;
#pragma unroll
            for (int dt = 0; dt < 4; ++dt) { const f32x4 o = O[dt] * inv; ssq_acc += (o[0] * o[0] + o[1] * o[1]) + (o[2] * o[2] + o[3] * o[3]);
                u32x2 w; w.x = cvt_pk_bf16(o[0], o[1]); w.y = cvt_pk_bf16(o[2], o[3]); *(u32x2*)(op + 16 * dt) = w; }
        }
        ssq_acc += __shfl_xor(ssq_acc, 16); ssq_acc += __shfl_xor(ssq_acc, 32);
        if (g4 == 0) unsafeAtomicAdd(ssqa + tq, ssq_acc);
    }
}

__device__ __forceinline__ void scan_phase(const Args& a, int vcu, int G, int tid) {
    if (tid >= 128) return;
    const float* E = (const float*)(a.ws + WS_E); bf16_t* A5 = (bf16_t*)(a.ws + WS_A5); const f32x2* LAML = (const f32x2*)(a.ws + WS_LAML);
    for (int idx = vcu * 128 + tid; idx < BATCH * SG * 2 * SP; idx += G * 128) {
        const int p = idx & 63, d = (idx >> 6) & 1, g = (idx >> 7) & 63, b = idx >> 13;
        const f32x2 lam = LAML[(g * 2 + d) * SP + p];
        float xr = 0.f, xi = 0.f;
#pragma unroll 8
        for (int kk = 0; kk < NCH; ++kk) { const int k = d == 0 ? kk : NCH - 1 - kk; const size_t R = (size_t)g * RCH + b * NCH + k;
            bf16_t* ap = A5 + R * KS5 + 512 + d * 128 + p; ap[0] = (bf16_t)(cvt_pk_bf16(xr, 0.f) & 0xffffu); ap[64] = (bf16_t)(cvt_pk_bf16(xi, 0.f) & 0xffffu);
            const float er = E[R * 256 + d * 128 + p], ei = E[R * 256 + d * 128 + 64 + p];
            const float nr = lam.x * xr - lam.y * xi + er, ni = lam.x * xi + lam.y * xr + ei; xr = nr; xi = ni; }
    }
}

__global__ void __launch_bounds__(512, 2) hymba_fwd(Args args) {
    extern __shared__ __attribute__((aligned(16))) unsigned char lds_raw[];
    LAS unsigned char* lds = (LAS unsigned char*)lds_raw;
    volatile LAS unsigned* MISC = (volatile LAS unsigned*)(lds + MISC_OFF);
    const int tid = threadIdx.x;
    const int G = gridDim.x; const int bx = blockIdx.x; const int vcu = (G % 8 == 0) ? (bx % 8) * (G / 8) + bx / 8 : bx;
    unsigned char* ws = args.ws;
    unsigned* ctl = (unsigned*)(ws + WS_CTL);
    for (int u = tid; u < (LDS_BYTES - MISC_OFF) / 4; u += 512) MISC[u] = 0u;
    __syncthreads();
    XcdBarrier bar; bar.bar = ctl + CW_BAR; bar.x = 0; bar.st = nullptr;
    if (MK_N_LAUNCHES == 1) bar = xcd_barrier_post(ctl + CW_BAR, MISC + 8);
    const int lo = args.ph_lo, hi = args.ph_hi;
#define IN(k) (lo <= (k) && (k) < hi)
#define SEAM(k) do { if (IN(k) && IN((k) + 1)) xcd_barrier(bar); } while (0)
    bf16_t* WIN = (bf16_t*)(ws + WS_WIN); bf16_t* WGLU = (bf16_t*)(ws + WS_WGLU); bf16_t* WOUT = (bf16_t*)(ws + WS_WOUT); bf16_t* WGU = (bf16_t*)(ws + WS_WGU); bf16_t* WD = (bf16_t*)(ws + WS_WD);
    bf16_t* WST = (bf16_t*)(ws + WS_WST); bf16_t* TW = (bf16_t*)(ws + WS_TW);
    bf16_t* XN = (bf16_t*)(ws + WS_XN); bf16_t* YG = (bf16_t*)(ws + WS_XN); bf16_t* XB = (bf16_t*)(ws + WS_XN);
    bf16_t* QKV = (bf16_t*)(ws + WS_BIG); bf16_t* A5 = (bf16_t*)(ws + WS_A5); float* E = (float*)(ws + WS_E); bf16_t* HB = (bf16_t*)(ws + WS_BIG);
    bf16_t* YAYS = (bf16_t*)(ws + WS_YAYS);
    float* ssqa = (float*)ctl + CW_SSQA; float* ssqs = (float*)ctl + CW_SSQS; float* ssqx = (float*)ctl + CW_SSQX;

    if (IN(0)) { p0_prologue(args, lds, vcu, G, tid); SEAM(0); }
    if (IN(1)) {
        pg8::Gemm g{XN, WIN, DM, DM, DM, 0, 0}; pg8::StaticOrder S; S.init(M, INW, G, bx);
        pg8::EpiZ Ep{QKV, A5};
        pg8::gemm_phase(lds, g, S, Ep); SEAM(1);
    }
    if (IN(2)) {
        { pg8::Gemm g{A5, WST, KS5, 512, 512, (size_t)RCH * KS5, (size_t)256 * 512}; pg8::BatchOrder S; S.init(2, 1, SG, G, bx);
          pg8::EpiE Ep{E};
          pg8::gemm_phase(lds, g, S, Ep); }
        __syncthreads();
        attn_phase(args, lds, vcu, G, tid);
        SEAM(2);
    }
    if (IN(3)) { scan_phase(args, vcu, G, tid); SEAM(3); }
    if (IN(4)) {
        pg8::Gemm g{A5, TW, KS5, KS5, KS5, (size_t)RCH * KS5, (size_t)512 * KS5}; pg8::BatchOrder S; S.init(2, 2, SG, G, bx);
        pg8::EpiS5Out Ep{YG};
        pg8::gemm_phase(lds, g, S, Ep); SEAM(4);
    }
    if (IN(5)) {
        pg8::Gemm g{YG, WGLU, SW, SW, SW, 0, 0}; pg8::StaticOrder S; S.init(M, SW, G, bx);
        pg8::EpiGlu Ep{YG, args.in[I_BGLU], YAYS, ssqs};
        pg8::gemm_phase(lds, g, S, Ep); SEAM(5);
    }
    if (IN(6)) {
        pg8::Gemm g{YAYS, WOUT, DM, DM, AW, 0, 0}; pg8::SplitKOrder S; S.so.init(M, DM, G, bx);
        pg8::EpiRes1 Ep{args.in[I_X], args.out, XB, ssqa, ssqs, ssqx};
        pg8::gemm_phase(lds, g, S, Ep); SEAM(6);
    }
    if (IN(7)) {
        pg8::Gemm g{XB, WGU, DM, DM, DM, 0, 0}; pg8::StaticOrder S; S.init(M, 2 * DFF, G, bx);
        pg8::EpiSwiGLU Ep{HB, ssqx};
        pg8::gemm_phase(lds, g, S, Ep); SEAM(7);
    }
    if (IN(8)) {
        pg8::Gemm g{HB, WD, DFF, DFF, DFF, 0, 0}; pg8::StaticOrder S; S.init(M, DM, G, bx);
        pg8::EpiRes2 Ep{args.out};
        pg8::gemm_phase(lds, g, S, Ep);
    }
#undef IN
#undef SEAM
}

extern "C" void kernel_launch(void* const* d_in, const int* in_sizes, int n_in, void* d_out, int out_size, void* d_ws, size_t ws_size, hipStream_t stream) {
    static int grid = 0;
    if (grid == 0) {
        if (n_in != 23 || in_sizes[0] != M * DM || out_size != M * DM || ws_size < WS_END) { fprintf(stderr, "kernel_launch: unexpected shapes (n_in %d, in0 %d, out %d, ws %zu < %zu)\n", n_in, n_in > 0 ? in_sizes[0] : -1, out_size, ws_size, (size_t)WS_END); grid = -1; return; }
        int dev = 0, cus = 0, per_cu = 0;
        if (hipGetDevice(&dev) != hipSuccess || hipDeviceGetAttribute(&cus, hipDeviceAttributeMultiprocessorCount, dev) != hipSuccess) { grid = -1; return; }
        if (hipFuncSetAttribute((const void*)hymba_fwd, hipFuncAttributeMaxDynamicSharedMemorySize, LDS_BYTES) != hipSuccess) { fprintf(stderr, "kernel_launch: hipFuncSetAttribute failed\n"); grid = -1; return; }
        if (hipOccupancyMaxActiveBlocksPerMultiprocessor(&per_cu, (const void*)hymba_fwd, 512, LDS_BYTES) != hipSuccess || per_cu < 1) { fprintf(stderr, "kernel_launch: occupancy query says %d blocks per CU\n", per_cu); (void)hipGetLastError(); per_cu = 1; }
        grid = cus;
    }
    if (grid < 0) return;
    (void)hipMemsetAsync((char*)d_ws + WS_CTL, 0, CTL_ZERO_BYTES, stream);
    Args a{};
    for (int i = 0; i < 23; ++i) a.in[i] = (const float*)d_in[i];
    a.out = (float*)d_out; a.ws = (unsigned char*)d_ws;
    if (MK_N_LAUNCHES == 1) {
        a.ph_lo = 0; a.ph_hi = NPHASE; a.li = 0;
        hipLaunchKernelGGL(hymba_fwd, dim3(grid), dim3(512), LDS_BYTES, stream, a);
    } else {
        for (int li = 0; li < NPHASE; ++li) { a.ph_lo = li; a.ph_hi = li + 1; a.li = li; hipLaunchKernelGGL(hymba_fwd, dim3(grid), dim3(512), LDS_BYTES, stream, a); }
    }
}
```

```cpp
#include <hip/hip_runtime.h>
#include <cstdio>
#include <cstdint>

#define DUP_PHASE (-1)
#ifndef MK_N_LAUNCHES
#define MK_N_LAUNCHES 1
#endif

#define GAS __attribute__((address_space(1)))
#define LAS __attribute__((address_space(3)))
typedef unsigned short bf16_t;
typedef short bf16x8 __attribute__((ext_vector_type(8)));
typedef short s16x4 __attribute__((ext_vector_type(4)));
typedef float f32x4 __attribute__((ext_vector_type(4)));
typedef float f32x2 __attribute__((ext_vector_type(2)));
typedef unsigned u32x4 __attribute__((ext_vector_type(4)));
typedef unsigned u32x2 __attribute__((ext_vector_type(2)));

constexpr int BATCH = 4, SEQ = 4096, DM = 2048, M = BATCH * SEQ;
constexpr int AW = 1024, SW = 1024, NH = 16, HD = 64, NQKV = 3 * AW, INW = 4096, DFF = 5632;
constexpr int GRIDW = 64, NROWS = SEQ / GRIDW;
constexpr int SG = 64, SC = 16, SP = 64;
constexpr int CL = 32, NCH = SEQ / CL, RCH = M / CL;
constexpr int KS5 = CL * SC + 256;
constexpr float RMS_EPS = 1e-6f;
constexpr int NPHASE = 9;

constexpr size_t MiB = 1u << 20;
constexpr size_t WS_CTL = 0, CTL_ZERO_BYTES = 1 * MiB;
constexpr size_t WS_WIN = 1 * MiB, WS_WGLU = 17 * MiB, WS_WOUT = 19 * MiB, WS_WGU = 27 * MiB, WS_WD = 71 * MiB;
constexpr size_t WS_WST = 93 * MiB, WS_TW = 109 * MiB, WS_LAML = 157 * MiB;
constexpr size_t WS_XN = 158 * MiB;
constexpr size_t WS_BIG = 222 * MiB;
constexpr size_t WS_A5 = WS_BIG + 96 * MiB, WS_E = WS_BIG + 144 * MiB;
constexpr size_t WS_YAYS = 398 * MiB, WS_END = 462 * MiB;
constexpr int CW_BAR = 4096;
constexpr int CW_SSQA = 65536, CW_SSQS = CW_SSQA + M, CW_SSQX = CW_SSQS + M;
static_assert((size_t)(CW_SSQX + M) * 4 <= CTL_ZERO_BYTES, "ctl");

constexpr int RING_BYTES = 131072;
constexpr int MISC_OFF = 143360;
constexpr int LDS_BYTES = 147456;

__device__ __forceinline__ unsigned cvt_pk_bf16(float lo, float hi) { unsigned r; asm volatile("v_cvt_pk_bf16_f32 %0, %1, %2" : "=v"(r) : "v"(lo), "v"(hi)); return r; }
__device__ __forceinline__ float bf_lo(unsigned w) { return __uint_as_float(w << 16); }
__device__ __forceinline__ float bf_hi(unsigned w) { return __uint_as_float(w & 0xffff0000u); }
__device__ __forceinline__ float fast_rcp(float x) { return __builtin_amdgcn_rcpf(x); }
__device__ __forceinline__ float fast_exp2(float x) { return __builtin_amdgcn_exp2f(x); }
__device__ __forceinline__ float sigmoidf_(float x) { return fast_rcp(1.0f + fast_exp2(-1.44269504089f * x)); }
__device__ __forceinline__ float gelu_tanh(float x) { const float t = x * (1.0f + 0.044715f * x * x); return x * fast_rcp(1.0f + fast_exp2(-2.30220818f * t)); }
__device__ __forceinline__ float wave_sum(float v) {
#pragma unroll
    for (int o = 1; o < 64; o <<= 1) v += __shfl_xor(v, o);
    return v;
}

namespace pg8 {
constexpr int BM = 256, BK = 64, HALF = 128, HTB = HALF * BK * 2, NXCD = 8, WGM = 8;
__host__ __device__ __forceinline__ int lds_byte(int r, int c) { const int st = (r >> 4) * 2 + (c >> 5), rr = r & 15, cc = c & 31, ob = rr * 64 + cc * 2; return st * 1024 + (ob ^ (((ob >> 9) & 1) << 5)); }
__host__ __device__ __forceinline__ void stage_rc(int b, int& R, int& C) { const int st = b / 1024, sb = b % 1024, swz = sb ^ (((sb >> 9) & 1) << 5); R = (st >> 1) * 16 + swz / 64; C = (st & 1) * 32 + (swz % 64) / 2; }
__host__ __device__ __forceinline__ int perm32(int rho) { const int n = rho >> 4, i = rho & 15; return 8 * (i >> 2) + 4 * n + (i & 3); }

struct Unit { int pm, pn, g, kh; };
struct Gemm { const bf16_t* A; const bf16_t* Bt; int lda, ldb, K; size_t sA, sB; };

struct StaticOrder {
    int nM, nN, nwg, G, c;
    __device__ void init(int M_, int N_, int G_, int c_) { nM = M_ / BM; nN = N_ / BM; nwg = nM * nN; G = G_; c = c_; }
    __device__ bool next(int i, Unit& u) const {
        const long L = (long)i * G + c; if (L >= nwg) return false;
        int wgid = (int)L; { const int q = nwg / NXCD, r = nwg % NXCD, xcd = wgid % NXCD, off = wgid / NXCD; wgid = (xcd < r ? xcd * (q + 1) : r * (q + 1) + (xcd - r) * q) + off; }
        const int nig = WGM * nN, gid = wgid / nig, fm = gid * WGM, gsz = (nM - fm) < WGM ? (nM - fm) : WGM;
        u.pm = fm + ((wgid % nig) % gsz); u.pn = (wgid % nig) / gsz; u.g = 0; u.kh = 0; return true;
    }
};
struct SplitKOrder {
    StaticOrder so;
    __device__ bool next(int i, Unit& u) const { if (!so.next(i >> 1, u)) return false; u.kh = i & 1; return true; }
};
struct BatchOrder {
    int nM, nN, nwg, G, c;
    __device__ void init(int nM_, int nN_, int nb, int G_, int c_) { nM = nM_; nN = nN_; nwg = nM * nN * nb; G = G_; c = c_; }
    __device__ bool next(int i, Unit& u) const {
        const long L = (long)i * G + c; if (L >= nwg) return false;
        const int l = (int)L; u.pn = l % nN; u.pm = (l / nN) % nM; u.g = (l / (nN * nM)) % SG; u.kh = 0; return true;
    }
};

template <class Epi, class Sched>
__device__ __forceinline__ void gemm_phase(LAS unsigned char* lds, const Gemm g, const Sched& S, const Epi& E) {
    const int tid = threadIdx.x, wid = __builtin_amdgcn_readfirstlane(tid >> 6), lane = tid & 63, wr = wid >> 2, wc = wid & 3, fr = lane & 15, fq = lane >> 4;
    const int K = g.K, nt = K / BK;
    unsigned voffA[2], voffB[2];
#pragma unroll
    for (int i = 0; i < 2; ++i) { int R, C; stage_rc(tid * 16 + i * 8192, R, C); const int Rb = Epi::PERM ? ((R & ~31) + perm32(R & 31)) : R;
        voffA[i] = (unsigned)(R * g.lda + C) * 2u; voffB[i] = (unsigned)(Rb * g.ldb + C) * 2u; }
    const size_t kstep = (size_t)(BK * 2);
    const size_t hstepA = (size_t)HALF * g.lda * 2, hstepB = (size_t)HALF * g.ldb * 2;
    const unsigned ldsw = (unsigned)wid * 1024u;
    const int aoff = lds_byte(wr * 64 + fr, fq * 8), boff = lds_byte(wc * 32 + fr, fq * 8);
#define PG8_SA(b, h) (((b) * 2 + (h)) * HTB)
#define PG8_SB(b, h) ((4 + (b) * 2 + (h)) * HTB)
#define PG8_STAGE(bufoff, gbase, voff) do { _Pragma("unroll") for (int _i = 0; _i < 2; ++_i) \
        __builtin_amdgcn_global_load_lds((const unsigned*)((const char*)(gbase) + (voff)[_i]), (LAS unsigned*)(lds + (bufoff) + ldsw + _i * 8192), 16, 0, 0); } while (0)
#define PG8_LDA(dst, b, h) do { _Pragma("unroll") for (int m = 0; m < 4; ++m) _Pragma("unroll") for (int k = 0; k < 2; ++k) dst[m][k] = *(const LAS bf16x8*)(lds + PG8_SA(b, h) + aoff + m * 2048 + k * 1024); } while (0)
#define PG8_LDB(dst, b, h) do { _Pragma("unroll") for (int n = 0; n < 2; ++n) _Pragma("unroll") for (int k = 0; k < 2; ++k) dst[n][k] = *(const LAS bf16x8*)(lds + PG8_SB(b, h) + boff + n * 2048 + k * 1024); } while (0)
#define PG8_MMA(ai, bj, At, Bt) do { __builtin_amdgcn_s_setprio(1); _Pragma("unroll") for (int m = 0; m < 4; ++m) _Pragma("unroll") for (int n = 0; n < 2; ++n) _Pragma("unroll") for (int k = 0; k < 2; ++k) \
        acc[ai][bj][m][n] = __builtin_amdgcn_mfma_f32_16x16x32_bf16(Bt[n][k], At[m][k], acc[ai][bj][m][n], 0, 0, 0); __builtin_amdgcn_s_setprio(0); } while (0)
#define PG8_WAIT_V(n) asm volatile("s_waitcnt vmcnt(" #n ")" ::: "memory")
#define PG8_WAIT_L(n) asm volatile("s_waitcnt lgkmcnt(" #n ")" ::: "memory")
#define PG8_BAR __builtin_amdgcn_s_barrier()
#define PG8_SCHED __builtin_amdgcn_sched_barrier(0)
    Unit cur, nxt; int ui = 0;
    if (!S.next(0, cur)) return;
    f32x4 acc[2][2][4][2];
#pragma unroll
    for (int a = 0; a < 2; ++a)
#pragma unroll
        for (int b = 0; b < 2; ++b)
#pragma unroll
            for (int m = 0; m < 4; ++m)
#pragma unroll
                for (int n = 0; n < 2; ++n) acc[a][b][m][n] = (f32x4){0.f, 0.f, 0.f, 0.f};
    bf16x8 At[4][2], B0[2][2], B1[2][2];
    const char* cA = (const char*)g.A + ((size_t)cur.g * g.sA + (size_t)cur.pm * BM * g.lda + (size_t)cur.kh * K) * 2;
    const char* cB = (const char*)g.Bt + ((size_t)cur.g * g.sB + (size_t)cur.pn * BM * g.ldb + (size_t)cur.kh * K) * 2;
    PG8_STAGE(PG8_SB(0, 0), cB, voffB); PG8_STAGE(PG8_SB(0, 1), cB + hstepB, voffB); PG8_STAGE(PG8_SA(0, 0), cA, voffA); PG8_STAGE(PG8_SA(0, 1), cA + hstepA, voffA);
    if (wr == 1) PG8_BAR;
    PG8_WAIT_V(2); PG8_BAR;
    PG8_STAGE(PG8_SB(1, 0), cB + kstep, voffB); PG8_STAGE(PG8_SA(1, 0), cA + kstep, voffA); PG8_STAGE(PG8_SB(1, 1), cB + hstepB + kstep, voffB);
    PG8_WAIT_V(6); PG8_BAR;
    for (;;) {
        const bool has_next = S.next(ui + 1, nxt);
        const char* nA = has_next ? (const char*)g.A + ((size_t)nxt.g * g.sA + (size_t)nxt.pm * BM * g.lda + (size_t)nxt.kh * K) * 2 : cA;
        const char* nB = has_next ? (const char*)g.Bt + ((size_t)nxt.g * g.sB + (size_t)nxt.pn * BM * g.ldb + (size_t)nxt.kh * K) * 2 : cB;
        for (int t = 0; t < nt; t += 2) {
            const bool last = (t == nt - 2);
            const char* a1 = cA + (size_t)(t + 1) * kstep;
            const char* a2 = last ? nA : cA + (size_t)(t + 2) * kstep; const char* b2 = last ? nB : cB + (size_t)(t + 2) * kstep;
            const char* a3 = a2 + kstep; const char* b3 = b2 + kstep;
            PG8_LDB(B0, 0, 0); PG8_LDB(B1, 0, 1); PG8_SCHED; PG8_LDA(At, 0, 0); PG8_STAGE(PG8_SA(1, 1), a1 + hstepA, voffA);
            PG8_WAIT_V(8); PG8_WAIT_L(0); PG8_BAR; PG8_MMA(0, 0, At, B0); PG8_MMA(0, 1, At, B1); PG8_BAR; PG8_SCHED;
            PG8_LDA(At, 0, 1); PG8_STAGE(PG8_SB(0, 0), b2, voffB); PG8_STAGE(PG8_SB(0, 1), b2 + hstepB, voffB); PG8_STAGE(PG8_SA(0, 0), a2, voffA);
            PG8_WAIT_V(8); PG8_WAIT_L(0); PG8_BAR; PG8_MMA(1, 0, At, B0); PG8_MMA(1, 1, At, B1); PG8_BAR; PG8_SCHED;
            PG8_LDB(B0, 1, 0); PG8_LDB(B1, 1, 1); PG8_SCHED; PG8_LDA(At, 1, 0); PG8_STAGE(PG8_SA(0, 1), a2 + hstepA, voffA);
            PG8_WAIT_V(8); PG8_WAIT_L(0); PG8_BAR; PG8_MMA(0, 0, At, B0); PG8_MMA(0, 1, At, B1); PG8_BAR; PG8_SCHED;
            PG8_LDA(At, 1, 1); PG8_STAGE(PG8_SB(1, 0), b3, voffB); PG8_STAGE(PG8_SB(1, 1), b3 + hstepB, voffB); PG8_STAGE(PG8_SA(1, 0), a3, voffA);
            PG8_WAIT_V(8); PG8_WAIT_L(0); PG8_BAR; PG8_MMA(1, 0, At, B0); PG8_MMA(1, 1, At, B1); PG8_BAR; PG8_SCHED;
        }
        if (wr == 0) PG8_BAR;
        E(acc, cur, wr, wc, fr, fq);
        if (!has_next) break;
        if (!(Epi::KSPLIT && cur.kh == 0)) {
#pragma unroll
        for (int a = 0; a < 2; ++a)
#pragma unroll
            for (int b = 0; b < 2; ++b)
#pragma unroll
                for (int m = 0; m < 4; ++m)
#pragma unroll
                    for (int n = 0; n < 2; ++n) acc[a][b][m][n] = (f32x4){0.f, 0.f, 0.f, 0.f};
        }
        cur = nxt; cA = nA; cB = nB; ++ui;
        if (wr == 1) PG8_BAR;
    }
    PG8_WAIT_V(0);
    PG8_BAR;
#undef PG8_SA
#undef PG8_SB
#undef PG8_STAGE
#undef PG8_LDA
#undef PG8_LDB
#undef PG8_MMA
#undef PG8_WAIT_V
#undef PG8_WAIT_L
#undef PG8_BAR
#undef PG8_SCHED
}

__device__ __forceinline__ u32x4 pack8(const f32x4 a, const f32x4 b) { u32x4 w; w.x = cvt_pk_bf16(a[0], a[1]); w.y = cvt_pk_bf16(a[2], a[3]); w.z = cvt_pk_bf16(b[0], b[1]); w.w = cvt_pk_bf16(b[2], b[3]); return w; }

struct EpiZ {
    static constexpr bool PERM = true, KSPLIT = false;
    bf16_t* QKV; bf16_t* A5;
    __device__ __forceinline__ void operator()(f32x4 (&acc)[2][2][4][2], const Unit& u, int wr, int wc, int fr, int fq) const {
#pragma unroll
        for (int ai = 0; ai < 2; ++ai)
#pragma unroll
            for (int m = 0; m < 4; ++m) { const int row = u.pm * BM + ai * HALF + wr * 64 + m * 16 + fr;
#pragma unroll
                for (int bj = 0; bj < 2; ++bj) { const int c8 = u.pn * BM + bj * HALF + wc * 32 + 8 * fq; const u32x4 w = pack8(acc[ai][bj][m][0], acc[ai][bj][m][1]);
                    if (u.pn < 12) *(u32x4*)(QKV + (size_t)row * NQKV + c8) = w;
                    else { const int ch = c8 - NQKV, gg = ch >> 4, c0 = ch & 15, R = row >> 5, s = row & 31; *(u32x4*)(A5 + ((size_t)gg * RCH + R) * KS5 + s * SC + c0) = w; } } }
    }
};
struct EpiE {
    static constexpr bool PERM = false, KSPLIT = false;
    float* E;
    __device__ __forceinline__ void operator()(f32x4 (&acc)[2][2][4][2], const Unit& u, int wr, int wc, int fr, int fq) const {
#pragma unroll
        for (int ai = 0; ai < 2; ++ai)
#pragma unroll
            for (int m = 0; m < 4; ++m) { const int R = u.pm * BM + ai * HALF + wr * 64 + m * 16 + fr; float* rowp = E + ((size_t)u.g * RCH + R) * 256 + wc * 32 + 4 * fq;
#pragma unroll
                for (int bj = 0; bj < 2; ++bj)
#pragma unroll
                    for (int n = 0; n < 2; ++n) *(f32x4*)(rowp + bj * HALF + n * 16) = acc[ai][bj][m][n]; }
    }
};
struct EpiS5Out {
    static constexpr bool PERM = true, KSPLIT = false;
    bf16_t* Yg;
    __device__ __forceinline__ void operator()(f32x4 (&acc)[2][2][4][2], const Unit& u, int wr, int wc, int fr, int fq) const {
#pragma unroll
        for (int ai = 0; ai < 2; ++ai)
#pragma unroll
            for (int m = 0; m < 4; ++m) { const int R = u.pm * BM + ai * HALF + wr * 64 + m * 16 + fr;
#pragma unroll
                for (int bj = 0; bj < 2; ++bj) { const int n8 = u.pn * BM + bj * HALF + wc * 32 + 8 * fq, s = n8 >> 4, c0 = n8 & 15;
                    f32x4 v0 = acc[ai][bj][m][0], v1 = acc[ai][bj][m][1];
#pragma unroll
                    for (int e = 0; e < 4; ++e) { v0[e] = gelu_tanh(v0[e]); v1[e] = gelu_tanh(v1[e]); }
                    *(u32x4*)(Yg + (size_t)(R * CL + s) * SW + u.g * SC + c0) = pack8(v0, v1); } }
    }
};
struct EpiGlu {
    static constexpr bool PERM = true, KSPLIT = false;
    const bf16_t* Yg; const float* bias; bf16_t* YAYS; float* ssq; float alpha;
    __device__ __forceinline__ void operator()(f32x4 (&acc)[2][2][4][2], const Unit& u, int wr, int wc, int fr, int fq) const {
        const int c8b = u.pn * BM + wc * 32 + 8 * fq;
        f32x4 bv[2][2];
#pragma unroll
        for (int bj = 0; bj < 2; ++bj)
#pragma unroll
            for (int n = 0; n < 2; ++n) bv[bj][n] = *(const f32x4*)(bias + c8b + bj * HALF + 4 * n);
#pragma unroll
        for (int ai = 0; ai < 2; ++ai)
#pragma unroll
            for (int m = 0; m < 4; ++m) { const int row = u.pm * BM + ai * HALF + wr * 64 + m * 16 + fr; float ss = 0.f;
#pragma unroll
                for (int bj = 0; bj < 2; ++bj) { const int c8 = c8b + bj * HALF; const u32x4 y = *(const u32x4*)(Yg + (size_t)row * SW + c8);
                    const f32x4 a0 = acc[ai][bj][m][0] + bv[bj][0], a1 = acc[ai][bj][m][1] + bv[bj][1];
                    f32x4 v0, v1;
                    v0[0] = bf_lo(y.x) * sigmoidf_(a0[0]); v0[1] = bf_hi(y.x) * sigmoidf_(a0[1]); v0[2] = bf_lo(y.y) * sigmoidf_(a0[2]); v0[3] = bf_hi(y.y) * sigmoidf_(a0[3]);
                    v1[0] = bf_lo(y.z) * sigmoidf_(a1[0]); v1[1] = bf_hi(y.z) * sigmoidf_(a1[1]); v1[2] = bf_lo(y.w) * sigmoidf_(a1[2]); v1[3] = bf_hi(y.w) * sigmoidf_(a1[3]);
#pragma unroll
                    for (int e = 0; e < 4; ++e) ss += v0[e] * v0[e] + v1[e] * v1[e];
                    *(u32x4*)(YAYS + (size_t)row * DM + AW + c8) = pack8(v0, v1); }
                ss += __shfl_xor(ss, 16); ss += __shfl_xor(ss, 32);
                if (fq == 0) unsafeAtomicAdd(ssq + row, ss * alpha); }
    }
};
struct EpiRes1 {
    static constexpr bool PERM = true, KSPLIT = true;
    const float* x; float* out; bf16_t* XB; const float* ssqa; const float* ssqs; float* ssqx; float alpha;
    __device__ __forceinline__ void operator()(f32x4 (&acc)[2][2][4][2], const Unit& u, int wr, int wc, int fr, int fq) const {
        if (u.kh == 0) {
#pragma unroll
        for (int ai = 0; ai < 2; ++ai)
#pragma unroll
            for (int m = 0; m < 4; ++m) { const int row = u.pm * BM + ai * HALF + wr * 64 + m * 16 + fr;
                const float ra = __builtin_amdgcn_rsqf(ssqa[row] * (1.0f / AW) + RMS_EPS), rs = __builtin_amdgcn_rsqf(ssqs[row] * (1.0f / SW) + RMS_EPS), f = ra * fast_rcp(rs);
#pragma unroll
                for (int bj = 0; bj < 2; ++bj)
#pragma unroll
                    for (int n = 0; n < 2; ++n) acc[ai][bj][m][n] *= f; }
        return; }
#pragma unroll
        for (int ai = 0; ai < 2; ++ai)
#pragma unroll
            for (int m = 0; m < 4; ++m) { const int row = u.pm * BM + ai * HALF + wr * 64 + m * 16 + fr; float ss = 0.f;
                const float rs = __builtin_amdgcn_rsqf(ssqs[row] * (1.0f / SW) + RMS_EPS);
#pragma unroll
                for (int bj = 0; bj < 2; ++bj) { const size_t off = (size_t)row * DM + u.pn * BM + bj * HALF + wc * 32 + 8 * fq;
                    const f32x4 x0 = *(const f32x4*)(x + off), x1 = *(const f32x4*)(x + off + 4);
                    const f32x4 v0 = x0 + acc[ai][bj][m][0] * rs, v1 = x1 + acc[ai][bj][m][1] * rs;
#pragma unroll
                    for (int e = 0; e < 4; ++e) ss += v0[e] * v0[e] + v1[e] * v1[e];
                    *(f32x4*)(out + off) = v0; *(f32x4*)(out + off + 4) = v1; *(u32x4*)(XB + off) = pack8(v0, v1); }
                ss += __shfl_xor(ss, 16); ss += __shfl_xor(ss, 32);
                if (fq == 0) unsafeAtomicAdd(ssqx + row, ss * alpha);
                asm volatile("" ::: "memory"); }
    }
};
struct EpiSwiGLU {
    static constexpr bool PERM = true, KSPLIT = false;
    bf16_t* H; const float* ssqx;
    __device__ __forceinline__ void operator()(f32x4 (&acc)[2][2][4][2], const Unit& u, int wr, int wc, int fr, int fq) const {
#pragma unroll
        for (int ai = 0; ai < 2; ++ai)
#pragma unroll
            for (int m = 0; m < 4; ++m) { const int row = u.pm * BM + ai * HALF + wr * 64 + m * 16 + fr;
                const float rs = __builtin_amdgcn_rsqf(ssqx[row] * (1.0f / DM) + RMS_EPS);
                f32x4 h0, h1;
#pragma unroll
                for (int e = 0; e < 4; ++e) { const float g0 = acc[ai][0][m][0][e] * rs, u0 = acc[ai][1][m][0][e] * rs, g1 = acc[ai][0][m][1][e] * rs, u1 = acc[ai][1][m][1][e] * rs;
                    h0[e] = g0 * sigmoidf_(g0) * u0; h1[e] = g1 * sigmoidf_(g1) * u1; }
                *(u32x4*)(H + (size_t)row * DFF + u.pn * HALF + wc * 32 + 8 * fq) = pack8(h0, h1); }
    }
};
struct EpiRes2 {
    static constexpr bool PERM = false, KSPLIT = false;
    float* out; float alpha;
    __device__ __forceinline__ void operator()(f32x4 (&acc)[2][2][4][2], const Unit& u, int wr, int wc, int fr, int fq) const {
#pragma unroll
        for (int ai = 0; ai < 2; ++ai)
#pragma unroll
            for (int m = 0; m < 4; ++m) { float* rowp = out + (size_t)(u.pm * BM + ai * HALF + wr * 64 + m * 16 + fr) * DM + u.pn * BM + wc * 32 + 4 * fq;
#pragma unroll
                for (int bj = 0; bj < 2; ++bj)
#pragma unroll
                    for (int n = 0; n < 2; ++n) { float* p = rowp + bj * HALF + n * 16; *(f32x4*)p = *(const f32x4*)p + acc[ai][bj][m][n] * alpha; } }
    }
};
}

#define RLX_AGENT __ATOMIC_RELAXED, __HIP_MEMORY_SCOPE_AGENT
#define XB_TMO      128
#define XB_XCNT(j)  (256  + 64 * (j))
#define XB_XSUB(j)  (1280 + 64 * (j))
#define XB_XGEN(j)  (2304 + 64 * (j))
#define XB_TOP      3328
#define XB_TOPGEN   3392
#define XCD_BAR_WORDS 3456
#define XB_SPIN_CAP (1u << 24)
__device__ __forceinline__ unsigned xb_ld(unsigned* p)              { return __hip_atomic_load(p, __ATOMIC_RELAXED, __HIP_MEMORY_SCOPE_AGENT); }
__device__ __forceinline__ unsigned xb_add(unsigned* p, unsigned v) { return __hip_atomic_fetch_add(p, v, __ATOMIC_RELAXED, __HIP_MEMORY_SCOPE_AGENT); }
__device__ __forceinline__ unsigned xb_xcc_id() { return (unsigned)__builtin_amdgcn_s_getreg((3 << 11) | 20) & 0xFu; }
#define XB_SPIN(cond, bar) do { unsigned _sp = 0; while (cond) { __builtin_amdgcn_s_sleep(1); \
    if ((++_sp & 255u) == 0u) { if (xb_ld(&(bar)[XB_TMO])) break; if (_sp > XB_SPIN_CAP) { atomicAdd(&(bar)[XB_TMO], 1u); break; } } } } while (0)
struct XcdBarrier { unsigned* bar; unsigned x; volatile LAS unsigned* st; };
__device__ __forceinline__ XcdBarrier xcd_barrier_post(unsigned* bar, volatile LAS unsigned* st) {
    XcdBarrier b; b.bar = bar; b.x = xb_xcc_id(); b.st = st;
    if (threadIdx.x == 0) (void)xb_add(&bar[XB_XCNT(b.x)], 1u);
    return b;
}
__device__ __forceinline__ void xcd_barrier_complete(unsigned* bar, unsigned x, unsigned& nloc, unsigned& nx) {
    const unsigned G = gridDim.x * gridDim.y * gridDim.z;
    unsigned sum, cnt, mine, sp = 0u;
    for (;;) {
        sum = 0u; cnt = 0u; mine = 0u;
#pragma unroll
        for (unsigned j = 0; j < 16; ++j) { const unsigned c = xb_ld(&bar[XB_XCNT(j)]); sum += c; cnt += (c > 0u) ? 1u : 0u; mine = (j == x) ? c : mine; }
        if (sum == G) break;
        __builtin_amdgcn_s_sleep(1);
        if ((++sp & 255u) == 0u) { if (xb_ld(&bar[XB_TMO])) break; if (sp > XB_SPIN_CAP) { atomicAdd(&bar[XB_TMO], 1u); break; } }
    }
    nloc = mine > 0u ? mine : 1u; nx = cnt > 0u ? cnt : 1u;
}
__device__ __forceinline__ void xcd_barrier(const XcdBarrier& b) {
    asm volatile("s_waitcnt vmcnt(0)" ::: "memory");
    __syncthreads();
    if (threadIdx.x == 0) {
        unsigned* bar = b.bar;
        __builtin_amdgcn_s_waitcnt(0);
        unsigned nloc = b.st[0], nx = b.st[1];
        if (nloc == 0u) { xcd_barrier_complete(bar, b.x, nloc, nx); b.st[0] = nloc; b.st[1] = nx; }
        const unsigned old = xb_add(&bar[XB_XSUB(b.x)], 1u);
        const unsigned gen = old / nloc;
        if (old + 1u == (gen + 1u) * nloc) {
            __builtin_amdgcn_fence(__ATOMIC_RELEASE, "agent");
            asm volatile("s_waitcnt vmcnt(0)" ::: "memory");
            const unsigned og = xb_add(&bar[XB_TOP], 1u);
            const unsigned tg = og / nx;
            if (og + 1u == (tg + 1u) * nx) xb_add(&bar[XB_TOPGEN], 1u);
            else XB_SPIN(xb_ld(&bar[XB_TOPGEN]) == tg, bar);
            __builtin_amdgcn_fence(__ATOMIC_ACQUIRE, "agent");
            xb_add(&bar[XB_XGEN(b.x)], 1u);
            asm volatile("s_waitcnt vmcnt(0)" ::: "memory");
        } else {
            XB_SPIN(xb_ld(&bar[XB_XGEN(b.x)]) == gen, bar);
            __builtin_amdgcn_fence(__ATOMIC_ACQUIRE, "agent");
            asm volatile("s_waitcnt vmcnt(0)" ::: "memory");
        }
    }
    __syncthreads();
}

struct Args { const float* in[23]; float* out; unsigned char* ws; int ph_lo, ph_hi, li, dup; };
enum { I_X = 0, I_GMIX, I_WIN, I_QG, I_KG, I_RPB, I_ARE, I_AIM, I_BRE, I_BIM, I_CRE, I_CIM, I_LS, I_D, I_WGLU, I_BGLU, I_GOA, I_GOS, I_WOUT, I_GFFN, I_WG, I_WU, I_WD };

#define LDS_WAIT() asm volatile("s_waitcnt lgkmcnt(0)" ::: "memory")

__device__ __forceinline__ void p0_transpose_item(const float* W, int N, const float* kscale, bf16_t* WT, int ldd, int drow0, int k0, int n0, int lane) {
    const int c = lane >> 3, n4 = (lane & 7) * 4;
    const float* src = W + (size_t)(k0 + 8 * c) * N + n0 + n4;
    f32x4 v[2][8];
#pragma unroll
    for (int h = 0; h < 2; ++h)
#pragma unroll
        for (int i = 0; i < 8; ++i) v[h][i] = __builtin_nontemporal_load((const f32x4*)(src + (size_t)i * N + 32 * h));
    if (kscale) { const f32x4 s0 = *(const f32x4*)(kscale + k0 + 8 * c), s1 = *(const f32x4*)(kscale + k0 + 8 * c + 4);
#pragma unroll
        for (int h = 0; h < 2; ++h)
#pragma unroll
            for (int i = 0; i < 8; ++i) v[h][i] *= (i < 4 ? s0[i & 3] : s1[i & 3]); }
#pragma unroll
    for (int h = 0; h < 2; ++h)
#pragma unroll
        for (int e = 0; e < 4; ++e) { u32x4 o; o.x = cvt_pk_bf16(v[h][0][e], v[h][1][e]); o.y = cvt_pk_bf16(v[h][2][e], v[h][3][e]); o.z = cvt_pk_bf16(v[h][4][e], v[h][5][e]); o.w = cvt_pk_bf16(v[h][6][e], v[h][7][e]);
            *(u32x4*)(WT + (size_t)(drow0 + 32 * h + n4 + e) * ldd + k0 + 8 * c) = o; }
}

__device__ __forceinline__ void dsincos(double a, double& s, double& c) {
    const double k = __builtin_rint(a * 0.63661977236758134308);
    double r = __builtin_fma(-k, 1.57079632679489655800e+00, a);
    r = __builtin_fma(-k, 6.12323399573676603587e-17, r);
    const double r2 = r * r;
    double sp = -7.6471637318198164759e-13; sp = sp * r2 + 1.6059043836821614599e-10; sp = sp * r2 - 2.5052108385441718775e-08; sp = sp * r2 + 2.7557319223985890653e-06;
    sp = sp * r2 - 1.9841269841269841270e-04; sp = sp * r2 + 8.3333333333333333333e-03; sp = sp * r2 - 1.6666666666666666667e-01; sp = sp * r2 * r + r;
    double cp = 4.7794773323873852974e-14; cp = cp * r2 - 1.1470745597729724714e-11; cp = cp * r2 + 2.0876756987868098979e-09; cp = cp * r2 - 2.7557319223985890653e-07;
    cp = cp * r2 + 2.4801587301587301587e-05; cp = cp * r2 - 1.3888888888888888889e-03; cp = cp * r2 + 4.1666666666666666667e-02; cp = cp * r2 - 0.5; cp = cp * r2 + 1.0;
    const int q = (int)((long long)k) & 3;
    s = (q == 0) ? sp : (q == 1) ? cp : (q == 2) ? -sp : -cp;
    c = (q == 0) ? cp : (q == 1) ? -sp : (q == 2) ? -cp : sp;
}

__device__ __forceinline__ void p0_s5_tables(const Args& a, LAS unsigned char* lds, int g, int q, int tid) {
    LAS f32x2* LP = (LAS f32x2*)lds;
    LAS float* Bb = (LAS float*)(lds + 33792);
    LAS f32x2* Cm = (LAS f32x2*)(lds + 50176);
    LAS float* Kt = (LAS float*)(lds + 66560);
    const float* a_re = a.in[I_ARE]; const float* a_im = a.in[I_AIM]; const float* b_re = a.in[I_BRE]; const float* b_im = a.in[I_BIM];
    const float* c_re = a.in[I_CRE]; const float* c_im = a.in[I_CIM]; const float* lstep = a.in[I_LS]; const float* dsk = a.in[I_D];
    unsigned char* ws = a.ws;
    __syncthreads();
    for (int i = tid; i < 2 * 64 * 33; i += 512) { const int tau = i % 33, p = (i / 33) & 63, d = i / (33 * 64);
        const double lre = (double)fminf(a_re[(d * SG + g) * SP + p], -1e-4f), lim = (double)a_im[(d * SG + g) * SP + p], dt = exp((double)lstep[d * SG + g]);
        const double mag = exp(lre * dt * tau); double s, c; dsincos(lim * dt * tau, s, c);
        LP[i] = (f32x2){(float)(mag * c), (float)(mag * s)}; }
    for (int i = tid; i < 2 * 64 * 16; i += 512) { const int c = i & 15, p = (i >> 4) & 63, d = i >> 10;
        const double lre = (double)fminf(a_re[(d * SG + g) * SP + p], -1e-4f), lim = (double)a_im[(d * SG + g) * SP + p], dt = exp((double)lstep[d * SG + g]);
        const double mag = exp(lre * dt); double sn, cs; dsincos(lim * dt, sn, cs);
        const double nr = mag * cs - 1.0, ni = mag * sn, den = 1.0 / (lre * lre + lim * lim);
        const double fr = (nr * lre + ni * lim) * den, fi = (ni * lre - nr * lim) * den;
        const size_t bi = (((size_t)d * SG + g) * SP + p) * SC + c; const double br = b_re[bi], bim = b_im[bi];
        Bb[(d * 64 + p) * 32 + c] = (float)(fr * br - fi * bim); Bb[(d * 64 + p) * 32 + 16 + c] = (float)(fr * bim + fi * br);
        const size_t ci = (((size_t)d * SG + g) * SC + c) * SP + p;
        Cm[i] = (f32x2){c_re[ci], c_im[ci]}; }
    __syncthreads();
    if (q == 0 && tid < 128) { const int p = tid & 63, d = tid >> 6; ((f32x2*)(ws + WS_LAML))[(g * 2 + d) * SP + p] = LP[(d * 64 + p) * 33 + CL]; }
    { const int tau = tid >> 4, c = tid & 15;
      for (int d = 0; d < 2; ++d) { f32x4 kacc[4];
#pragma unroll
        for (int e = 0; e < 4; ++e) kacc[e] = (f32x4){0.f, 0.f, 0.f, 0.f};
#pragma unroll 4
        for (int p = 0; p < 64; ++p) { const f32x2 cm = Cm[(d * 64 + p) * 16 + c], lp = LP[(d * 64 + p) * 33 + tau];
            const float gr = cm.x * lp.x - cm.y * lp.y, gi = -(cm.x * lp.y + cm.y * lp.x);
            const LAS f32x4* bp = (const LAS f32x4*)(Bb + (d * 64 + p) * 32);
#pragma unroll
            for (int e = 0; e < 4; ++e) kacc[e] += bp[e] * gr + bp[4 + e] * gi; }
#pragma unroll
        for (int e = 0; e < 4; ++e) *(LAS f32x4*)(Kt + ((d * 32 + tau) * 16 + c) * 16 + 4 * e) = kacc[e]; } }
    __syncthreads();
    { const int d = q >> 1, ri = q & 1, p = tid >> 3, s0 = (tid & 7) * 4;
      bf16_t* dst = (bf16_t*)(ws + WS_WST) + ((size_t)g * 256 + q * 64 + p) * 512 + s0 * 16;
#pragma unroll
      for (int sp = 0; sp < 4; ++sp) { const int pw = d == 0 ? (CL - 1 - (s0 + sp)) : (s0 + sp); const f32x2 lp = LP[(d * 64 + p) * 33 + pw]; float v[16];
#pragma unroll
          for (int e = 0; e < 16; ++e) { const float bx_ = Bb[(d * 64 + p) * 32 + e], by_ = Bb[(d * 64 + p) * 32 + 16 + e]; v[e] = ri == 0 ? (lp.x * bx_ - lp.y * by_) : (lp.x * by_ + lp.y * bx_); }
          u32x4 w0, w1; w0.x = cvt_pk_bf16(v[0], v[1]); w0.y = cvt_pk_bf16(v[2], v[3]); w0.z = cvt_pk_bf16(v[4], v[5]); w0.w = cvt_pk_bf16(v[6], v[7]);
          w1.x = cvt_pk_bf16(v[8], v[9]); w1.y = cvt_pk_bf16(v[10], v[11]); w1.z = cvt_pk_bf16(v[12], v[13]); w1.w = cvt_pk_bf16(v[14], v[15]);
          *(u32x4*)(dst + sp * 16) = w0; *(u32x4*)(dst + sp * 16 + 8) = w1; } }
    { const int rl = tid >> 2, s = 8 * q + (rl >> 4), c = rl & 15, part = tid & 3;
      bf16_t* dst = (bf16_t*)(ws + WS_TW) + ((size_t)g * 512 + s * 16 + c) * KS5;
      const float dsv = dsk[g * SC + c];
      for (int j = 0; j < 24; ++j) { const int k0 = part * 192 + j * 8; float v[8];
          if (k0 < 512) { const int sp = k0 >> 4, c0 = k0 & 15;
#pragma unroll
              for (int e = 0; e < 8; ++e) { float t = 0.f;
                  if (sp <= s) t += Kt[((0 * 32 + (s - sp)) * 16 + c) * 16 + c0 + e];
                  if (sp >= s) t += Kt[((1 * 32 + (sp - s)) * 16 + c) * 16 + c0 + e];
                  if (sp == s && c0 + e == c) t += dsv;
                  v[e] = t; }
          } else { const int kk = k0 - 512, d = kk >> 7, ri = (kk >> 6) & 1, p0 = kk & 63, pw = d == 0 ? (s + 1) : (CL - s);
#pragma unroll
              for (int e = 0; e < 8; ++e) { const f32x2 cm = Cm[(d * 64 + p0 + e) * 16 + c], lp = LP[(d * 64 + p0 + e) * 33 + pw];
                  v[e] = ri == 0 ? (cm.x * lp.x - cm.y * lp.y) : -(cm.x * lp.y + cm.y * lp.x); }
          }
          u32x4 w; w.x = cvt_pk_bf16(v[0], v[1]); w.y = cvt_pk_bf16(v[2], v[3]); w.z = cvt_pk_bf16(v[4], v[5]); w.w = cvt_pk_bf16(v[6], v[7]);
          *(u32x4*)(dst + k0) = w; } }
    __syncthreads();
}

__device__ __forceinline__ void p0_prologue(const Args& a, LAS unsigned char* lds, int vcu, int G, int tid) {
    const int wave = __builtin_amdgcn_readfirstlane(tid >> 6), lane = tid & 63;
    unsigned char* ws = a.ws;
    if (vcu & 1) { for (int it = vcu; it < SG * 4; it += G) p0_s5_tables(a, lds, it >> 2, it & 3, tid); }
    const int gw = vcu * 8 + wave, NGW = G * 8;
    constexpr int I_IN = (DM / 64) * (INW / 64), I_GL = (SW / 64) * (SW / 64), I_OUT = (DM / 64) * (DM / 64), I_GU = (DM / 64) * (DFF / 64), I_DN = (DFF / 64) * (DM / 64);
    constexpr int NITEMS = I_IN + I_GL + I_OUT + 2 * I_GU + I_DN;
    for (int it = gw; it < NITEMS; it += NGW) {
        int r = it;
        if (r < I_IN) { const int nb = INW / 64, kb = r / nb, n0 = (r % nb) * 64; p0_transpose_item(a.in[I_WIN], INW, nullptr, (bf16_t*)(ws + WS_WIN), DM, n0, kb * 64, n0, lane); continue; } r -= I_IN;
        if (r < I_GL) { const int nb = SW / 64, kb = r / nb, n0 = (r % nb) * 64; p0_transpose_item(a.in[I_WGLU], SW, nullptr, (bf16_t*)(ws + WS_WGLU), SW, n0, kb * 64, n0, lane); continue; } r -= I_GL;
        if (r < I_OUT) { const int nb = DM / 64, kb = r / nb, n0 = (r % nb) * 64, k0 = kb * 64;
            p0_transpose_item(a.in[I_WOUT], DM, k0 < AW ? a.in[I_GOA] : a.in[I_GOS] - AW, (bf16_t*)(ws + WS_WOUT), DM, n0, k0, n0, lane); continue; } r -= I_OUT;
        if (r < 2 * I_GU) { const int up = r >= I_GU; if (up) r -= I_GU; const int nb = DFF / 64, kb = r / nb, n0 = (r % nb) * 64;
            p0_transpose_item(up ? a.in[I_WU] : a.in[I_WG], DFF, a.in[I_GFFN], (bf16_t*)(ws + WS_WGU), DM, 256 * (n0 >> 7) + (n0 & 127) + (up ? 128 : 0), kb * 64, n0, lane); continue; } r -= 2 * I_GU;
        { const int nb = DM / 64, kb = r / nb, n0 = (r % nb) * 64; p0_transpose_item(a.in[I_WD], DM, nullptr, (bf16_t*)(ws + WS_WD), DFF, n0, kb * 64, n0, lane); }
    }
    const float* x = a.in[I_X]; const float* gm = a.in[I_GMIX]; bf16_t* XN = (bf16_t*)(ws + WS_XN);
    for (int m = gw; m < M; m += NGW) { const f32x4* xr = (const f32x4*)(x + (size_t)m * DM) + lane; f32x4 v[8]; float s = 0.f;
#pragma unroll
        for (int j = 0; j < 8; ++j) { v[j] = xr[64 * j]; s += (v[j][0] * v[j][0] + v[j][1] * v[j][1]) + (v[j][2] * v[j][2] + v[j][3] * v[j][3]); }
        const float rstd = 1.0f / sqrtf(wave_sum(s) * (1.0f / DM) + RMS_EPS);
        u32x2* o8 = (u32x2*)(XN + (size_t)m * DM) + lane;
#pragma unroll
        for (int j = 0; j < 8; ++j) { const f32x4 gv = ((const f32x4*)gm)[64 * j + lane]; u32x2 w; w.x = cvt_pk_bf16(v[j][0] * rstd * gv[0], v[j][1] * rstd * gv[1]); w.y = cvt_pk_bf16(v[j][2] * rstd * gv[2], v[j][3] * rstd * gv[3]); o8[64 * j] = w; } }
    if (!(vcu & 1)) { for (int it = vcu; it < SG * 4; it += G) p0_s5_tables(a, lds, it >> 2, it & 3, tid); }
}

constexpr int VROW = 160;
constexpr int VBUF = 32 * VROW;
constexpr int ATT_RPB_OFF = 8 * 2 * VBUF;
static_assert(ATT_RPB_OFF + 16 * 465 * 4 <= MISC_OFF, "attention LDS");

__device__ __forceinline__ void attn_phase(const Args& a, LAS unsigned char* lds, int vcu, int G, int tid, float alpha) {
    const int wave = __builtin_amdgcn_readfirstlane(tid >> 6), lane = tid & 63, ql = lane & 15, g4 = lane >> 4;
    const bf16_t* QKV = (const bf16_t*)(a.ws + WS_BIG); bf16_t* YAYS = (bf16_t*)(a.ws + WS_YAYS); float* ssqa = (float*)(a.ws + WS_CTL) + CW_SSQA;
    LAS float* rpbL = (LAS float*)(lds + ATT_RPB_OFF);
    for (int i = tid; i < 16 * 465; i += 512) rpbL[i] = a.in[I_RPB][i];
    __syncthreads();
    LAS unsigned char* vb = lds + wave * 2 * VBUF;
    const int j = wave & 3, hsel = wave >> 2;
    const int cq = 16 * j + ql, cs = min(max(cq - 8, 0), GRIDW - 16), wb = (j == 0) ? 0 : (j == 1) ? 8 : (j == 2) ? 24 : 32;
    float gg[16];
#pragma unroll
    for (int ks = 0; ks < 2; ++ks)
#pragma unroll
        for (int e = 0; e < 8; ++e) { const int d = 32 * ks + 8 * g4 + e; gg[ks * 8 + e] = a.in[I_QG][d] * a.in[I_KG][d] * 0.125f; }
    for (int un = vcu; un < BATCH * NROWS; un += G) {
        const int b = un >> 6, r = un & 63, row_start = min(max(r - 4, 0), NROWS - 8);
        const size_t tq = (size_t)b * SEQ + 64 * r + cq;
        float ssq_acc = 0.f;
        for (int it = 0; it < 8; ++it) { const int h = 2 * it + hsel;
            bf16x8 Qf[2];
            { const u32x4* qp = (const u32x4*)(QKV + tq * NQKV + 64 * h + 8 * g4); const u32x4 q0 = qp[0], q1 = qp[4]; float qf[16];
              qf[0] = bf_lo(q0.x); qf[1] = bf_hi(q0.x); qf[2] = bf_lo(q0.y); qf[3] = bf_hi(q0.y); qf[4] = bf_lo(q0.z); qf[5] = bf_hi(q0.z); qf[6] = bf_lo(q0.w); qf[7] = bf_hi(q0.w);
              qf[8] = bf_lo(q1.x); qf[9] = bf_hi(q1.x); qf[10] = bf_lo(q1.y); qf[11] = bf_hi(q1.y); qf[12] = bf_lo(q1.z); qf[13] = bf_hi(q1.z); qf[14] = bf_lo(q1.w); qf[15] = bf_hi(q1.w);
              float ss = 0.f;
#pragma unroll
              for (int e = 0; e < 16; ++e) ss += qf[e] * qf[e];
              ss += __shfl_xor(ss, 16); ss += __shfl_xor(ss, 32);
              const float rq = __builtin_amdgcn_rsqf(ss * (1.0f / HD) + RMS_EPS);
#pragma unroll
              for (int e = 0; e < 16; ++e) qf[e] *= rq * gg[e];
              u32x4 w0, w1; w0.x = cvt_pk_bf16(qf[0], qf[1]); w0.y = cvt_pk_bf16(qf[2], qf[3]); w0.z = cvt_pk_bf16(qf[4], qf[5]); w0.w = cvt_pk_bf16(qf[6], qf[7]);
              w1.x = cvt_pk_bf16(qf[8], qf[9]); w1.y = cvt_pk_bf16(qf[10], qf[11]); w1.z = cvt_pk_bf16(qf[12], qf[13]); w1.w = cvt_pk_bf16(qf[14], qf[15]);
              Qf[0] = __builtin_bit_cast(bf16x8, w0); Qf[1] = __builtin_bit_cast(bf16x8, w1); }
            f32x4 S[8][2];
            const bf16_t* kbase = QKV + ((size_t)b * SEQ + 64 * row_start + wb + ql) * NQKV + AW + 64 * h + 8 * g4;
            const LAS float* bl = rpbL + h * 465 + (row_start - r + 7) * 31 + (wb + 4 * g4 - cq + 15);
#pragma unroll
            for (int kr = 0; kr < 8; ++kr)
#pragma unroll
                for (int t = 0; t < 2; ++t) {
                    const u32x4* kp = (const u32x4*)(kbase + (size_t)(64 * kr + 16 * t) * NQKV); const u32x4 k0 = kp[0], k1 = kp[4];
                    float ss = 0.f;
                    { const unsigned kw[8] = {k0.x, k0.y, k0.z, k0.w, k1.x, k1.y, k1.z, k1.w};
#pragma unroll
                      for (int e = 0; e < 8; ++e) { const float lo = bf_lo(kw[e]), hi = bf_hi(kw[e]); ss += lo * lo + hi * hi; } }
                    ss += __shfl_xor(ss, 16); ss += __shfl_xor(ss, 32);
                    const float rk = __builtin_amdgcn_rsqf(ss * (1.0f / HD) + RMS_EPS);
                    f32x4 acc = (f32x4){0.f, 0.f, 0.f, 0.f};
                    acc = __builtin_amdgcn_mfma_f32_16x16x32_bf16(__builtin_bit_cast(bf16x8, k0), Qf[0], acc, 0, 0, 0);
                    acc = __builtin_amdgcn_mfma_f32_16x16x32_bf16(__builtin_bit_cast(bf16x8, k1), Qf[1], acc, 0, 0, 0);
#pragma unroll
                    for (int e = 0; e < 4; ++e) { const float rkr = __shfl(rk, 4 * g4 + e); const int ck = wb + 16 * t + 4 * g4 + e;
                        const float bias = bl[kr * 31 + 16 * t + e];
                        acc[e] = (ck >= cs && ck < cs + 16) ? acc[e] * rkr + bias : -1e30f; }
                    S[kr][t] = acc; }
            float mx = -1e30f;
#pragma unroll
            for (int kr = 0; kr < 8; ++kr)
#pragma unroll
                for (int t = 0; t < 2; ++t)
#pragma unroll
                    for (int e = 0; e < 4; ++e) mx = fmaxf(mx, S[kr][t][e]);
            mx = fmaxf(mx, __shfl_xor(mx, 16)); mx = fmaxf(mx, __shfl_xor(mx, 32));
            float sum = 0.f; bf16x8 Pf[8];
#pragma unroll
            for (int kr = 0; kr < 8; ++kr) { f32x4 p0, p1;
#pragma unroll
                for (int e = 0; e < 4; ++e) { p0[e] = fast_exp2((S[kr][0][e] - mx) * 1.44269504089f); p1[e] = fast_exp2((S[kr][1][e] - mx) * 1.44269504089f); sum += p0[e] + p1[e]; }
                Pf[kr] = __builtin_bit_cast(bf16x8, pg8::pack8(p0, p1)); }
            sum += __shfl_xor(sum, 16); sum += __shfl_xor(sum, 32);
            f32x4 O[4];
#pragma unroll
            for (int dt = 0; dt < 4; ++dt) O[dt] = (f32x4){0.f, 0.f, 0.f, 0.f};
            const bf16_t* vbase = QKV + ((size_t)b * SEQ + 64 * row_start + wb + (lane >> 3)) * NQKV + 2 * AW + 64 * h + 8 * (lane & 7);
            u32x4 vr[3][4];
#pragma unroll
            for (int i = 0; i < 4; ++i) vr[0][i] = *(const u32x4*)(vbase + (size_t)(8 * i) * NQKV);
#pragma unroll
            for (int i = 0; i < 4; ++i) vr[1][i] = *(const u32x4*)(vbase + (size_t)(64 + 8 * i) * NQKV);
#pragma unroll
            for (int kr = 0; kr < 8; ++kr) {
                if (kr + 2 < 8) {
#pragma unroll
                    for (int i = 0; i < 4; ++i) vr[(kr + 2) % 3][i] = *(const u32x4*)(vbase + (size_t)(64 * (kr + 2) + 8 * i) * NQKV); }
                LAS unsigned char* vbuf = vb + (kr & 1) * VBUF;
#pragma unroll
                for (int i = 0; i < 4; ++i) *(LAS u32x4*)(vbuf + ((lane >> 3) + 8 * i) * VROW + (lane & 7) * 16) = vr[kr % 3][i];
                const LAS unsigned char* rp = vbuf + (4 * g4 + ((lane & 15) >> 2)) * VROW + (lane & 3) * 8;
#pragma unroll
                for (int dt = 0; dt < 4; ++dt) {
                    const s16x4 lo = __builtin_amdgcn_ds_read_tr16_b64_v4i16((LAS s16x4*)(rp + dt * 32));
                    const s16x4 hi = __builtin_amdgcn_ds_read_tr16_b64_v4i16((LAS s16x4*)(rp + 16 * VROW + dt * 32));
                    const bf16x8 av = (bf16x8){lo[0], lo[1], lo[2], lo[3], hi[0], hi[1], hi[2], hi[3]};
                    O[dt] = __builtin_amdgcn_mfma_f32_16x16x32_bf16(av, Pf[kr], O[dt], 0, 0, 0); }
            }
            const float inv = fast_rcp(sum);
            bf16_t* op = YAYS + tq * DM + 64 * h + 4 * g4;
#pragma unroll
            for (int dt = 0; dt < 4; ++dt) { const f32x4 o = O[dt] * inv; ssq_acc += (o[0] * o[0] + o[1] * o[1]) + (o[2] * o[2] + o[3] * o[3]);
                u32x2 w; w.x = cvt_pk_bf16(o[0], o[1]); w.y = cvt_pk_bf16(o[2], o[3]); *(u32x2*)(op + 16 * dt) = w; }
        }
        ssq_acc += __shfl_xor(ssq_acc, 16); ssq_acc += __shfl_xor(ssq_acc, 32);
        if (g4 == 0) unsafeAtomicAdd(ssqa + tq, ssq_acc * alpha);
    }
}

__device__ __forceinline__ void scan_phase(const Args& a, int vcu, int G, int tid) {
    if (tid >= 128) return;
    const float* E = (const float*)(a.ws + WS_E); bf16_t* A5 = (bf16_t*)(a.ws + WS_A5); const f32x2* LAML = (const f32x2*)(a.ws + WS_LAML);
    for (int idx = vcu * 128 + tid; idx < BATCH * SG * 2 * SP; idx += G * 128) {
        const int p = idx & 63, d = (idx >> 6) & 1, g = (idx >> 7) & 63, b = idx >> 13;
        const f32x2 lam = LAML[(g * 2 + d) * SP + p];
        float xr = 0.f, xi = 0.f;
#pragma unroll 8
        for (int kk = 0; kk < NCH; ++kk) { const int k = d == 0 ? kk : NCH - 1 - kk; const size_t R = (size_t)g * RCH + b * NCH + k;
            bf16_t* ap = A5 + R * KS5 + 512 + d * 128 + p; ap[0] = (bf16_t)(cvt_pk_bf16(xr, 0.f) & 0xffffu); ap[64] = (bf16_t)(cvt_pk_bf16(xi, 0.f) & 0xffffu);
            const float er = E[R * 256 + d * 128 + p], ei = E[R * 256 + d * 128 + 64 + p];
            const float nr = lam.x * xr - lam.y * xi + er, ni = lam.x * xi + lam.y * xr + ei; xr = nr; xi = ni; }
    }
}

__global__ void __launch_bounds__(512, 2) hymba_fwd(Args args) {
    extern __shared__ __attribute__((aligned(16))) unsigned char lds_raw[];
    LAS unsigned char* lds = (LAS unsigned char*)lds_raw;
    volatile LAS unsigned* MISC = (volatile LAS unsigned*)(lds + MISC_OFF);
    const int tid = threadIdx.x;
    const int G = gridDim.x; const int bx = blockIdx.x; const int vcu = (G % 8 == 0) ? (bx % 8) * (G / 8) + bx / 8 : bx;
    unsigned char* ws = args.ws;
    unsigned* ctl = (unsigned*)(ws + WS_CTL);
    for (int u = tid; u < (LDS_BYTES - MISC_OFF) / 4; u += 512) MISC[u] = 0u;
    __syncthreads();
    XcdBarrier bar; bar.bar = ctl + CW_BAR; bar.x = 0; bar.st = nullptr;
    if (MK_N_LAUNCHES == 1) bar = xcd_barrier_post(ctl + CW_BAR, MISC + 8);
    const int lo = args.ph_lo, hi = args.ph_hi;
#define IN(k) (lo <= (k) && (k) < hi)
#define SEAM(k) do { if (IN(k) && IN((k) + 1)) xcd_barrier(bar); } while (0)
    bf16_t* WIN = (bf16_t*)(ws + WS_WIN); bf16_t* WGLU = (bf16_t*)(ws + WS_WGLU); bf16_t* WOUT = (bf16_t*)(ws + WS_WOUT); bf16_t* WGU = (bf16_t*)(ws + WS_WGU); bf16_t* WD = (bf16_t*)(ws + WS_WD);
    bf16_t* WST = (bf16_t*)(ws + WS_WST); bf16_t* TW = (bf16_t*)(ws + WS_TW);
    bf16_t* XN = (bf16_t*)(ws + WS_XN); bf16_t* YG = (bf16_t*)(ws + WS_XN); bf16_t* XB = (bf16_t*)(ws + WS_XN);
    bf16_t* QKV = (bf16_t*)(ws + WS_BIG); bf16_t* A5 = (bf16_t*)(ws + WS_A5); float* E = (float*)(ws + WS_E); bf16_t* HB = (bf16_t*)(ws + WS_BIG);
    bf16_t* YAYS = (bf16_t*)(ws + WS_YAYS);
    float* ssqa = (float*)ctl + CW_SSQA; float* ssqs = (float*)ctl + CW_SSQS; float* ssqx = (float*)ctl + CW_SSQX;

#define REP(k) _Pragma("unroll") for (int rep_ = (DUP_PHASE == (k)) ? 0 : 1; rep_ < 2; ++rep_)
#define ALPHA ((rep_ == 0 && args.dup >= 0) ? 0.0f : 1.0f)
    if (IN(0)) { REP(0) { p0_prologue(args, lds, vcu, G, tid); __syncthreads(); } SEAM(0); }
    if (IN(1)) {
        pg8::Gemm g{XN, WIN, DM, DM, DM, 0, 0}; pg8::StaticOrder S; S.init(M, INW, G, bx);
        pg8::EpiZ Ep{QKV, A5};
        REP(1) pg8::gemm_phase(lds, g, S, Ep);
        SEAM(1);
    }
    if (IN(2)) {
        { pg8::Gemm g{A5, WST, KS5, 512, 512, (size_t)RCH * KS5, (size_t)256 * 512}; pg8::BatchOrder S; S.init(2, 1, SG * (DUP_PHASE == 2 ? 2 : 1), G, bx);
          pg8::EpiE Ep{E};
          pg8::gemm_phase(lds, g, S, Ep); }
        __syncthreads();
        REP(9) { attn_phase(args, lds, vcu, G, tid, ALPHA); __syncthreads(); }
        SEAM(2);
    }
    if (IN(3)) { REP(3) scan_phase(args, vcu, G, tid); SEAM(3); }
    if (IN(4)) {
        pg8::Gemm g{A5, TW, KS5, KS5, KS5, (size_t)RCH * KS5, (size_t)512 * KS5}; pg8::BatchOrder S; S.init(2, 2, SG * (DUP_PHASE == 4 ? 2 : 1), G, bx);
        pg8::EpiS5Out Ep{YG};
        pg8::gemm_phase(lds, g, S, Ep);
        SEAM(4);
    }
    if (IN(5)) {
        pg8::Gemm g{YG, WGLU, SW, SW, SW, 0, 0}; pg8::StaticOrder S; S.init(M, SW, G, bx);
        REP(5) { pg8::EpiGlu Ep{YG, args.in[I_BGLU], YAYS, ssqs, ALPHA}; pg8::gemm_phase(lds, g, S, Ep); }
        SEAM(5);
    }
    if (IN(6)) {
        pg8::Gemm g{YAYS, WOUT, DM, DM, AW, 0, 0}; pg8::SplitKOrder S; S.so.init(M, DM, G, bx);
        REP(6) { pg8::EpiRes1 Ep{args.in[I_X], args.out, XB, ssqa, ssqs, ssqx, ALPHA}; pg8::gemm_phase(lds, g, S, Ep); }
        SEAM(6);
    }
    if (IN(7)) {
        pg8::Gemm g{XB, WGU, DM, DM, DM, 0, 0}; pg8::StaticOrder S; S.init(M, 2 * DFF, G, bx);
        pg8::EpiSwiGLU Ep{HB, ssqx};
        REP(7) pg8::gemm_phase(lds, g, S, Ep);
        SEAM(7);
    }
    if (IN(8)) {
        pg8::Gemm g{HB, WD, DFF, DFF, DFF, 0, 0}; pg8::StaticOrder S; S.init(M, DM, G, bx);
        REP(8) { pg8::EpiRes2 Ep{args.out, ALPHA}; pg8::gemm_phase(lds, g, S, Ep); }
    }
#undef IN
#undef SEAM
}

extern "C" void kernel_launch(void* const* d_in, const int* in_sizes, int n_in, void* d_out, int out_size, void* d_ws, size_t ws_size, hipStream_t stream) {
    static int grid = 0;
    if (grid == 0) {
        if (n_in != 23 || in_sizes[0] != M * DM || out_size != M * DM || ws_size < WS_END) { fprintf(stderr, "kernel_launch: unexpected shapes (n_in %d, in0 %d, out %d, ws %zu < %zu)\n", n_in, n_in > 0 ? in_sizes[0] : -1, out_size, ws_size, (size_t)WS_END); grid = -1; return; }
        int dev = 0, cus = 0, per_cu = 0;
        if (hipGetDevice(&dev) != hipSuccess || hipDeviceGetAttribute(&cus, hipDeviceAttributeMultiprocessorCount, dev) != hipSuccess) { grid = -1; return; }
        if (hipFuncSetAttribute((const void*)hymba_fwd, hipFuncAttributeMaxDynamicSharedMemorySize, LDS_BYTES) != hipSuccess) { fprintf(stderr, "kernel_launch: hipFuncSetAttribute failed\n"); grid = -1; return; }
        if (hipOccupancyMaxActiveBlocksPerMultiprocessor(&per_cu, (const void*)hymba_fwd, 512, LDS_BYTES) != hipSuccess || per_cu < 1) { fprintf(stderr, "kernel_launch: occupancy query says %d blocks per CU\n", per_cu); (void)hipGetLastError(); per_cu = 1; }
        grid = cus;
    }
    if (grid < 0) return;
    (void)hipMemsetAsync((char*)d_ws + WS_CTL, 0, CTL_ZERO_BYTES, stream);
    Args a{}; a.dup = DUP_PHASE;
    for (int i = 0; i < 23; ++i) a.in[i] = (const float*)d_in[i];
    a.out = (float*)d_out; a.ws = (unsigned char*)d_ws;
    if (MK_N_LAUNCHES == 1) {
        a.ph_lo = 0; a.ph_hi = NPHASE; a.li = 0;
        hipLaunchKernelGGL(hymba_fwd, dim3(grid), dim3(512), LDS_BYTES, stream, a);
    } else {
        for (int li = 0; li < NPHASE; ++li) { a.ph_lo = li; a.ph_hi = li + 1; a.li = li; hipLaunchKernelGGL(hymba_fwd, dim3(grid), dim3(512), LDS_BYTES, stream, a); }
    }
}
```

```cpp
#include <hip/hip_runtime.h>
#include <cstdio>
#include <cstdint>

#define DUP_PHASE (-1)
#ifndef MK_N_LAUNCHES
#define MK_N_LAUNCHES 1
#endif

#define GAS __attribute__((address_space(1)))
#define LAS __attribute__((address_space(3)))
typedef unsigned short bf16_t;
typedef short bf16x8 __attribute__((ext_vector_type(8)));
typedef short s16x4 __attribute__((ext_vector_type(4)));
typedef float f32x4 __attribute__((ext_vector_type(4)));
typedef float f32x2 __attribute__((ext_vector_type(2)));
typedef unsigned u32x4 __attribute__((ext_vector_type(4)));
typedef unsigned u32x2 __attribute__((ext_vector_type(2)));

constexpr int BATCH = 4, SEQ = 4096, DM = 2048, M = BATCH * SEQ;
constexpr int AW = 1024, SW = 1024, NH = 16, HD = 64, NQKV = 3 * AW, INW = 4096, DFF = 5632;
constexpr int GRIDW = 64, NROWS = SEQ / GRIDW;
constexpr int SG = 64, SC = 16, SP = 64;
constexpr int CL = 32, NCH = SEQ / CL, RCH = M / CL;
constexpr int KS5 = CL * SC + 256;
constexpr float RMS_EPS = 1e-6f;
constexpr int NPHASE = 9;

constexpr size_t MiB = 1u << 20;
constexpr size_t WS_CTL = 0, CTL_ZERO_BYTES = 1 * MiB;
constexpr size_t WS_WIN = 1 * MiB, WS_WGLU = 17 * MiB, WS_WOUT = 19 * MiB, WS_WGU = 27 * MiB, WS_WD = 71 * MiB;
constexpr size_t WS_WST = 93 * MiB, WS_TW = 109 * MiB, WS_LAML = 157 * MiB;
constexpr size_t WS_XN = 158 * MiB;
constexpr size_t WS_BIG = 222 * MiB;
constexpr size_t WS_A5 = WS_BIG + 96 * MiB, WS_E = WS_BIG + 144 * MiB;
constexpr size_t WS_YAYS = 398 * MiB, WS_END = 462 * MiB;
constexpr int CW_BAR = 4096;
constexpr int CW_SSQA = 65536, CW_SSQS = CW_SSQA + M, CW_SSQX = CW_SSQS + M;
static_assert((size_t)(CW_SSQX + M) * 4 <= CTL_ZERO_BYTES, "ctl");

constexpr int RING_BYTES = 131072;
constexpr int MISC_OFF = 143360;
constexpr int LDS_BYTES = 147456;

__device__ __forceinline__ unsigned cvt_pk_bf16(float lo, float hi) { unsigned r; asm volatile("v_cvt_pk_bf16_f32 %0, %1, %2" : "=v"(r) : "v"(lo), "v"(hi)); return r; }
__device__ __forceinline__ float bf_lo(unsigned w) { return __uint_as_float(w << 16); }
__device__ __forceinline__ float bf_hi(unsigned w) { return __uint_as_float(w & 0xffff0000u); }
__device__ __forceinline__ float fast_rcp(float x) { return __builtin_amdgcn_rcpf(x); }
__device__ __forceinline__ float fast_exp2(float x) { return __builtin_amdgcn_exp2f(x); }
__device__ __forceinline__ float sigmoidf_(float x) { return fast_rcp(1.0f + fast_exp2(-1.44269504089f * x)); }
__device__ __forceinline__ float gelu_tanh(float x) { const float t = x * (1.0f + 0.044715f * x * x); return x * fast_rcp(1.0f + fast_exp2(-2.30220818f * t)); }
__device__ __forceinline__ float wave_sum(float v) {
#pragma unroll
    for (int o = 1; o < 64; o <<= 1) v += __shfl_xor(v, o);
    return v;
}

namespace pg8 {
constexpr int BM = 256, BK = 64, HALF = 128, HTB = HALF * BK * 2, NXCD = 8, WGM = 8;
__host__ __device__ __forceinline__ int lds_byte(int r, int c) { const int st = (r >> 4) * 2 + (c >> 5), rr = r & 15, cc = c & 31, ob = rr * 64 + cc * 2; return st * 1024 + (ob ^ (((ob >> 9) & 1) << 5)); }
__host__ __device__ __forceinline__ void stage_rc(int b, int& R, int& C) { const int st = b / 1024, sb = b % 1024, swz = sb ^ (((sb >> 9) & 1) << 5); R = (st >> 1) * 16 + swz / 64; C = (st & 1) * 32 + (swz % 64) / 2; }
__host__ __device__ __forceinline__ int perm32(int rho) { const int n = rho >> 4, i = rho & 15; return 8 * (i >> 2) + 4 * n + (i & 3); }

struct Unit { int pm, pn, g, kh; };
struct Gemm { const bf16_t* A; const bf16_t* Bt; int lda, ldb, K; size_t sA, sB; };

struct StaticOrder {
    int nM, nN, nwg, G, c;
    __device__ void init(int M_, int N_, int G_, int c_) { nM = M_ / BM; nN = N_ / BM; nwg = nM * nN; G = G_; c = c_; }
    __device__ bool next(int i, Unit& u) const {
        const long L = (long)i * G + c; if (L >= nwg) return false;
        int wgid = (int)L; { const int q = nwg / NXCD, r = nwg % NXCD, xcd = wgid % NXCD, off = wgid / NXCD; wgid = (xcd < r ? xcd * (q + 1) : r * (q + 1) + (xcd - r) * q) + off; }
        const int nig = WGM * nN, gid = wgid / nig, fm = gid * WGM, gsz = (nM - fm) < WGM ? (nM - fm) : WGM;
        u.pm = fm + ((wgid % nig) % gsz); u.pn = (wgid % nig) / gsz; u.g = 0; u.kh = 0; return true;
    }
};
struct SplitKOrder {
    StaticOrder so;
    __device__ bool next(int i, Unit& u) const { if (!so.next(i >> 1, u)) return false; u.kh = i & 1; return true; }
};
struct BatchOrder {
    int nM, nN, nwg, G, c;
    __device__ void init(int nM_, int nN_, int nb, int G_, int c_) { nM = nM_; nN = nN_; nwg = nM * nN * nb; G = G_; c = c_; }
    __device__ bool next(int i, Unit& u) const {
        const long L = (long)i * G + c; if (L >= nwg) return false;
        const int l = (int)L; u.pn = l % nN; u.pm = (l / nN) % nM; u.g = (l / (nN * nM)) % SG; u.kh = 0; return true;
    }
};

template <class Epi, class Sched>
__device__ __forceinline__ void gemm_phase(LAS unsigned char* lds, const Gemm g, const Sched& S, const Epi& E) {
    int tid = threadIdx.x; asm volatile("" : "+v"(tid));
    const int wid = __builtin_amdgcn_readfirstlane(tid >> 6), lane = tid & 63, wr = wid >> 2, wc = wid & 3, fr = lane & 15, fq = lane >> 4;
    const int K = g.K, nt = K / BK;
    unsigned voffA[2], voffB[2];
#pragma unroll
    for (int i = 0; i < 2; ++i) { int R, C; stage_rc(tid * 16 + i * 8192, R, C); const int Rb = Epi::PERM ? ((R & ~31) + perm32(R & 31)) : R;
        voffA[i] = (unsigned)(R * g.lda + C) * 2u; voffB[i] = (unsigned)(Rb * g.ldb + C) * 2u; }
    const size_t kstep = (size_t)(BK * 2);
    const size_t hstepA = (size_t)HALF * g.lda * 2, hstepB = (size_t)HALF * g.ldb * 2;
    const unsigned ldsw = (unsigned)wid * 1024u;
    const int aoff = lds_byte(wr * 64 + fr, fq * 8), boff = lds_byte(wc * 32 + fr, fq * 8);
#define PG8_SA(b, h) (((b) * 2 + (h)) * HTB)
#define PG8_SB(b, h) ((4 + (b) * 2 + (h)) * HTB)
#define PG8_STAGE(bufoff, gbase, voff) do { _Pragma("unroll") for (int _i = 0; _i < 2; ++_i) \
        __builtin_amdgcn_global_load_lds((const unsigned*)((const char*)(gbase) + (voff)[_i]), (LAS unsigned*)(lds + (bufoff) + ldsw + _i * 8192), 16, 0, 0); } while (0)
#define PG8_LDA(dst, b, h) do { _Pragma("unroll") for (int m = 0; m < 4; ++m) _Pragma("unroll") for (int k = 0; k < 2; ++k) dst[m][k] = *(const LAS bf16x8*)(lds + PG8_SA(b, h) + aoff + m * 2048 + k * 1024); } while (0)
#define PG8_LDB(dst, b, h) do { _Pragma("unroll") for (int n = 0; n < 2; ++n) _Pragma("unroll") for (int k = 0; k < 2; ++k) dst[n][k] = *(const LAS bf16x8*)(lds + PG8_SB(b, h) + boff + n * 2048 + k * 1024); } while (0)
#define PG8_MMA(ai, bj, At, Bt) do { __builtin_amdgcn_s_setprio(1); _Pragma("unroll") for (int m = 0; m < 4; ++m) _Pragma("unroll") for (int n = 0; n < 2; ++n) _Pragma("unroll") for (int k = 0; k < 2; ++k) \
        acc[ai][bj][m][n] = __builtin_amdgcn_mfma_f32_16x16x32_bf16(Bt[n][k], At[m][k], acc[ai][bj][m][n], 0, 0, 0); __builtin_amdgcn_s_setprio(0); } while (0)
#define PG8_WAIT_V(n) asm volatile("s_waitcnt vmcnt(" #n ")" ::: "memory")
#define PG8_WAIT_L(n) asm volatile("s_waitcnt lgkmcnt(" #n ")" ::: "memory")
#define PG8_BAR __builtin_amdgcn_s_barrier()
#define PG8_SCHED __builtin_amdgcn_sched_barrier(0)
    Unit cur, nxt; int ui = 0;
    if (!S.next(0, cur)) return;
    f32x4 acc[2][2][4][2];
#pragma unroll
    for (int a = 0; a < 2; ++a)
#pragma unroll
        for (int b = 0; b < 2; ++b)
#pragma unroll
            for (int m = 0; m < 4; ++m)
#pragma unroll
                for (int n = 0; n < 2; ++n) acc[a][b][m][n] = (f32x4){0.f, 0.f, 0.f, 0.f};
    bf16x8 At[4][2], B0[2][2], B1[2][2];
    const char* cA = (const char*)g.A + ((size_t)cur.g * g.sA + (size_t)cur.pm * BM * g.lda + (size_t)cur.kh * K) * 2;
    const char* cB = (const char*)g.Bt + ((size_t)cur.g * g.sB + (size_t)cur.pn * BM * g.ldb + (size_t)cur.kh * K) * 2;
    PG8_STAGE(PG8_SB(0, 0), cB, voffB); PG8_STAGE(PG8_SB(0, 1), cB + hstepB, voffB); PG8_STAGE(PG8_SA(0, 0), cA, voffA); PG8_STAGE(PG8_SA(0, 1), cA + hstepA, voffA);
    if (wr == 1) PG8_BAR;
    PG8_WAIT_V(2); PG8_BAR;
    PG8_STAGE(PG8_SB(1, 0), cB + kstep, voffB); PG8_STAGE(PG8_SA(1, 0), cA + kstep, voffA); PG8_STAGE(PG8_SB(1, 1), cB + hstepB + kstep, voffB);
    PG8_WAIT_V(6); PG8_BAR;
    for (;;) {
        const bool has_next = S.next(ui + 1, nxt);
        const char* nA = has_next ? (const char*)g.A + ((size_t)nxt.g * g.sA + (size_t)nxt.pm * BM * g.lda + (size_t)nxt.kh * K) * 2 : cA;
        const char* nB = has_next ? (const char*)g.Bt + ((size_t)nxt.g * g.sB + (size_t)nxt.pn * BM * g.ldb + (size_t)nxt.kh * K) * 2 : cB;
        for (int t = 0; t < nt; t += 2) {
            const bool last = (t == nt - 2);
            const char* a1 = cA + (size_t)(t + 1) * kstep;
            const char* a2 = last ? nA : cA + (size_t)(t + 2) * kstep; const char* b2 = last ? nB : cB + (size_t)(t + 2) * kstep;
            const char* a3 = a2 + kstep; const char* b3 = b2 + kstep;
            PG8_LDB(B0, 0, 0); PG8_LDB(B1, 0, 1); PG8_SCHED; PG8_LDA(At, 0, 0); PG8_STAGE(PG8_SA(1, 1), a1 + hstepA, voffA);
            PG8_WAIT_V(8); PG8_WAIT_L(0); PG8_BAR; PG8_MMA(0, 0, At, B0); PG8_MMA(0, 1, At, B1); PG8_BAR; PG8_SCHED;
            PG8_LDA(At, 0, 1); PG8_STAGE(PG8_SB(0, 0), b2, voffB); PG8_STAGE(PG8_SB(0, 1), b2 + hstepB, voffB); PG8_STAGE(PG8_SA(0, 0), a2, voffA);
            PG8_WAIT_V(8); PG8_WAIT_L(0); PG8_BAR; PG8_MMA(1, 0, At, B0); PG8_MMA(1, 1, At, B1); PG8_BAR; PG8_SCHED;
            PG8_LDB(B0, 1, 0); PG8_LDB(B1, 1, 1); PG8_SCHED; PG8_LDA(At, 1, 0); PG8_STAGE(PG8_SA(0, 1), a2 + hstepA, voffA);
            PG8_WAIT_V(8); PG8_WAIT_L(0); PG8_BAR; PG8_MMA(0, 0, At, B0); PG8_MMA(0, 1, At, B1); PG8_BAR; PG8_SCHED;
            PG8_LDA(At, 1, 1); PG8_STAGE(PG8_SB(1, 0), b3, voffB); PG8_STAGE(PG8_SB(1, 1), b3 + hstepB, voffB); PG8_STAGE(PG8_SA(1, 0), a3, voffA);
            PG8_WAIT_V(8); PG8_WAIT_L(0); PG8_BAR; PG8_MMA(1, 0, At, B0); PG8_MMA(1, 1, At, B1); PG8_BAR; PG8_SCHED;
        }
        if (wr == 0) PG8_BAR;
        E(acc, cur, wr, wc, fr, fq);
        if (!has_next) break;
        if (!(Epi::KSPLIT && cur.kh == 0)) {
#pragma unroll
        for (int a = 0; a < 2; ++a)
#pragma unroll
            for (int b = 0; b < 2; ++b)
#pragma unroll
                for (int m = 0; m < 4; ++m)
#pragma unroll
                    for (int n = 0; n < 2; ++n) acc[a][b][m][n] = (f32x4){0.f, 0.f, 0.f, 0.f};
        }
        cur = nxt; cA = nA; cB = nB; ++ui;
        if (wr == 1) PG8_BAR;
    }
    PG8_WAIT_V(0);
    PG8_BAR;
#undef PG8_SA
#undef PG8_SB
#undef PG8_STAGE
#undef PG8_LDA
#undef PG8_LDB
#undef PG8_MMA
#undef PG8_WAIT_V
#undef PG8_WAIT_L
#undef PG8_BAR
#undef PG8_SCHED
}

__device__ __forceinline__ u32x4 pack8(const f32x4 a, const f32x4 b) { u32x4 w; w.x = cvt_pk_bf16(a[0], a[1]); w.y = cvt_pk_bf16(a[2], a[3]); w.z = cvt_pk_bf16(b[0], b[1]); w.w = cvt_pk_bf16(b[2], b[3]); return w; }

struct EpiZ {
    static constexpr bool PERM = true, KSPLIT = false;
    bf16_t* QKV; bf16_t* A5;
    __device__ __forceinline__ void operator()(f32x4 (&acc)[2][2][4][2], const Unit& u, int wr, int wc, int fr, int fq) const {
#pragma unroll
        for (int ai = 0; ai < 2; ++ai)
#pragma unroll
            for (int m = 0; m < 4; ++m) { const int row = u.pm * BM + ai * HALF + wr * 64 + m * 16 + fr;
#pragma unroll
                for (int bj = 0; bj < 2; ++bj) { const int c8 = u.pn * BM + bj * HALF + wc * 32 + 8 * fq; const u32x4 w = pack8(acc[ai][bj][m][0], acc[ai][bj][m][1]);
                    if (u.pn < 12) *(u32x4*)(QKV + (size_t)row * NQKV + c8) = w;
                    else { const int ch = c8 - NQKV, gg = ch >> 4, c0 = ch & 15, R = row >> 5, s = row & 31; *(u32x4*)(A5 + ((size_t)gg * RCH + R) * KS5 + s * SC + c0) = w; } } }
    }
};
struct EpiE {
    static constexpr bool PERM = false, KSPLIT = false;
    float* E;
    __device__ __forceinline__ void operator()(f32x4 (&acc)[2][2][4][2], const Unit& u, int wr, int wc, int fr, int fq) const {
#pragma unroll
        for (int ai = 0; ai < 2; ++ai)
#pragma unroll
            for (int m = 0; m < 4; ++m) { const int R = u.pm * BM + ai * HALF + wr * 64 + m * 16 + fr; float* rowp = E + ((size_t)u.g * RCH + R) * 256 + wc * 32 + 4 * fq;
#pragma unroll
                for (int bj = 0; bj < 2; ++bj)
#pragma unroll
                    for (int n = 0; n < 2; ++n) *(f32x4*)(rowp + bj * HALF + n * 16) = acc[ai][bj][m][n]; }
    }
};
struct EpiS5Out {
    static constexpr bool PERM = true, KSPLIT = false;
    bf16_t* Yg;
    __device__ __forceinline__ void operator()(f32x4 (&acc)[2][2][4][2], const Unit& u, int wr, int wc, int fr, int fq) const {
#pragma unroll
        for (int ai = 0; ai < 2; ++ai)
#pragma unroll
            for (int m = 0; m < 4; ++m) { const int R = u.pm * BM + ai * HALF + wr * 64 + m * 16 + fr;
#pragma unroll
                for (int bj = 0; bj < 2; ++bj) { const int n8 = u.pn * BM + bj * HALF + wc * 32 + 8 * fq, s = n8 >> 4, c0 = n8 & 15;
                    f32x4 v0 = acc[ai][bj][m][0], v1 = acc[ai][bj][m][1];
#pragma unroll
                    for (int e = 0; e < 4; ++e) { v0[e] = gelu_tanh(v0[e]); v1[e] = gelu_tanh(v1[e]); }
                    *(u32x4*)(Yg + (size_t)(R * CL + s) * SW + u.g * SC + c0) = pack8(v0, v1); } }
    }
};
struct EpiGlu {
    static constexpr bool PERM = true, KSPLIT = false;
    const bf16_t* Yg; const float* bias; bf16_t* YAYS; float* ssq; float alpha;
    __device__ __forceinline__ void operator()(f32x4 (&acc)[2][2][4][2], const Unit& u, int wr, int wc, int fr, int fq) const {
        const int c8b = u.pn * BM + wc * 32 + 8 * fq;
        f32x4 bv[2][2];
#pragma unroll
        for (int bj = 0; bj < 2; ++bj)
#pragma unroll
            for (int n = 0; n < 2; ++n) bv[bj][n] = *(const f32x4*)(bias + c8b + bj * HALF + 4 * n);
#pragma unroll
        for (int ai = 0; ai < 2; ++ai)
#pragma unroll
            for (int m = 0; m < 4; ++m) { const int row = u.pm * BM + ai * HALF + wr * 64 + m * 16 + fr; float ss = 0.f;
#pragma unroll
                for (int bj = 0; bj < 2; ++bj) { const int c8 = c8b + bj * HALF; const u32x4 y = *(const u32x4*)(Yg + (size_t)row * SW + c8);
                    const f32x4 a0 = acc[ai][bj][m][0] + bv[bj][0], a1 = acc[ai][bj][m][1] + bv[bj][1];
                    f32x4 v0, v1;
                    v0[0] = bf_lo(y.x) * sigmoidf_(a0[0]); v0[1] = bf_hi(y.x) * sigmoidf_(a0[1]); v0[2] = bf_lo(y.y) * sigmoidf_(a0[2]); v0[3] = bf_hi(y.y) * sigmoidf_(a0[3]);
                    v1[0] = bf_lo(y.z) * sigmoidf_(a1[0]); v1[1] = bf_hi(y.z) * sigmoidf_(a1[1]); v1[2] = bf_lo(y.w) * sigmoidf_(a1[2]); v1[3] = bf_hi(y.w) * sigmoidf_(a1[3]);
#pragma unroll
                    for (int e = 0; e < 4; ++e) ss += v0[e] * v0[e] + v1[e] * v1[e];
                    *(u32x4*)(YAYS + (size_t)row * DM + AW + c8) = pack8(v0, v1); }
                ss += __shfl_xor(ss, 16); ss += __shfl_xor(ss, 32);
                if (fq == 0) unsafeAtomicAdd(ssq + row, ss * alpha); }
    }
};
struct EpiRes1 {
    static constexpr bool PERM = true, KSPLIT = true;
    const float* x; bf16_t* XB; const float* ssqa; const float* ssqs; float* ssqx; float alpha;
    __device__ __forceinline__ void operator()(f32x4 (&acc)[2][2][4][2], const Unit& u, int wr, int wc, int fr, int fq) const {
        if (u.kh == 0) {
#pragma unroll
        for (int ai = 0; ai < 2; ++ai)
#pragma unroll
            for (int m = 0; m < 4; ++m) { const int row = u.pm * BM + ai * HALF + wr * 64 + m * 16 + fr;
                const float ra = __builtin_amdgcn_rsqf(ssqa[row] * (1.0f / AW) + RMS_EPS), rs = __builtin_amdgcn_rsqf(ssqs[row] * (1.0f / SW) + RMS_EPS), f = ra * fast_rcp(rs);
#pragma unroll
                for (int bj = 0; bj < 2; ++bj)
#pragma unroll
                    for (int n = 0; n < 2; ++n) acc[ai][bj][m][n] *= f; }
        return; }
#pragma unroll
        for (int ai = 0; ai < 2; ++ai)
#pragma unroll
            for (int m = 0; m < 4; ++m) { const int row = u.pm * BM + ai * HALF + wr * 64 + m * 16 + fr; float ss = 0.f;
                const float rs = __builtin_amdgcn_rsqf(ssqs[row] * (1.0f / SW) + RMS_EPS);
#pragma unroll
                for (int bj = 0; bj < 2; ++bj) { const size_t off = (size_t)row * DM + u.pn * BM + bj * HALF + wc * 32 + 8 * fq;
                    const f32x4 x0 = *(const f32x4*)(x + off), x1 = *(const f32x4*)(x + off + 4);
                    const f32x4 v0 = x0 + acc[ai][bj][m][0] * rs, v1 = x1 + acc[ai][bj][m][1] * rs;
#pragma unroll
                    for (int e = 0; e < 4; ++e) ss += v0[e] * v0[e] + v1[e] * v1[e];
                    *(u32x4*)(XB + off) = pack8(v0, v1); }
                ss += __shfl_xor(ss, 16); ss += __shfl_xor(ss, 32);
                if (fq == 0) unsafeAtomicAdd(ssqx + row, ss * alpha);
                asm volatile("" ::: "memory"); }
    }
};
struct EpiSwiGLU {
    static constexpr bool PERM = true, KSPLIT = false;
    bf16_t* H; const float* ssqx;
    __device__ __forceinline__ void operator()(f32x4 (&acc)[2][2][4][2], const Unit& u, int wr, int wc, int fr, int fq) const {
#pragma unroll
        for (int ai = 0; ai < 2; ++ai)
#pragma unroll
            for (int m = 0; m < 4; ++m) { const int row = u.pm * BM + ai * HALF + wr * 64 + m * 16 + fr;
                const float rs = __builtin_amdgcn_rsqf(ssqx[row] * (1.0f / DM) + RMS_EPS);
                f32x4 h0, h1;
#pragma unroll
                for (int e = 0; e < 4; ++e) { const float g0 = acc[ai][0][m][0][e] * rs, u0 = acc[ai][1][m][0][e] * rs, g1 = acc[ai][0][m][1][e] * rs, u1 = acc[ai][1][m][1][e] * rs;
                    h0[e] = g0 * sigmoidf_(g0) * u0; h1[e] = g1 * sigmoidf_(g1) * u1; }
                *(u32x4*)(H + (size_t)row * DFF + u.pn * HALF + wc * 32 + 8 * fq) = pack8(h0, h1); }
    }
};
struct EpiRes2 {
    static constexpr bool PERM = true, KSPLIT = false;
    float* out; const bf16_t* XB; float alpha;
    __device__ __forceinline__ void operator()(f32x4 (&acc)[2][2][4][2], const Unit& u, int wr, int wc, int fr, int fq) const {
#pragma unroll
        for (int ai = 0; ai < 2; ++ai)
#pragma unroll
            for (int m = 0; m < 4; ++m) { const size_t roff = (size_t)(u.pm * BM + ai * HALF + wr * 64 + m * 16 + fr) * DM + u.pn * BM + wc * 32 + 8 * fq;
#pragma unroll
                for (int bj = 0; bj < 2; ++bj) { const size_t off = roff + bj * HALF; const u32x4 xb = *(const u32x4*)(XB + off);
                    f32x4 v0, v1; v0[0] = bf_lo(xb.x); v0[1] = bf_hi(xb.x); v0[2] = bf_lo(xb.y); v0[3] = bf_hi(xb.y); v1[0] = bf_lo(xb.z); v1[1] = bf_hi(xb.z); v1[2] = bf_lo(xb.w); v1[3] = bf_hi(xb.w);
                    *(f32x4*)(out + off) = v0 + acc[ai][bj][m][0] * alpha; *(f32x4*)(out + off + 4) = v1 + acc[ai][bj][m][1] * alpha; }
                asm volatile("" ::: "memory"); }
    }
};
}

#define RLX_AGENT __ATOMIC_RELAXED, __HIP_MEMORY_SCOPE_AGENT
#define XB_TMO      128
#define XB_XCNT(j)  (256  + 64 * (j))
#define XB_XSUB(j)  (1280 + 64 * (j))
#define XB_XGEN(j)  (2304 + 64 * (j))
#define XB_TOP      3328
#define XB_TOPGEN   3392
#define XCD_BAR_WORDS 3456
#define XB_SPIN_CAP (1u << 24)
__device__ __forceinline__ unsigned xb_ld(unsigned* p)              { return __hip_atomic_load(p, __ATOMIC_RELAXED, __HIP_MEMORY_SCOPE_AGENT); }
__device__ __forceinline__ unsigned xb_add(unsigned* p, unsigned v) { return __hip_atomic_fetch_add(p, v, __ATOMIC_RELAXED, __HIP_MEMORY_SCOPE_AGENT); }
__device__ __forceinline__ unsigned xb_xcc_id() { return (unsigned)__builtin_amdgcn_s_getreg((3 << 11) | 20) & 0xFu; }
#define XB_SPIN(cond, bar) do { unsigned _sp = 0; while (cond) { __builtin_amdgcn_s_sleep(1); \
    if ((++_sp & 255u) == 0u) { if (xb_ld(&(bar)[XB_TMO])) break; if (_sp > XB_SPIN_CAP) { atomicAdd(&(bar)[XB_TMO], 1u); break; } } } } while (0)
struct XcdBarrier { unsigned* bar; unsigned x; volatile LAS unsigned* st; };
__device__ __forceinline__ XcdBarrier xcd_barrier_post(unsigned* bar, volatile LAS unsigned* st) {
    XcdBarrier b; b.bar = bar; b.x = xb_xcc_id(); b.st = st;
    if (threadIdx.x == 0) (void)xb_add(&bar[XB_XCNT(b.x)], 1u);
    return b;
}
__device__ __forceinline__ void xcd_barrier_complete(unsigned* bar, unsigned x, unsigned& nloc, unsigned& nx) {
    const unsigned G = gridDim.x * gridDim.y * gridDim.z;
    unsigned sum, cnt, mine, sp = 0u;
    for (;;) {
        sum = 0u; cnt = 0u; mine = 0u;
#pragma unroll
        for (unsigned j = 0; j < 16; ++j) { const unsigned c = xb_ld(&bar[XB_XCNT(j)]); sum += c; cnt += (c > 0u) ? 1u : 0u; mine = (j == x) ? c : mine; }
        if (sum == G) break;
        __builtin_amdgcn_s_sleep(1);
        if ((++sp & 255u) == 0u) { if (xb_ld(&bar[XB_TMO])) break; if (sp > XB_SPIN_CAP) { atomicAdd(&bar[XB_TMO], 1u); break; } }
    }
    nloc = mine > 0u ? mine : 1u; nx = cnt > 0u ? cnt : 1u;
}
__device__ __forceinline__ void xcd_barrier(const XcdBarrier& b) {
    asm volatile("s_waitcnt vmcnt(0)" ::: "memory");
    __syncthreads();
    if (threadIdx.x == 0) {
        unsigned* bar = b.bar;
        __builtin_amdgcn_s_waitcnt(0);
        unsigned nloc = b.st[0], nx = b.st[1];
        if (nloc == 0u) { xcd_barrier_complete(bar, b.x, nloc, nx); b.st[0] = nloc; b.st[1] = nx; }
        const unsigned old = xb_add(&bar[XB_XSUB(b.x)], 1u);
        const unsigned gen = old / nloc;
        if (old + 1u == (gen + 1u) * nloc) {
            __builtin_amdgcn_fence(__ATOMIC_RELEASE, "agent");
            asm volatile("s_waitcnt vmcnt(0)" ::: "memory");
            const unsigned og = xb_add(&bar[XB_TOP], 1u);
            const unsigned tg = og / nx;
            if (og + 1u == (tg + 1u) * nx) xb_add(&bar[XB_TOPGEN], 1u);
            else XB_SPIN(xb_ld(&bar[XB_TOPGEN]) == tg, bar);
            __builtin_amdgcn_fence(__ATOMIC_ACQUIRE, "agent");
            xb_add(&bar[XB_XGEN(b.x)], 1u);
            asm volatile("s_waitcnt vmcnt(0)" ::: "memory");
        } else {
            XB_SPIN(xb_ld(&bar[XB_XGEN(b.x)]) == gen, bar);
            __builtin_amdgcn_fence(__ATOMIC_ACQUIRE, "agent");
            asm volatile("s_waitcnt vmcnt(0)" ::: "memory");
        }
    }
    __syncthreads();
}

struct Args { const float* in[23]; float* out; unsigned char* ws; int ph_lo, ph_hi, li, dup; };
enum { I_X = 0, I_GMIX, I_WIN, I_QG, I_KG, I_RPB, I_ARE, I_AIM, I_BRE, I_BIM, I_CRE, I_CIM, I_LS, I_D, I_WGLU, I_BGLU, I_GOA, I_GOS, I_WOUT, I_GFFN, I_WG, I_WU, I_WD };

#define LDS_WAIT() asm volatile("s_waitcnt lgkmcnt(0)" ::: "memory")

__device__ __forceinline__ void p0_transpose_item(const float* W, int N, const float* kscale, bf16_t* WT, int ldd, int drow0, int k0, int n0, int lane) {
    const int c = lane >> 3, n4 = (lane & 7) * 4;
    const float* src = W + (size_t)(k0 + 8 * c) * N + n0 + n4;
    f32x4 v[2][8];
#pragma unroll
    for (int h = 0; h < 2; ++h)
#pragma unroll
        for (int i = 0; i < 8; ++i) v[h][i] = __builtin_nontemporal_load((const f32x4*)(src + (size_t)i * N + 32 * h));
    if (kscale) { const f32x4 s0 = *(const f32x4*)(kscale + k0 + 8 * c), s1 = *(const f32x4*)(kscale + k0 + 8 * c + 4);
#pragma unroll
        for (int h = 0; h < 2; ++h)
#pragma unroll
            for (int i = 0; i < 8; ++i) v[h][i] *= (i < 4 ? s0[i & 3] : s1[i & 3]); }
#pragma unroll
    for (int h = 0; h < 2; ++h)
#pragma unroll
        for (int e = 0; e < 4; ++e) { u32x4 o; o.x = cvt_pk_bf16(v[h][0][e], v[h][1][e]); o.y = cvt_pk_bf16(v[h][2][e], v[h][3][e]); o.z = cvt_pk_bf16(v[h][4][e], v[h][5][e]); o.w = cvt_pk_bf16(v[h][6][e], v[h][7][e]);
            *(u32x4*)(WT + (size_t)(drow0 + 32 * h + n4 + e) * ldd + k0 + 8 * c) = o; }
}

__device__ __forceinline__ void dsincos(double a, double& s, double& c) {
    const double k = __builtin_rint(a * 0.63661977236758134308);
    double r = __builtin_fma(-k, 1.57079632679489655800e+00, a);
    r = __builtin_fma(-k, 6.12323399573676603587e-17, r);
    const double r2 = r * r;
    double sp = -7.6471637318198164759e-13; sp = sp * r2 + 1.6059043836821614599e-10; sp = sp * r2 - 2.5052108385441718775e-08; sp = sp * r2 + 2.7557319223985890653e-06;
    sp = sp * r2 - 1.9841269841269841270e-04; sp = sp * r2 + 8.3333333333333333333e-03; sp = sp * r2 - 1.6666666666666666667e-01; sp = sp * r2 * r + r;
    double cp = 4.7794773323873852974e-14; cp = cp * r2 - 1.1470745597729724714e-11; cp = cp * r2 + 2.0876756987868098979e-09; cp = cp * r2 - 2.7557319223985890653e-07;
    cp = cp * r2 + 2.4801587301587301587e-05; cp = cp * r2 - 1.3888888888888888889e-03; cp = cp * r2 + 4.1666666666666666667e-02; cp = cp * r2 - 0.5; cp = cp * r2 + 1.0;
    const int q = (int)((long long)k) & 3;
    s = (q == 0) ? sp : (q == 1) ? cp : (q == 2) ? -sp : -cp;
    c = (q == 0) ? cp : (q == 1) ? -sp : (q == 2) ? -cp : sp;
}

__device__ __forceinline__ void p0_s5_tables(const Args& a, LAS unsigned char* lds, int g, int q, int tid) {
    LAS f32x2* LP = (LAS f32x2*)lds;
    LAS float* Bb = (LAS float*)(lds + 33792);
    LAS f32x2* Cm = (LAS f32x2*)(lds + 50176);
    LAS float* Kt = (LAS float*)(lds + 66560);
    const float* a_re = a.in[I_ARE]; const float* a_im = a.in[I_AIM]; const float* b_re = a.in[I_BRE]; const float* b_im = a.in[I_BIM];
    const float* c_re = a.in[I_CRE]; const float* c_im = a.in[I_CIM]; const float* lstep = a.in[I_LS]; const float* dsk = a.in[I_D];
    unsigned char* ws = a.ws;
    __syncthreads();
    for (int i = tid; i < 2 * 64 * 33; i += 512) { const int tau = i % 33, p = (i / 33) & 63, d = i / (33 * 64);
        const double lre = (double)fminf(a_re[(d * SG + g) * SP + p], -1e-4f), lim = (double)a_im[(d * SG + g) * SP + p], dt = exp((double)lstep[d * SG + g]);
        const double mag = exp(lre * dt * tau); double s, c; dsincos(lim * dt * tau, s, c);
        LP[i] = (f32x2){(float)(mag * c), (float)(mag * s)}; }
    for (int i = tid; i < 2 * 64 * 16; i += 512) { const int c = i & 15, p = (i >> 4) & 63, d = i >> 10;
        const double lre = (double)fminf(a_re[(d * SG + g) * SP + p], -1e-4f), lim = (double)a_im[(d * SG + g) * SP + p], dt = exp((double)lstep[d * SG + g]);
        const double mag = exp(lre * dt); double sn, cs; dsincos(lim * dt, sn, cs);
        const double nr = mag * cs - 1.0, ni = mag * sn, den = 1.0 / (lre * lre + lim * lim);
        const double fr = (nr * lre + ni * lim) * den, fi = (ni * lre - nr * lim) * den;
        const size_t bi = (((size_t)d * SG + g) * SP + p) * SC + c; const double br = b_re[bi], bim = b_im[bi];
        Bb[(d * 64 + p) * 32 + c] = (float)(fr * br - fi * bim); Bb[(d * 64 + p) * 32 + 16 + c] = (float)(fr * bim + fi * br);
        const size_t ci = (((size_t)d * SG + g) * SC + c) * SP + p;
        Cm[i] = (f32x2){c_re[ci], c_im[ci]}; }
    __syncthreads();
    if (q == 0 && tid < 128) { const int p = tid & 63, d = tid >> 6; ((f32x2*)(ws + WS_LAML))[(g * 2 + d) * SP + p] = LP[(d * 64 + p) * 33 + CL]; }
    { const int tau = tid >> 4, c = tid & 15;
      for (int d = 0; d < 2; ++d) { f32x4 kacc[4];
#pragma unroll
        for (int e = 0; e < 4; ++e) kacc[e] = (f32x4){0.f, 0.f, 0.f, 0.f};
#pragma unroll 4
        for (int p = 0; p < 64; ++p) { const f32x2 cm = Cm[(d * 64 + p) * 16 + c], lp = LP[(d * 64 + p) * 33 + tau];
            const float gr = cm.x * lp.x - cm.y * lp.y, gi = -(cm.x * lp.y + cm.y * lp.x);
            const LAS f32x4* bp = (const LAS f32x4*)(Bb + (d * 64 + p) * 32);
#pragma unroll
            for (int e = 0; e < 4; ++e) kacc[e] += bp[e] * gr + bp[4 + e] * gi; }
#pragma unroll
        for (int e = 0; e < 4; ++e) *(LAS f32x4*)(Kt + ((d * 32 + tau) * 16 + c) * 16 + 4 * e) = kacc[e]; } }
    __syncthreads();
    { const int d = q >> 1, ri = q & 1, p = tid >> 3, s0 = (tid & 7) * 4;
      bf16_t* dst = (bf16_t*)(ws + WS_WST) + ((size_t)g * 256 + q * 64 + p) * 512 + s0 * 16;
#pragma unroll
      for (int sp = 0; sp < 4; ++sp) { const int pw = d == 0 ? (CL - 1 - (s0 + sp)) : (s0 + sp); const f32x2 lp = LP[(d * 64 + p) * 33 + pw]; float v[16];
#pragma unroll
          for (int e = 0; e < 16; ++e) { const float bx_ = Bb[(d * 64 + p) * 32 + e], by_ = Bb[(d * 64 + p) * 32 + 16 + e]; v[e] = ri == 0 ? (lp.x * bx_ - lp.y * by_) : (lp.x * by_ + lp.y * bx_); }
          u32x4 w0, w1; w0.x = cvt_pk_bf16(v[0], v[1]); w0.y = cvt_pk_bf16(v[2], v[3]); w0.z = cvt_pk_bf16(v[4], v[5]); w0.w = cvt_pk_bf16(v[6], v[7]);
          w1.x = cvt_pk_bf16(v[8], v[9]); w1.y = cvt_pk_bf16(v[10], v[11]); w1.z = cvt_pk_bf16(v[12], v[13]); w1.w = cvt_pk_bf16(v[14], v[15]);
          *(u32x4*)(dst + sp * 16) = w0; *(u32x4*)(dst + sp * 16 + 8) = w1; } }
    { const int rl = tid >> 2, s = 8 * q + (rl >> 4), c = rl & 15, part = tid & 3;
      bf16_t* dst = (bf16_t*)(ws + WS_TW) + ((size_t)g * 512 + s * 16 + c) * KS5;
      const float dsv = dsk[g * SC + c];
      for (int j = 0; j < 24; ++j) { const int k0 = part * 192 + j * 8; float v[8];
          if (k0 < 512) { const int sp = k0 >> 4, c0 = k0 & 15;
#pragma unroll
              for (int e = 0; e < 8; ++e) { float t = 0.f;
                  if (sp <= s) t += Kt[((0 * 32 + (s - sp)) * 16 + c) * 16 + c0 + e];
                  if (sp >= s) t += Kt[((1 * 32 + (sp - s)) * 16 + c) * 16 + c0 + e];
                  if (sp == s && c0 + e == c) t += dsv;
                  v[e] = t; }
          } else { const int kk = k0 - 512, d = kk >> 7, ri = (kk >> 6) & 1, p0 = kk & 63, pw = d == 0 ? (s + 1) : (CL - s);
#pragma unroll
              for (int e = 0; e < 8; ++e) { const f32x2 cm = Cm[(d * 64 + p0 + e) * 16 + c], lp = LP[(d * 64 + p0 + e) * 33 + pw];
                  v[e] = ri == 0 ? (cm.x * lp.x - cm.y * lp.y) : -(cm.x * lp.y + cm.y * lp.x); }
          }
          u32x4 w; w.x = cvt_pk_bf16(v[0], v[1]); w.y = cvt_pk_bf16(v[2], v[3]); w.z = cvt_pk_bf16(v[4], v[5]); w.w = cvt_pk_bf16(v[6], v[7]);
          *(u32x4*)(dst + k0) = w; } }
    __syncthreads();
}

__device__ __forceinline__ void p0_prologue(const Args& a, LAS unsigned char* lds, int vcu, int G, int tid) {
    asm volatile("" : "+v"(tid));
    const int wave = __builtin_amdgcn_readfirstlane(tid >> 6), lane = tid & 63;
    unsigned char* ws = a.ws;
    if (vcu & 1) { for (int it = vcu; it < SG * 4; it += G) p0_s5_tables(a, lds, it >> 2, it & 3, tid); }
    const int gw = vcu * 8 + wave, NGW = G * 8;
    constexpr int I_IN = (DM / 64) * (INW / 64), I_GL = (SW / 64) * (SW / 64), I_OUT = (DM / 64) * (DM / 64), I_GU = (DM / 64) * (DFF / 64), I_DN = (DFF / 64) * (DM / 64);
    constexpr int NITEMS = I_IN + I_GL + I_OUT + 2 * I_GU + I_DN;
    for (int it = gw; it < NITEMS; it += NGW) {
        int r = it;
        if (r < I_IN) { const int nb = INW / 64, kb = r / nb, n0 = (r % nb) * 64; p0_transpose_item(a.in[I_WIN], INW, nullptr, (bf16_t*)(ws + WS_WIN), DM, n0, kb * 64, n0, lane); continue; } r -= I_IN;
        if (r < I_GL) { const int nb = SW / 64, kb = r / nb, n0 = (r % nb) * 64; p0_transpose_item(a.in[I_WGLU], SW, nullptr, (bf16_t*)(ws + WS_WGLU), SW, n0, kb * 64, n0, lane); continue; } r -= I_GL;
        if (r < I_OUT) { const int nb = DM / 64, kb = r / nb, n0 = (r % nb) * 64, k0 = kb * 64;
            p0_transpose_item(a.in[I_WOUT], DM, k0 < AW ? a.in[I_GOA] : a.in[I_GOS] - AW, (bf16_t*)(ws + WS_WOUT), DM, n0, k0, n0, lane); continue; } r -= I_OUT;
        if (r < 2 * I_GU) { const int up = r >= I_GU; if (up) r -= I_GU; const int nb = DFF / 64, kb = r / nb, n0 = (r % nb) * 64;
            p0_transpose_item(up ? a.in[I_WU] : a.in[I_WG], DFF, a.in[I_GFFN], (bf16_t*)(ws + WS_WGU), DM, 256 * (n0 >> 7) + (n0 & 127) + (up ? 128 : 0), kb * 64, n0, lane); continue; } r -= 2 * I_GU;
        { const int nb = DM / 64, kb = r / nb, n0 = (r % nb) * 64; p0_transpose_item(a.in[I_WD], DM, nullptr, (bf16_t*)(ws + WS_WD), DFF, n0, kb * 64, n0, lane); }
    }
    const float* x = a.in[I_X]; const float* gm = a.in[I_GMIX]; bf16_t* XN = (bf16_t*)(ws + WS_XN);
    for (int m = gw; m < M; m += NGW) { const f32x4* xr = (const f32x4*)(x + (size_t)m * DM) + lane; f32x4 v[8]; float s = 0.f;
#pragma unroll
        for (int j = 0; j < 8; ++j) { v[j] = xr[64 * j]; s += (v[j][0] * v[j][0] + v[j][1] * v[j][1]) + (v[j][2] * v[j][2] + v[j][3] * v[j][3]); }
        const float rstd = 1.0f / sqrtf(wave_sum(s) * (1.0f / DM) + RMS_EPS);
        u32x2* o8 = (u32x2*)(XN + (size_t)m * DM) + lane;
#pragma unroll
        for (int j = 0; j < 8; ++j) { const f32x4 gv = ((const f32x4*)gm)[64 * j + lane]; u32x2 w; w.x = cvt_pk_bf16(v[j][0] * rstd * gv[0], v[j][1] * rstd * gv[1]); w.y = cvt_pk_bf16(v[j][2] * rstd * gv[2], v[j][3] * rstd * gv[3]); o8[64 * j] = w; } }
    if (!(vcu & 1)) { for (int it = vcu; it < SG * 4; it += G) p0_s5_tables(a, lds, it >> 2, it & 3, tid); }
}

constexpr int VROW = 160;
constexpr int VBUF = 32 * VROW;
constexpr int ATT_RPB_OFF = 8 * 2 * VBUF;
static_assert(ATT_RPB_OFF + 16 * 465 * 4 <= MISC_OFF, "attention LDS");

__device__ __forceinline__ void attn_phase(const Args& a, LAS unsigned char* lds, int vcu, int G, int tid, float alpha) {
    asm volatile("" : "+v"(tid));
    const int wave = __builtin_amdgcn_readfirstlane(tid >> 6), lane = tid & 63, ql = lane & 15, g4 = lane >> 4;
    const bf16_t* QKV = (const bf16_t*)(a.ws + WS_BIG); bf16_t* YAYS = (bf16_t*)(a.ws + WS_YAYS); float* ssqa = (float*)(a.ws + WS_CTL) + CW_SSQA;
    LAS float* rpbL = (LAS float*)(lds + ATT_RPB_OFF);
    for (int i = tid; i < 16 * 465; i += 512) rpbL[i] = a.in[I_RPB][i];
    __syncthreads();
    LAS unsigned char* vb = lds + wave * 2 * VBUF;
    const int j = wave & 3, hsel = wave >> 2;
    const int cq = 16 * j + ql, cs = min(max(cq - 8, 0), GRIDW - 16), wb = (j == 0) ? 0 : (j == 1) ? 8 : (j == 2) ? 24 : 32;
    float gg[16];
#pragma unroll
    for (int ks = 0; ks < 2; ++ks)
#pragma unroll
        for (int e = 0; e < 8; ++e) { const int d = 32 * ks + 8 * g4 + e; gg[ks * 8 + e] = a.in[I_QG][d] * a.in[I_KG][d] * 0.125f; }
    for (int un = vcu; un < BATCH * NROWS; un += G) {
        const int b = un >> 6, r = un & 63, row_start = min(max(r - 4, 0), NROWS - 8);
        const size_t tq = (size_t)b * SEQ + 64 * r + cq;
        float ssq_acc = 0.f;
        for (int it = 0; it < 8; ++it) { const int h = 2 * it + hsel;
            bf16x8 Qf[2];
            { const u32x4* qp = (const u32x4*)(QKV + tq * NQKV + 64 * h + 8 * g4); const u32x4 q0 = qp[0], q1 = qp[4]; float qf[16];
              qf[0] = bf_lo(q0.x); qf[1] = bf_hi(q0.x); qf[2] = bf_lo(q0.y); qf[3] = bf_hi(q0.y); qf[4] = bf_lo(q0.z); qf[5] = bf_hi(q0.z); qf[6] = bf_lo(q0.w); qf[7] = bf_hi(q0.w);
              qf[8] = bf_lo(q1.x); qf[9] = bf_hi(q1.x); qf[10] = bf_lo(q1.y); qf[11] = bf_hi(q1.y); qf[12] = bf_lo(q1.z); qf[13] = bf_hi(q1.z); qf[14] = bf_lo(q1.w); qf[15] = bf_hi(q1.w);
              float ss = 0.f;
#pragma unroll
              for (int e = 0; e < 16; ++e) ss += qf[e] * qf[e];
              ss += __shfl_xor(ss, 16); ss += __shfl_xor(ss, 32);
              const float rq = __builtin_amdgcn_rsqf(ss * (1.0f / HD) + RMS_EPS);
#pragma unroll
              for (int e = 0; e < 16; ++e) qf[e] *= rq * gg[e];
              u32x4 w0, w1; w0.x = cvt_pk_bf16(qf[0], qf[1]); w0.y = cvt_pk_bf16(qf[2], qf[3]); w0.z = cvt_pk_bf16(qf[4], qf[5]); w0.w = cvt_pk_bf16(qf[6], qf[7]);
              w1.x = cvt_pk_bf16(qf[8], qf[9]); w1.y = cvt_pk_bf16(qf[10], qf[11]); w1.z = cvt_pk_bf16(qf[12], qf[13]); w1.w = cvt_pk_bf16(qf[14], qf[15]);
              Qf[0] = __builtin_bit_cast(bf16x8, w0); Qf[1] = __builtin_bit_cast(bf16x8, w1); }
            f32x4 S[8][2];
            const bf16_t* kbase = QKV + ((size_t)b * SEQ + 64 * row_start + wb + ql) * NQKV + AW + 64 * h + 8 * g4;
            const LAS float* bl = rpbL + h * 465 + (row_start - r + 7) * 31 + (wb + 4 * g4 - cq + 15);
#pragma unroll
            for (int kr = 0; kr < 8; ++kr)
#pragma unroll
                for (int t = 0; t < 2; ++t) {
                    const u32x4* kp = (const u32x4*)(kbase + (size_t)(64 * kr + 16 * t) * NQKV); const u32x4 k0 = kp[0], k1 = kp[4];
                    float ss = 0.f;
                    { const unsigned kw[8] = {k0.x, k0.y, k0.z, k0.w, k1.x, k1.y, k1.z, k1.w};
#pragma unroll
                      for (int e = 0; e < 8; ++e) { const float lo = bf_lo(kw[e]), hi = bf_hi(kw[e]); ss += lo * lo + hi * hi; } }
                    ss += __shfl_xor(ss, 16); ss += __shfl_xor(ss, 32);
                    const float rk = __builtin_amdgcn_rsqf(ss * (1.0f / HD) + RMS_EPS);
                    f32x4 acc = (f32x4){0.f, 0.f, 0.f, 0.f};
                    acc = __builtin_amdgcn_mfma_f32_16x16x32_bf16(__builtin_bit_cast(bf16x8, k0), Qf[0], acc, 0, 0, 0);
                    acc = __builtin_amdgcn_mfma_f32_16x16x32_bf16(__builtin_bit_cast(bf16x8, k1), Qf[1], acc, 0, 0, 0);
#pragma unroll
                    for (int e = 0; e < 4; ++e) { const float rkr = __shfl(rk, 4 * g4 + e); const int ck = wb + 16 * t + 4 * g4 + e;
                        const float bias = bl[kr * 31 + 16 * t + e];
                        acc[e] = (ck >= cs && ck < cs + 16) ? acc[e] * rkr + bias : -1e30f; }
                    S[kr][t] = acc; }
            float mx = -1e30f;
#pragma unroll
            for (int kr = 0; kr < 8; ++kr)
#pragma unroll
                for (int t = 0; t < 2; ++t)
#pragma unroll
                    for (int e = 0; e < 4; ++e) mx = fmaxf(mx, S[kr][t][e]);
            mx = fmaxf(mx, __shfl_xor(mx, 16)); mx = fmaxf(mx, __shfl_xor(mx, 32));
            float sum = 0.f; bf16x8 Pf[8];
#pragma unroll
            for (int kr = 0; kr < 8; ++kr) { f32x4 p0, p1;
#pragma unroll
                for (int e = 0; e < 4; ++e) { p0[e] = fast_exp2((S[kr][0][e] - mx) * 1.44269504089f); p1[e] = fast_exp2((S[kr][1][e] - mx) * 1.44269504089f); sum += p0[e] + p1[e]; }
                Pf[kr] = __builtin_bit_cast(bf16x8, pg8::pack8(p0, p1)); }
            sum += __shfl_xor(sum, 16); sum += __shfl_xor(sum, 32);
            f32x4 O[4];
#pragma unroll
            for (int dt = 0; dt < 4; ++dt) O[dt] = (f32x4){0.f, 0.f, 0.f, 0.f};
            const bf16_t* vbase = QKV + ((size_t)b * SEQ + 64 * row_start + wb + (lane >> 3)) * NQKV + 2 * AW + 64 * h + 8 * (lane & 7);
            u32x4 vr[3][4];
#pragma unroll
            for (int i = 0; i < 4; ++i) vr[0][i] = *(const u32x4*)(vbase + (size_t)(8 * i) * NQKV);
#pragma unroll
            for (int i = 0; i < 4; ++i) vr[1][i] = *(const u32x4*)(vbase + (size_t)(64 + 8 * i) * NQKV);
#pragma unroll
            for (int kr = 0; kr < 8; ++kr) {
                if (kr + 2 < 8) {
#pragma unroll
                    for (int i = 0; i < 4; ++i) vr[(kr + 2) % 3][i] = *(const u32x4*)(vbase + (size_t)(64 * (kr + 2) + 8 * i) * NQKV); }
                LAS unsigned char* vbuf = vb + (kr & 1) * VBUF;
#pragma unroll
                for (int i = 0; i < 4; ++i) *(LAS u32x4*)(vbuf + ((lane >> 3) + 8 * i) * VROW + (lane & 7) * 16) = vr[kr % 3][i];
                const LAS unsigned char* rp = vbuf + (4 * g4 + ((lane & 15) >> 2)) * VROW + (lane & 3) * 8;
#pragma unroll
                for (int dt = 0; dt < 4; ++dt) {
                    const s16x4 lo = __builtin_amdgcn_ds_read_tr16_b64_v4i16((LAS s16x4*)(rp + dt * 32));
                    const s16x4 hi = __builtin_amdgcn_ds_read_tr16_b64_v4i16((LAS s16x4*)(rp + 16 * VROW + dt * 32));
                    const bf16x8 av = (bf16x8){lo[0], lo[1], lo[2], lo[3], hi[0], hi[1], hi[2], hi[3]};
                    O[dt] = __builtin_amdgcn_mfma_f32_16x16x32_bf16(av, Pf[kr], O[dt], 0, 0, 0); }
            }
            const float inv = fast_rcp(sum);
            bf16_t* op = YAYS + tq * DM + 64 * h + 4 * g4;
#pragma unroll
            for (int dt = 0; dt < 4; ++dt) { const f32x4 o = O[dt] * inv; ssq_acc += (o[0] * o[0] + o[1] * o[1]) + (o[2] * o[2] + o[3] * o[3]);
                u32x2 w; w.x = cvt_pk_bf16(o[0], o[1]); w.y = cvt_pk_bf16(o[2], o[3]); *(u32x2*)(op + 16 * dt) = w; }
        }
        ssq_acc += __shfl_xor(ssq_acc, 16); ssq_acc += __shfl_xor(ssq_acc, 32);
        if (g4 == 0) unsafeAtomicAdd(ssqa + tq, ssq_acc * alpha);
    }
}

__device__ __forceinline__ void scan_phase(const Args& a, int vcu, int G, int tid) {
    asm volatile("" : "+v"(tid));
    if (tid >= 128) return;
    const float* E = (const float*)(a.ws + WS_E); bf16_t* A5 = (bf16_t*)(a.ws + WS_A5); const f32x2* LAML = (const f32x2*)(a.ws + WS_LAML);
    for (int idx = vcu * 128 + tid; idx < BATCH * SG * 2 * SP; idx += G * 128) {
        const int p = idx & 63, d = (idx >> 6) & 1, g = (idx >> 7) & 63, b = idx >> 13;
        const f32x2 lam = LAML[(g * 2 + d) * SP + p];
        float xr = 0.f, xi = 0.f;
#pragma unroll 8
        for (int kk = 0; kk < NCH; ++kk) { const int k = d == 0 ? kk : NCH - 1 - kk; const size_t R = (size_t)g * RCH + b * NCH + k;
            bf16_t* ap = A5 + R * KS5 + 512 + d * 128 + p; ap[0] = (bf16_t)(cvt_pk_bf16(xr, 0.f) & 0xffffu); ap[64] = (bf16_t)(cvt_pk_bf16(xi, 0.f) & 0xffffu);
            const float er = E[R * 256 + d * 128 + p], ei = E[R * 256 + d * 128 + 64 + p];
            const float nr = lam.x * xr - lam.y * xi + er, ni = lam.x * xi + lam.y * xr + ei; xr = nr; xi = ni; }
    }
}

__global__ void __launch_bounds__(512, 2) hymba_fwd(Args args) {
    extern __shared__ __attribute__((aligned(16))) unsigned char lds_raw[];
    LAS unsigned char* lds = (LAS unsigned char*)lds_raw;
    volatile LAS unsigned* MISC = (volatile LAS unsigned*)(lds + MISC_OFF);
    const int tid = threadIdx.x;
    const int G = gridDim.x; const int bx = blockIdx.x; const int vcu = (G % 8 == 0) ? (bx % 8) * (G / 8) + bx / 8 : bx;
    unsigned char* ws = args.ws;
    unsigned* ctl = (unsigned*)(ws + WS_CTL);
    for (int u = tid; u < (LDS_BYTES - MISC_OFF) / 4; u += 512) MISC[u] = 0u;
    __syncthreads();
    XcdBarrier bar; bar.bar = ctl + CW_BAR; bar.x = 0; bar.st = nullptr;
    if (MK_N_LAUNCHES == 1) bar = xcd_barrier_post(ctl + CW_BAR, MISC + 8);
    const int lo = args.ph_lo, hi = args.ph_hi;
#define IN(k) (lo <= (k) && (k) < hi)
#define SEAM(k) do { if (IN(k) && IN((k) + 1)) xcd_barrier(bar); } while (0)
    bf16_t* WIN = (bf16_t*)(ws + WS_WIN); bf16_t* WGLU = (bf16_t*)(ws + WS_WGLU); bf16_t* WOUT = (bf16_t*)(ws + WS_WOUT); bf16_t* WGU = (bf16_t*)(ws + WS_WGU); bf16_t* WD = (bf16_t*)(ws + WS_WD);
    bf16_t* WST = (bf16_t*)(ws + WS_WST); bf16_t* TW = (bf16_t*)(ws + WS_TW);
    bf16_t* XN = (bf16_t*)(ws + WS_XN); bf16_t* YG = (bf16_t*)(ws + WS_XN); bf16_t* XB = (bf16_t*)(ws + WS_XN);
    bf16_t* QKV = (bf16_t*)(ws + WS_BIG); bf16_t* A5 = (bf16_t*)(ws + WS_A5); float* E = (float*)(ws + WS_E); bf16_t* HB = (bf16_t*)(ws + WS_BIG);
    bf16_t* YAYS = (bf16_t*)(ws + WS_YAYS);
    float* ssqa = (float*)ctl + CW_SSQA; float* ssqs = (float*)ctl + CW_SSQS; float* ssqx = (float*)ctl + CW_SSQX;

#define REP(k) _Pragma("unroll") for (int rep_ = (DUP_PHASE == (k)) ? 0 : 1; rep_ < 2; ++rep_)
#define ALPHA ((rep_ == 0 && args.dup >= 0) ? 0.0f : 1.0f)
    if (IN(0)) { REP(0) { p0_prologue(args, lds, vcu, G, tid); __syncthreads(); } SEAM(0); }
    if (IN(1)) {
        pg8::Gemm g{XN, WIN, DM, DM, DM, 0, 0}; pg8::StaticOrder S; S.init(M, INW, G, bx);
        pg8::EpiZ Ep{QKV, A5};
        REP(1) pg8::gemm_phase(lds, g, S, Ep);
        SEAM(1);
    }
    if (IN(2)) {
        { pg8::Gemm g{A5, WST, KS5, 512, 512, (size_t)RCH * KS5, (size_t)256 * 512}; pg8::BatchOrder S; S.init(2, 1, SG * (DUP_PHASE == 2 ? 2 : 1), G, bx);
          pg8::EpiE Ep{E};
          pg8::gemm_phase(lds, g, S, Ep); }
        __syncthreads();
        REP(9) { attn_phase(args, lds, vcu, G, tid, ALPHA); __syncthreads(); }
        SEAM(2);
    }
    if (IN(3)) { REP(3) scan_phase(args, vcu, G, tid); SEAM(3); }
    if (IN(4)) {
        pg8::Gemm g{A5, TW, KS5, KS5, KS5, (size_t)RCH * KS5, (size_t)512 * KS5}; pg8::BatchOrder S; S.init(2, 2, SG * (DUP_PHASE == 4 ? 2 : 1), G, bx);
        pg8::EpiS5Out Ep{YG};
        pg8::gemm_phase(lds, g, S, Ep);
        SEAM(4);
    }
    if (IN(5)) {
        pg8::Gemm g{YG, WGLU, SW, SW, SW, 0, 0}; pg8::StaticOrder S; S.init(M, SW, G, bx);
        REP(5) { pg8::EpiGlu Ep{YG, args.in[I_BGLU], YAYS, ssqs, ALPHA}; pg8::gemm_phase(lds, g, S, Ep); }
        SEAM(5);
    }
    if (IN(6)) {
        pg8::Gemm g{YAYS, WOUT, DM, DM, AW, 0, 0}; pg8::SplitKOrder S; S.so.init(M, DM, G, bx);
        REP(6) { pg8::EpiRes1 Ep{args.in[I_X], XB, ssqa, ssqs, ssqx, ALPHA}; pg8::gemm_phase(lds, g, S, Ep); }
        SEAM(6);
    }
    if (IN(7)) {
        pg8::Gemm g{XB, WGU, DM, DM, DM, 0, 0}; pg8::StaticOrder S; S.init(M, 2 * DFF, G, bx);
        pg8::EpiSwiGLU Ep{HB, ssqx};
        REP(7) pg8::gemm_phase(lds, g, S, Ep);
        SEAM(7);
    }
    if (IN(8)) {
        pg8::Gemm g{HB, WD, DFF, DFF, DFF, 0, 0}; pg8::StaticOrder S; S.init(M, DM, G, bx);
        REP(8) { pg8::EpiRes2 Ep{args.out, XB, ALPHA}; pg8::gemm_phase(lds, g, S, Ep); }
    }
#undef IN
#undef SEAM
}

extern "C" void kernel_launch(void* const* d_in, const int* in_sizes, int n_in, void* d_out, int out_size, void* d_ws, size_t ws_size, hipStream_t stream) {
    static int grid = 0;
    if (grid == 0) {
        if (n_in != 23 || in_sizes[0] != M * DM || out_size != M * DM || ws_size < WS_END) { fprintf(stderr, "kernel_launch: unexpected shapes (n_in %d, in0 %d, out %d, ws %zu < %zu)\n", n_in, n_in > 0 ? in_sizes[0] : -1, out_size, ws_size, (size_t)WS_END); grid = -1; return; }
        int dev = 0, cus = 0, per_cu = 0;
        if (hipGetDevice(&dev) != hipSuccess || hipDeviceGetAttribute(&cus, hipDeviceAttributeMultiprocessorCount, dev) != hipSuccess) { grid = -1; return; }
        if (hipFuncSetAttribute((const void*)hymba_fwd, hipFuncAttributeMaxDynamicSharedMemorySize, LDS_BYTES) != hipSuccess) { fprintf(stderr, "kernel_launch: hipFuncSetAttribute failed\n"); grid = -1; return; }
        if (hipOccupancyMaxActiveBlocksPerMultiprocessor(&per_cu, (const void*)hymba_fwd, 512, LDS_BYTES) != hipSuccess || per_cu < 1) { fprintf(stderr, "kernel_launch: occupancy query says %d blocks per CU\n", per_cu); (void)hipGetLastError(); per_cu = 1; }
        grid = cus;
    }
    if (grid < 0) return;
    (void)hipMemsetAsync((char*)d_ws + WS_CTL, 0, CTL_ZERO_BYTES, stream);
    Args a{}; a.dup = DUP_PHASE;
    for (int i = 0; i < 23; ++i) a.in[i] = (const float*)d_in[i];
    a.out = (float*)d_out; a.ws = (unsigned char*)d_ws;
    if (MK_N_LAUNCHES == 1) {
        a.ph_lo = 0; a.ph_hi = NPHASE; a.li = 0;
        hipLaunchKernelGGL(hymba_fwd, dim3(grid), dim3(512), LDS_BYTES, stream, a);
    } else {
        for (int li = 0; li < NPHASE; ++li) { a.ph_lo = li; a.ph_hi = li + 1; a.li = li; hipLaunchKernelGGL(hymba_fwd, dim3(grid), dim3(512), LDS_BYTES, stream, a); }
    }
}
```

```cpp
#include <hip/hip_runtime.h>
#include <cstdio>
#include <cstdint>

#define DUP_PHASE (-1)
#ifndef MK_N_LAUNCHES
#define MK_N_LAUNCHES 1
#endif

#define GAS __attribute__((address_space(1)))
#define LAS __attribute__((address_space(3)))
typedef unsigned short bf16_t;
typedef short bf16x8 __attribute__((ext_vector_type(8)));
typedef short s16x4 __attribute__((ext_vector_type(4)));
typedef float f32x4 __attribute__((ext_vector_type(4)));
typedef float f32x2 __attribute__((ext_vector_type(2)));
typedef unsigned u32x4 __attribute__((ext_vector_type(4)));
typedef unsigned u32x2 __attribute__((ext_vector_type(2)));

constexpr int BATCH = 4, SEQ = 4096, DM = 2048, M = BATCH * SEQ;
constexpr int AW = 1024, SW = 1024, NH = 16, HD = 64, NQKV = 3 * AW, INW = 4096, DFF = 5632;
constexpr int GRIDW = 64, NROWS = SEQ / GRIDW;
constexpr int SG = 64, SC = 16, SP = 64;
constexpr int CL = 32, NCH = SEQ / CL, RCH = M / CL;
constexpr int KS5 = CL * SC + 256;
constexpr float RMS_EPS = 1e-6f;
constexpr int NPHASE = 9;

constexpr size_t MiB = 1u << 20;
constexpr size_t WS_CTL = 0, CTL_ZERO_BYTES = 65536;
constexpr size_t WS_WIN = 1 * MiB, WS_WGLU = 17 * MiB, WS_WOUT = 19 * MiB, WS_WGU = 27 * MiB, WS_WD = 71 * MiB;
constexpr size_t WS_WST = 93 * MiB, WS_TW = 109 * MiB, WS_LAML = 157 * MiB;
constexpr size_t WS_XN = 158 * MiB;
constexpr size_t WS_BIG = 222 * MiB;
constexpr size_t WS_A5 = WS_BIG + 96 * MiB, WS_E = WS_BIG + 144 * MiB;
constexpr size_t WS_YAYS = 398 * MiB, WS_SSQ = 462 * MiB, WS_END = 464 * MiB;
constexpr size_t WS_SSQA16 = WS_SSQ, WS_SSQA = WS_SSQ + 1 * MiB, WS_SSQS4 = WS_SSQA + 65536, WS_SSQX8 = WS_SSQS4 + 4 * 65536;
constexpr int CW_BAR = 4096;
static_assert((size_t)(CW_BAR + 3456) * 4 <= CTL_ZERO_BYTES, "ctl");

constexpr int RING_BYTES = 131072;
constexpr int MISC_OFF = 143360;
constexpr int LDS_BYTES = 147456;

__device__ __forceinline__ unsigned cvt_pk_bf16(float lo, float hi) { unsigned r; asm volatile("v_cvt_pk_bf16_f32 %0, %1, %2" : "=v"(r) : "v"(lo), "v"(hi)); return r; }
__device__ __forceinline__ float bf_lo(unsigned w) { return __uint_as_float(w << 16); }
__device__ __forceinline__ float bf_hi(unsigned w) { return __uint_as_float(w & 0xffff0000u); }
__device__ __forceinline__ float fast_rcp(float x) { return __builtin_amdgcn_rcpf(x); }
__device__ __forceinline__ float fast_exp2(float x) { return __builtin_amdgcn_exp2f(x); }
__device__ __forceinline__ float sigmoidf_(float x) { return fast_rcp(1.0f + fast_exp2(-1.44269504089f * x)); }
__device__ __forceinline__ float gelu_tanh(float x) { const float t = x * (1.0f + 0.044715f * x * x); return x * fast_rcp(1.0f + fast_exp2(-2.30220818f * t)); }
__device__ __forceinline__ float wave_sum(float v) {
#pragma unroll
    for (int o = 1; o < 64; o <<= 1) v += __shfl_xor(v, o);
    return v;
}

namespace pg8 {
constexpr int BM = 256, BK = 64, HALF = 128, HTB = HALF * BK * 2, NXCD = 8, WGM = 8;
__host__ __device__ __forceinline__ int lds_byte(int r, int c) { const int st = (r >> 4) * 2 + (c >> 5), rr = r & 15, cc = c & 31, ob = rr * 64 + cc * 2; return st * 1024 + (ob ^ (((ob >> 9) & 1) << 5)); }
__host__ __device__ __forceinline__ void stage_rc(int b, int& R, int& C) { const int st = b / 1024, sb = b % 1024, swz = sb ^ (((sb >> 9) & 1) << 5); R = (st >> 1) * 16 + swz / 64; C = (st & 1) * 32 + (swz % 64) / 2; }
__host__ __device__ __forceinline__ int perm32(int rho) { const int n = rho >> 4, i = rho & 15; return 8 * (i >> 2) + 4 * n + (i & 3); }

struct Unit { int pm, pn, g, kh; };
struct Gemm { const bf16_t* A; const bf16_t* Bt; int lda, ldb, K; size_t sA, sB; };

struct StaticOrder {
    int nM, nN, nwg, G, c;
    __device__ void init(int M_, int N_, int G_, int c_) { nM = M_ / BM; nN = N_ / BM; nwg = nM * nN; G = G_; c = c_; }
    __device__ bool next(int i, Unit& u) const {
        const long L = (long)i * G + c; if (L >= nwg) return false;
        int wgid = (int)L; { const int q = nwg / NXCD, r = nwg % NXCD, xcd = wgid % NXCD, off = wgid / NXCD; wgid = (xcd < r ? xcd * (q + 1) : r * (q + 1) + (xcd - r) * q) + off; }
        const int nig = WGM * nN, gid = wgid / nig, fm = gid * WGM, gsz = (nM - fm) < WGM ? (nM - fm) : WGM;
        u.pm = fm + ((wgid % nig) % gsz); u.pn = (wgid % nig) / gsz; u.g = 0; u.kh = 0; return true;
    }
};
struct SplitKOrder {
    StaticOrder so;
    __device__ bool next(int i, Unit& u) const { if (!so.next(i >> 1, u)) return false; u.kh = i & 1; return true; }
};
struct BatchOrder {
    int nM, nN, nwg, G, c;
    __device__ void init(int nM_, int nN_, int nb, int G_, int c_) { nM = nM_; nN = nN_; nwg = nM * nN * nb; G = G_; c = c_; }
    __device__ bool next(int i, Unit& u) const {
        const long L = (long)i * G + c; if (L >= nwg) return false;
        const int l = (int)L; u.pn = l % nN; u.pm = (l / nN) % nM; u.g = (l / (nN * nM)) % SG; u.kh = 0; return true;
    }
};

template <class Epi, class Sched>
__device__ __forceinline__ void gemm_phase(LAS unsigned char* lds, const Gemm g, const Sched& S, const Epi& E) {
    int tid = threadIdx.x; asm volatile("" : "+v"(tid));
    const int wid = __builtin_amdgcn_readfirstlane(tid >> 6), lane = tid & 63, wr = wid >> 2, wc = wid & 3, fr = lane & 15, fq = lane >> 4;
    const int K = g.K, nt = K / BK;
    unsigned voffA[2], voffB[2];
#pragma unroll
    for (int i = 0; i < 2; ++i) { int R, C; stage_rc(tid * 16 + i * 8192, R, C); const int Rb = Epi::PERM ? ((R & ~31) + perm32(R & 31)) : R;
        voffA[i] = (unsigned)(R * g.lda + C) * 2u; voffB[i] = (unsigned)(Rb * g.ldb + C) * 2u; }
    const size_t kstep = (size_t)(BK * 2);
    const size_t hstepA = (size_t)HALF * g.lda * 2, hstepB = (size_t)HALF * g.ldb * 2;
    const unsigned ldsw = (unsigned)wid * 1024u;
    const int aoff = lds_byte(wr * 64 + fr, fq * 8), boff = lds_byte(wc * 32 + fr, fq * 8);
#define PG8_SA(b, h) (((b) * 2 + (h)) * HTB)
#define PG8_SB(b, h) ((4 + (b) * 2 + (h)) * HTB)
#define PG8_STAGE(bufoff, gbase, voff) do { _Pragma("unroll") for (int _i = 0; _i < 2; ++_i) \
        __builtin_amdgcn_global_load_lds((const unsigned*)((const char*)(gbase) + (voff)[_i]), (LAS unsigned*)(lds + (bufoff) + ldsw + _i * 8192), 16, 0, 0); } while (0)
#define PG8_LDA(dst, b, h) do { _Pragma("unroll") for (int m = 0; m < 4; ++m) _Pragma("unroll") for (int k = 0; k < 2; ++k) dst[m][k] = *(const LAS bf16x8*)(lds + PG8_SA(b, h) + aoff + m * 2048 + k * 1024); } while (0)
#define PG8_LDB(dst, b, h) do { _Pragma("unroll") for (int n = 0; n < 2; ++n) _Pragma("unroll") for (int k = 0; k < 2; ++k) dst[n][k] = *(const LAS bf16x8*)(lds + PG8_SB(b, h) + boff + n * 2048 + k * 1024); } while (0)
#define PG8_MMA(ai, bj, At, Bt) do { __builtin_amdgcn_s_setprio(1); _Pragma("unroll") for (int m = 0; m < 4; ++m) _Pragma("unroll") for (int n = 0; n < 2; ++n) _Pragma("unroll") for (int k = 0; k < 2; ++k) \
        acc[ai][bj][m][n] = __builtin_amdgcn_mfma_f32_16x16x32_bf16(Bt[n][k], At[m][k], acc[ai][bj][m][n], 0, 0, 0); __builtin_amdgcn_s_setprio(0); } while (0)
#define PG8_WAIT_V(n) asm volatile("s_waitcnt vmcnt(" #n ")" ::: "memory")
#define PG8_WAIT_L(n) asm volatile("s_waitcnt lgkmcnt(" #n ")" ::: "memory")
#define PG8_BAR __builtin_amdgcn_s_barrier()
#define PG8_SCHED __builtin_amdgcn_sched_barrier(0)
    Unit cur, nxt; int ui = 0;
    if (!S.next(0, cur)) return;
    f32x4 acc[2][2][4][2];
#pragma unroll
    for (int a = 0; a < 2; ++a)
#pragma unroll
        for (int b = 0; b < 2; ++b)
#pragma unroll
            for (int m = 0; m < 4; ++m)
#pragma unroll
                for (int n = 0; n < 2; ++n) acc[a][b][m][n] = (f32x4){0.f, 0.f, 0.f, 0.f};
    bf16x8 At[4][2], B0[2][2], B1[2][2];
    const char* cA = (const char*)g.A + ((size_t)cur.g * g.sA + (size_t)cur.pm * BM * g.lda + (size_t)cur.kh * K) * 2;
    const char* cB = (const char*)g.Bt + ((size_t)cur.g * g.sB + (size_t)cur.pn * BM * g.ldb + (size_t)cur.kh * K) * 2;
    PG8_STAGE(PG8_SB(0, 0), cB, voffB); PG8_STAGE(PG8_SB(0, 1), cB + hstepB, voffB); PG8_STAGE(PG8_SA(0, 0), cA, voffA); PG8_STAGE(PG8_SA(0, 1), cA + hstepA, voffA);
    if (wr == 1) PG8_BAR;
    PG8_WAIT_V(2); PG8_BAR;
    PG8_STAGE(PG8_SB(1, 0), cB + kstep, voffB); PG8_STAGE(PG8_SA(1, 0), cA + kstep, voffA); PG8_STAGE(PG8_SB(1, 1), cB + hstepB + kstep, voffB);
    PG8_WAIT_V(6); PG8_BAR;
    for (;;) {
        const bool has_next = S.next(ui + 1, nxt);
        const char* nA = has_next ? (const char*)g.A + ((size_t)nxt.g * g.sA + (size_t)nxt.pm * BM * g.lda + (size_t)nxt.kh * K) * 2 : cA;
        const char* nB = has_next ? (const char*)g.Bt + ((size_t)nxt.g * g.sB + (size_t)nxt.pn * BM * g.ldb + (size_t)nxt.kh * K) * 2 : cB;
        for (int t = 0; t < nt; t += 2) {
            const bool last = (t == nt - 2);
            const char* a1 = cA + (size_t)(t + 1) * kstep;
            const char* a2 = last ? nA : cA + (size_t)(t + 2) * kstep; const char* b2 = last ? nB : cB + (size_t)(t + 2) * kstep;
            const char* a3 = a2 + kstep; const char* b3 = b2 + kstep;
            PG8_LDB(B0, 0, 0); PG8_LDB(B1, 0, 1); PG8_SCHED; PG8_LDA(At, 0, 0); PG8_STAGE(PG8_SA(1, 1), a1 + hstepA, voffA);
            PG8_WAIT_V(8); PG8_WAIT_L(0); PG8_BAR; PG8_MMA(0, 0, At, B0); PG8_MMA(0, 1, At, B1); PG8_BAR; PG8_SCHED;
            PG8_LDA(At, 0, 1); PG8_STAGE(PG8_SB(0, 0), b2, voffB); PG8_STAGE(PG8_SB(0, 1), b2 + hstepB, voffB); PG8_STAGE(PG8_SA(0, 0), a2, voffA);
            PG8_WAIT_V(8); PG8_WAIT_L(0); PG8_BAR; PG8_MMA(1, 0, At, B0); PG8_MMA(1, 1, At, B1); PG8_BAR; PG8_SCHED;
            PG8_LDB(B0, 1, 0); PG8_LDB(B1, 1, 1); PG8_SCHED; PG8_LDA(At, 1, 0); PG8_STAGE(PG8_SA(0, 1), a2 + hstepA, voffA);
            PG8_WAIT_V(8); PG8_WAIT_L(0); PG8_BAR; PG8_MMA(0, 0, At, B0); PG8_MMA(0, 1, At, B1); PG8_BAR; PG8_SCHED;
            PG8_LDA(At, 1, 1); PG8_STAGE(PG8_SB(1, 0), b3, voffB); PG8_STAGE(PG8_SB(1, 1), b3 + hstepB, voffB); PG8_STAGE(PG8_SA(1, 0), a3, voffA);
            PG8_WAIT_V(8); PG8_WAIT_L(0); PG8_BAR; PG8_MMA(1, 0, At, B0); PG8_MMA(1, 1, At, B1); PG8_BAR; PG8_SCHED;
        }
        if (wr == 0) PG8_BAR;
        E(acc, cur, wr, wc, fr, fq);
        if (!has_next) break;
        if (!(Epi::KSPLIT && cur.kh == 0)) {
#pragma unroll
        for (int a = 0; a < 2; ++a)
#pragma unroll
            for (int b = 0; b < 2; ++b)
#pragma unroll
                for (int m = 0; m < 4; ++m)
#pragma unroll
                    for (int n = 0; n < 2; ++n) acc[a][b][m][n] = (f32x4){0.f, 0.f, 0.f, 0.f};
        }
        cur = nxt; cA = nA; cB = nB; ++ui;
        if (wr == 1) PG8_BAR;
    }
    PG8_WAIT_V(0);
    PG8_BAR;
#undef PG8_SA
#undef PG8_SB
#undef PG8_STAGE
#undef PG8_LDA
#undef PG8_LDB
#undef PG8_MMA
#undef PG8_WAIT_V
#undef PG8_WAIT_L
#undef PG8_BAR
#undef PG8_SCHED
}

__device__ __forceinline__ u32x4 pack8(const f32x4 a, const f32x4 b) { u32x4 w; w.x = cvt_pk_bf16(a[0], a[1]); w.y = cvt_pk_bf16(a[2], a[3]); w.z = cvt_pk_bf16(b[0], b[1]); w.w = cvt_pk_bf16(b[2], b[3]); return w; }

struct EpiZ {
    static constexpr bool PERM = true, KSPLIT = false;
    bf16_t* QKV; bf16_t* A5; const float* qg; const float* kg; LAS float* X;
    __device__ __forceinline__ void operator()(f32x4 (&acc)[2][2][4][2], const Unit& u, int wr, int wc, int fr, int fq) const {
        if (u.pn < 8) {
#pragma unroll
            for (int ai = 0; ai < 2; ++ai)
#pragma unroll
                for (int m = 0; m < 4; ++m)
#pragma unroll
                    for (int bj = 0; bj < 2; ++bj) { const f32x4 a0 = acc[ai][bj][m][0], a1 = acc[ai][bj][m][1];
                        float ss = (a0[0] * a0[0] + a0[1] * a0[1]) + (a0[2] * a0[2] + a0[3] * a0[3]) + (a1[0] * a1[0] + a1[1] * a1[1]) + (a1[2] * a1[2] + a1[3] * a1[3]);
                        ss += __shfl_xor(ss, 16); ss += __shfl_xor(ss, 32);
                        if (fq == 0) X[(ai * HALF + wr * 64 + m * 16 + fr) * 8 + bj * 4 + wc] = ss; }
            asm volatile("s_waitcnt lgkmcnt(0)" ::: "memory"); __builtin_amdgcn_s_barrier(); asm volatile("" ::: "memory");
            const float* gp = (u.pn < 4 ? qg : kg) + ((wc & 1) * 32 + 8 * fq); const float gs = u.pn < 4 ? 0.125f : 1.0f;
            const f32x4 g0 = *(const f32x4*)gp * gs, g1 = *(const f32x4*)(gp + 4) * gs;
#pragma unroll
            for (int ai = 0; ai < 2; ++ai)
#pragma unroll
                for (int m = 0; m < 4; ++m) { const int rl = ai * HALF + wr * 64 + m * 16 + fr, row = u.pm * BM + rl;
#pragma unroll
                    for (int bj = 0; bj < 2; ++bj) { const f32x2 pr = *(const LAS f32x2*)(X + rl * 8 + bj * 4 + (wc & 2)); const float rn = __builtin_amdgcn_rsqf((pr.x + pr.y) * (1.0f / HD) + RMS_EPS);
                        const int c8 = u.pn * BM + bj * HALF + wc * 32 + 8 * fq;
                        *(u32x4*)(QKV + (size_t)row * NQKV + c8) = pack8(acc[ai][bj][m][0] * g0 * rn, acc[ai][bj][m][1] * g1 * rn); } }
            return;
        }
#pragma unroll
        for (int ai = 0; ai < 2; ++ai)
#pragma unroll
            for (int m = 0; m < 4; ++m) { const int row = u.pm * BM + ai * HALF + wr * 64 + m * 16 + fr;
#pragma unroll
                for (int bj = 0; bj < 2; ++bj) { const int c8 = u.pn * BM + bj * HALF + wc * 32 + 8 * fq; const u32x4 w = pack8(acc[ai][bj][m][0], acc[ai][bj][m][1]);
                    if (u.pn < 12) *(u32x4*)(QKV + (size_t)row * NQKV + c8) = w;
                    else { const int ch = c8 - NQKV, gg = ch >> 4, c0 = ch & 15, R = row >> 5, s = row & 31; *(u32x4*)(A5 + ((size_t)gg * RCH + R) * KS5 + s * SC + c0) = w; } } }
    }
};
struct EpiE {
    static constexpr bool PERM = false, KSPLIT = false;
    float* E;
    __device__ __forceinline__ void operator()(f32x4 (&acc)[2][2][4][2], const Unit& u, int wr, int wc, int fr, int fq) const {
#pragma unroll
        for (int ai = 0; ai < 2; ++ai)
#pragma unroll
            for (int m = 0; m < 4; ++m) { const int R = u.pm * BM + ai * HALF + wr * 64 + m * 16 + fr; float* rowp = E + ((size_t)u.g * RCH + R) * 256 + wc * 32 + 4 * fq;
#pragma unroll
                for (int bj = 0; bj < 2; ++bj)
#pragma unroll
                    for (int n = 0; n < 2; ++n) *(f32x4*)(rowp + bj * HALF + n * 16) = acc[ai][bj][m][n]; }
    }
};
struct EpiS5Out {
    static constexpr bool PERM = true, KSPLIT = false;
    bf16_t* Yg;
    __device__ __forceinline__ void operator()(f32x4 (&acc)[2][2][4][2], const Unit& u, int wr, int wc, int fr, int fq) const {
#pragma unroll
        for (int ai = 0; ai < 2; ++ai)
#pragma unroll
            for (int m = 0; m < 4; ++m) { const int R = u.pm * BM + ai * HALF + wr * 64 + m * 16 + fr;
#pragma unroll
                for (int bj = 0; bj < 2; ++bj) { const int n8 = u.pn * BM + bj * HALF + wc * 32 + 8 * fq, s = n8 >> 4, c0 = n8 & 15;
                    f32x4 v0 = acc[ai][bj][m][0], v1 = acc[ai][bj][m][1];
#pragma unroll
                    for (int e = 0; e < 4; ++e) { v0[e] = gelu_tanh(v0[e]); v1[e] = gelu_tanh(v1[e]); }
                    *(u32x4*)(Yg + (size_t)(R * CL + s) * SW + u.g * SC + c0) = pack8(v0, v1); } }
    }
};
struct EpiGlu {
    static constexpr bool PERM = true, KSPLIT = false;
    const bf16_t* Yg; const float* bias; bf16_t* YAYS; float* ssq4; LAS float* X;
    __device__ __forceinline__ void operator()(f32x4 (&acc)[2][2][4][2], const Unit& u, int wr, int wc, int fr, int fq) const {
        const int c8b = u.pn * BM + wc * 32 + 8 * fq;
        f32x4 bv[2][2];
#pragma unroll
        for (int bj = 0; bj < 2; ++bj)
#pragma unroll
            for (int n = 0; n < 2; ++n) bv[bj][n] = *(const f32x4*)(bias + c8b + bj * HALF + 4 * n);
#pragma unroll
        for (int ai = 0; ai < 2; ++ai)
#pragma unroll
            for (int m = 0; m < 4; ++m) { const int row = u.pm * BM + ai * HALF + wr * 64 + m * 16 + fr; float ss = 0.f;
#pragma unroll
                for (int bj = 0; bj < 2; ++bj) { const int c8 = c8b + bj * HALF; const u32x4 y = *(const u32x4*)(Yg + (size_t)row * SW + c8);
                    const f32x4 a0 = acc[ai][bj][m][0] + bv[bj][0], a1 = acc[ai][bj][m][1] + bv[bj][1];
                    f32x4 v0, v1;
                    v0[0] = bf_lo(y.x) * sigmoidf_(a0[0]); v0[1] = bf_hi(y.x) * sigmoidf_(a0[1]); v0[2] = bf_lo(y.y) * sigmoidf_(a0[2]); v0[3] = bf_hi(y.y) * sigmoidf_(a0[3]);
                    v1[0] = bf_lo(y.z) * sigmoidf_(a1[0]); v1[1] = bf_hi(y.z) * sigmoidf_(a1[1]); v1[2] = bf_lo(y.w) * sigmoidf_(a1[2]); v1[3] = bf_hi(y.w) * sigmoidf_(a1[3]);
#pragma unroll
                    for (int e = 0; e < 4; ++e) ss += v0[e] * v0[e] + v1[e] * v1[e];
                    *(u32x4*)(YAYS + (size_t)row * DM + AW + c8) = pack8(v0, v1); }
                ss += __shfl_xor(ss, 16); ss += __shfl_xor(ss, 32);
                if (fq == 0) X[(ai * HALF + wr * 64 + m * 16 + fr) * 4 + wc] = ss; }
        asm volatile("s_waitcnt lgkmcnt(0)" ::: "memory"); __builtin_amdgcn_s_barrier(); asm volatile("" ::: "memory");
        if (wc == 0 && fq == 0) {
#pragma unroll
            for (int ai = 0; ai < 2; ++ai)
#pragma unroll
                for (int m = 0; m < 4; ++m) { const int rl = ai * HALF + wr * 64 + m * 16 + fr; const f32x4 p = *(const LAS f32x4*)(X + rl * 4);
                    ssq4[(size_t)u.pn * M + u.pm * BM + rl] = (p[0] + p[1]) + (p[2] + p[3]); } }
    }
};
struct EpiRes1 {
    static constexpr bool PERM = true, KSPLIT = true;
    const float* x; bf16_t* XB; const float* ssqa; const float* ssqs4; float* ssqx8; LAS float* X;
    __device__ __forceinline__ void operator()(f32x4 (&acc)[2][2][4][2], const Unit& u, int wr, int wc, int fr, int fq) const {
        if (u.kh == 0) {
#pragma unroll
        for (int ai = 0; ai < 2; ++ai)
#pragma unroll
            for (int m = 0; m < 4; ++m) { const int row = u.pm * BM + ai * HALF + wr * 64 + m * 16 + fr;
                const float sq = (ssqs4[row] + ssqs4[M + row]) + (ssqs4[2 * M + row] + ssqs4[3 * M + row]);
                const float ra = __builtin_amdgcn_rsqf(ssqa[row] * (1.0f / AW) + RMS_EPS), rs = __builtin_amdgcn_rsqf(sq * (1.0f / SW) + RMS_EPS), f = ra * fast_rcp(rs);
#pragma unroll
                for (int bj = 0; bj < 2; ++bj)
#pragma unroll
                    for (int n = 0; n < 2; ++n) acc[ai][bj][m][n] *= f; }
        return; }
#pragma unroll
        for (int ai = 0; ai < 2; ++ai)
#pragma unroll
            for (int m = 0; m < 4; ++m) { const int row = u.pm * BM + ai * HALF + wr * 64 + m * 16 + fr; float ss = 0.f;
                const float sq = (ssqs4[row] + ssqs4[M + row]) + (ssqs4[2 * M + row] + ssqs4[3 * M + row]);
                const float rs = __builtin_amdgcn_rsqf(sq * (1.0f / SW) + RMS_EPS);
#pragma unroll
                for (int bj = 0; bj < 2; ++bj) { const size_t off = (size_t)row * DM + u.pn * BM + bj * HALF + wc * 32 + 8 * fq;
                    const f32x4 x0 = *(const f32x4*)(x + off), x1 = *(const f32x4*)(x + off + 4);
                    const f32x4 v0 = x0 + acc[ai][bj][m][0] * rs, v1 = x1 + acc[ai][bj][m][1] * rs;
#pragma unroll
                    for (int e = 0; e < 4; ++e) ss += v0[e] * v0[e] + v1[e] * v1[e];
                    *(u32x4*)(XB + off) = pack8(v0, v1); }
                ss += __shfl_xor(ss, 16); ss += __shfl_xor(ss, 32);
                if (fq == 0) X[(ai * HALF + wr * 64 + m * 16 + fr) * 4 + wc] = ss;
                asm volatile("" ::: "memory"); }
        asm volatile("s_waitcnt lgkmcnt(0)" ::: "memory"); __builtin_amdgcn_s_barrier(); asm volatile("" ::: "memory");
        if (wc == 0 && fq == 0) {
#pragma unroll
            for (int ai = 0; ai < 2; ++ai)
#pragma unroll
                for (int m = 0; m < 4; ++m) { const int rl = ai * HALF + wr * 64 + m * 16 + fr; const f32x4 p = *(const LAS f32x4*)(X + rl * 4);
                    ssqx8[(size_t)u.pn * M + u.pm * BM + rl] = (p[0] + p[1]) + (p[2] + p[3]); } }
    }
};
struct EpiSwiGLU {
    static constexpr bool PERM = true, KSPLIT = false;
    bf16_t* H; const float* ssqx8;
    __device__ __forceinline__ void operator()(f32x4 (&acc)[2][2][4][2], const Unit& u, int wr, int wc, int fr, int fq) const {
#pragma unroll
        for (int ai = 0; ai < 2; ++ai)
#pragma unroll
            for (int m = 0; m < 4; ++m) { const int row = u.pm * BM + ai * HALF + wr * 64 + m * 16 + fr;
                float sq = 0.f;
#pragma unroll
                for (int t = 0; t < 8; ++t) sq += ssqx8[(size_t)t * M + row];
                const float rs = __builtin_amdgcn_rsqf(sq * (1.0f / DM) + RMS_EPS);
                f32x4 h0, h1;
#pragma unroll
                for (int e = 0; e < 4; ++e) { const float g0 = acc[ai][0][m][0][e] * rs, u0 = acc[ai][1][m][0][e] * rs, g1 = acc[ai][0][m][1][e] * rs, u1 = acc[ai][1][m][1][e] * rs;
                    h0[e] = g0 * sigmoidf_(g0) * u0; h1[e] = g1 * sigmoidf_(g1) * u1; }
                *(u32x4*)(H + (size_t)row * DFF + u.pn * HALF + wc * 32 + 8 * fq) = pack8(h0, h1); }
    }
};
struct EpiRes2 {
    static constexpr bool PERM = true, KSPLIT = false;
    float* out; const bf16_t* XB;
    __device__ __forceinline__ void operator()(f32x4 (&acc)[2][2][4][2], const Unit& u, int wr, int wc, int fr, int fq) const {
#pragma unroll
        for (int ai = 0; ai < 2; ++ai)
#pragma unroll
            for (int m = 0; m < 4; ++m) { const size_t roff = (size_t)(u.pm * BM + ai * HALF + wr * 64 + m * 16 + fr) * DM + u.pn * BM + wc * 32 + 8 * fq;
#pragma unroll
                for (int bj = 0; bj < 2; ++bj) { const size_t off = roff + bj * HALF; const u32x4 xb = *(const u32x4*)(XB + off);
                    f32x4 v0, v1; v0[0] = bf_lo(xb.x); v0[1] = bf_hi(xb.x); v0[2] = bf_lo(xb.y); v0[3] = bf_hi(xb.y); v1[0] = bf_lo(xb.z); v1[1] = bf_hi(xb.z); v1[2] = bf_lo(xb.w); v1[3] = bf_hi(xb.w);
                    *(f32x4*)(out + off) = v0 + acc[ai][bj][m][0]; *(f32x4*)(out + off + 4) = v1 + acc[ai][bj][m][1]; }
                asm volatile("" ::: "memory"); }
    }
};
}

#define RLX_AGENT __ATOMIC_RELAXED, __HIP_MEMORY_SCOPE_AGENT
#define XB_TMO      128
#define XB_XCNT(j)  (256  + 64 * (j))
#define XB_XSUB(j)  (1280 + 64 * (j))
#define XB_XGEN(j)  (2304 + 64 * (j))
#define XB_TOP      3328
#define XB_TOPGEN   3392
#define XCD_BAR_WORDS 3456
#define XB_SPIN_CAP (1u << 24)
__device__ __forceinline__ unsigned xb_ld(unsigned* p)              { return __hip_atomic_load(p, __ATOMIC_RELAXED, __HIP_MEMORY_SCOPE_AGENT); }
__device__ __forceinline__ unsigned xb_add(unsigned* p, unsigned v) { return __hip_atomic_fetch_add(p, v, __ATOMIC_RELAXED, __HIP_MEMORY_SCOPE_AGENT); }
__device__ __forceinline__ unsigned xb_xcc_id() { return (unsigned)__builtin_amdgcn_s_getreg((3 << 11) | 20) & 0xFu; }
#define XB_SPIN(cond, bar) do { unsigned _sp = 0; while (cond) { __builtin_amdgcn_s_sleep(1); \
    if ((++_sp & 255u) == 0u) { if (xb_ld(&(bar)[XB_TMO])) break; if (_sp > XB_SPIN_CAP) { atomicAdd(&(bar)[XB_TMO], 1u); break; } } } } while (0)
struct XcdBarrier { unsigned* bar; unsigned x; volatile LAS unsigned* st; };
__device__ __forceinline__ XcdBarrier xcd_barrier_post(unsigned* bar, volatile LAS unsigned* st) {
    XcdBarrier b; b.bar = bar; b.x = xb_xcc_id(); b.st = st;
    if (threadIdx.x == 0) (void)xb_add(&bar[XB_XCNT(b.x)], 1u);
    return b;
}
__device__ __forceinline__ void xcd_barrier_complete(unsigned* bar, unsigned x, unsigned& nloc, unsigned& nx) {
    const unsigned G = gridDim.x * gridDim.y * gridDim.z;
    unsigned sum, cnt, mine, sp = 0u;
    for (;;) {
        sum = 0u; cnt = 0u; mine = 0u;
#pragma unroll
        for (unsigned j = 0; j < 16; ++j) { const unsigned c = xb_ld(&bar[XB_XCNT(j)]); sum += c; cnt += (c > 0u) ? 1u : 0u; mine = (j == x) ? c : mine; }
        if (sum == G) break;
        __builtin_amdgcn_s_sleep(1);
        if ((++sp & 255u) == 0u) { if (xb_ld(&bar[XB_TMO])) break; if (sp > XB_SPIN_CAP) { atomicAdd(&bar[XB_TMO], 1u); break; } }
    }
    nloc = mine > 0u ? mine : 1u; nx = cnt > 0u ? cnt : 1u;
}
__device__ __forceinline__ void xcd_barrier(const XcdBarrier& b) {
    asm volatile("s_waitcnt vmcnt(0)" ::: "memory");
    __syncthreads();
    if (threadIdx.x == 0) {
        unsigned* bar = b.bar;
        __builtin_amdgcn_s_waitcnt(0);
        unsigned nloc = b.st[0], nx = b.st[1];
        if (nloc == 0u) { xcd_barrier_complete(bar, b.x, nloc, nx); b.st[0] = nloc; b.st[1] = nx; }
        const unsigned old = xb_add(&bar[XB_XSUB(b.x)], 1u);
        const unsigned gen = old / nloc;
        if (old + 1u == (gen + 1u) * nloc) {
            __builtin_amdgcn_fence(__ATOMIC_RELEASE, "agent");
            asm volatile("s_waitcnt vmcnt(0)" ::: "memory");
            const unsigned og = xb_add(&bar[XB_TOP], 1u);
            const unsigned tg = og / nx;
            if (og + 1u == (tg + 1u) * nx) xb_add(&bar[XB_TOPGEN], 1u);
            else XB_SPIN(xb_ld(&bar[XB_TOPGEN]) == tg, bar);
            __builtin_amdgcn_fence(__ATOMIC_ACQUIRE, "agent");
            xb_add(&bar[XB_XGEN(b.x)], 1u);
            asm volatile("s_waitcnt vmcnt(0)" ::: "memory");
        } else {
            XB_SPIN(xb_ld(&bar[XB_XGEN(b.x)]) == gen, bar);
            __builtin_amdgcn_fence(__ATOMIC_ACQUIRE, "agent");
            asm volatile("s_waitcnt vmcnt(0)" ::: "memory");
        }
    }
    __syncthreads();
}

struct Args { const float* in[23]; float* out; unsigned char* ws; int ph_lo, ph_hi, li, dup; };
enum { I_X = 0, I_GMIX, I_WIN, I_QG, I_KG, I_RPB, I_ARE, I_AIM, I_BRE, I_BIM, I_CRE, I_CIM, I_LS, I_D, I_WGLU, I_BGLU, I_GOA, I_GOS, I_WOUT, I_GFFN, I_WG, I_WU, I_WD };

#define LDS_WAIT() asm volatile("s_waitcnt lgkmcnt(0)" ::: "memory")

__device__ __forceinline__ void p0_transpose_item(const float* W, int N, const float* kscale, bf16_t* WT, int ldd, int drow0, int k0, int n0, int lane) {
    const int c = lane >> 3, n4 = (lane & 7) * 4;
    const float* src = W + (size_t)(k0 + 8 * c) * N + n0 + n4;
    f32x4 v[2][8];
#pragma unroll
    for (int h = 0; h < 2; ++h)
#pragma unroll
        for (int i = 0; i < 8; ++i) v[h][i] = __builtin_nontemporal_load((const f32x4*)(src + (size_t)i * N + 32 * h));
    if (kscale) { const f32x4 s0 = *(const f32x4*)(kscale + k0 + 8 * c), s1 = *(const f32x4*)(kscale + k0 + 8 * c + 4);
#pragma unroll
        for (int h = 0; h < 2; ++h)
#pragma unroll
            for (int i = 0; i < 8; ++i) v[h][i] *= (i < 4 ? s0[i & 3] : s1[i & 3]); }
#pragma unroll
    for (int h = 0; h < 2; ++h)
#pragma unroll
        for (int e = 0; e < 4; ++e) { u32x4 o; o.x = cvt_pk_bf16(v[h][0][e], v[h][1][e]); o.y = cvt_pk_bf16(v[h][2][e], v[h][3][e]); o.z = cvt_pk_bf16(v[h][4][e], v[h][5][e]); o.w = cvt_pk_bf16(v[h][6][e], v[h][7][e]);
            *(u32x4*)(WT + (size_t)(drow0 + 32 * h + n4 + e) * ldd + k0 + 8 * c) = o; }
}

__device__ __forceinline__ void dsincos(double a, double& s, double& c) {
    const double k = __builtin_rint(a * 0.63661977236758134308);
    double r = __builtin_fma(-k, 1.57079632679489655800e+00, a);
    r = __builtin_fma(-k, 6.12323399573676603587e-17, r);
    const double r2 = r * r;
    double sp = -7.6471637318198164759e-13; sp = sp * r2 + 1.6059043836821614599e-10; sp = sp * r2 - 2.5052108385441718775e-08; sp = sp * r2 + 2.7557319223985890653e-06;
    sp = sp * r2 - 1.9841269841269841270e-04; sp = sp * r2 + 8.3333333333333333333e-03; sp = sp * r2 - 1.6666666666666666667e-01; sp = sp * r2 * r + r;
    double cp = 4.7794773323873852974e-14; cp = cp * r2 - 1.1470745597729724714e-11; cp = cp * r2 + 2.0876756987868098979e-09; cp = cp * r2 - 2.7557319223985890653e-07;
    cp = cp * r2 + 2.4801587301587301587e-05; cp = cp * r2 - 1.3888888888888888889e-03; cp = cp * r2 + 4.1666666666666666667e-02; cp = cp * r2 - 0.5; cp = cp * r2 + 1.0;
    const int q = (int)((long long)k) & 3;
    s = (q == 0) ? sp : (q == 1) ? cp : (q == 2) ? -sp : -cp;
    c = (q == 0) ? cp : (q == 1) ? -sp : (q == 2) ? -cp : sp;
}

__device__ __forceinline__ void p0_s5_tables(const Args& a, LAS unsigned char* lds, int g, int q, int tid) {
    LAS f32x2* LP = (LAS f32x2*)lds;
    LAS float* Bb = (LAS float*)(lds + 33792);
    LAS f32x2* Cm = (LAS f32x2*)(lds + 50176);
    LAS float* Kt = (LAS float*)(lds + 66560);
    const float* a_re = a.in[I_ARE]; const float* a_im = a.in[I_AIM]; const float* b_re = a.in[I_BRE]; const float* b_im = a.in[I_BIM];
    const float* c_re = a.in[I_CRE]; const float* c_im = a.in[I_CIM]; const float* lstep = a.in[I_LS]; const float* dsk = a.in[I_D];
    unsigned char* ws = a.ws;
    __syncthreads();
    for (int i = tid; i < 2 * 64 * 33; i += 512) { const int tau = i % 33, p = (i / 33) & 63, d = i / (33 * 64);
        const double lre = (double)fminf(a_re[(d * SG + g) * SP + p], -1e-4f), lim = (double)a_im[(d * SG + g) * SP + p], dt = exp((double)lstep[d * SG + g]);
        const double mag = exp(lre * dt * tau); double s, c; dsincos(lim * dt * tau, s, c);
        LP[i] = (f32x2){(float)(mag * c), (float)(mag * s)}; }
    for (int i = tid; i < 2 * 64 * 16; i += 512) { const int c = i & 15, p = (i >> 4) & 63, d = i >> 10;
        const double lre = (double)fminf(a_re[(d * SG + g) * SP + p], -1e-4f), lim = (double)a_im[(d * SG + g) * SP + p], dt = exp((double)lstep[d * SG + g]);
        const double mag = exp(lre * dt); double sn, cs; dsincos(lim * dt, sn, cs);
        const double nr = mag * cs - 1.0, ni = mag * sn, den = 1.0 / (lre * lre + lim * lim);
        const double fr = (nr * lre + ni * lim) * den, fi = (ni * lre - nr * lim) * den;
        const size_t bi = (((size_t)d * SG + g) * SP + p) * SC + c; const double br = b_re[bi], bim = b_im[bi];
        Bb[(d * 64 + p) * 32 + c] = (float)(fr * br - fi * bim); Bb[(d * 64 + p) * 32 + 16 + c] = (float)(fr * bim + fi * br);
        const size_t ci = (((size_t)d * SG + g) * SC + c) * SP + p;
        Cm[i] = (f32x2){c_re[ci], c_im[ci]}; }
    __syncthreads();
    if (q == 0 && tid < 128) { const int p = tid & 63, d = tid >> 6; ((f32x2*)(ws + WS_LAML))[(g * 2 + d) * SP + p] = LP[(d * 64 + p) * 33 + CL]; }
    { const int tau = tid >> 4, c = tid & 15;
      for (int d = 0; d < 2; ++d) { f32x4 kacc[4];
#pragma unroll
        for (int e = 0; e < 4; ++e) kacc[e] = (f32x4){0.f, 0.f, 0.f, 0.f};
#pragma unroll 4
        for (int p = 0; p < 64; ++p) { const f32x2 cm = Cm[(d * 64 + p) * 16 + c], lp = LP[(d * 64 + p) * 33 + tau];
            const float gr = cm.x * lp.x - cm.y * lp.y, gi = -(cm.x * lp.y + cm.y * lp.x);
            const LAS f32x4* bp = (const LAS f32x4*)(Bb + (d * 64 + p) * 32);
#pragma unroll
            for (int e = 0; e < 4; ++e) kacc[e] += bp[e] * gr + bp[4 + e] * gi; }
#pragma unroll
        for (int e = 0; e < 4; ++e) *(LAS f32x4*)(Kt + ((d * 32 + tau) * 16 + c) * 16 + 4 * e) = kacc[e]; } }
    __syncthreads();
    { const int d = q >> 1, ri = q & 1, p = tid >> 3, s0 = (tid & 7) * 4;
      bf16_t* dst = (bf16_t*)(ws + WS_WST) + ((size_t)g * 256 + q * 64 + p) * 512 + s0 * 16;
#pragma unroll
      for (int sp = 0; sp < 4; ++sp) { const int pw = d == 0 ? (CL - 1 - (s0 + sp)) : (s0 + sp); const f32x2 lp = LP[(d * 64 + p) * 33 + pw]; float v[16];
#pragma unroll
          for (int e = 0; e < 16; ++e) { const float bx_ = Bb[(d * 64 + p) * 32 + e], by_ = Bb[(d * 64 + p) * 32 + 16 + e]; v[e] = ri == 0 ? (lp.x * bx_ - lp.y * by_) : (lp.x * by_ + lp.y * bx_); }
          u32x4 w0, w1; w0.x = cvt_pk_bf16(v[0], v[1]); w0.y = cvt_pk_bf16(v[2], v[3]); w0.z = cvt_pk_bf16(v[4], v[5]); w0.w = cvt_pk_bf16(v[6], v[7]);
          w1.x = cvt_pk_bf16(v[8], v[9]); w1.y = cvt_pk_bf16(v[10], v[11]); w1.z = cvt_pk_bf16(v[12], v[13]); w1.w = cvt_pk_bf16(v[14], v[15]);
          *(u32x4*)(dst + sp * 16) = w0; *(u32x4*)(dst + sp * 16 + 8) = w1; } }
    { const int rl = tid >> 2, s = 8 * q + (rl >> 4), c = rl & 15, part = tid & 3;
      bf16_t* dst = (bf16_t*)(ws + WS_TW) + ((size_t)g * 512 + s * 16 + c) * KS5;
      const float dsv = dsk[g * SC + c];
      for (int j = 0; j < 24; ++j) { const int k0 = part * 192 + j * 8; float v[8];
          if (k0 < 512) { const int sp = k0 >> 4, c0 = k0 & 15;
#pragma unroll
              for (int e = 0; e < 8; ++e) { float t = 0.f;
                  if (sp <= s) t += Kt[((0 * 32 + (s - sp)) * 16 + c) * 16 + c0 + e];
                  if (sp >= s) t += Kt[((1 * 32 + (sp - s)) * 16 + c) * 16 + c0 + e];
                  if (sp == s && c0 + e == c) t += dsv;
                  v[e] = t; }
          } else { const int kk = k0 - 512, d = kk >> 7, ri = (kk >> 6) & 1, p0 = kk & 63, pw = d == 0 ? (s + 1) : (CL - s);
#pragma unroll
              for (int e = 0; e < 8; ++e) { const f32x2 cm = Cm[(d * 64 + p0 + e) * 16 + c], lp = LP[(d * 64 + p0 + e) * 33 + pw];
                  v[e] = ri == 0 ? (cm.x * lp.x - cm.y * lp.y) : -(cm.x * lp.y + cm.y * lp.x); }
          }
          u32x4 w; w.x = cvt_pk_bf16(v[0], v[1]); w.y = cvt_pk_bf16(v[2], v[3]); w.z = cvt_pk_bf16(v[4], v[5]); w.w = cvt_pk_bf16(v[6], v[7]);
          *(u32x4*)(dst + k0) = w; } }
    __syncthreads();
}

__device__ __forceinline__ void p0_prologue(const Args& a, LAS unsigned char* lds, int vcu, int G, int tid) {
    asm volatile("" : "+v"(tid));
    const int wave = __builtin_amdgcn_readfirstlane(tid >> 6), lane = tid & 63;
    unsigned char* ws = a.ws;
    if (vcu & 1) { for (int it = vcu; it < SG * 4; it += G) p0_s5_tables(a, lds, it >> 2, it & 3, tid); }
    const int gw = vcu * 8 + wave, NGW = G * 8;
    constexpr int I_IN = (DM / 64) * (INW / 64), I_GL = (SW / 64) * (SW / 64), I_OUT = (DM / 64) * (DM / 64), I_GU = (DM / 64) * (DFF / 64), I_DN = (DFF / 64) * (DM / 64);
    constexpr int NITEMS = I_IN + I_GL + I_OUT + 2 * I_GU + I_DN;
    for (int it = gw; it < NITEMS; it += NGW) {
        int r = it;
        if (r < I_IN) { const int nb = INW / 64, kb = r / nb, n0 = (r % nb) * 64; p0_transpose_item(a.in[I_WIN], INW, nullptr, (bf16_t*)(ws + WS_WIN), DM, n0, kb * 64, n0, lane); continue; } r -= I_IN;
        if (r < I_GL) { const int nb = SW / 64, kb = r / nb, n0 = (r % nb) * 64; p0_transpose_item(a.in[I_WGLU], SW, nullptr, (bf16_t*)(ws + WS_WGLU), SW, n0, kb * 64, n0, lane); continue; } r -= I_GL;
        if (r < I_OUT) { const int nb = DM / 64, kb = r / nb, n0 = (r % nb) * 64, k0 = kb * 64;
            p0_transpose_item(a.in[I_WOUT], DM, k0 < AW ? a.in[I_GOA] : a.in[I_GOS] - AW, (bf16_t*)(ws + WS_WOUT), DM, n0, k0, n0, lane); continue; } r -= I_OUT;
        if (r < 2 * I_GU) { const int up = r >= I_GU; if (up) r -= I_GU; const int nb = DFF / 64, kb = r / nb, n0 = (r % nb) * 64;
            p0_transpose_item(up ? a.in[I_WU] : a.in[I_WG], DFF, a.in[I_GFFN], (bf16_t*)(ws + WS_WGU), DM, 256 * (n0 >> 7) + (n0 & 127) + (up ? 128 : 0), kb * 64, n0, lane); continue; } r -= 2 * I_GU;
        { const int nb = DM / 64, kb = r / nb, n0 = (r % nb) * 64; p0_transpose_item(a.in[I_WD], DM, nullptr, (bf16_t*)(ws + WS_WD), DFF, n0, kb * 64, n0, lane); }
    }
    const float* x = a.in[I_X]; const float* gm = a.in[I_GMIX]; bf16_t* XN = (bf16_t*)(ws + WS_XN);
    for (int m = gw; m < M; m += NGW) { const f32x4* xr = (const f32x4*)(x + (size_t)m * DM) + lane; f32x4 v[8]; float s = 0.f;
#pragma unroll
        for (int j = 0; j < 8; ++j) { v[j] = xr[64 * j]; s += (v[j][0] * v[j][0] + v[j][1] * v[j][1]) + (v[j][2] * v[j][2] + v[j][3] * v[j][3]); }
        const float rstd = 1.0f / sqrtf(wave_sum(s) * (1.0f / DM) + RMS_EPS);
        u32x2* o8 = (u32x2*)(XN + (size_t)m * DM) + lane;
#pragma unroll
        for (int j = 0; j < 8; ++j) { const f32x4 gv = ((const f32x4*)gm)[64 * j + lane]; u32x2 w; w.x = cvt_pk_bf16(v[j][0] * rstd * gv[0], v[j][1] * rstd * gv[1]); w.y = cvt_pk_bf16(v[j][2] * rstd * gv[2], v[j][3] * rstd * gv[3]); o8[64 * j] = w; } }
    if (!(vcu & 1)) { for (int it = vcu; it < SG * 4; it += G) p0_s5_tables(a, lds, it >> 2, it & 3, tid); }
}

constexpr int KROW = 144, AROW = 160;
constexpr int AHEAD = 64 * AROW;
constexpr int ABUF = 2 * AHEAD;
constexpr int ATT_RPB_OFF = 2 * ABUF;
static_assert(ATT_RPB_OFF + 16 * 465 * 4 <= MISC_OFF, "attention LDS");

__device__ __forceinline__ void attn_phase(const Args& a, LAS unsigned char* lds, volatile LAS unsigned* MISC, int vcu, int G, int has_g2, int tid) {
    asm volatile("" : "+v"(tid));
    const int wave = __builtin_amdgcn_readfirstlane(tid >> 6), lane = tid & 63, ql = lane & 15, g4 = lane >> 4;
    const bf16_t* QKV = (const bf16_t*)(a.ws + WS_BIG); bf16_t* YAYS = (bf16_t*)(a.ws + WS_YAYS); float* ssqa16 = (float*)(a.ws + WS_SSQA16);
    LAS float* rpbL = (LAS float*)(lds + ATT_RPB_OFF);
    for (int i = tid; i < 16 * 465; i += 512) rpbL[i] = a.in[I_RPB][i];
    const int j = wave & 3, hsel = wave >> 2;
    const int cq = 16 * j + ql, cs = min(max(cq - 8, 0), GRIDW - 16), wb = (j == 0) ? 0 : (j == 1) ? 8 : (j == 2) ? 24 : 32;
    int it_lo, it_hi, it_step = 1;
    if (G == 256) { const int x_ = vcu >> 5, k_ = vcu & 31; if (has_g2) { it_lo = x_ * 256 + 6 * (k_ & 15); it_hi = it_lo + 6; } else { it_lo = x_ * 256 + 96 + 10 * (k_ & 15); it_hi = it_lo + 10; } }
    else { it_lo = vcu; it_hi = BATCH * NROWS * 8; it_step = G; }
#define ATT_FETCH(dst) do { if (tid == 0) { const int nx_ = ((dst) == 20) ? it_lo : item + it_step; MISC[dst] = (unsigned)(nx_ < it_hi ? nx_ : -1); } } while (0)
    int item = 0;
    ATT_FETCH(20);
    __syncthreads();
    item = __builtin_amdgcn_readfirstlane((int)MISC[20]);
    const int skey = tid >> 3, sch = tid & 7;
    const unsigned ldstK = (unsigned)(skey * KROW + sch * 16), ldstV = (unsigned)(skey * AROW + sch * 16);
    u32x4 R[4][2];
#define ATT_SRC(it_, st_, i_) (QKV + ((size_t)((it_) >> 9) * SEQ + 64 * (min(max((((it_) >> 3) & 63) - 4, 0), NROWS - 8) + ((st_) & 7)) + skey) * NQKV + ((st_) < 8 ? AW : 2 * AW) + 64 * (2 * ((it_) & 7) + (i_)) + 8 * sch)
    if (item >= 0) {
#pragma unroll
        for (int p = 0; p < 3; ++p)
#pragma unroll
            for (int i = 0; i < 2; ++i) R[p][i] = *(const u32x4*)ATT_SRC(item, p, i);
    }
    while (item >= 0) {
        const int b = item >> 9, r = (item >> 3) & 63, hp = item & 7, h = 2 * hp + hsel, row_start = min(max(r - 4, 0), NROWS - 8);
        ATT_FETCH(21);
        const size_t tq = (size_t)b * SEQ + 64 * r + cq;
        bf16x8 Qf[2];
        { const u32x4* qp = (const u32x4*)(QKV + tq * NQKV + 64 * h + 8 * g4); Qf[0] = __builtin_bit_cast(bf16x8, qp[0]); Qf[1] = __builtin_bit_cast(bf16x8, qp[4]); }
        const LAS float* bl = rpbL + h * 465 + (row_start - r + 7) * 31 + (wb + 4 * g4 - cq + 15);
        f32x4 S[8][2]; bf16x8 Pf[8]; f32x4 O[4]; float sum = 0.f; int nitem = -1;
#pragma unroll
        for (int dt = 0; dt < 4; ++dt) O[dt] = (f32x4){0.f, 0.f, 0.f, 0.f};
#pragma unroll
        for (int st = 0; st < 16; ++st) {
            LAS unsigned char* buf = lds + (st & 1) * ABUF;
            { const unsigned ld_ = st < 8 ? ldstK : ldstV; *(LAS u32x4*)(buf + ld_) = R[st & 3][0]; *(LAS u32x4*)(buf + AHEAD + ld_) = R[st & 3][1]; }
            if (st + 3 < 16) {
#pragma unroll
                for (int i = 0; i < 2; ++i) R[(st + 3) & 3][i] = *(const u32x4*)ATT_SRC(item, st + 3, i);
            } else if (nitem >= 0) {
#pragma unroll
                for (int i = 0; i < 2; ++i) R[(st + 3) & 3][i] = *(const u32x4*)ATT_SRC(nitem, st + 3 - 16, i);
            }
            asm volatile("s_waitcnt lgkmcnt(0)" ::: "memory"); __builtin_amdgcn_s_barrier(); asm volatile("" ::: "memory");
            if (st == 0) nitem = __builtin_amdgcn_readfirstlane((int)MISC[21]);
            const LAS unsigned char* hb = buf + hsel * AHEAD;
            if (st < 8) {
                const int kr = st;
#pragma unroll
                for (int t = 0; t < 2; ++t) {
                    const LAS unsigned char* kp = hb + (wb + 16 * t + ql) * KROW + g4 * 16;
                    const bf16x8 k0 = *(const LAS bf16x8*)kp, k1 = *(const LAS bf16x8*)(kp + 64);
                    f32x4 acc = (f32x4){0.f, 0.f, 0.f, 0.f};
                    acc = __builtin_amdgcn_mfma_f32_16x16x32_bf16(k0, Qf[0], acc, 0, 0, 0);
                    acc = __builtin_amdgcn_mfma_f32_16x16x32_bf16(k1, Qf[1], acc, 0, 0, 0);
#pragma unroll
                    for (int e = 0; e < 4; ++e) { const int ck = wb + 16 * t + 4 * g4 + e;
                        const float bias = bl[kr * 31 + 16 * t + e];
                        acc[e] = (ck >= cs && ck < cs + 16) ? acc[e] + bias : -1e30f; }
                    S[kr][t] = acc; }
                if (st == 7) {
                    float mx = -1e30f;
#pragma unroll
                    for (int k2 = 0; k2 < 8; ++k2)
#pragma unroll
                        for (int t = 0; t < 2; ++t)
#pragma unroll
                            for (int e = 0; e < 4; ++e) mx = fmaxf(mx, S[k2][t][e]);
                    mx = fmaxf(mx, __shfl_xor(mx, 16)); mx = fmaxf(mx, __shfl_xor(mx, 32));
#pragma unroll
                    for (int k2 = 0; k2 < 8; ++k2) { f32x4 p0, p1;
#pragma unroll
                        for (int e = 0; e < 4; ++e) { p0[e] = fast_exp2((S[k2][0][e] - mx) * 1.44269504089f); p1[e] = fast_exp2((S[k2][1][e] - mx) * 1.44269504089f); sum += p0[e] + p1[e]; }
                        Pf[k2] = __builtin_bit_cast(bf16x8, pg8::pack8(p0, p1)); }
                    sum += __shfl_xor(sum, 16); sum += __shfl_xor(sum, 32);
                }
            } else {
                const int kr = st - 8;
                const LAS unsigned char* rp = hb + (wb + 4 * g4 + ((lane & 15) >> 2)) * AROW + (lane & 3) * 8;
#pragma unroll
                for (int dt = 0; dt < 4; ++dt) {
                    const s16x4 lo = __builtin_amdgcn_ds_read_tr16_b64_v4i16((LAS s16x4*)(rp + dt * 32));
                    const s16x4 hi = __builtin_amdgcn_ds_read_tr16_b64_v4i16((LAS s16x4*)(rp + 16 * AROW + dt * 32));
                    const bf16x8 av = (bf16x8){lo[0], lo[1], lo[2], lo[3], hi[0], hi[1], hi[2], hi[3]};
                    O[dt] = __builtin_amdgcn_mfma_f32_16x16x32_bf16(av, Pf[kr], O[dt], 0, 0, 0); }
            }
        }
        const float inv = fast_rcp(sum); float ssq_acc = 0.f;
        bf16_t* op = YAYS + tq * DM + 64 * h + 4 * g4;
#pragma unroll
        for (int dt = 0; dt < 4; ++dt) { const f32x4 o = O[dt] * inv; ssq_acc += (o[0] * o[0] + o[1] * o[1]) + (o[2] * o[2] + o[3] * o[3]);
            u32x2 w; w.x = cvt_pk_bf16(o[0], o[1]); w.y = cvt_pk_bf16(o[2], o[3]); *(u32x2*)(op + 16 * dt) = w; }
        ssq_acc += __shfl_xor(ssq_acc, 16); ssq_acc += __shfl_xor(ssq_acc, 32);
        if (g4 == 0) ssqa16[tq * 16 + h] = ssq_acc;
        item = nitem;
    }
#undef ATT_FETCH
#undef ATT_SRC
}

__device__ __forceinline__ void scan_phase(const Args& a, int vcu, int G, int tid) {
    asm volatile("" : "+v"(tid));
    if (tid >= 128) return;
    const float* E = (const float*)(a.ws + WS_E); bf16_t* A5 = (bf16_t*)(a.ws + WS_A5); const f32x2* LAML = (const f32x2*)(a.ws + WS_LAML);
    for (int idx = vcu * 128 + tid; idx < BATCH * SG * 2 * SP; idx += G * 128) {
        const int p = idx & 63, d = (idx >> 6) & 1, g = (idx >> 7) & 63, b = idx >> 13;
        const f32x2 lam = LAML[(g * 2 + d) * SP + p];
        float xr = 0.f, xi = 0.f;
#pragma unroll 8
        for (int kk = 0; kk < NCH; ++kk) { const int k = d == 0 ? kk : NCH - 1 - kk; const size_t R = (size_t)g * RCH + b * NCH + k;
            bf16_t* ap = A5 + R * KS5 + 512 + d * 128 + p; ap[0] = (bf16_t)(cvt_pk_bf16(xr, 0.f) & 0xffffu); ap[64] = (bf16_t)(cvt_pk_bf16(xi, 0.f) & 0xffffu);
            const float er = E[R * 256 + d * 128 + p], ei = E[R * 256 + d * 128 + 64 + p];
            const float nr = lam.x * xr - lam.y * xi + er, ni = lam.x * xi + lam.y * xr + ei; xr = nr; xi = ni; }
    }
}

__global__ void __launch_bounds__(512, 2) hymba_fwd(Args args) {
    extern __shared__ __attribute__((aligned(16))) unsigned char lds_raw[];
    LAS unsigned char* lds = (LAS unsigned char*)lds_raw;
    volatile LAS unsigned* MISC = (volatile LAS unsigned*)(lds + MISC_OFF);
    const int tid = threadIdx.x;
    const int G = gridDim.x; const int bx = blockIdx.x; const int vcu = (G % 8 == 0) ? (bx % 8) * (G / 8) + bx / 8 : bx;
    unsigned char* ws = args.ws;
    unsigned* ctl = (unsigned*)(ws + WS_CTL);
    for (int u = tid; u < (LDS_BYTES - MISC_OFF) / 4; u += 512) MISC[u] = 0u;
    __syncthreads();
    XcdBarrier bar; bar.bar = ctl + CW_BAR; bar.x = 0; bar.st = nullptr;
    if (MK_N_LAUNCHES == 1) bar = xcd_barrier_post(ctl + CW_BAR, MISC + 8);
    const int lo = args.ph_lo, hi = args.ph_hi;
#define IN(k) (lo <= (k) && (k) < hi)
#define SEAM(k) do { if (IN(k) && IN((k) + 1)) xcd_barrier(bar); } while (0)
    bf16_t* WIN = (bf16_t*)(ws + WS_WIN); bf16_t* WGLU = (bf16_t*)(ws + WS_WGLU); bf16_t* WOUT = (bf16_t*)(ws + WS_WOUT); bf16_t* WGU = (bf16_t*)(ws + WS_WGU); bf16_t* WD = (bf16_t*)(ws + WS_WD);
    bf16_t* WST = (bf16_t*)(ws + WS_WST); bf16_t* TW = (bf16_t*)(ws + WS_TW);
    bf16_t* XN = (bf16_t*)(ws + WS_XN); bf16_t* YG = (bf16_t*)(ws + WS_XN); bf16_t* XB = (bf16_t*)(ws + WS_XN);
    bf16_t* QKV = (bf16_t*)(ws + WS_BIG); bf16_t* A5 = (bf16_t*)(ws + WS_A5); float* E = (float*)(ws + WS_E); bf16_t* HB = (bf16_t*)(ws + WS_BIG);
    bf16_t* YAYS = (bf16_t*)(ws + WS_YAYS);
    float* ssqa16 = (float*)(ws + WS_SSQA16); float* ssqa = (float*)(ws + WS_SSQA); float* ssqs4 = (float*)(ws + WS_SSQS4); float* ssqx8 = (float*)(ws + WS_SSQX8);
    LAS float* XL = (LAS float*)(lds + RING_BYTES);

#define REP(k) _Pragma("unroll") for (int rep_ = (DUP_PHASE == (k)) ? 0 : 1; rep_ < 2; ++rep_)
#define ALPHA ((rep_ == 0 && args.dup >= 0) ? 0.0f : 1.0f)
    if (IN(0)) { REP(0) { p0_prologue(args, lds, vcu, G, tid); __syncthreads(); } SEAM(0); }
    if (IN(1)) {
        pg8::Gemm g{XN, WIN, DM, DM, DM, 0, 0}; pg8::StaticOrder S; S.init(M, INW, G, bx);
        pg8::EpiZ Ep{QKV, A5, args.in[I_QG], args.in[I_KG], XL};
        REP(1) pg8::gemm_phase(lds, g, S, Ep);
        SEAM(1);
    }
    if (IN(2)) {
        { pg8::Gemm g{A5, WST, KS5, 512, 512, (size_t)RCH * KS5, (size_t)256 * 512}; pg8::BatchOrder S; S.init(2, 1, SG * (DUP_PHASE == 2 ? 2 : 1), G, bx);
          pg8::EpiE Ep{E};
          pg8::gemm_phase(lds, g, S, Ep); }
        __syncthreads();
        attn_phase(args, lds, MISC, vcu, G, bx < 128 ? 1 : 0, tid);
        SEAM(2);
    }
    if (IN(3)) { REP(3) scan_phase(args, vcu, G, tid); SEAM(3); }
    if (IN(4)) {
        pg8::Gemm g{A5, TW, KS5, KS5, KS5, (size_t)RCH * KS5, (size_t)512 * KS5}; pg8::BatchOrder S; S.init(2, 2, SG * (DUP_PHASE == 4 ? 2 : 1), G, bx);
        pg8::EpiS5Out Ep{YG};
        pg8::gemm_phase(lds, g, S, Ep);
        SEAM(4);
    }
    if (IN(5)) {
        pg8::Gemm g{YG, WGLU, SW, SW, SW, 0, 0}; pg8::StaticOrder S; S.init(M, SW, G, bx);
        for (int t = vcu * 512 + tid; t < M; t += G * 512) { const f32x4* p = (const f32x4*)(ssqa16 + (size_t)t * 16); const f32x4 s0 = p[0], s1 = p[1], s2 = p[2], s3 = p[3];
            const f32x4 sv = (s0 + s1) + (s2 + s3); ssqa[t] = (sv[0] + sv[1]) + (sv[2] + sv[3]); }
        REP(5) { pg8::EpiGlu Ep{YG, args.in[I_BGLU], YAYS, ssqs4, XL}; pg8::gemm_phase(lds, g, S, Ep); }
        SEAM(5);
    }
    if (IN(6)) {
        pg8::Gemm g{YAYS, WOUT, DM, DM, AW, 0, 0}; pg8::SplitKOrder S; S.so.init(M, DM, G, bx);
        REP(6) { pg8::EpiRes1 Ep{args.in[I_X], XB, ssqa, ssqs4, ssqx8, XL}; pg8::gemm_phase(lds, g, S, Ep); }
        SEAM(6);
    }
    if (IN(7)) {
        pg8::Gemm g{XB, WGU, DM, DM, DM, 0, 0}; pg8::StaticOrder S; S.init(M, 2 * DFF, G, bx);
        pg8::EpiSwiGLU Ep{HB, ssqx8};
        REP(7) pg8::gemm_phase(lds, g, S, Ep);
        SEAM(7);
    }
    if (IN(8)) {
        pg8::Gemm g{HB, WD, DFF, DFF, DFF, 0, 0}; pg8::StaticOrder S; S.init(M, DM, G, bx);
        REP(8) { pg8::EpiRes2 Ep{args.out, XB}; pg8::gemm_phase(lds, g, S, Ep); }
    }
#undef IN
#undef SEAM
}

extern "C" void kernel_launch(void* const* d_in, const int* in_sizes, int n_in, void* d_out, int out_size, void* d_ws, size_t ws_size, hipStream_t stream) {
    static int grid = 0;
    if (grid == 0) {
        if (n_in != 23 || in_sizes[0] != M * DM || out_size != M * DM || ws_size < WS_END) { fprintf(stderr, "kernel_launch: unexpected shapes (n_in %d, in0 %d, out %d, ws %zu < %zu)\n", n_in, n_in > 0 ? in_sizes[0] : -1, out_size, ws_size, (size_t)WS_END); grid = -1; return; }
        int dev = 0, cus = 0, per_cu = 0;
        if (hipGetDevice(&dev) != hipSuccess || hipDeviceGetAttribute(&cus, hipDeviceAttributeMultiprocessorCount, dev) != hipSuccess) { grid = -1; return; }
        if (hipFuncSetAttribute((const void*)hymba_fwd, hipFuncAttributeMaxDynamicSharedMemorySize, LDS_BYTES) != hipSuccess) { fprintf(stderr, "kernel_launch: hipFuncSetAttribute failed\n"); grid = -1; return; }
        if (hipOccupancyMaxActiveBlocksPerMultiprocessor(&per_cu, (const void*)hymba_fwd, 512, LDS_BYTES) != hipSuccess || per_cu < 1) { fprintf(stderr, "kernel_launch: occupancy query says %d blocks per CU\n", per_cu); (void)hipGetLastError(); per_cu = 1; }
        grid = cus;
    }
    if (grid < 0) return;
    (void)hipMemsetAsync((char*)d_ws + WS_CTL, 0, CTL_ZERO_BYTES, stream);
    Args a{}; a.dup = DUP_PHASE;
    for (int i = 0; i < 23; ++i) a.in[i] = (const float*)d_in[i];
    a.out = (float*)d_out; a.ws = (unsigned char*)d_ws;
    if (MK_N_LAUNCHES == 1) {
        a.ph_lo = 0; a.ph_hi = NPHASE; a.li = 0;
        hipLaunchKernelGGL(hymba_fwd, dim3(grid), dim3(512), LDS_BYTES, stream, a);
    } else {
        for (int li = 0; li < NPHASE; ++li) { a.ph_lo = li; a.ph_hi = li + 1; a.li = li; hipLaunchKernelGGL(hymba_fwd, dim3(grid), dim3(512), LDS_BYTES, stream, a); }
    }
}
```

```cpp
#include <hip/hip_runtime.h>
#include <cstdio>
#include <cstdint>

#define DUP_PHASE (-1)
#ifndef MK_N_LAUNCHES
#define MK_N_LAUNCHES 1
#endif

#define GAS __attribute__((address_space(1)))
#define LAS __attribute__((address_space(3)))
typedef unsigned short bf16_t;
typedef short bf16x8 __attribute__((ext_vector_type(8)));
typedef short s16x4 __attribute__((ext_vector_type(4)));
typedef float f32x4 __attribute__((ext_vector_type(4)));
typedef float f32x2 __attribute__((ext_vector_type(2)));
typedef unsigned u32x4 __attribute__((ext_vector_type(4)));
typedef unsigned u32x2 __attribute__((ext_vector_type(2)));

constexpr int BATCH = 4, SEQ = 4096, DM = 2048, M = BATCH * SEQ;
constexpr int AW = 1024, SW = 1024, NH = 16, HD = 64, NQKV = 3 * AW, INW = 4096, DFF = 5632;
constexpr int GRIDW = 64, NROWS = SEQ / GRIDW;
constexpr int SG = 64, SC = 16, SP = 64;
constexpr int CL = 32, NCH = SEQ / CL, RCH = M / CL;
constexpr int KS5 = CL * SC + 256;
constexpr float RMS_EPS = 1e-6f;
constexpr int NPHASE = 9;

constexpr size_t MiB = 1u << 20;
constexpr size_t WS_CTL = 0, CTL_ZERO_BYTES = 65536;
constexpr size_t WS_WIN = 1 * MiB, WS_WGLU = 17 * MiB, WS_WOUT = 19 * MiB, WS_WGU = 27 * MiB, WS_WD = 71 * MiB;
constexpr size_t WS_WST = 93 * MiB, WS_TW = 109 * MiB, WS_LAML = 157 * MiB;
constexpr size_t WS_XN = 158 * MiB;
constexpr size_t WS_BIG = 222 * MiB;
constexpr size_t WS_A5 = WS_BIG + 96 * MiB, WS_E = WS_BIG + 144 * MiB;
constexpr size_t WS_YAYS = 398 * MiB, WS_SSQ = 462 * MiB, WS_END = 464 * MiB;
constexpr size_t WS_SSQA16 = WS_SSQ, WS_SSQA = WS_SSQ + 1 * MiB, WS_SSQS4 = WS_SSQA + 65536, WS_SSQX8 = WS_SSQS4 + 4 * 65536;
constexpr int CW_BAR = 4096;
static_assert((size_t)(CW_BAR + 3456) * 4 <= CTL_ZERO_BYTES, "ctl");

constexpr int RING_BYTES = 131072;
constexpr int MISC_OFF = 143360;
constexpr int LDS_BYTES = 147456;

__device__ __forceinline__ unsigned cvt_pk_bf16(float lo, float hi) { unsigned r; asm volatile("v_cvt_pk_bf16_f32 %0, %1, %2" : "=v"(r) : "v"(lo), "v"(hi)); return r; }
__device__ __forceinline__ float bf_lo(unsigned w) { return __uint_as_float(w << 16); }
__device__ __forceinline__ float bf_hi(unsigned w) { return __uint_as_float(w & 0xffff0000u); }
__device__ __forceinline__ float fast_rcp(float x) { return __builtin_amdgcn_rcpf(x); }
__device__ __forceinline__ float fast_exp2(float x) { return __builtin_amdgcn_exp2f(x); }
__device__ __forceinline__ float sigmoidf_(float x) { return fast_rcp(1.0f + fast_exp2(-1.44269504089f * x)); }
__device__ __forceinline__ float gelu_tanh(float x) { const float t = x * (1.0f + 0.044715f * x * x); return x * fast_rcp(1.0f + fast_exp2(-2.30220818f * t)); }
__device__ __forceinline__ float wave_sum(float v) {
#pragma unroll
    for (int o = 1; o < 64; o <<= 1) v += __shfl_xor(v, o);
    return v;
}

namespace pg8 {
constexpr int BM = 256, BK = 64, HALF = 128, HTB = HALF * BK * 2, NXCD = 8, WGM = 8;
__host__ __device__ __forceinline__ int lds_byte(int r, int c) { const int st = (r >> 4) * 2 + (c >> 5), rr = r & 15, cc = c & 31, ob = rr * 64 + cc * 2; return st * 1024 + (ob ^ (((ob >> 9) & 1) << 5)); }
__host__ __device__ __forceinline__ void stage_rc(int b, int& R, int& C) { const int st = b / 1024, sb = b % 1024, swz = sb ^ (((sb >> 9) & 1) << 5); R = (st >> 1) * 16 + swz / 64; C = (st & 1) * 32 + (swz % 64) / 2; }
__host__ __device__ __forceinline__ int perm32(int rho) { const int n = rho >> 4, i = rho & 15; return 8 * (i >> 2) + 4 * n + (i & 3); }

struct Unit { int pm, pn, g, kh; };
struct Gemm { const bf16_t* A; const bf16_t* Bt; int lda, ldb, K; size_t sA, sB; };

struct StaticOrder {
    int nM, nN, nwg, G, c;
    __device__ void init(int M_, int N_, int G_, int c_) { nM = M_ / BM; nN = N_ / BM; nwg = nM * nN; G = G_; c = c_; }
    __device__ bool next(int i, Unit& u) const {
        const long L = (long)i * G + c; if (L >= nwg) return false;
        int wgid = (int)L; { const int q = nwg / NXCD, r = nwg % NXCD, xcd = wgid % NXCD, off = wgid / NXCD; wgid = (xcd < r ? xcd * (q + 1) : r * (q + 1) + (xcd - r) * q) + off; }
        const int nig = WGM * nN, gid = wgid / nig, fm = gid * WGM, gsz = (nM - fm) < WGM ? (nM - fm) : WGM;
        u.pm = fm + ((wgid % nig) % gsz); u.pn = (wgid % nig) / gsz; u.g = 0; u.kh = 0; return true;
    }
};
struct SplitKOrder {
    StaticOrder so;
    __device__ bool next(int i, Unit& u) const { if (!so.next(i >> 1, u)) return false; u.kh = i & 1; return true; }
};
struct BatchOrder {
    int nM, nN, nwg, G, c;
    __device__ void init(int nM_, int nN_, int nb, int G_, int c_) { nM = nM_; nN = nN_; nwg = nM * nN * nb; G = G_; c = c_; }
    __device__ bool next(int i, Unit& u) const {
        const long L = (long)i * G + c; if (L >= nwg) return false;
        const int l = (int)L; u.pn = l % nN; u.pm = (l / nN) % nM; u.g = (l / (nN * nM)) % SG; u.kh = 0; return true;
    }
};

template <class Epi, class Sched>
__device__ __forceinline__ void gemm_phase(LAS unsigned char* lds, const Gemm g, const Sched& S, const Epi& E) {
    int tid = threadIdx.x; asm volatile("" : "+v"(tid));
    const int wid = __builtin_amdgcn_readfirstlane(tid >> 6), lane = tid & 63, wr = wid >> 2, wc = wid & 3, fr = lane & 15, fq = lane >> 4;
    const int K = g.K, nt = K / BK;
    unsigned voffA[2], voffB[2];
#pragma unroll
    for (int i = 0; i < 2; ++i) { int R, C; stage_rc(tid * 16 + i * 8192, R, C); const int Rb = Epi::PERM ? ((R & ~31) + perm32(R & 31)) : R;
        voffA[i] = (unsigned)(R * g.lda + C) * 2u; voffB[i] = (unsigned)(Rb * g.ldb + C) * 2u; }
    const size_t kstep = (size_t)(BK * 2);
    const size_t hstepA = (size_t)HALF * g.lda * 2, hstepB = (size_t)HALF * g.ldb * 2;
    const unsigned ldsw = (unsigned)wid * 1024u;
    const int aoff = lds_byte(wr * 64 + fr, fq * 8), boff = lds_byte(wc * 32 + fr, fq * 8);
#define PG8_SA(b, h) (((b) * 2 + (h)) * HTB)
#define PG8_SB(b, h) ((4 + (b) * 2 + (h)) * HTB)
#define PG8_STAGE(bufoff, gbase, voff) do { _Pragma("unroll") for (int _i = 0; _i < 2; ++_i) \
        __builtin_amdgcn_global_load_lds((const unsigned*)((const char*)(gbase) + (voff)[_i]), (LAS unsigned*)(lds + (bufoff) + ldsw + _i * 8192), 16, 0, 0); } while (0)
#define PG8_LDA(dst, b, h) do { _Pragma("unroll") for (int m = 0; m < 4; ++m) _Pragma("unroll") for (int k = 0; k < 2; ++k) dst[m][k] = *(const LAS bf16x8*)(lds + PG8_SA(b, h) + aoff + m * 2048 + k * 1024); } while (0)
#define PG8_LDB(dst, b, h) do { _Pragma("unroll") for (int n = 0; n < 2; ++n) _Pragma("unroll") for (int k = 0; k < 2; ++k) dst[n][k] = *(const LAS bf16x8*)(lds + PG8_SB(b, h) + boff + n * 2048 + k * 1024); } while (0)
#define PG8_MMA(ai, bj, At, Bt) do { __builtin_amdgcn_s_setprio(1); _Pragma("unroll") for (int m = 0; m < 4; ++m) _Pragma("unroll") for (int n = 0; n < 2; ++n) _Pragma("unroll") for (int k = 0; k < 2; ++k) \
        acc[ai][bj][m][n] = __builtin_amdgcn_mfma_f32_16x16x32_bf16(Bt[n][k], At[m][k], acc[ai][bj][m][n], 0, 0, 0); __builtin_amdgcn_s_setprio(0); } while (0)
#define PG8_WAIT_V(n) asm volatile("s_waitcnt vmcnt(" #n ")" ::: "memory")
#define PG8_WAIT_L(n) asm volatile("s_waitcnt lgkmcnt(" #n ")" ::: "memory")
#define PG8_BAR __builtin_amdgcn_s_barrier()
#define PG8_SCHED __builtin_amdgcn_sched_barrier(0)
    Unit cur, nxt; int ui = 0;
    if (!S.next(0, cur)) return;
    f32x4 acc[2][2][4][2];
#pragma unroll
    for (int a = 0; a < 2; ++a)
#pragma unroll
        for (int b = 0; b < 2; ++b)
#pragma unroll
            for (int m = 0; m < 4; ++m)
#pragma unroll
                for (int n = 0; n < 2; ++n) acc[a][b][m][n] = (f32x4){0.f, 0.f, 0.f, 0.f};
    bf16x8 At[4][2], B0[2][2], B1[2][2];
    const char* cA = (const char*)g.A + ((size_t)cur.g * g.sA + (size_t)cur.pm * BM * g.lda + (size_t)cur.kh * K) * 2;
    const char* cB = (const char*)g.Bt + ((size_t)cur.g * g.sB + (size_t)cur.pn * BM * g.ldb + (size_t)cur.kh * K) * 2;
    PG8_STAGE(PG8_SB(0, 0), cB, voffB); PG8_STAGE(PG8_SB(0, 1), cB + hstepB, voffB); PG8_STAGE(PG8_SA(0, 0), cA, voffA); PG8_STAGE(PG8_SA(0, 1), cA + hstepA, voffA);
    if (wr == 1) PG8_BAR;
    PG8_WAIT_V(2); PG8_BAR;
    PG8_STAGE(PG8_SB(1, 0), cB + kstep, voffB); PG8_STAGE(PG8_SA(1, 0), cA + kstep, voffA); PG8_STAGE(PG8_SB(1, 1), cB + hstepB + kstep, voffB);
    PG8_WAIT_V(6); PG8_BAR;
    for (;;) {
        const bool has_next = S.next(ui + 1, nxt);
        const char* nA = has_next ? (const char*)g.A + ((size_t)nxt.g * g.sA + (size_t)nxt.pm * BM * g.lda + (size_t)nxt.kh * K) * 2 : cA;
        const char* nB = has_next ? (const char*)g.Bt + ((size_t)nxt.g * g.sB + (size_t)nxt.pn * BM * g.ldb + (size_t)nxt.kh * K) * 2 : cB;
        for (int t = 0; t < nt; t += 2) {
            const bool last = (t == nt - 2);
            const char* a1 = cA + (size_t)(t + 1) * kstep;
            const char* a2 = last ? nA : cA + (size_t)(t + 2) * kstep; const char* b2 = last ? nB : cB + (size_t)(t + 2) * kstep;
            const char* a3 = a2 + kstep; const char* b3 = b2 + kstep;
            PG8_LDB(B0, 0, 0); PG8_LDB(B1, 0, 1); PG8_SCHED; PG8_LDA(At, 0, 0); PG8_STAGE(PG8_SA(1, 1), a1 + hstepA, voffA);
            PG8_WAIT_V(8); PG8_WAIT_L(0); PG8_BAR; PG8_MMA(0, 0, At, B0); PG8_MMA(0, 1, At, B1); PG8_BAR; PG8_SCHED;
            PG8_LDA(At, 0, 1); PG8_STAGE(PG8_SB(0, 0), b2, voffB); PG8_STAGE(PG8_SB(0, 1), b2 + hstepB, voffB); PG8_STAGE(PG8_SA(0, 0), a2, voffA);
            PG8_WAIT_V(8); PG8_WAIT_L(0); PG8_BAR; PG8_MMA(1, 0, At, B0); PG8_MMA(1, 1, At, B1); PG8_BAR; PG8_SCHED;
            PG8_LDB(B0, 1, 0); PG8_LDB(B1, 1, 1); PG8_SCHED; PG8_LDA(At, 1, 0); PG8_STAGE(PG8_SA(0, 1), a2 + hstepA, voffA);
            PG8_WAIT_V(8); PG8_WAIT_L(0); PG8_BAR; PG8_MMA(0, 0, At, B0); PG8_MMA(0, 1, At, B1); PG8_BAR; PG8_SCHED;
            PG8_LDA(At, 1, 1); PG8_STAGE(PG8_SB(1, 0), b3, voffB); PG8_STAGE(PG8_SB(1, 1), b3 + hstepB, voffB); PG8_STAGE(PG8_SA(1, 0), a3, voffA);
            PG8_WAIT_V(8); PG8_WAIT_L(0); PG8_BAR; PG8_MMA(1, 0, At, B0); PG8_MMA(1, 1, At, B1); PG8_BAR; PG8_SCHED;
        }
        if (wr == 0) PG8_BAR;
        E(acc, cur, wr, wc, fr, fq);
        if (!has_next) break;
        if (!(Epi::KSPLIT && cur.kh == 0)) {
#pragma unroll
        for (int a = 0; a < 2; ++a)
#pragma unroll
            for (int b = 0; b < 2; ++b)
#pragma unroll
                for (int m = 0; m < 4; ++m)
#pragma unroll
                    for (int n = 0; n < 2; ++n) acc[a][b][m][n] = (f32x4){0.f, 0.f, 0.f, 0.f};
        }
        cur = nxt; cA = nA; cB = nB; ++ui;
        if (wr == 1) PG8_BAR;
    }
    PG8_WAIT_V(0);
    PG8_BAR;
#undef PG8_SA
#undef PG8_SB
#undef PG8_STAGE
#undef PG8_LDA
#undef PG8_LDB
#undef PG8_MMA
#undef PG8_WAIT_V
#undef PG8_WAIT_L
#undef PG8_BAR
#undef PG8_SCHED
}

__device__ __forceinline__ u32x4 pack8(const f32x4 a, const f32x4 b) { u32x4 w; w.x = cvt_pk_bf16(a[0], a[1]); w.y = cvt_pk_bf16(a[2], a[3]); w.z = cvt_pk_bf16(b[0], b[1]); w.w = cvt_pk_bf16(b[2], b[3]); return w; }

struct EpiZ {
    static constexpr bool PERM = true, KSPLIT = false;
    bf16_t* QKV; bf16_t* A5; const float* qg; const float* kg; LAS float* X;
    __device__ __forceinline__ void operator()(f32x4 (&acc)[2][2][4][2], const Unit& u, int wr, int wc, int fr, int fq) const {
        if (u.pn < 8) {
#pragma unroll
            for (int ai = 0; ai < 2; ++ai)
#pragma unroll
                for (int m = 0; m < 4; ++m)
#pragma unroll
                    for (int bj = 0; bj < 2; ++bj) { const f32x4 a0 = acc[ai][bj][m][0], a1 = acc[ai][bj][m][1];
                        float ss = (a0[0] * a0[0] + a0[1] * a0[1]) + (a0[2] * a0[2] + a0[3] * a0[3]) + (a1[0] * a1[0] + a1[1] * a1[1]) + (a1[2] * a1[2] + a1[3] * a1[3]);
                        ss += __shfl_xor(ss, 16); ss += __shfl_xor(ss, 32);
                        if (fq == 0) X[(ai * HALF + wr * 64 + m * 16 + fr) * 8 + bj * 4 + wc] = ss; }
            asm volatile("s_waitcnt lgkmcnt(0)" ::: "memory"); __builtin_amdgcn_s_barrier(); asm volatile("" ::: "memory");
            const float* gp = (u.pn < 4 ? qg : kg) + ((wc & 1) * 32 + 8 * fq); const float gs = u.pn < 4 ? 0.125f : 1.0f;
            const f32x4 g0 = *(const f32x4*)gp * gs, g1 = *(const f32x4*)(gp + 4) * gs;
#pragma unroll
            for (int ai = 0; ai < 2; ++ai)
#pragma unroll
                for (int m = 0; m < 4; ++m) { const int rl = ai * HALF + wr * 64 + m * 16 + fr, row = u.pm * BM + rl;
#pragma unroll
                    for (int bj = 0; bj < 2; ++bj) { const f32x2 pr = *(const LAS f32x2*)(X + rl * 8 + bj * 4 + (wc & 2)); const float rn = __builtin_amdgcn_rsqf((pr.x + pr.y) * (1.0f / HD) + RMS_EPS);
                        const int c8 = u.pn * BM + bj * HALF + wc * 32 + 8 * fq;
                        *(u32x4*)(QKV + (size_t)row * NQKV + c8) = pack8(acc[ai][bj][m][0] * g0 * rn, acc[ai][bj][m][1] * g1 * rn); } }
            return;
        }
#pragma unroll
        for (int ai = 0; ai < 2; ++ai)
#pragma unroll
            for (int m = 0; m < 4; ++m) { const int row = u.pm * BM + ai * HALF + wr * 64 + m * 16 + fr;
#pragma unroll
                for (int bj = 0; bj < 2; ++bj) { const int c8 = u.pn * BM + bj * HALF + wc * 32 + 8 * fq; const u32x4 w = pack8(acc[ai][bj][m][0], acc[ai][bj][m][1]);
                    if (u.pn < 12) *(u32x4*)(QKV + (size_t)row * NQKV + c8) = w;
                    else { const int ch = c8 - NQKV, gg = ch >> 4, c0 = ch & 15, R = row >> 5, s = row & 31; *(u32x4*)(A5 + ((size_t)gg * RCH + R) * KS5 + s * SC + c0) = w; } } }
    }
};
struct EpiE {
    static constexpr bool PERM = false, KSPLIT = false;
    float* E;
    __device__ __forceinline__ void operator()(f32x4 (&acc)[2][2][4][2], const Unit& u, int wr, int wc, int fr, int fq) const {
#pragma unroll
        for (int ai = 0; ai < 2; ++ai)
#pragma unroll
            for (int m = 0; m < 4; ++m) { const int R = u.pm * BM + ai * HALF + wr * 64 + m * 16 + fr; float* rowp = E + ((size_t)u.g * RCH + R) * 256 + wc * 32 + 4 * fq;
#pragma unroll
                for (int bj = 0; bj < 2; ++bj)
#pragma unroll
                    for (int n = 0; n < 2; ++n) *(f32x4*)(rowp + bj * HALF + n * 16) = acc[ai][bj][m][n]; }
    }
};
struct EpiS5Out {
    static constexpr bool PERM = true, KSPLIT = false;
    bf16_t* Yg;
    __device__ __forceinline__ void operator()(f32x4 (&acc)[2][2][4][2], const Unit& u, int wr, int wc, int fr, int fq) const {
#pragma unroll
        for (int ai = 0; ai < 2; ++ai)
#pragma unroll
            for (int m = 0; m < 4; ++m) { const int R = u.pm * BM + ai * HALF + wr * 64 + m * 16 + fr;
#pragma unroll
                for (int bj = 0; bj < 2; ++bj) { const int n8 = u.pn * BM + bj * HALF + wc * 32 + 8 * fq, s = n8 >> 4, c0 = n8 & 15;
                    f32x4 v0 = acc[ai][bj][m][0], v1 = acc[ai][bj][m][1];
#pragma unroll
                    for (int e = 0; e < 4; ++e) { v0[e] = gelu_tanh(v0[e]); v1[e] = gelu_tanh(v1[e]); }
                    *(u32x4*)(Yg + (size_t)(R * CL + s) * SW + u.g * SC + c0) = pack8(v0, v1); } }
    }
};
struct EpiGlu {
    static constexpr bool PERM = true, KSPLIT = false;
    const bf16_t* Yg; const float* bias; bf16_t* YAYS; float* ssq4; LAS float* X;
    __device__ __forceinline__ void operator()(f32x4 (&acc)[2][2][4][2], const Unit& u, int wr, int wc, int fr, int fq) const {
        const int c8b = u.pn * BM + wc * 32 + 8 * fq;
        f32x4 bv[2][2];
#pragma unroll
        for (int bj = 0; bj < 2; ++bj)
#pragma unroll
            for (int n = 0; n < 2; ++n) bv[bj][n] = *(const f32x4*)(bias + c8b + bj * HALF + 4 * n);
#pragma unroll
        for (int ai = 0; ai < 2; ++ai)
#pragma unroll
            for (int m = 0; m < 4; ++m) { const int row = u.pm * BM + ai * HALF + wr * 64 + m * 16 + fr; float ss = 0.f;
#pragma unroll
                for (int bj = 0; bj < 2; ++bj) { const int c8 = c8b + bj * HALF; const u32x4 y = *(const u32x4*)(Yg + (size_t)row * SW + c8);
                    const f32x4 a0 = acc[ai][bj][m][0] + bv[bj][0], a1 = acc[ai][bj][m][1] + bv[bj][1];
                    f32x4 v0, v1;
                    v0[0] = bf_lo(y.x) * sigmoidf_(a0[0]); v0[1] = bf_hi(y.x) * sigmoidf_(a0[1]); v0[2] = bf_lo(y.y) * sigmoidf_(a0[2]); v0[3] = bf_hi(y.y) * sigmoidf_(a0[3]);
                    v1[0] = bf_lo(y.z) * sigmoidf_(a1[0]); v1[1] = bf_hi(y.z) * sigmoidf_(a1[1]); v1[2] = bf_lo(y.w) * sigmoidf_(a1[2]); v1[3] = bf_hi(y.w) * sigmoidf_(a1[3]);
#pragma unroll
                    for (int e = 0; e < 4; ++e) ss += v0[e] * v0[e] + v1[e] * v1[e];
                    *(u32x4*)(YAYS + (size_t)row * DM + AW + c8) = pack8(v0, v1); }
                ss += __shfl_xor(ss, 16); ss += __shfl_xor(ss, 32);
                if (fq == 0) X[(ai * HALF + wr * 64 + m * 16 + fr) * 4 + wc] = ss; }
        asm volatile("s_waitcnt lgkmcnt(0)" ::: "memory"); __builtin_amdgcn_s_barrier(); asm volatile("" ::: "memory");
        if (wc == 0 && fq == 0) {
#pragma unroll
            for (int ai = 0; ai < 2; ++ai)
#pragma unroll
                for (int m = 0; m < 4; ++m) { const int rl = ai * HALF + wr * 64 + m * 16 + fr; const f32x4 p = *(const LAS f32x4*)(X + rl * 4);
                    ssq4[(size_t)u.pn * M + u.pm * BM + rl] = (p[0] + p[1]) + (p[2] + p[3]); } }
    }
};
struct EpiRes1 {
    static constexpr bool PERM = true, KSPLIT = true;
    const float* x; bf16_t* XB; const float* ssqa; const float* ssqs4; float* ssqx8; LAS float* X;
    __device__ __forceinline__ void operator()(f32x4 (&acc)[2][2][4][2], const Unit& u, int wr, int wc, int fr, int fq) const {
        if (u.kh == 0) {
#pragma unroll
        for (int ai = 0; ai < 2; ++ai)
#pragma unroll
            for (int m = 0; m < 4; ++m) { const int row = u.pm * BM + ai * HALF + wr * 64 + m * 16 + fr;
                const float sq = (ssqs4[row] + ssqs4[M + row]) + (ssqs4[2 * M + row] + ssqs4[3 * M + row]);
                const float ra = __builtin_amdgcn_rsqf(ssqa[row] * (1.0f / AW) + RMS_EPS), rs = __builtin_amdgcn_rsqf(sq * (1.0f / SW) + RMS_EPS), f = ra * fast_rcp(rs);
#pragma unroll
                for (int bj = 0; bj < 2; ++bj)
#pragma unroll
                    for (int n = 0; n < 2; ++n) acc[ai][bj][m][n] *= f; }
        return; }
#pragma unroll
        for (int ai = 0; ai < 2; ++ai)
#pragma unroll
            for (int m = 0; m < 4; ++m) { const int row = u.pm * BM + ai * HALF + wr * 64 + m * 16 + fr; float ss = 0.f;
                const float sq = (ssqs4[row] + ssqs4[M + row]) + (ssqs4[2 * M + row] + ssqs4[3 * M + row]);
                const float rs = __builtin_amdgcn_rsqf(sq * (1.0f / SW) + RMS_EPS);
#pragma unroll
                for (int bj = 0; bj < 2; ++bj) { const size_t off = (size_t)row * DM + u.pn * BM + bj * HALF + wc * 32 + 8 * fq;
                    const f32x4 x0 = *(const f32x4*)(x + off), x1 = *(const f32x4*)(x + off + 4);
                    const f32x4 v0 = x0 + acc[ai][bj][m][0] * rs, v1 = x1 + acc[ai][bj][m][1] * rs;
#pragma unroll
                    for (int e = 0; e < 4; ++e) ss += v0[e] * v0[e] + v1[e] * v1[e];
                    *(u32x4*)(XB + off) = pack8(v0, v1); }
                ss += __shfl_xor(ss, 16); ss += __shfl_xor(ss, 32);
                if (fq == 0) X[(ai * HALF + wr * 64 + m * 16 + fr) * 4 + wc] = ss;
                asm volatile("" ::: "memory"); }
        asm volatile("s_waitcnt lgkmcnt(0)" ::: "memory"); __builtin_amdgcn_s_barrier(); asm volatile("" ::: "memory");
        if (wc == 0 && fq == 0) {
#pragma unroll
            for (int ai = 0; ai < 2; ++ai)
#pragma unroll
                for (int m = 0; m < 4; ++m) { const int rl = ai * HALF + wr * 64 + m * 16 + fr; const f32x4 p = *(const LAS f32x4*)(X + rl * 4);
                    ssqx8[(size_t)u.pn * M + u.pm * BM + rl] = (p[0] + p[1]) + (p[2] + p[3]); } }
    }
};
struct EpiSwiGLU {
    static constexpr bool PERM = true, KSPLIT = false;
    bf16_t* H; const float* ssqx8;
    __device__ __forceinline__ void operator()(f32x4 (&acc)[2][2][4][2], const Unit& u, int wr, int wc, int fr, int fq) const {
#pragma unroll
        for (int ai = 0; ai < 2; ++ai)
#pragma unroll
            for (int m = 0; m < 4; ++m) { const int row = u.pm * BM + ai * HALF + wr * 64 + m * 16 + fr;
                float sq = 0.f;
#pragma unroll
                for (int t = 0; t < 8; ++t) sq += ssqx8[(size_t)t * M + row];
                const float rs = __builtin_amdgcn_rsqf(sq * (1.0f / DM) + RMS_EPS);
                f32x4 h0, h1;
#pragma unroll
                for (int e = 0; e < 4; ++e) { const float g0 = acc[ai][0][m][0][e] * rs, u0 = acc[ai][1][m][0][e] * rs, g1 = acc[ai][0][m][1][e] * rs, u1 = acc[ai][1][m][1][e] * rs;
                    h0[e] = g0 * sigmoidf_(g0) * u0; h1[e] = g1 * sigmoidf_(g1) * u1; }
                *(u32x4*)(H + (size_t)row * DFF + u.pn * HALF + wc * 32 + 8 * fq) = pack8(h0, h1); }
    }
};
struct EpiRes2 {
    static constexpr bool PERM = true, KSPLIT = false;
    float* out; const bf16_t* XB;
    __device__ __forceinline__ void operator()(f32x4 (&acc)[2][2][4][2], const Unit& u, int wr, int wc, int fr, int fq) const {
#pragma unroll
        for (int ai = 0; ai < 2; ++ai)
#pragma unroll
            for (int m = 0; m < 4; ++m) { const size_t roff = (size_t)(u.pm * BM + ai * HALF + wr * 64 + m * 16 + fr) * DM + u.pn * BM + wc * 32 + 8 * fq;
#pragma unroll
                for (int bj = 0; bj < 2; ++bj) { const size_t off = roff + bj * HALF; const u32x4 xb = *(const u32x4*)(XB + off);
                    f32x4 v0, v1; v0[0] = bf_lo(xb.x); v0[1] = bf_hi(xb.x); v0[2] = bf_lo(xb.y); v0[3] = bf_hi(xb.y); v1[0] = bf_lo(xb.z); v1[1] = bf_hi(xb.z); v1[2] = bf_lo(xb.w); v1[3] = bf_hi(xb.w);
                    *(f32x4*)(out + off) = v0 + acc[ai][bj][m][0]; *(f32x4*)(out + off + 4) = v1 + acc[ai][bj][m][1]; }
                asm volatile("" ::: "memory"); }
    }
};
}

#define RLX_AGENT __ATOMIC_RELAXED, __HIP_MEMORY_SCOPE_AGENT
#define XB_TMO      128
#define XB_XCNT(j)  (256  + 64 * (j))
#define XB_XSUB(j)  (1280 + 64 * (j))
#define XB_XGEN(j)  (2304 + 64 * (j))
#define XB_TOP      3328
#define XB_TOPGEN   3392
#define XCD_BAR_WORDS 3456
#define XB_SPIN_CAP (1u << 24)
__device__ __forceinline__ unsigned xb_ld(unsigned* p)              { return __hip_atomic_load(p, __ATOMIC_RELAXED, __HIP_MEMORY_SCOPE_AGENT); }
__device__ __forceinline__ unsigned xb_add(unsigned* p, unsigned v) { return __hip_atomic_fetch_add(p, v, __ATOMIC_RELAXED, __HIP_MEMORY_SCOPE_AGENT); }
__device__ __forceinline__ unsigned xb_xcc_id() { return (unsigned)__builtin_amdgcn_s_getreg((3 << 11) | 20) & 0xFu; }
#define XB_SPIN(cond, bar) do { unsigned _sp = 0; while (cond) { __builtin_amdgcn_s_sleep(1); \
    if ((++_sp & 255u) == 0u) { if (xb_ld(&(bar)[XB_TMO])) break; if (_sp > XB_SPIN_CAP) { atomicAdd(&(bar)[XB_TMO], 1u); break; } } } } while (0)
struct XcdBarrier { unsigned* bar; unsigned x; volatile LAS unsigned* st; };
__device__ __forceinline__ XcdBarrier xcd_barrier_post(unsigned* bar, volatile LAS unsigned* st) {
    XcdBarrier b; b.bar = bar; b.x = xb_xcc_id(); b.st = st;
    if (threadIdx.x == 0) (void)xb_add(&bar[XB_XCNT(b.x)], 1u);
    return b;
}
__device__ __forceinline__ void xcd_barrier_complete(unsigned* bar, unsigned x, unsigned& nloc, unsigned& nx) {
    const unsigned G = gridDim.x * gridDim.y * gridDim.z;
    unsigned sum, cnt, mine, sp = 0u;
    for (;;) {
        sum = 0u; cnt = 0u; mine = 0u;
#pragma unroll
        for (unsigned j = 0; j < 16; ++j) { const unsigned c = xb_ld(&bar[XB_XCNT(j)]); sum += c; cnt += (c > 0u) ? 1u : 0u; mine = (j == x) ? c : mine; }
        if (sum == G) break;
        __builtin_amdgcn_s_sleep(1);
        if ((++sp & 255u) == 0u) { if (xb_ld(&bar[XB_TMO])) break; if (sp > XB_SPIN_CAP) { atomicAdd(&bar[XB_TMO], 1u); break; } }
    }
    nloc = mine > 0u ? mine : 1u; nx = cnt > 0u ? cnt : 1u;
}
__device__ __forceinline__ void xcd_barrier(const XcdBarrier& b) {
    asm volatile("s_waitcnt vmcnt(0)" ::: "memory");
    __syncthreads();
    if (threadIdx.x == 0) {
        unsigned* bar = b.bar;
        __builtin_amdgcn_s_waitcnt(0);
        unsigned nloc = b.st[0], nx = b.st[1];
        if (nloc == 0u) { xcd_barrier_complete(bar, b.x, nloc, nx); b.st[0] = nloc; b.st[1] = nx; }
        const unsigned old = xb_add(&bar[XB_XSUB(b.x)], 1u);
        const unsigned gen = old / nloc;
        if (old + 1u == (gen + 1u) * nloc) {
            __builtin_amdgcn_fence(__ATOMIC_RELEASE, "agent");
            asm volatile("s_waitcnt vmcnt(0)" ::: "memory");
            const unsigned og = xb_add(&bar[XB_TOP], 1u);
            const unsigned tg = og / nx;
            if (og + 1u == (tg + 1u) * nx) xb_add(&bar[XB_TOPGEN], 1u);
            else XB_SPIN(xb_ld(&bar[XB_TOPGEN]) == tg, bar);
            __builtin_amdgcn_fence(__ATOMIC_ACQUIRE, "agent");
            xb_add(&bar[XB_XGEN(b.x)], 1u);
            asm volatile("s_waitcnt vmcnt(0)" ::: "memory");
        } else {
            XB_SPIN(xb_ld(&bar[XB_XGEN(b.x)]) == gen, bar);
            __builtin_amdgcn_fence(__ATOMIC_ACQUIRE, "agent");
            asm volatile("s_waitcnt vmcnt(0)" ::: "memory");
        }
    }
    __syncthreads();
}

struct Args { const float* in[23]; float* out; unsigned char* ws; int ph_lo, ph_hi, li, dup; };
enum { I_X = 0, I_GMIX, I_WIN, I_QG, I_KG, I_RPB, I_ARE, I_AIM, I_BRE, I_BIM, I_CRE, I_CIM, I_LS, I_D, I_WGLU, I_BGLU, I_GOA, I_GOS, I_WOUT, I_GFFN, I_WG, I_WU, I_WD };

#define LDS_WAIT() asm volatile("s_waitcnt lgkmcnt(0)" ::: "memory")

__device__ __forceinline__ void p0_transpose_item(const float* W, int N, const float* kscale, bf16_t* WT, int ldd, int drow0, int k0, int n0, int lane) {
    const int c = lane >> 3, n4 = (lane & 7) * 4;
    const float* src = W + (size_t)(k0 + 8 * c) * N + n0 + n4;
    f32x4 v[2][8];
#pragma unroll
    for (int h = 0; h < 2; ++h)
#pragma unroll
        for (int i = 0; i < 8; ++i) v[h][i] = __builtin_nontemporal_load((const f32x4*)(src + (size_t)i * N + 32 * h));
    if (kscale) { const f32x4 s0 = *(const f32x4*)(kscale + k0 + 8 * c), s1 = *(const f32x4*)(kscale + k0 + 8 * c + 4);
#pragma unroll
        for (int h = 0; h < 2; ++h)
#pragma unroll
            for (int i = 0; i < 8; ++i) v[h][i] *= (i < 4 ? s0[i & 3] : s1[i & 3]); }
#pragma unroll
    for (int h = 0; h < 2; ++h)
#pragma unroll
        for (int e = 0; e < 4; ++e) { u32x4 o; o.x = cvt_pk_bf16(v[h][0][e], v[h][1][e]); o.y = cvt_pk_bf16(v[h][2][e], v[h][3][e]); o.z = cvt_pk_bf16(v[h][4][e], v[h][5][e]); o.w = cvt_pk_bf16(v[h][6][e], v[h][7][e]);
            *(u32x4*)(WT + (size_t)(drow0 + 32 * h + n4 + e) * ldd + k0 + 8 * c) = o; }
}

__device__ __forceinline__ void dsincos(double a, double& s, double& c) {
    const double k = __builtin_rint(a * 0.63661977236758134308);
    double r = __builtin_fma(-k, 1.57079632679489655800e+00, a);
    r = __builtin_fma(-k, 6.12323399573676603587e-17, r);
    const double r2 = r * r;
    double sp = -7.6471637318198164759e-13; sp = sp * r2 + 1.6059043836821614599e-10; sp = sp * r2 - 2.5052108385441718775e-08; sp = sp * r2 + 2.7557319223985890653e-06;
    sp = sp * r2 - 1.9841269841269841270e-04; sp = sp * r2 + 8.3333333333333333333e-03; sp = sp * r2 - 1.6666666666666666667e-01; sp = sp * r2 * r + r;
    double cp = 4.7794773323873852974e-14; cp = cp * r2 - 1.1470745597729724714e-11; cp = cp * r2 + 2.0876756987868098979e-09; cp = cp * r2 - 2.7557319223985890653e-07;
    cp = cp * r2 + 2.4801587301587301587e-05; cp = cp * r2 - 1.3888888888888888889e-03; cp = cp * r2 + 4.1666666666666666667e-02; cp = cp * r2 - 0.5; cp = cp * r2 + 1.0;
    const int q = (int)((long long)k) & 3;
    s = (q == 0) ? sp : (q == 1) ? cp : (q == 2) ? -sp : -cp;
    c = (q == 0) ? cp : (q == 1) ? -sp : (q == 2) ? -cp : sp;
}

struct S5Params { f32x4 br4, bi4, cr4, ci4; float are, aim, ls; };
__device__ __forceinline__ void p0_s5_params(const Args& a, int g, int tid, S5Params& P) {
    const float* a_re = a.in[I_ARE]; const float* a_im = a.in[I_AIM]; const float* b_re = a.in[I_BRE]; const float* b_im = a.in[I_BIM];
    const float* c_re = a.in[I_CRE]; const float* c_im = a.in[I_CIM]; const float* lstep = a.in[I_LS];
#pragma unroll
    for (int j = 0; j < 4; ++j) { const int i = tid + 512 * j, c = i & 15, p = (i >> 4) & 63, d = i >> 10;
        const size_t bi = (((size_t)d * SG + g) * SP + p) * SC + c, ci = (((size_t)d * SG + g) * SC + c) * SP + p;
        P.br4[j] = b_re[bi]; P.bi4[j] = b_im[bi]; P.cr4[j] = c_re[ci]; P.ci4[j] = c_im[ci]; }
    { const int p = tid & 63, d = (tid >> 6) & 1; P.are = a_re[(d * SG + g) * SP + p]; P.aim = a_im[(d * SG + g) * SP + p]; P.ls = lstep[d * SG + g]; }
}
__device__ __forceinline__ void p0_s5_tables(const Args& a, LAS unsigned char* lds, int g, int q, int tid, const S5Params& P) {
    LAS f32x2* LP = (LAS f32x2*)lds;
    LAS float* Bb = (LAS float*)(lds + 33792);
    LAS f32x2* Cm = (LAS f32x2*)(lds + 50176);
    LAS float* Kt = (LAS float*)(lds + 66560);
    const float* dsk = a.in[I_D];
    unsigned char* ws = a.ws;
    __syncthreads();
    LAS f32x2* Fp = (LAS f32x2*)(Kt);
    if (tid < 128) { const int p = tid & 63, d = tid >> 6;
        const double lre = (double)fminf(P.are, -1e-4f), lim = (double)P.aim, dt = exp((double)P.ls);
        const double mag = exp(lre * dt); double sn, cs; dsincos(lim * dt, sn, cs);
        const double lr = mag * cs, li = mag * sn;
        const double nr = lr - 1.0, ni = li, den = 1.0 / (lre * lre + lim * lim);
        Fp[d * 64 + p] = (f32x2){(float)((nr * lre + ni * lim) * den), (float)((ni * lre - nr * lim) * den)};
        double wr_ = 1.0, wi_ = 0.0;
        for (int tau = 0; tau <= CL; ++tau) { LP[(d * 64 + p) * 33 + tau] = (f32x2){(float)wr_, (float)wi_}; const double t_ = wr_ * lr - wi_ * li; wi_ = wr_ * li + wi_ * lr; wr_ = t_; } }
    __syncthreads();
#pragma unroll
    for (int j = 0; j < 4; ++j) { const int i = tid + 512 * j, c = i & 15, p = (i >> 4) & 63, d = i >> 10; const f32x2 f = Fp[d * 64 + p];
        Bb[(d * 64 + p) * 32 + c] = f.x * P.br4[j] - f.y * P.bi4[j]; Bb[(d * 64 + p) * 32 + 16 + c] = f.x * P.bi4[j] + f.y * P.br4[j];
        Cm[i] = (f32x2){P.cr4[j], P.ci4[j]}; }
    __syncthreads();
    if (q == 0 && tid < 128) { const int p = tid & 63, d = tid >> 6; ((f32x2*)(ws + WS_LAML))[(g * 2 + d) * SP + p] = LP[(d * 64 + p) * 33 + CL]; }
    { const int wv = __builtin_amdgcn_readfirstlane(tid >> 6), l = tid & 63, c16 = l & 15, g4 = l >> 4;
#pragma unroll 1
      for (int d = 0; d < 2; ++d) {
        bf16x8 Bf[4];
#pragma unroll
        for (int ks = 0; ks < 4; ++ks) { float v[8];
#pragma unroll
            for (int j = 0; j < 8; ++j) v[j] = Bb[(d * 64 + 32 * (ks & 1) + 8 * g4 + j) * 32 + (ks >> 1) * 16 + c16];
            u32x4 w; w.x = cvt_pk_bf16(v[0], v[1]); w.y = cvt_pk_bf16(v[2], v[3]); w.z = cvt_pk_bf16(v[4], v[5]); w.w = cvt_pk_bf16(v[6], v[7]); Bf[ks] = __builtin_bit_cast(bf16x8, w); }
#pragma unroll 1
        for (int tt = 0; tt < 4; ++tt) { const int tau = wv + 8 * tt;
            f32x4 acc = (f32x4){0.f, 0.f, 0.f, 0.f};
#pragma unroll
            for (int ks = 0; ks < 2; ++ks) { float gr[8], gi[8];
#pragma unroll
                for (int j = 0; j < 8; ++j) { const int p = 32 * ks + 8 * g4 + j; const f32x2 cm = Cm[(d * 64 + p) * 16 + c16], lp = LP[(d * 64 + p) * 33 + tau];
                    gr[j] = cm.x * lp.x - cm.y * lp.y; gi[j] = -(cm.x * lp.y + cm.y * lp.x); }
                u32x4 wr_, wi_; wr_.x = cvt_pk_bf16(gr[0], gr[1]); wr_.y = cvt_pk_bf16(gr[2], gr[3]); wr_.z = cvt_pk_bf16(gr[4], gr[5]); wr_.w = cvt_pk_bf16(gr[6], gr[7]);
                wi_.x = cvt_pk_bf16(gi[0], gi[1]); wi_.y = cvt_pk_bf16(gi[2], gi[3]); wi_.z = cvt_pk_bf16(gi[4], gi[5]); wi_.w = cvt_pk_bf16(gi[6], gi[7]);
                acc = __builtin_amdgcn_mfma_f32_16x16x32_bf16(__builtin_bit_cast(bf16x8, wr_), Bf[ks], acc, 0, 0, 0);
                acc = __builtin_amdgcn_mfma_f32_16x16x32_bf16(__builtin_bit_cast(bf16x8, wi_), Bf[2 + ks], acc, 0, 0, 0); }
#pragma unroll
            for (int e = 0; e < 4; ++e) Kt[((d * 32 + tau) * 16 + 4 * g4 + e) * 16 + c16] = acc[e]; } } }
    __syncthreads();
    { const int d = q >> 1, ri = q & 1, p = tid >> 3, s0 = (tid & 7) * 4;
      bf16_t* dst = (bf16_t*)(ws + WS_WST) + ((size_t)g * 256 + q * 64 + p) * 512 + s0 * 16;
      float bx_[16], by_[16];
#pragma unroll
      for (int e = 0; e < 16; ++e) { bx_[e] = Bb[(d * 64 + p) * 32 + e]; by_[e] = Bb[(d * 64 + p) * 32 + 16 + e]; }
#pragma unroll
      for (int sp = 0; sp < 4; ++sp) { const int pw = d == 0 ? (CL - 1 - (s0 + sp)) : (s0 + sp); const f32x2 lp = LP[(d * 64 + p) * 33 + pw]; float v[16];
#pragma unroll
          for (int e = 0; e < 16; ++e) v[e] = ri == 0 ? (lp.x * bx_[e] - lp.y * by_[e]) : (lp.x * by_[e] + lp.y * bx_[e]);
          u32x4 w0, w1; w0.x = cvt_pk_bf16(v[0], v[1]); w0.y = cvt_pk_bf16(v[2], v[3]); w0.z = cvt_pk_bf16(v[4], v[5]); w0.w = cvt_pk_bf16(v[6], v[7]);
          w1.x = cvt_pk_bf16(v[8], v[9]); w1.y = cvt_pk_bf16(v[10], v[11]); w1.z = cvt_pk_bf16(v[12], v[13]); w1.w = cvt_pk_bf16(v[14], v[15]);
          *(u32x4*)(dst + sp * 16) = w0; *(u32x4*)(dst + sp * 16 + 8) = w1; } }
    { const int c = tid & 15, s = 8 * q + ((tid >> 4) & 7), hi2 = tid >> 7;
      bf16_t* dst = (bf16_t*)(ws + WS_TW) + ((size_t)g * 512 + s * 16 + c) * KS5;
      const float dsv = dsk[g * SC + c];
#pragma unroll 1
      for (int it = 0; it < 8; ++it) { const int sp = hi2 + 4 * it; f32x4 v[4];
          const LAS f32x4* k0 = (const LAS f32x4*)(Kt + ((sp <= s ? (s - sp) : (32 + sp - s)) * 16 + c) * 16);
#pragma unroll
          for (int e = 0; e < 4; ++e) v[e] = k0[e];
          if (sp == s) { const LAS f32x4* k1 = (const LAS f32x4*)(Kt + (32 * 16 + c) * 16);
#pragma unroll
              for (int e = 0; e < 4; ++e) v[e] += k1[e];
#pragma unroll
              for (int e = 0; e < 4; ++e)
#pragma unroll
                  for (int k = 0; k < 4; ++k) v[e][k] += (c == 4 * e + k) ? dsv : 0.f; }
          u32x4 w0, w1; w0.x = cvt_pk_bf16(v[0][0], v[0][1]); w0.y = cvt_pk_bf16(v[0][2], v[0][3]); w0.z = cvt_pk_bf16(v[1][0], v[1][1]); w0.w = cvt_pk_bf16(v[1][2], v[1][3]);
          w1.x = cvt_pk_bf16(v[2][0], v[2][1]); w1.y = cvt_pk_bf16(v[2][2], v[2][3]); w1.z = cvt_pk_bf16(v[3][0], v[3][1]); w1.w = cvt_pk_bf16(v[3][2], v[3][3]);
          *(u32x4*)(dst + sp * 16) = w0; *(u32x4*)(dst + sp * 16 + 8) = w1; }
      { const int d = hi2 >> 1, ri = hi2 & 1, pw = d == 0 ? (s + 1) : (CL - s);
#pragma unroll 1
        for (int pb = 0; pb < 8; ++pb) { float v[8];
#pragma unroll
            for (int e = 0; e < 8; ++e) { const int p = 8 * pb + e; const f32x2 cm = Cm[(d * 64 + p) * 16 + c], lp = LP[(d * 64 + p) * 33 + pw];
                v[e] = ri == 0 ? (cm.x * lp.x - cm.y * lp.y) : -(cm.x * lp.y + cm.y * lp.x); }
            u32x4 w; w.x = cvt_pk_bf16(v[0], v[1]); w.y = cvt_pk_bf16(v[2], v[3]); w.z = cvt_pk_bf16(v[4], v[5]); w.w = cvt_pk_bf16(v[6], v[7]);
            *(u32x4*)(dst + 512 + hi2 * 64 + 8 * pb) = w; } } }
    __syncthreads();
}

__device__ __forceinline__ void p0_prologue(const Args& a, LAS unsigned char* lds, int vcu, int G, int tid) {
    asm volatile("" : "+v"(tid));
    const int wave = __builtin_amdgcn_readfirstlane(tid >> 6), lane = tid & 63;
    unsigned char* ws = a.ws;
    S5Params P5; p0_s5_params(a, (vcu < SG * 4 ? vcu : SG * 4 - 1) >> 2, tid, P5);
    if (vcu & 1) { for (int it = vcu; it < SG * 4; it += G) { if (it != vcu) p0_s5_params(a, it >> 2, tid, P5); p0_s5_tables(a, lds, it >> 2, it & 3, tid, P5); } }
    const int gw = vcu * 8 + wave, NGW = G * 8;
    constexpr int I_IN = (DM / 64) * (INW / 64), I_GL = (SW / 64) * (SW / 64), I_OUT = (DM / 64) * (DM / 64), I_GU = (DM / 64) * (DFF / 64), I_DN = (DFF / 64) * (DM / 64);
    constexpr int NITEMS = I_IN + I_GL + I_OUT + 2 * I_GU + I_DN;
    for (int it = gw; it < NITEMS; it += NGW) {
        int r = it;
        if (r < I_IN) { const int nb = INW / 64, kb = r / nb, n0 = (r % nb) * 64; p0_transpose_item(a.in[I_WIN], INW, nullptr, (bf16_t*)(ws + WS_WIN), DM, n0, kb * 64, n0, lane); continue; } r -= I_IN;
        if (r < I_GL) { const int nb = SW / 64, kb = r / nb, n0 = (r % nb) * 64; p0_transpose_item(a.in[I_WGLU], SW, nullptr, (bf16_t*)(ws + WS_WGLU), SW, n0, kb * 64, n0, lane); continue; } r -= I_GL;
        if (r < I_OUT) { const int nb = DM / 64, kb = r / nb, n0 = (r % nb) * 64, k0 = kb * 64;
            p0_transpose_item(a.in[I_WOUT], DM, k0 < AW ? a.in[I_GOA] : a.in[I_GOS] - AW, (bf16_t*)(ws + WS_WOUT), DM, n0, k0, n0, lane); continue; } r -= I_OUT;
        if (r < 2 * I_GU) { const int up = r >= I_GU; if (up) r -= I_GU; const int nb = DFF / 64, kb = r / nb, n0 = (r % nb) * 64;
            p0_transpose_item(up ? a.in[I_WU] : a.in[I_WG], DFF, a.in[I_GFFN], (bf16_t*)(ws + WS_WGU), DM, 256 * (n0 >> 7) + (n0 & 127) + (up ? 128 : 0), kb * 64, n0, lane); continue; } r -= 2 * I_GU;
        { const int nb = DM / 64, kb = r / nb, n0 = (r % nb) * 64; p0_transpose_item(a.in[I_WD], DM, nullptr, (bf16_t*)(ws + WS_WD), DFF, n0, kb * 64, n0, lane); }
    }
    const float* x = a.in[I_X]; const float* gm = a.in[I_GMIX]; bf16_t* XN = (bf16_t*)(ws + WS_XN);
    for (int m = gw; m < M; m += 2 * NGW) { const int m1 = m + NGW < M ? m + NGW : m;
        const f32x4* xr0 = (const f32x4*)(x + (size_t)m * DM) + lane; const f32x4* xr1 = (const f32x4*)(x + (size_t)m1 * DM) + lane; f32x4 v0[8], v1[8]; float s0 = 0.f, s1 = 0.f;
#pragma unroll
        for (int j = 0; j < 8; ++j) { v0[j] = __builtin_nontemporal_load(xr0 + 64 * j); v1[j] = __builtin_nontemporal_load(xr1 + 64 * j); }
#pragma unroll
        for (int j = 0; j < 8; ++j) { s0 += (v0[j][0] * v0[j][0] + v0[j][1] * v0[j][1]) + (v0[j][2] * v0[j][2] + v0[j][3] * v0[j][3]); s1 += (v1[j][0] * v1[j][0] + v1[j][1] * v1[j][1]) + (v1[j][2] * v1[j][2] + v1[j][3] * v1[j][3]); }
        const float r0 = 1.0f / sqrtf(wave_sum(s0) * (1.0f / DM) + RMS_EPS), r1 = 1.0f / sqrtf(wave_sum(s1) * (1.0f / DM) + RMS_EPS);
        u32x2* o0 = (u32x2*)(XN + (size_t)m * DM) + lane; u32x2* o1 = (u32x2*)(XN + (size_t)m1 * DM) + lane;
#pragma unroll
        for (int j = 0; j < 8; ++j) { const f32x4 gq = ((const f32x4*)gm)[64 * j + lane]; u32x2 w; w.x = cvt_pk_bf16(v0[j][0] * r0 * gq[0], v0[j][1] * r0 * gq[1]); w.y = cvt_pk_bf16(v0[j][2] * r0 * gq[2], v0[j][3] * r0 * gq[3]); o0[64 * j] = w;
            u32x2 w2; w2.x = cvt_pk_bf16(v1[j][0] * r1 * gq[0], v1[j][1] * r1 * gq[1]); w2.y = cvt_pk_bf16(v1[j][2] * r1 * gq[2], v1[j][3] * r1 * gq[3]); o1[64 * j] = w2; }
    }
    if (!(vcu & 1)) { for (int it = vcu; it < SG * 4; it += G) { if (it != vcu) p0_s5_params(a, it >> 2, tid, P5); p0_s5_tables(a, lds, it >> 2, it & 3, tid, P5); } }
}

constexpr int KROW = 144, AROW = 160;
constexpr int AHEAD = 64 * AROW;
constexpr int ABUF = 2 * AHEAD;
constexpr int ATT_RPB_OFF = 2 * ABUF;
static_assert(ATT_RPB_OFF + 16 * 465 * 4 <= MISC_OFF, "attention LDS");

__device__ __forceinline__ void attn_phase(const Args& a, LAS unsigned char* lds, volatile LAS unsigned* MISC, int vcu, int G, int has_g2, int tid) {
    asm volatile("" : "+v"(tid));
    const int wave = __builtin_amdgcn_readfirstlane(tid >> 6), lane = tid & 63, ql = lane & 15, g4 = lane >> 4;
    const bf16_t* QKV = (const bf16_t*)(a.ws + WS_BIG); bf16_t* YAYS = (bf16_t*)(a.ws + WS_YAYS); float* ssqa16 = (float*)(a.ws + WS_SSQA16);
    LAS float* rpbL = (LAS float*)(lds + ATT_RPB_OFF);
    for (int i = tid; i < 16 * 465; i += 512) rpbL[i] = a.in[I_RPB][i];
    const int j = wave & 3, hsel = wave >> 2;
    const int cq = 16 * j + ql, cs = min(max(cq - 8, 0), GRIDW - 16), wb = (j == 0) ? 0 : (j == 1) ? 8 : (j == 2) ? 24 : 32;
    int it_lo, it_hi, it_step = 1;
    if (G == 256) { const int x_ = vcu >> 5, k_ = vcu & 31; if (has_g2) { it_lo = x_ * 256 + 6 * (k_ & 15); it_hi = it_lo + 6; } else { it_lo = x_ * 256 + 96 + 10 * (k_ & 15); it_hi = it_lo + 10; } }
    else { it_lo = vcu; it_hi = BATCH * NROWS * 8; it_step = G; }
#define ATT_FETCH(dst) do { if (tid == 0) { const int nx_ = ((dst) == 20) ? it_lo : item + it_step; MISC[dst] = (unsigned)(nx_ < it_hi ? nx_ : -1); } } while (0)
    int item = 0;
    ATT_FETCH(20);
    __syncthreads();
    item = __builtin_amdgcn_readfirstlane((int)MISC[20]);
    const int skey = tid >> 3, sch = tid & 7;
    const unsigned ldstK = (unsigned)(skey * KROW + sch * 16), ldstV = (unsigned)(skey * AROW + sch * 16);
    u32x4 R[4][2];
#define ATT_SRC(it_, st_, i_) (QKV + ((size_t)((it_) >> 9) * SEQ + 64 * (min(max((((it_) >> 3) & 63) - 4, 0), NROWS - 8) + ((st_) & 7)) + skey) * NQKV + ((st_) < 8 ? AW : 2 * AW) + 64 * (2 * ((it_) & 7) + (i_)) + 8 * sch)
    if (item >= 0) {
#pragma unroll
        for (int p = 0; p < 3; ++p)
#pragma unroll
            for (int i = 0; i < 2; ++i) R[p][i] = *(const u32x4*)ATT_SRC(item, p, i);
    }
    while (item >= 0) {
        const int b = item >> 9, r = (item >> 3) & 63, hp = item & 7, h = 2 * hp + hsel, row_start = min(max(r - 4, 0), NROWS - 8);
        ATT_FETCH(21);
        const size_t tq = (size_t)b * SEQ + 64 * r + cq;
        bf16x8 Qf[2];
        { const u32x4* qp = (const u32x4*)(QKV + tq * NQKV + 64 * h + 8 * g4); Qf[0] = __builtin_bit_cast(bf16x8, qp[0]); Qf[1] = __builtin_bit_cast(bf16x8, qp[4]); }
        const LAS float* bl = rpbL + h * 465 + (row_start - r + 7) * 31 + (wb + 4 * g4 - cq + 15);
        f32x4 S[8][2]; bf16x8 Pf[8]; f32x4 O[4]; float sum = 0.f; int nitem = -1;
#pragma unroll
        for (int dt = 0; dt < 4; ++dt) O[dt] = (f32x4){0.f, 0.f, 0.f, 0.f};
#pragma unroll
        for (int st = 0; st < 16; ++st) {
            LAS unsigned char* buf = lds + (st & 1) * ABUF;
            { const unsigned ld_ = st < 8 ? ldstK : ldstV; *(LAS u32x4*)(buf + ld_) = R[st & 3][0]; *(LAS u32x4*)(buf + AHEAD + ld_) = R[st & 3][1]; }
            if (st + 3 < 16) {
#pragma unroll
                for (int i = 0; i < 2; ++i) R[(st + 3) & 3][i] = *(const u32x4*)ATT_SRC(item, st + 3, i);
            } else if (nitem >= 0) {
#pragma unroll
                for (int i = 0; i < 2; ++i) R[(st + 3) & 3][i] = *(const u32x4*)ATT_SRC(nitem, st + 3 - 16, i);
            }
            asm volatile("s_waitcnt lgkmcnt(0)" ::: "memory"); __builtin_amdgcn_s_barrier(); asm volatile("" ::: "memory");
            if (st == 0) nitem = __builtin_amdgcn_readfirstlane((int)MISC[21]);
            const LAS unsigned char* hb = buf + hsel * AHEAD;
            if (st < 8) {
                const int kr = st;
#pragma unroll
                for (int t = 0; t < 2; ++t) {
                    const LAS unsigned char* kp = hb + (wb + 16 * t + ql) * KROW + g4 * 16;
                    const bf16x8 k0 = *(const LAS bf16x8*)kp, k1 = *(const LAS bf16x8*)(kp + 64);
                    f32x4 acc = (f32x4){0.f, 0.f, 0.f, 0.f};
                    acc = __builtin_amdgcn_mfma_f32_16x16x32_bf16(k0, Qf[0], acc, 0, 0, 0);
                    acc = __builtin_amdgcn_mfma_f32_16x16x32_bf16(k1, Qf[1], acc, 0, 0, 0);
#pragma unroll
                    for (int e = 0; e < 4; ++e) { const int ck = wb + 16 * t + 4 * g4 + e;
                        const float bias = bl[kr * 31 + 16 * t + e];
                        acc[e] = (ck >= cs && ck < cs + 16) ? acc[e] + bias : -1e30f; }
                    S[kr][t] = acc; }
                if (st == 7) {
                    float mx = -1e30f;
#pragma unroll
                    for (int k2 = 0; k2 < 8; ++k2)
#pragma unroll
                        for (int t = 0; t < 2; ++t)
#pragma unroll
                            for (int e = 0; e < 4; ++e) mx = fmaxf(mx, S[k2][t][e]);
                    mx = fmaxf(mx, __shfl_xor(mx, 16)); mx = fmaxf(mx, __shfl_xor(mx, 32));
#pragma unroll
                    for (int k2 = 0; k2 < 8; ++k2) { f32x4 p0, p1;
#pragma unroll
                        for (int e = 0; e < 4; ++e) { p0[e] = fast_exp2((S[k2][0][e] - mx) * 1.44269504089f); p1[e] = fast_exp2((S[k2][1][e] - mx) * 1.44269504089f); sum += p0[e] + p1[e]; }
                        Pf[k2] = __builtin_bit_cast(bf16x8, pg8::pack8(p0, p1)); }
                    sum += __shfl_xor(sum, 16); sum += __shfl_xor(sum, 32);
                }
            } else {
                const int kr = st - 8;
                const LAS unsigned char* rp = hb + (wb + 4 * g4 + ((lane & 15) >> 2)) * AROW + (lane & 3) * 8;
#pragma unroll
                for (int dt = 0; dt < 4; ++dt) {
                    const s16x4 lo = __builtin_amdgcn_ds_read_tr16_b64_v4i16((LAS s16x4*)(rp + dt * 32));
                    const s16x4 hi = __builtin_amdgcn_ds_read_tr16_b64_v4i16((LAS s16x4*)(rp + 16 * AROW + dt * 32));
                    const bf16x8 av = (bf16x8){lo[0], lo[1], lo[2], lo[3], hi[0], hi[1], hi[2], hi[3]};
                    O[dt] = __builtin_amdgcn_mfma_f32_16x16x32_bf16(av, Pf[kr], O[dt], 0, 0, 0); }
            }
        }
        const float inv = fast_rcp(sum); float ssq_acc = 0.f;
        bf16_t* op = YAYS + tq * DM + 64 * h + 4 * g4;
#pragma unroll
        for (int dt = 0; dt < 4; ++dt) { const f32x4 o = O[dt] * inv; ssq_acc += (o[0] * o[0] + o[1] * o[1]) + (o[2] * o[2] + o[3] * o[3]);
            u32x2 w; w.x = cvt_pk_bf16(o[0], o[1]); w.y = cvt_pk_bf16(o[2], o[3]); *(u32x2*)(op + 16 * dt) = w; }
        ssq_acc += __shfl_xor(ssq_acc, 16); ssq_acc += __shfl_xor(ssq_acc, 32);
        if (g4 == 0) ssqa16[tq * 16 + h] = ssq_acc;
        item = nitem;
    }
#undef ATT_FETCH
#undef ATT_SRC
}

__device__ __forceinline__ void scan_phase(const Args& a, int vcu, int G, int tid) {
    asm volatile("" : "+v"(tid));
    if (tid >= 128) return;
    const float* E = (const float*)(a.ws + WS_E); bf16_t* A5 = (bf16_t*)(a.ws + WS_A5); const f32x2* LAML = (const f32x2*)(a.ws + WS_LAML);
    for (int idx = vcu * 128 + tid; idx < BATCH * SG * 2 * SP; idx += G * 128) {
        const int p = idx & 63, d = (idx >> 6) & 1, g = (idx >> 7) & 63, b = idx >> 13;
        const f32x2 lam = LAML[(g * 2 + d) * SP + p];
        float xr = 0.f, xi = 0.f;
#pragma unroll 8
        for (int kk = 0; kk < NCH; ++kk) { const int k = d == 0 ? kk : NCH - 1 - kk; const size_t R = (size_t)g * RCH + b * NCH + k;
            bf16_t* ap = A5 + R * KS5 + 512 + d * 128 + p; ap[0] = (bf16_t)(cvt_pk_bf16(xr, 0.f) & 0xffffu); ap[64] = (bf16_t)(cvt_pk_bf16(xi, 0.f) & 0xffffu);
            const float er = E[R * 256 + d * 128 + p], ei = E[R * 256 + d * 128 + 64 + p];
            const float nr = lam.x * xr - lam.y * xi + er, ni = lam.x * xi + lam.y * xr + ei; xr = nr; xi = ni; }
    }
}

__global__ void __launch_bounds__(512, 2) hymba_fwd(Args args) {
    extern __shared__ __attribute__((aligned(16))) unsigned char lds_raw[];
    LAS unsigned char* lds = (LAS unsigned char*)lds_raw;
    volatile LAS unsigned* MISC = (volatile LAS unsigned*)(lds + MISC_OFF);
    const int tid = threadIdx.x;
    const int G = gridDim.x; const int bx = blockIdx.x; const int vcu = (G % 8 == 0) ? (bx % 8) * (G / 8) + bx / 8 : bx;
    unsigned char* ws = args.ws;
    unsigned* ctl = (unsigned*)(ws + WS_CTL);
    for (int u = tid; u < (LDS_BYTES - MISC_OFF) / 4; u += 512) MISC[u] = 0u;
    __syncthreads();
    XcdBarrier bar; bar.bar = ctl + CW_BAR; bar.x = 0; bar.st = nullptr;
    if (MK_N_LAUNCHES == 1) bar = xcd_barrier_post(ctl + CW_BAR, MISC + 8);
    const int lo = args.ph_lo, hi = args.ph_hi;
#define IN(k) (lo <= (k) && (k) < hi)
#define SEAM(k) do { if (IN(k) && IN((k) + 1)) xcd_barrier(bar); } while (0)
    bf16_t* WIN = (bf16_t*)(ws + WS_WIN); bf16_t* WGLU = (bf16_t*)(ws + WS_WGLU); bf16_t* WOUT = (bf16_t*)(ws + WS_WOUT); bf16_t* WGU = (bf16_t*)(ws + WS_WGU); bf16_t* WD = (bf16_t*)(ws + WS_WD);
    bf16_t* WST = (bf16_t*)(ws + WS_WST); bf16_t* TW = (bf16_t*)(ws + WS_TW);
    bf16_t* XN = (bf16_t*)(ws + WS_XN); bf16_t* YG = (bf16_t*)(ws + WS_XN); bf16_t* XB = (bf16_t*)(ws + WS_XN);
    bf16_t* QKV = (bf16_t*)(ws + WS_BIG); bf16_t* A5 = (bf16_t*)(ws + WS_A5); float* E = (float*)(ws + WS_E); bf16_t* HB = (bf16_t*)(ws + WS_BIG);
    bf16_t* YAYS = (bf16_t*)(ws + WS_YAYS);
    float* ssqa16 = (float*)(ws + WS_SSQA16); float* ssqa = (float*)(ws + WS_SSQA); float* ssqs4 = (float*)(ws + WS_SSQS4); float* ssqx8 = (float*)(ws + WS_SSQX8);
    LAS float* XL = (LAS float*)(lds + RING_BYTES);

#define REP(k) _Pragma("unroll") for (int rep_ = (DUP_PHASE == (k)) ? 0 : 1; rep_ < 2; ++rep_)
#define ALPHA ((rep_ == 0 && args.dup >= 0) ? 0.0f : 1.0f)
    if (IN(0)) { REP(0) { p0_prologue(args, lds, vcu, G, tid); __syncthreads(); } SEAM(0); }
    if (IN(1)) {
        pg8::Gemm g{XN, WIN, DM, DM, DM, 0, 0}; pg8::StaticOrder S; S.init(M, INW, G, bx);
        pg8::EpiZ Ep{QKV, A5, args.in[I_QG], args.in[I_KG], XL};
        REP(1) pg8::gemm_phase(lds, g, S, Ep);
        SEAM(1);
    }
    if (IN(2)) {
        { pg8::Gemm g{A5, WST, KS5, 512, 512, (size_t)RCH * KS5, (size_t)256 * 512}; pg8::BatchOrder S; S.init(2, 1, SG * (DUP_PHASE == 2 ? 2 : 1), G, bx);
          pg8::EpiE Ep{E};
          pg8::gemm_phase(lds, g, S, Ep); }
        __syncthreads();
        attn_phase(args, lds, MISC, vcu, G, bx < 128 ? 1 : 0, tid);
        SEAM(2);
    }
    if (IN(3)) { REP(3) scan_phase(args, vcu, G, tid); SEAM(3); }
    if (IN(4)) {
        pg8::Gemm g{A5, TW, KS5, KS5, KS5, (size_t)RCH * KS5, (size_t)512 * KS5}; pg8::BatchOrder S; S.init(2, 2, SG * (DUP_PHASE == 4 ? 2 : 1), G, bx);
        pg8::EpiS5Out Ep{YG};
        pg8::gemm_phase(lds, g, S, Ep);
        SEAM(4);
    }
    if (IN(5)) {
        pg8::Gemm g{YG, WGLU, SW, SW, SW, 0, 0}; pg8::StaticOrder S; S.init(M, SW, G, bx);
        for (int t = vcu * 512 + tid; t < M; t += G * 512) { const f32x4* p = (const f32x4*)(ssqa16 + (size_t)t * 16); const f32x4 s0 = p[0], s1 = p[1], s2 = p[2], s3 = p[3];
            const f32x4 sv = (s0 + s1) + (s2 + s3); ssqa[t] = (sv[0] + sv[1]) + (sv[2] + sv[3]); }
        REP(5) { pg8::EpiGlu Ep{YG, args.in[I_BGLU], YAYS, ssqs4, XL}; pg8::gemm_phase(lds, g, S, Ep); }
        SEAM(5);
    }
    if (IN(6)) {
        pg8::Gemm g{YAYS, WOUT, DM, DM, AW, 0, 0}; pg8::SplitKOrder S; S.so.init(M, DM, G, bx);
        REP(6) { pg8::EpiRes1 Ep{args.in[I_X], XB, ssqa, ssqs4, ssqx8, XL}; pg8::gemm_phase(lds, g, S, Ep); }
        SEAM(6);
    }
    if (IN(7)) {
        pg8::Gemm g{XB, WGU, DM, DM, DM, 0, 0}; pg8::StaticOrder S; S.init(M, 2 * DFF, G, bx);
        pg8::EpiSwiGLU Ep{HB, ssqx8};
        REP(7) pg8::gemm_phase(lds, g, S, Ep);
        SEAM(7);
    }
    if (IN(8)) {
        pg8::Gemm g{HB, WD, DFF, DFF, DFF, 0, 0}; pg8::StaticOrder S; S.init(M, DM, G, bx);
        REP(8) { pg8::EpiRes2 Ep{args.out, XB}; pg8::gemm_phase(lds, g, S, Ep); }
    }
#undef IN
#undef SEAM
}

extern "C" void kernel_launch(void* const* d_in, const int* in_sizes, int n_in, void* d_out, int out_size, void* d_ws, size_t ws_size, hipStream_t stream) {
    static int grid = 0;
    if (grid == 0) {
        if (n_in != 23 || in_sizes[0] != M * DM || out_size != M * DM || ws_size < WS_END) { fprintf(stderr, "kernel_launch: unexpected shapes (n_in %d, in0 %d, out %d, ws %zu < %zu)\n", n_in, n_in > 0 ? in_sizes[0] : -1, out_size, ws_size, (size_t)WS_END); grid = -1; return; }
        int dev = 0, cus = 0, per_cu = 0;
        if (hipGetDevice(&dev) != hipSuccess || hipDeviceGetAttribute(&cus, hipDeviceAttributeMultiprocessorCount, dev) != hipSuccess) { grid = -1; return; }
        if (hipFuncSetAttribute((const void*)hymba_fwd, hipFuncAttributeMaxDynamicSharedMemorySize, LDS_BYTES) != hipSuccess) { fprintf(stderr, "kernel_launch: hipFuncSetAttribute failed\n"); grid = -1; return; }
        if (hipOccupancyMaxActiveBlocksPerMultiprocessor(&per_cu, (const void*)hymba_fwd, 512, LDS_BYTES) != hipSuccess || per_cu < 1) { fprintf(stderr, "kernel_launch: occupancy query says %d blocks per CU\n", per_cu); (void)hipGetLastError(); per_cu = 1; }
        grid = cus;
    }
    if (grid < 0) return;
    (void)hipMemsetAsync((char*)d_ws + WS_CTL, 0, CTL_ZERO_BYTES, stream);
    Args a{}; a.dup = DUP_PHASE;
    for (int i = 0; i < 23; ++i) a.in[i] = (const float*)d_in[i];
    a.out = (float*)d_out; a.ws = (unsigned char*)d_ws;
    if (MK_N_LAUNCHES == 1) {
        a.ph_lo = 0; a.ph_hi = NPHASE; a.li = 0;
        hipLaunchKernelGGL(hymba_fwd, dim3(grid), dim3(512), LDS_BYTES, stream, a);
    } else {
        for (int li = 0; li < NPHASE; ++li) { a.ph_lo = li; a.ph_hi = li + 1; a.li = li; hipLaunchKernelGGL(hymba_fwd, dim3(grid), dim3(512), LDS_BYTES, stream, a); }
    }
}
```

```cpp
#include <hip/hip_runtime.h>
#include <cstdio>
#include <cstdint>

#define DUP_PHASE (-1)
#ifndef MK_N_LAUNCHES
#define MK_N_LAUNCHES 1
#endif

#define GAS __attribute__((address_space(1)))
#define LAS __attribute__((address_space(3)))
typedef unsigned short bf16_t;
typedef short bf16x8 __attribute__((ext_vector_type(8)));
typedef short s16x4 __attribute__((ext_vector_type(4)));
typedef float f32x4 __attribute__((ext_vector_type(4)));
typedef float f32x2 __attribute__((ext_vector_type(2)));
typedef unsigned u32x4 __attribute__((ext_vector_type(4)));
typedef unsigned u32x2 __attribute__((ext_vector_type(2)));

constexpr int BATCH = 4, SEQ = 4096, DM = 2048, M = BATCH * SEQ;
constexpr int AW = 1024, SW = 1024, NH = 16, HD = 64, NQKV = 3 * AW, INW = 4096, DFF = 5632;
constexpr int GRIDW = 64, NROWS = SEQ / GRIDW;
constexpr int SG = 64, SC = 16, SP = 64;
constexpr int CL = 32, NCH = SEQ / CL, RCH = M / CL;
constexpr int KS5 = CL * SC + 256;
constexpr float RMS_EPS = 1e-6f;
constexpr int NPHASE = 9;

constexpr size_t MiB = 1u << 20;
constexpr size_t WS_CTL = 0, CTL_ZERO_BYTES = 65536;
constexpr size_t WS_WIN = 1 * MiB, WS_WGLU = 17 * MiB, WS_WOUT = 19 * MiB, WS_WGU = 27 * MiB, WS_WD = 71 * MiB;
constexpr size_t WS_WST = 93 * MiB, WS_TW = 109 * MiB, WS_LAML = 157 * MiB;
constexpr size_t WS_XN = 158 * MiB;
constexpr size_t WS_BIG = 222 * MiB;
constexpr size_t WS_A5 = WS_BIG + 96 * MiB, WS_E = WS_BIG + 144 * MiB;
constexpr size_t WS_YAYS = 398 * MiB, WS_SSQ = 462 * MiB, WS_END = 464 * MiB;
constexpr size_t WS_SSQA16 = WS_SSQ, WS_SSQA = WS_SSQ + 1 * MiB, WS_SSQS4 = WS_SSQA + 65536, WS_SSQX8 = WS_SSQS4 + 4 * 65536;
constexpr int CW_BAR = 4096;
static_assert((size_t)(CW_BAR + 3456) * 4 <= CTL_ZERO_BYTES, "ctl");

constexpr int RING_BYTES = 131072;
constexpr int MISC_OFF = 143360;
constexpr int LDS_BYTES = 147456;

__device__ __forceinline__ unsigned cvt_pk_bf16(float lo, float hi) { unsigned r; asm volatile("v_cvt_pk_bf16_f32 %0, %1, %2" : "=v"(r) : "v"(lo), "v"(hi)); return r; }
__device__ __forceinline__ float bf_lo(unsigned w) { return __uint_as_float(w << 16); }
__device__ __forceinline__ float bf_hi(unsigned w) { return __uint_as_float(w & 0xffff0000u); }
__device__ __forceinline__ float fast_rcp(float x) { return __builtin_amdgcn_rcpf(x); }
__device__ __forceinline__ float fast_exp2(float x) { return __builtin_amdgcn_exp2f(x); }
__device__ __forceinline__ float sigmoidf_(float x) { return fast_rcp(1.0f + fast_exp2(-1.44269504089f * x)); }
__device__ __forceinline__ float gelu_tanh(float x) { const float t = x * (1.0f + 0.044715f * x * x); return x * fast_rcp(1.0f + fast_exp2(-2.30220818f * t)); }
__device__ __forceinline__ float wave_sum(float v) {
#pragma unroll
    for (int o = 1; o < 64; o <<= 1) v += __shfl_xor(v, o);
    return v;
}

namespace pg8 {
constexpr int BM = 256, BK = 64, HALF = 128, HTB = HALF * BK * 2, NXCD = 8, WGM = 8;
__host__ __device__ __forceinline__ int lds_byte(int r, int c) { const int st = (r >> 4) * 2 + (c >> 5), rr = r & 15, cc = c & 31, ob = rr * 64 + cc * 2; return st * 1024 + (ob ^ (((ob >> 9) & 1) << 5)); }
__host__ __device__ __forceinline__ void stage_rc(int b, int& R, int& C) { const int st = b / 1024, sb = b % 1024, swz = sb ^ (((sb >> 9) & 1) << 5); R = (st >> 1) * 16 + swz / 64; C = (st & 1) * 32 + (swz % 64) / 2; }
__host__ __device__ __forceinline__ int perm32(int rho) { const int n = rho >> 4, i = rho & 15; return 8 * (i >> 2) + 4 * n + (i & 3); }

struct Unit { int pm, pn, g, kh; };
struct Gemm { const bf16_t* A; const bf16_t* Bt; int lda, ldb, K; size_t sA, sB; };

struct StaticOrder {
    int nM, nN, nwg, G, c;
    __device__ void init(int M_, int N_, int G_, int c_) { nM = M_ / BM; nN = N_ / BM; nwg = nM * nN; G = G_; c = c_; }
    __device__ bool next(int i, Unit& u) const {
        const long L = (long)i * G + c; if (L >= nwg) return false;
        int wgid = (int)L; { const int q = nwg / NXCD, r = nwg % NXCD, xcd = wgid % NXCD, off = wgid / NXCD; wgid = (xcd < r ? xcd * (q + 1) : r * (q + 1) + (xcd - r) * q) + off; }
        const int nig = WGM * nN, gid = wgid / nig, fm = gid * WGM, gsz = (nM - fm) < WGM ? (nM - fm) : WGM;
        u.pm = fm + ((wgid % nig) % gsz); u.pn = (wgid % nig) / gsz; u.g = 0; u.kh = 0; return true;
    }
};
struct SplitKOrder {
    StaticOrder so;
    __device__ bool next(int i, Unit& u) const { if (!so.next(i >> 1, u)) return false; u.kh = i & 1; return true; }
};
struct BatchOrder {
    int nM, nN, nwg, G, c;
    __device__ void init(int nM_, int nN_, int nb, int G_, int c_) { nM = nM_; nN = nN_; nwg = nM * nN * nb; G = G_; c = c_; }
    __device__ bool next(int i, Unit& u) const {
        const long L = (long)i * G + c; if (L >= nwg) return false;
        const int l = (int)L; u.pn = l % nN; u.pm = (l / nN) % nM; u.g = (l / (nN * nM)) % SG; u.kh = 0; return true;
    }
};

template <class Epi, class Sched>
__device__ __forceinline__ void gemm_phase(LAS unsigned char* lds, const Gemm g, const Sched& S, const Epi& E) {
    int tid = threadIdx.x; asm volatile("" : "+v"(tid));
    const int wid = __builtin_amdgcn_readfirstlane(tid >> 6), lane = tid & 63, wr = wid >> 2, wc = wid & 3, fr = lane & 15, fq = lane >> 4;
    const int K = g.K, nt = K / BK;
    unsigned voffA[2], voffB[2];
#pragma unroll
    for (int i = 0; i < 2; ++i) { int R, C; stage_rc(tid * 16 + i * 8192, R, C); const int Rb = Epi::PERM ? ((R & ~31) + perm32(R & 31)) : R;
        voffA[i] = (unsigned)(R * g.lda + C) * 2u; voffB[i] = (unsigned)(Rb * g.ldb + C) * 2u; }
    const size_t kstep = (size_t)(BK * 2);
    const size_t hstepA = (size_t)HALF * g.lda * 2, hstepB = (size_t)HALF * g.ldb * 2;
    const unsigned ldsw = (unsigned)wid * 1024u;
    const int aoff = lds_byte(wr * 64 + fr, fq * 8), boff = lds_byte(wc * 32 + fr, fq * 8);
#define PG8_SA(b, h) (((b) * 2 + (h)) * HTB)
#define PG8_SB(b, h) ((4 + (b) * 2 + (h)) * HTB)
#define PG8_STAGE(bufoff, gbase, voff) do { _Pragma("unroll") for (int _i = 0; _i < 2; ++_i) \
        __builtin_amdgcn_global_load_lds((const unsigned*)((const char*)(gbase) + (voff)[_i]), (LAS unsigned*)(lds + (bufoff) + ldsw + _i * 8192), 16, 0, 0); } while (0)
#define PG8_LDA(dst, b, h) do { _Pragma("unroll") for (int m = 0; m < 4; ++m) _Pragma("unroll") for (int k = 0; k < 2; ++k) dst[m][k] = *(const LAS bf16x8*)(lds + PG8_SA(b, h) + aoff + m * 2048 + k * 1024); } while (0)
#define PG8_LDB(dst, b, h) do { _Pragma("unroll") for (int n = 0; n < 2; ++n) _Pragma("unroll") for (int k = 0; k < 2; ++k) dst[n][k] = *(const LAS bf16x8*)(lds + PG8_SB(b, h) + boff + n * 2048 + k * 1024); } while (0)
#define PG8_MMA(ai, bj, At, Bt) do { __builtin_amdgcn_s_setprio(1); _Pragma("unroll") for (int m = 0; m < 4; ++m) _Pragma("unroll") for (int n = 0; n < 2; ++n) _Pragma("unroll") for (int k = 0; k < 2; ++k) \
        acc[ai][bj][m][n] = __builtin_amdgcn_mfma_f32_16x16x32_bf16(Bt[n][k], At[m][k], acc[ai][bj][m][n], 0, 0, 0); __builtin_amdgcn_s_setprio(0); } while (0)
#define PG8_WAIT_V(n) asm volatile("s_waitcnt vmcnt(" #n ")" ::: "memory")
#define PG8_WAIT_L(n) asm volatile("s_waitcnt lgkmcnt(" #n ")" ::: "memory")
#define PG8_BAR __builtin_amdgcn_s_barrier()
#define PG8_SCHED __builtin_amdgcn_sched_barrier(0)
    Unit cur, nxt; int ui = 0;
    if (!S.next(0, cur)) return;
    f32x4 acc[2][2][4][2];
#pragma unroll
    for (int a = 0; a < 2; ++a)
#pragma unroll
        for (int b = 0; b < 2; ++b)
#pragma unroll
            for (int m = 0; m < 4; ++m)
#pragma unroll
                for (int n = 0; n < 2; ++n) acc[a][b][m][n] = (f32x4){0.f, 0.f, 0.f, 0.f};
    bf16x8 At[4][2], B0[2][2], B1[2][2];
    const char* cA = (const char*)g.A + ((size_t)cur.g * g.sA + (size_t)cur.pm * BM * g.lda + (size_t)cur.kh * K) * 2;
    const char* cB = (const char*)g.Bt + ((size_t)cur.g * g.sB + (size_t)cur.pn * BM * g.ldb + (size_t)cur.kh * K) * 2;
    PG8_STAGE(PG8_SB(0, 0), cB, voffB); PG8_STAGE(PG8_SB(0, 1), cB + hstepB, voffB); PG8_STAGE(PG8_SA(0, 0), cA, voffA); PG8_STAGE(PG8_SA(0, 1), cA + hstepA, voffA);
    if (wr == 1) PG8_BAR;
    PG8_WAIT_V(2); PG8_BAR;
    PG8_STAGE(PG8_SB(1, 0), cB + kstep, voffB); PG8_STAGE(PG8_SA(1, 0), cA + kstep, voffA); PG8_STAGE(PG8_SB(1, 1), cB + hstepB + kstep, voffB);
    PG8_WAIT_V(6); PG8_BAR;
    for (;;) {
        const bool has_next = S.next(ui + 1, nxt);
        const char* nA = has_next ? (const char*)g.A + ((size_t)nxt.g * g.sA + (size_t)nxt.pm * BM * g.lda + (size_t)nxt.kh * K) * 2 : cA;
        const char* nB = has_next ? (const char*)g.Bt + ((size_t)nxt.g * g.sB + (size_t)nxt.pn * BM * g.ldb + (size_t)nxt.kh * K) * 2 : cB;
        for (int t = 0; t < nt; t += 2) {
            const bool last = (t == nt - 2);
            const char* a1 = cA + (size_t)(t + 1) * kstep;
            const char* a2 = last ? nA : cA + (size_t)(t + 2) * kstep; const char* b2 = last ? nB : cB + (size_t)(t + 2) * kstep;
            const char* a3 = a2 + kstep; const char* b3 = b2 + kstep;
            PG8_LDB(B0, 0, 0); PG8_LDB(B1, 0, 1); PG8_SCHED; PG8_LDA(At, 0, 0); PG8_STAGE(PG8_SA(1, 1), a1 + hstepA, voffA);
            PG8_WAIT_V(8); PG8_WAIT_L(0); PG8_BAR; PG8_MMA(0, 0, At, B0); PG8_MMA(0, 1, At, B1); PG8_BAR; PG8_SCHED;
            PG8_LDA(At, 0, 1); PG8_STAGE(PG8_SB(0, 0), b2, voffB); PG8_STAGE(PG8_SB(0, 1), b2 + hstepB, voffB); PG8_STAGE(PG8_SA(0, 0), a2, voffA);
            PG8_WAIT_V(8); PG8_WAIT_L(0); PG8_BAR; PG8_MMA(1, 0, At, B0); PG8_MMA(1, 1, At, B1); PG8_BAR; PG8_SCHED;
            PG8_LDB(B0, 1, 0); PG8_LDB(B1, 1, 1); PG8_SCHED; PG8_LDA(At, 1, 0); PG8_STAGE(PG8_SA(0, 1), a2 + hstepA, voffA);
            PG8_WAIT_V(8); PG8_WAIT_L(0); PG8_BAR; PG8_MMA(0, 0, At, B0); PG8_MMA(0, 1, At, B1); PG8_BAR; PG8_SCHED;
            PG8_LDA(At, 1, 1); PG8_STAGE(PG8_SB(1, 0), b3, voffB); PG8_STAGE(PG8_SB(1, 1), b3 + hstepB, voffB); PG8_STAGE(PG8_SA(1, 0), a3, voffA);
            PG8_WAIT_V(8); PG8_WAIT_L(0); PG8_BAR; PG8_MMA(1, 0, At, B0); PG8_MMA(1, 1, At, B1); PG8_BAR; PG8_SCHED;
        }
        if (wr == 0) PG8_BAR;
        E(acc, cur, wr, wc, fr, fq);
        if (!has_next) break;
        if (!(Epi::KSPLIT && cur.kh == 0)) {
#pragma unroll
        for (int a = 0; a < 2; ++a)
#pragma unroll
            for (int b = 0; b < 2; ++b)
#pragma unroll
                for (int m = 0; m < 4; ++m)
#pragma unroll
                    for (int n = 0; n < 2; ++n) acc[a][b][m][n] = (f32x4){0.f, 0.f, 0.f, 0.f};
        }
        cur = nxt; cA = nA; cB = nB; ++ui;
        if (wr == 1) PG8_BAR;
    }
    PG8_WAIT_V(0);
    PG8_BAR;
#undef PG8_SA
#undef PG8_SB
#undef PG8_STAGE
#undef PG8_LDA
#undef PG8_LDB
#undef PG8_MMA
#undef PG8_WAIT_V
#undef PG8_WAIT_L
#undef PG8_BAR
#undef PG8_SCHED
}

__device__ __forceinline__ u32x4 pack8(const f32x4 a, const f32x4 b) { u32x4 w; w.x = cvt_pk_bf16(a[0], a[1]); w.y = cvt_pk_bf16(a[2], a[3]); w.z = cvt_pk_bf16(b[0], b[1]); w.w = cvt_pk_bf16(b[2], b[3]); return w; }

struct EpiZ {
    static constexpr bool PERM = true, KSPLIT = false;
    bf16_t* QKV; bf16_t* A5; const float* qg; const float* kg; LAS float* X;
    __device__ __forceinline__ void operator()(f32x4 (&acc)[2][2][4][2], const Unit& u, int wr, int wc, int fr, int fq) const {
        if (u.pn < 8) {
#pragma unroll
            for (int ai = 0; ai < 2; ++ai)
#pragma unroll
                for (int m = 0; m < 4; ++m)
#pragma unroll
                    for (int bj = 0; bj < 2; ++bj) { const f32x4 a0 = acc[ai][bj][m][0], a1 = acc[ai][bj][m][1];
                        float ss = (a0[0] * a0[0] + a0[1] * a0[1]) + (a0[2] * a0[2] + a0[3] * a0[3]) + (a1[0] * a1[0] + a1[1] * a1[1]) + (a1[2] * a1[2] + a1[3] * a1[3]);
                        ss += __shfl_xor(ss, 16); ss += __shfl_xor(ss, 32);
                        if (fq == 0) X[(ai * HALF + wr * 64 + m * 16 + fr) * 8 + bj * 4 + wc] = ss; }
            asm volatile("s_waitcnt lgkmcnt(0)" ::: "memory"); __builtin_amdgcn_s_barrier(); asm volatile("" ::: "memory");
            const float* gp = (u.pn < 4 ? qg : kg) + ((wc & 1) * 32 + 8 * fq); const float gs = u.pn < 4 ? 0.125f : 1.0f;
            const f32x4 g0 = *(const f32x4*)gp * gs, g1 = *(const f32x4*)(gp + 4) * gs;
#pragma unroll
            for (int ai = 0; ai < 2; ++ai)
#pragma unroll
                for (int m = 0; m < 4; ++m) { const int rl = ai * HALF + wr * 64 + m * 16 + fr, row = u.pm * BM + rl;
#pragma unroll
                    for (int bj = 0; bj < 2; ++bj) { const f32x2 pr = *(const LAS f32x2*)(X + rl * 8 + bj * 4 + (wc & 2)); const float rn = __builtin_amdgcn_rsqf((pr.x + pr.y) * (1.0f / HD) + RMS_EPS);
                        const int c8 = u.pn * BM + bj * HALF + wc * 32 + 8 * fq;
                        *(u32x4*)(QKV + (size_t)row * NQKV + c8) = pack8(acc[ai][bj][m][0] * g0 * rn, acc[ai][bj][m][1] * g1 * rn); } }
            return;
        }
#pragma unroll
        for (int ai = 0; ai < 2; ++ai)
#pragma unroll
            for (int m = 0; m < 4; ++m) { const int row = u.pm * BM + ai * HALF + wr * 64 + m * 16 + fr;
#pragma unroll
                for (int bj = 0; bj < 2; ++bj) { const int c8 = u.pn * BM + bj * HALF + wc * 32 + 8 * fq; const u32x4 w = pack8(acc[ai][bj][m][0], acc[ai][bj][m][1]);
                    if (u.pn < 12) *(u32x4*)(QKV + (size_t)row * NQKV + c8) = w;
                    else { const int ch = c8 - NQKV, gg = ch >> 4, c0 = ch & 15, R = row >> 5, s = row & 31; *(u32x4*)(A5 + ((size_t)gg * RCH + R) * KS5 + s * SC + c0) = w; } } }
    }
};
struct EpiE {
    static constexpr bool PERM = false, KSPLIT = false;
    float* E;
    __device__ __forceinline__ void operator()(f32x4 (&acc)[2][2][4][2], const Unit& u, int wr, int wc, int fr, int fq) const {
#pragma unroll
        for (int ai = 0; ai < 2; ++ai)
#pragma unroll
            for (int m = 0; m < 4; ++m) { const int R = u.pm * BM + ai * HALF + wr * 64 + m * 16 + fr; float* rowp = E + ((size_t)u.g * RCH + R) * 256 + wc * 32 + 4 * fq;
#pragma unroll
                for (int bj = 0; bj < 2; ++bj)
#pragma unroll
                    for (int n = 0; n < 2; ++n) *(f32x4*)(rowp + bj * HALF + n * 16) = acc[ai][bj][m][n]; }
    }
};
struct EpiS5Out {
    static constexpr bool PERM = true, KSPLIT = false;
    bf16_t* Yg;
    __device__ __forceinline__ void operator()(f32x4 (&acc)[2][2][4][2], const Unit& u, int wr, int wc, int fr, int fq) const {
#pragma unroll
        for (int ai = 0; ai < 2; ++ai)
#pragma unroll
            for (int m = 0; m < 4; ++m) { const int R = u.pm * BM + ai * HALF + wr * 64 + m * 16 + fr;
#pragma unroll
                for (int bj = 0; bj < 2; ++bj) { const int n8 = u.pn * BM + bj * HALF + wc * 32 + 8 * fq, s = n8 >> 4, c0 = n8 & 15;
                    f32x4 v0 = acc[ai][bj][m][0], v1 = acc[ai][bj][m][1];
#pragma unroll
                    for (int e = 0; e < 4; ++e) { v0[e] = gelu_tanh(v0[e]); v1[e] = gelu_tanh(v1[e]); }
                    *(u32x4*)(Yg + (size_t)(R * CL + s) * SW + u.g * SC + c0) = pack8(v0, v1); } }
    }
};
struct EpiGlu {
    static constexpr bool PERM = true, KSPLIT = false;
    const bf16_t* Yg; const float* bias; bf16_t* YAYS; float* ssq4; LAS float* X;
    __device__ __forceinline__ void operator()(f32x4 (&acc)[2][2][4][2], const Unit& u, int wr, int wc, int fr, int fq) const {
        const int c8b = u.pn * BM + wc * 32 + 8 * fq;
        f32x4 bv[2][2];
#pragma unroll
        for (int bj = 0; bj < 2; ++bj)
#pragma unroll
            for (int n = 0; n < 2; ++n) bv[bj][n] = *(const f32x4*)(bias + c8b + bj * HALF + 4 * n);
#pragma unroll
        for (int ai = 0; ai < 2; ++ai) {
            u32x4 yv[4][2];
#pragma unroll
            for (int m = 0; m < 4; ++m)
#pragma unroll
                for (int bj = 0; bj < 2; ++bj) yv[m][bj] = *(const u32x4*)(Yg + (size_t)(u.pm * BM + ai * HALF + wr * 64 + m * 16 + fr) * SW + c8b + bj * HALF);
#pragma unroll
            for (int m = 0; m < 4; ++m) { const int row = u.pm * BM + ai * HALF + wr * 64 + m * 16 + fr; float ss = 0.f;
#pragma unroll
                for (int bj = 0; bj < 2; ++bj) { const int c8 = c8b + bj * HALF; const u32x4 y = yv[m][bj];
                    const f32x4 a0 = acc[ai][bj][m][0] + bv[bj][0], a1 = acc[ai][bj][m][1] + bv[bj][1];
                    f32x4 v0, v1;
                    v0[0] = bf_lo(y.x) * sigmoidf_(a0[0]); v0[1] = bf_hi(y.x) * sigmoidf_(a0[1]); v0[2] = bf_lo(y.y) * sigmoidf_(a0[2]); v0[3] = bf_hi(y.y) * sigmoidf_(a0[3]);
                    v1[0] = bf_lo(y.z) * sigmoidf_(a1[0]); v1[1] = bf_hi(y.z) * sigmoidf_(a1[1]); v1[2] = bf_lo(y.w) * sigmoidf_(a1[2]); v1[3] = bf_hi(y.w) * sigmoidf_(a1[3]);
#pragma unroll
                    for (int e = 0; e < 4; ++e) ss += v0[e] * v0[e] + v1[e] * v1[e];
                    *(u32x4*)(YAYS + (size_t)row * DM + AW + c8) = pack8(v0, v1); }
                ss += __shfl_xor(ss, 16); ss += __shfl_xor(ss, 32);
                if (fq == 0) X[(ai * HALF + wr * 64 + m * 16 + fr) * 4 + wc] = ss; }
            asm volatile("" ::: "memory"); }
        asm volatile("s_waitcnt lgkmcnt(0)" ::: "memory"); __builtin_amdgcn_s_barrier(); asm volatile("" ::: "memory");
        if (wc == 0 && fq == 0) {
#pragma unroll
            for (int ai = 0; ai < 2; ++ai)
#pragma unroll
                for (int m = 0; m < 4; ++m) { const int rl = ai * HALF + wr * 64 + m * 16 + fr; const f32x4 p = *(const LAS f32x4*)(X + rl * 4);
                    ssq4[(size_t)u.pn * M + u.pm * BM + rl] = (p[0] + p[1]) + (p[2] + p[3]); } }
    }
};
struct EpiRes1 {
    static constexpr bool PERM = true, KSPLIT = true;
    const float* x; bf16_t* XB; const float* ssqa; const float* ssqs4; float* ssqx8; LAS float* X;
    __device__ __forceinline__ void operator()(f32x4 (&acc)[2][2][4][2], const Unit& u, int wr, int wc, int fr, int fq) const {
        if (u.kh == 0) {
#pragma unroll
        for (int ai = 0; ai < 2; ++ai)
#pragma unroll
            for (int m = 0; m < 4; ++m) { const int row = u.pm * BM + ai * HALF + wr * 64 + m * 16 + fr;
                const float sq = (ssqs4[row] + ssqs4[M + row]) + (ssqs4[2 * M + row] + ssqs4[3 * M + row]);
                const float ra = __builtin_amdgcn_rsqf(ssqa[row] * (1.0f / AW) + RMS_EPS), rs = __builtin_amdgcn_rsqf(sq * (1.0f / SW) + RMS_EPS), f = ra * fast_rcp(rs);
#pragma unroll
                for (int bj = 0; bj < 2; ++bj)
#pragma unroll
                    for (int n = 0; n < 2; ++n) acc[ai][bj][m][n] *= f; }
        return; }
        float rsv[2][4];
#pragma unroll
        for (int ai = 0; ai < 2; ++ai)
#pragma unroll
            for (int m = 0; m < 4; ++m) { const int row = u.pm * BM + ai * HALF + wr * 64 + m * 16 + fr;
                const float sq = (ssqs4[row] + ssqs4[M + row]) + (ssqs4[2 * M + row] + ssqs4[3 * M + row]); rsv[ai][m] = __builtin_amdgcn_rsqf(sq * (1.0f / SW) + RMS_EPS); }
#pragma unroll
        for (int am = 0; am < 4; ++am) { const int ai = am >> 1, mb = (am & 1) * 2;
            f32x4 xv[2][2][2];
#pragma unroll
            for (int mm = 0; mm < 2; ++mm)
#pragma unroll
                for (int bj = 0; bj < 2; ++bj) { const float* xp = x + (size_t)(u.pm * BM + ai * HALF + wr * 64 + (mb + mm) * 16 + fr) * DM + u.pn * BM + bj * HALF + wc * 32 + 8 * fq; xv[mm][bj][0] = *(const f32x4*)xp; xv[mm][bj][1] = *(const f32x4*)(xp + 4); }
#pragma unroll
            for (int mm = 0; mm < 2; ++mm) { const int m = mb + mm; const int row = u.pm * BM + ai * HALF + wr * 64 + m * 16 + fr; float ss = 0.f; const float rs = rsv[ai][m];
#pragma unroll
                for (int bj = 0; bj < 2; ++bj) { const size_t off = (size_t)row * DM + u.pn * BM + bj * HALF + wc * 32 + 8 * fq;
                    const f32x4 v0 = xv[mm][bj][0] + acc[ai][bj][m][0] * rs, v1 = xv[mm][bj][1] + acc[ai][bj][m][1] * rs;
#pragma unroll
                    for (int e = 0; e < 4; ++e) ss += v0[e] * v0[e] + v1[e] * v1[e];
                    *(u32x4*)(XB + off) = pack8(v0, v1); }
                ss += __shfl_xor(ss, 16); ss += __shfl_xor(ss, 32);
                if (fq == 0) X[(ai * HALF + wr * 64 + m * 16 + fr) * 4 + wc] = ss; }
            asm volatile("" ::: "memory"); }
        asm volatile("s_waitcnt lgkmcnt(0)" ::: "memory"); __builtin_amdgcn_s_barrier(); asm volatile("" ::: "memory");
        if (wc == 0 && fq == 0) {
#pragma unroll
            for (int ai = 0; ai < 2; ++ai)
#pragma unroll
                for (int m = 0; m < 4; ++m) { const int rl = ai * HALF + wr * 64 + m * 16 + fr; const f32x4 p = *(const LAS f32x4*)(X + rl * 4);
                    ssqx8[(size_t)u.pn * M + u.pm * BM + rl] = (p[0] + p[1]) + (p[2] + p[3]); } }
    }
};
struct EpiSwiGLU {
    static constexpr bool PERM = true, KSPLIT = false;
    bf16_t* H; const float* ssqx8;
    __device__ __forceinline__ void operator()(f32x4 (&acc)[2][2][4][2], const Unit& u, int wr, int wc, int fr, int fq) const {
        float rsv[2][4];
#pragma unroll
        for (int ai = 0; ai < 2; ++ai)
#pragma unroll
            for (int m = 0; m < 4; ++m) { const int row = u.pm * BM + ai * HALF + wr * 64 + m * 16 + fr; float sq = 0.f;
#pragma unroll
                for (int t = 0; t < 8; ++t) sq += ssqx8[(size_t)t * M + row];
                rsv[ai][m] = __builtin_amdgcn_rsqf(sq * (1.0f / DM) + RMS_EPS); }
#pragma unroll
        for (int ai = 0; ai < 2; ++ai)
#pragma unroll
            for (int m = 0; m < 4; ++m) { const int row = u.pm * BM + ai * HALF + wr * 64 + m * 16 + fr; const float rs = rsv[ai][m];
                f32x4 h0, h1;
#pragma unroll
                for (int e = 0; e < 4; ++e) { const float g0 = acc[ai][0][m][0][e] * rs, u0 = acc[ai][1][m][0][e] * rs, g1 = acc[ai][0][m][1][e] * rs, u1 = acc[ai][1][m][1][e] * rs;
                    h0[e] = g0 * sigmoidf_(g0) * u0; h1[e] = g1 * sigmoidf_(g1) * u1; }
                *(u32x4*)(H + (size_t)row * DFF + u.pn * HALF + wc * 32 + 8 * fq) = pack8(h0, h1); }
    }
};
struct EpiRes2 {
    static constexpr bool PERM = true, KSPLIT = false;
    float* out; const bf16_t* XB;
    __device__ __forceinline__ void operator()(f32x4 (&acc)[2][2][4][2], const Unit& u, int wr, int wc, int fr, int fq) const {
#pragma unroll
        for (int ai = 0; ai < 2; ++ai) {
            u32x4 xb[4][2];
#pragma unroll
            for (int m = 0; m < 4; ++m)
#pragma unroll
                for (int bj = 0; bj < 2; ++bj) xb[m][bj] = *(const u32x4*)(XB + (size_t)(u.pm * BM + ai * HALF + wr * 64 + m * 16 + fr) * DM + u.pn * BM + wc * 32 + 8 * fq + bj * HALF);
#pragma unroll
            for (int m = 0; m < 4; ++m) { const size_t roff = (size_t)(u.pm * BM + ai * HALF + wr * 64 + m * 16 + fr) * DM + u.pn * BM + wc * 32 + 8 * fq;
#pragma unroll
                for (int bj = 0; bj < 2; ++bj) { const size_t off = roff + bj * HALF; const u32x4 x4 = xb[m][bj];
                    f32x4 v0, v1; v0[0] = bf_lo(x4.x); v0[1] = bf_hi(x4.x); v0[2] = bf_lo(x4.y); v0[3] = bf_hi(x4.y); v1[0] = bf_lo(x4.z); v1[1] = bf_hi(x4.z); v1[2] = bf_lo(x4.w); v1[3] = bf_hi(x4.w);
                    *(f32x4*)(out + off) = v0 + acc[ai][bj][m][0]; *(f32x4*)(out + off + 4) = v1 + acc[ai][bj][m][1]; } }
            asm volatile("" ::: "memory"); }
    }
};
}

#define RLX_AGENT __ATOMIC_RELAXED, __HIP_MEMORY_SCOPE_AGENT
#define XB_TMO      128
#define XB_XCNT(j)  (256  + 64 * (j))
#define XB_XSUB(j)  (1280 + 64 * (j))
#define XB_XGEN(j)  (2304 + 64 * (j))
#define XB_TOP      3328
#define XB_TOPGEN   3392
#define XCD_BAR_WORDS 3456
#define XB_SPIN_CAP (1u << 24)
__device__ __forceinline__ unsigned xb_ld(unsigned* p)              { return __hip_atomic_load(p, __ATOMIC_RELAXED, __HIP_MEMORY_SCOPE_AGENT); }
__device__ __forceinline__ unsigned xb_add(unsigned* p, unsigned v) { return __hip_atomic_fetch_add(p, v, __ATOMIC_RELAXED, __HIP_MEMORY_SCOPE_AGENT); }
__device__ __forceinline__ unsigned xb_xcc_id() { return (unsigned)__builtin_amdgcn_s_getreg((3 << 11) | 20) & 0xFu; }
#define XB_SPIN(cond, bar) do { unsigned _sp = 0; while (cond) { __builtin_amdgcn_s_sleep(1); \
    if ((++_sp & 255u) == 0u) { if (xb_ld(&(bar)[XB_TMO])) break; if (_sp > XB_SPIN_CAP) { atomicAdd(&(bar)[XB_TMO], 1u); break; } } } } while (0)
struct XcdBarrier { unsigned* bar; unsigned x; volatile LAS unsigned* st; };
__device__ __forceinline__ XcdBarrier xcd_barrier_post(unsigned* bar, volatile LAS unsigned* st) {
    XcdBarrier b; b.bar = bar; b.x = xb_xcc_id(); b.st = st;
    if (threadIdx.x == 0) (void)xb_add(&bar[XB_XCNT(b.x)], 1u);
    return b;
}
__device__ __forceinline__ void xcd_barrier_complete(unsigned* bar, unsigned x, unsigned& nloc, unsigned& nx) {
    const unsigned G = gridDim.x * gridDim.y * gridDim.z;
    unsigned sum, cnt, mine, sp = 0u;
    for (;;) {
        sum = 0u; cnt = 0u; mine = 0u;
#pragma unroll
        for (unsigned j = 0; j < 16; ++j) { const unsigned c = xb_ld(&bar[XB_XCNT(j)]); sum += c; cnt += (c > 0u) ? 1u : 0u; mine = (j == x) ? c : mine; }
        if (sum == G) break;
        __builtin_amdgcn_s_sleep(1);
        if ((++sp & 255u) == 0u) { if (xb_ld(&bar[XB_TMO])) break; if (sp > XB_SPIN_CAP) { atomicAdd(&bar[XB_TMO], 1u); break; } }
    }
    nloc = mine > 0u ? mine : 1u; nx = cnt > 0u ? cnt : 1u;
}
__device__ __forceinline__ void xcd_barrier(const XcdBarrier& b) {
    asm volatile("s_waitcnt vmcnt(0)" ::: "memory");
    __syncthreads();
    if (threadIdx.x == 0) {
        unsigned* bar = b.bar;
        __builtin_amdgcn_s_waitcnt(0);
        unsigned nloc = b.st[0], nx = b.st[1];
        if (nloc == 0u) { xcd_barrier_complete(bar, b.x, nloc, nx); b.st[0] = nloc; b.st[1] = nx; }
        const unsigned old = xb_add(&bar[XB_XSUB(b.x)], 1u);
        const unsigned gen = old / nloc;
        if (old + 1u == (gen + 1u) * nloc) {
            __builtin_amdgcn_fence(__ATOMIC_RELEASE, "agent");
            asm volatile("s_waitcnt vmcnt(0)" ::: "memory");
            const unsigned og = xb_add(&bar[XB_TOP], 1u);
            const unsigned tg = og / nx;
            if (og + 1u == (tg + 1u) * nx) xb_add(&bar[XB_TOPGEN], 1u);
            else XB_SPIN(xb_ld(&bar[XB_TOPGEN]) == tg, bar);
            __builtin_amdgcn_fence(__ATOMIC_ACQUIRE, "agent");
            xb_add(&bar[XB_XGEN(b.x)], 1u);
            asm volatile("s_waitcnt vmcnt(0)" ::: "memory");
        } else {
            XB_SPIN(xb_ld(&bar[XB_XGEN(b.x)]) == gen, bar);
            __builtin_amdgcn_fence(__ATOMIC_ACQUIRE, "agent");
            asm volatile("s_waitcnt vmcnt(0)" ::: "memory");
        }
    }
    __syncthreads();
}

struct Args { const float* in[23]; float* out; unsigned char* ws; int ph_lo, ph_hi, li, dup; };
enum { I_X = 0, I_GMIX, I_WIN, I_QG, I_KG, I_RPB, I_ARE, I_AIM, I_BRE, I_BIM, I_CRE, I_CIM, I_LS, I_D, I_WGLU, I_BGLU, I_GOA, I_GOS, I_WOUT, I_GFFN, I_WG, I_WU, I_WD };

#define LDS_WAIT() asm volatile("s_waitcnt lgkmcnt(0)" ::: "memory")

__device__ __forceinline__ void p0_transpose_item(const float* W, int N, const float* kscale, bf16_t* WT, int ldd, int drow0, int k0, int n0, int lane) {
    const int c = lane >> 3, n4 = (lane & 7) * 4;
    const float* src = W + (size_t)(k0 + 8 * c) * N + n0 + n4;
    f32x4 v[2][8];
#pragma unroll
    for (int h = 0; h < 2; ++h)
#pragma unroll
        for (int i = 0; i < 8; ++i) v[h][i] = __builtin_nontemporal_load((const f32x4*)(src + (size_t)i * N + 32 * h));
    if (kscale) { const f32x4 s0 = *(const f32x4*)(kscale + k0 + 8 * c), s1 = *(const f32x4*)(kscale + k0 + 8 * c + 4);
#pragma unroll
        for (int h = 0; h < 2; ++h)
#pragma unroll
            for (int i = 0; i < 8; ++i) v[h][i] *= (i < 4 ? s0[i & 3] : s1[i & 3]); }
#pragma unroll
    for (int h = 0; h < 2; ++h)
#pragma unroll
        for (int e = 0; e < 4; ++e) { u32x4 o; o.x = cvt_pk_bf16(v[h][0][e], v[h][1][e]); o.y = cvt_pk_bf16(v[h][2][e], v[h][3][e]); o.z = cvt_pk_bf16(v[h][4][e], v[h][5][e]); o.w = cvt_pk_bf16(v[h][6][e], v[h][7][e]);
            *(u32x4*)(WT + (size_t)(drow0 + 32 * h + n4 + e) * ldd + k0 + 8 * c) = o; }
}

__device__ __forceinline__ void dsincos(double a, double& s, double& c) {
    const double k = __builtin_rint(a * 0.63661977236758134308);
    double r = __builtin_fma(-k, 1.57079632679489655800e+00, a);
    r = __builtin_fma(-k, 6.12323399573676603587e-17, r);
    const double r2 = r * r;
    double sp = -7.6471637318198164759e-13; sp = sp * r2 + 1.6059043836821614599e-10; sp = sp * r2 - 2.5052108385441718775e-08; sp = sp * r2 + 2.7557319223985890653e-06;
    sp = sp * r2 - 1.9841269841269841270e-04; sp = sp * r2 + 8.3333333333333333333e-03; sp = sp * r2 - 1.6666666666666666667e-01; sp = sp * r2 * r + r;
    double cp = 4.7794773323873852974e-14; cp = cp * r2 - 1.1470745597729724714e-11; cp = cp * r2 + 2.0876756987868098979e-09; cp = cp * r2 - 2.7557319223985890653e-07;
    cp = cp * r2 + 2.4801587301587301587e-05; cp = cp * r2 - 1.3888888888888888889e-03; cp = cp * r2 + 4.1666666666666666667e-02; cp = cp * r2 - 0.5; cp = cp * r2 + 1.0;
    const int q = (int)((long long)k) & 3;
    s = (q == 0) ? sp : (q == 1) ? cp : (q == 2) ? -sp : -cp;
    c = (q == 0) ? cp : (q == 1) ? -sp : (q == 2) ? -cp : sp;
}

struct S5Params { f32x4 br4, bi4, cr4, ci4; float are, aim, ls; };
__device__ __forceinline__ void p0_s5_params(const Args& a, int g, int tid, S5Params& P) {
    const float* a_re = a.in[I_ARE]; const float* a_im = a.in[I_AIM]; const float* b_re = a.in[I_BRE]; const float* b_im = a.in[I_BIM];
    const float* c_re = a.in[I_CRE]; const float* c_im = a.in[I_CIM]; const float* lstep = a.in[I_LS];
#pragma unroll
    for (int j = 0; j < 4; ++j) { const int i = tid + 512 * j, c = i & 15, p = (i >> 4) & 63, d = i >> 10;
        const size_t bi = (((size_t)d * SG + g) * SP + p) * SC + c, ci = (((size_t)d * SG + g) * SC + c) * SP + p;
        P.br4[j] = b_re[bi]; P.bi4[j] = b_im[bi]; P.cr4[j] = c_re[ci]; P.ci4[j] = c_im[ci]; }
    { const int p = tid & 63, d = (tid >> 6) & 1; P.are = a_re[(d * SG + g) * SP + p]; P.aim = a_im[(d * SG + g) * SP + p]; P.ls = lstep[d * SG + g]; }
}
__device__ __forceinline__ void p0_s5_tables(const Args& a, LAS unsigned char* lds, int g, int q, int tid, const S5Params& P) {
    LAS f32x2* LP = (LAS f32x2*)lds;
    LAS float* Bb = (LAS float*)(lds + 33792);
    LAS f32x2* Cm = (LAS f32x2*)(lds + 50176);
    LAS float* Kt = (LAS float*)(lds + 66560);
    const float* dsk = a.in[I_D];
    unsigned char* ws = a.ws;
    __syncthreads();
    LAS f32x2* Fp = (LAS f32x2*)(Kt);
    if (tid < 128) { const int p = tid & 63, d = tid >> 6;
        const double lre = (double)fminf(P.are, -1e-4f), lim = (double)P.aim, dt = exp((double)P.ls);
        const double mag = exp(lre * dt); double sn, cs; dsincos(lim * dt, sn, cs);
        const double lr = mag * cs, li = mag * sn;
        const double nr = lr - 1.0, ni = li, den = 1.0 / (lre * lre + lim * lim);
        Fp[d * 64 + p] = (f32x2){(float)((nr * lre + ni * lim) * den), (float)((ni * lre - nr * lim) * den)};
        double wr_ = 1.0, wi_ = 0.0;
        for (int tau = 0; tau <= CL; ++tau) { LP[(d * 64 + p) * 33 + tau] = (f32x2){(float)wr_, (float)wi_}; const double t_ = wr_ * lr - wi_ * li; wi_ = wr_ * li + wi_ * lr; wr_ = t_; } }
    __syncthreads();
#pragma unroll
    for (int j = 0; j < 4; ++j) { const int i = tid + 512 * j, c = i & 15, p = (i >> 4) & 63, d = i >> 10; const f32x2 f = Fp[d * 64 + p];
        Bb[(d * 64 + p) * 32 + c] = f.x * P.br4[j] - f.y * P.bi4[j]; Bb[(d * 64 + p) * 32 + 16 + c] = f.x * P.bi4[j] + f.y * P.br4[j];
        Cm[i] = (f32x2){P.cr4[j], P.ci4[j]}; }
    __syncthreads();
    if (q == 0 && tid < 128) { const int p = tid & 63, d = tid >> 6; ((f32x2*)(ws + WS_LAML))[(g * 2 + d) * SP + p] = LP[(d * 64 + p) * 33 + CL]; }
    { const int wv = __builtin_amdgcn_readfirstlane(tid >> 6), l = tid & 63, c16 = l & 15, g4 = l >> 4;
#pragma unroll 1
      for (int d = 0; d < 2; ++d) {
        bf16x8 Bf[4];
#pragma unroll
        for (int ks = 0; ks < 4; ++ks) { float v[8];
#pragma unroll
            for (int j = 0; j < 8; ++j) v[j] = Bb[(d * 64 + 32 * (ks & 1) + 8 * g4 + j) * 32 + (ks >> 1) * 16 + c16];
            u32x4 w; w.x = cvt_pk_bf16(v[0], v[1]); w.y = cvt_pk_bf16(v[2], v[3]); w.z = cvt_pk_bf16(v[4], v[5]); w.w = cvt_pk_bf16(v[6], v[7]); Bf[ks] = __builtin_bit_cast(bf16x8, w); }
#pragma unroll 1
        for (int tt = 0; tt < 4; ++tt) { const int tau = wv + 8 * tt;
            f32x4 acc = (f32x4){0.f, 0.f, 0.f, 0.f};
#pragma unroll
            for (int ks = 0; ks < 2; ++ks) { float gr[8], gi[8];
#pragma unroll
                for (int j = 0; j < 8; ++j) { const int p = 32 * ks + 8 * g4 + j; const f32x2 cm = Cm[(d * 64 + p) * 16 + c16], lp = LP[(d * 64 + p) * 33 + tau];
                    gr[j] = cm.x * lp.x - cm.y * lp.y; gi[j] = -(cm.x * lp.y + cm.y * lp.x); }
                u32x4 wr_, wi_; wr_.x = cvt_pk_bf16(gr[0], gr[1]); wr_.y = cvt_pk_bf16(gr[2], gr[3]); wr_.z = cvt_pk_bf16(gr[4], gr[5]); wr_.w = cvt_pk_bf16(gr[6], gr[7]);
                wi_.x = cvt_pk_bf16(gi[0], gi[1]); wi_.y = cvt_pk_bf16(gi[2], gi[3]); wi_.z = cvt_pk_bf16(gi[4], gi[5]); wi_.w = cvt_pk_bf16(gi[6], gi[7]);
                acc = __builtin_amdgcn_mfma_f32_16x16x32_bf16(__builtin_bit_cast(bf16x8, wr_), Bf[ks], acc, 0, 0, 0);
                acc = __builtin_amdgcn_mfma_f32_16x16x32_bf16(__builtin_bit_cast(bf16x8, wi_), Bf[2 + ks], acc, 0, 0, 0); }
#pragma unroll
            for (int e = 0; e < 4; ++e) Kt[((d * 32 + tau) * 16 + 4 * g4 + e) * 16 + c16] = acc[e]; } } }
    __syncthreads();
    { const int d = q >> 1, ri = q & 1, p = tid >> 3, s0 = (tid & 7) * 4;
      bf16_t* dst = (bf16_t*)(ws + WS_WST) + ((size_t)g * 256 + q * 64 + p) * 512 + s0 * 16;
      float bx_[16], by_[16];
#pragma unroll
      for (int e = 0; e < 16; ++e) { bx_[e] = Bb[(d * 64 + p) * 32 + e]; by_[e] = Bb[(d * 64 + p) * 32 + 16 + e]; }
#pragma unroll
      for (int sp = 0; sp < 4; ++sp) { const int pw = d == 0 ? (CL - 1 - (s0 + sp)) : (s0 + sp); const f32x2 lp = LP[(d * 64 + p) * 33 + pw]; float v[16];
#pragma unroll
          for (int e = 0; e < 16; ++e) v[e] = ri == 0 ? (lp.x * bx_[e] - lp.y * by_[e]) : (lp.x * by_[e] + lp.y * bx_[e]);
          u32x4 w0, w1; w0.x = cvt_pk_bf16(v[0], v[1]); w0.y = cvt_pk_bf16(v[2], v[3]); w0.z = cvt_pk_bf16(v[4], v[5]); w0.w = cvt_pk_bf16(v[6], v[7]);
          w1.x = cvt_pk_bf16(v[8], v[9]); w1.y = cvt_pk_bf16(v[10], v[11]); w1.z = cvt_pk_bf16(v[12], v[13]); w1.w = cvt_pk_bf16(v[14], v[15]);
          *(u32x4*)(dst + sp * 16) = w0; *(u32x4*)(dst + sp * 16 + 8) = w1; } }
    { const int c = tid & 15, s = 8 * q + ((tid >> 4) & 7), hi2 = tid >> 7;
      bf16_t* dst = (bf16_t*)(ws + WS_TW) + ((size_t)g * 512 + s * 16 + c) * KS5;
      const float dsv = dsk[g * SC + c];
#pragma unroll 1
      for (int it = 0; it < 8; ++it) { const int sp = hi2 + 4 * it; f32x4 v[4];
          const LAS f32x4* k0 = (const LAS f32x4*)(Kt + ((sp <= s ? (s - sp) : (32 + sp - s)) * 16 + c) * 16);
#pragma unroll
          for (int e = 0; e < 4; ++e) v[e] = k0[e];
          if (sp == s) { const LAS f32x4* k1 = (const LAS f32x4*)(Kt + (32 * 16 + c) * 16);
#pragma unroll
              for (int e = 0; e < 4; ++e) v[e] += k1[e];
#pragma unroll
              for (int e = 0; e < 4; ++e)
#pragma unroll
                  for (int k = 0; k < 4; ++k) v[e][k] += (c == 4 * e + k) ? dsv : 0.f; }
          u32x4 w0, w1; w0.x = cvt_pk_bf16(v[0][0], v[0][1]); w0.y = cvt_pk_bf16(v[0][2], v[0][3]); w0.z = cvt_pk_bf16(v[1][0], v[1][1]); w0.w = cvt_pk_bf16(v[1][2], v[1][3]);
          w1.x = cvt_pk_bf16(v[2][0], v[2][1]); w1.y = cvt_pk_bf16(v[2][2], v[2][3]); w1.z = cvt_pk_bf16(v[3][0], v[3][1]); w1.w = cvt_pk_bf16(v[3][2], v[3][3]);
          *(u32x4*)(dst + sp * 16) = w0; *(u32x4*)(dst + sp * 16 + 8) = w1; }
      { const int d = hi2 >> 1, ri = hi2 & 1, pw = d == 0 ? (s + 1) : (CL - s);
#pragma unroll 1
        for (int pb = 0; pb < 8; ++pb) { float v[8];
#pragma unroll
            for (int e = 0; e < 8; ++e) { const int p = 8 * pb + e; const f32x2 cm = Cm[(d * 64 + p) * 16 + c], lp = LP[(d * 64 + p) * 33 + pw];
                v[e] = ri == 0 ? (cm.x * lp.x - cm.y * lp.y) : -(cm.x * lp.y + cm.y * lp.x); }
            u32x4 w; w.x = cvt_pk_bf16(v[0], v[1]); w.y = cvt_pk_bf16(v[2], v[3]); w.z = cvt_pk_bf16(v[4], v[5]); w.w = cvt_pk_bf16(v[6], v[7]);
            *(u32x4*)(dst + 512 + hi2 * 64 + 8 * pb) = w; } } }
    __syncthreads();
}

__device__ __forceinline__ void p0_prologue(const Args& a, LAS unsigned char* lds, int vcu, int G, int tid) {
    asm volatile("" : "+v"(tid));
    const int wave = __builtin_amdgcn_readfirstlane(tid >> 6), lane = tid & 63;
    unsigned char* ws = a.ws;
    S5Params P5; p0_s5_params(a, (vcu < SG * 4 ? vcu : SG * 4 - 1) >> 2, tid, P5);
    if (vcu & 1) { for (int it = vcu; it < SG * 4; it += G) { if (it != vcu) p0_s5_params(a, it >> 2, tid, P5); p0_s5_tables(a, lds, it >> 2, it & 3, tid, P5); } }
    const int gw = vcu * 8 + wave, NGW = G * 8;
    constexpr int I_IN = (DM / 64) * (INW / 64), I_GL = (SW / 64) * (SW / 64), I_OUT = (DM / 64) * (DM / 64), I_GU = (DM / 64) * (DFF / 64), I_DN = (DFF / 64) * (DM / 64);
    constexpr int NITEMS = I_IN + I_GL + I_OUT + 2 * I_GU + I_DN;
    for (int it = gw; it < NITEMS; it += NGW) {
        int r = it;
        if (r < I_IN) { const int nb = INW / 64, kb = r / nb, n0 = (r % nb) * 64; p0_transpose_item(a.in[I_WIN], INW, nullptr, (bf16_t*)(ws + WS_WIN), DM, n0, kb * 64, n0, lane); continue; } r -= I_IN;
        if (r < I_GL) { const int nb = SW / 64, kb = r / nb, n0 = (r % nb) * 64; p0_transpose_item(a.in[I_WGLU], SW, nullptr, (bf16_t*)(ws + WS_WGLU), SW, n0, kb * 64, n0, lane); continue; } r -= I_GL;
        if (r < I_OUT) { const int nb = DM / 64, kb = r / nb, n0 = (r % nb) * 64, k0 = kb * 64;
            p0_transpose_item(a.in[I_WOUT], DM, k0 < AW ? a.in[I_GOA] : a.in[I_GOS] - AW, (bf16_t*)(ws + WS_WOUT), DM, n0, k0, n0, lane); continue; } r -= I_OUT;
        if (r < 2 * I_GU) { const int up = r >= I_GU; if (up) r -= I_GU; const int nb = DFF / 64, kb = r / nb, n0 = (r % nb) * 64;
            p0_transpose_item(up ? a.in[I_WU] : a.in[I_WG], DFF, a.in[I_GFFN], (bf16_t*)(ws + WS_WGU), DM, 256 * (n0 >> 7) + (n0 & 127) + (up ? 128 : 0), kb * 64, n0, lane); continue; } r -= 2 * I_GU;
        { const int nb = DM / 64, kb = r / nb, n0 = (r % nb) * 64; p0_transpose_item(a.in[I_WD], DM, nullptr, (bf16_t*)(ws + WS_WD), DFF, n0, kb * 64, n0, lane); }
    }
    const float* x = a.in[I_X]; const float* gm = a.in[I_GMIX]; bf16_t* XN = (bf16_t*)(ws + WS_XN);
    for (int m = gw; m < M; m += 2 * NGW) { const int m1 = m + NGW < M ? m + NGW : m;
        const f32x4* xr0 = (const f32x4*)(x + (size_t)m * DM) + lane; const f32x4* xr1 = (const f32x4*)(x + (size_t)m1 * DM) + lane; f32x4 v0[8], v1[8]; float s0 = 0.f, s1 = 0.f;
#pragma unroll
        for (int j = 0; j < 8; ++j) { v0[j] = __builtin_nontemporal_load(xr0 + 64 * j); v1[j] = __builtin_nontemporal_load(xr1 + 64 * j); }
#pragma unroll
        for (int j = 0; j < 8; ++j) { s0 += (v0[j][0] * v0[j][0] + v0[j][1] * v0[j][1]) + (v0[j][2] * v0[j][2] + v0[j][3] * v0[j][3]); s1 += (v1[j][0] * v1[j][0] + v1[j][1] * v1[j][1]) + (v1[j][2] * v1[j][2] + v1[j][3] * v1[j][3]); }
        const float r0 = 1.0f / sqrtf(wave_sum(s0) * (1.0f / DM) + RMS_EPS), r1 = 1.0f / sqrtf(wave_sum(s1) * (1.0f / DM) + RMS_EPS);
        u32x2* o0 = (u32x2*)(XN + (size_t)m * DM) + lane; u32x2* o1 = (u32x2*)(XN + (size_t)m1 * DM) + lane;
#pragma unroll
        for (int j = 0; j < 8; ++j) { const f32x4 gq = ((const f32x4*)gm)[64 * j + lane]; u32x2 w; w.x = cvt_pk_bf16(v0[j][0] * r0 * gq[0], v0[j][1] * r0 * gq[1]); w.y = cvt_pk_bf16(v0[j][2] * r0 * gq[2], v0[j][3] * r0 * gq[3]); o0[64 * j] = w;
            u32x2 w2; w2.x = cvt_pk_bf16(v1[j][0] * r1 * gq[0], v1[j][1] * r1 * gq[1]); w2.y = cvt_pk_bf16(v1[j][2] * r1 * gq[2], v1[j][3] * r1 * gq[3]); o1[64 * j] = w2; }
    }
    if (!(vcu & 1)) { for (int it = vcu; it < SG * 4; it += G) { if (it != vcu) p0_s5_params(a, it >> 2, tid, P5); p0_s5_tables(a, lds, it >> 2, it & 3, tid, P5); } }
}

constexpr int KROW = 144, AROW = 160;
constexpr int AHEAD = 64 * AROW;
constexpr int ABUF = 2 * AHEAD;
constexpr int ATT_RPB_OFF = 2 * ABUF;
static_assert(ATT_RPB_OFF + 16 * 465 * 4 <= MISC_OFF, "attention LDS");

__device__ __forceinline__ void attn_phase(const Args& a, LAS unsigned char* lds, volatile LAS unsigned* MISC, int vcu, int G, int has_g2, int tid) {
    asm volatile("" : "+v"(tid));
    const int wave = __builtin_amdgcn_readfirstlane(tid >> 6), lane = tid & 63, ql = lane & 15, g4 = lane >> 4;
    const bf16_t* QKV = (const bf16_t*)(a.ws + WS_BIG); bf16_t* YAYS = (bf16_t*)(a.ws + WS_YAYS); float* ssqa16 = (float*)(a.ws + WS_SSQA16);
    LAS float* rpbL = (LAS float*)(lds + ATT_RPB_OFF);
    for (int i = tid; i < 16 * 465; i += 512) rpbL[i] = a.in[I_RPB][i];
    const int j = wave & 3, hsel = wave >> 2;
    const int cq = 16 * j + ql, cs = min(max(cq - 8, 0), GRIDW - 16), wb = (j == 0) ? 0 : (j == 1) ? 8 : (j == 2) ? 24 : 32;
    int it_lo, it_hi, it_step = 1;
    if (G == 256) { const int x_ = vcu >> 5, k_ = vcu & 31; if (has_g2) { it_lo = x_ * 256 + 6 * (k_ & 15); it_hi = it_lo + 6; } else { it_lo = x_ * 256 + 96 + 10 * (k_ & 15); it_hi = it_lo + 10; } }
    else { it_lo = vcu; it_hi = BATCH * NROWS * 8; it_step = G; }
#define ATT_FETCH(dst) do { if (tid == 0) { const int nx_ = ((dst) == 20) ? it_lo : item + it_step; MISC[dst] = (unsigned)(nx_ < it_hi ? nx_ : -1); } } while (0)
    int item = 0;
    ATT_FETCH(20);
    __syncthreads();
    item = __builtin_amdgcn_readfirstlane((int)MISC[20]);
    const int skey = tid >> 3, sch = tid & 7;
    const unsigned ldstK = (unsigned)(skey * KROW + sch * 16), ldstV = (unsigned)(skey * AROW + sch * 16);
    u32x4 R[4][2];
#define ATT_SRC(it_, st_, i_) (QKV + ((size_t)((it_) >> 9) * SEQ + 64 * (min(max((((it_) >> 3) & 63) - 4, 0), NROWS - 8) + ((st_) & 7)) + skey) * NQKV + ((st_) < 8 ? AW : 2 * AW) + 64 * (2 * ((it_) & 7) + (i_)) + 8 * sch)
    if (item >= 0) {
#pragma unroll
        for (int p = 0; p < 3; ++p)
#pragma unroll
            for (int i = 0; i < 2; ++i) R[p][i] = *(const u32x4*)ATT_SRC(item, p, i);
    }
    while (item >= 0) {
        const int b = item >> 9, r = (item >> 3) & 63, hp = item & 7, h = 2 * hp + hsel, row_start = min(max(r - 4, 0), NROWS - 8);
        ATT_FETCH(21);
        const size_t tq = (size_t)b * SEQ + 64 * r + cq;
        bf16x8 Qf[2];
        { const u32x4* qp = (const u32x4*)(QKV + tq * NQKV + 64 * h + 8 * g4); Qf[0] = __builtin_bit_cast(bf16x8, qp[0]); Qf[1] = __builtin_bit_cast(bf16x8, qp[4]); }
        const LAS float* bl = rpbL + h * 465 + (row_start - r + 7) * 31 + (wb + 4 * g4 - cq + 15);
        f32x4 S[8][2]; bf16x8 Pf[8]; f32x4 O[4]; float sum = 0.f; int nitem = -1;
#pragma unroll
        for (int dt = 0; dt < 4; ++dt) O[dt] = (f32x4){0.f, 0.f, 0.f, 0.f};
#pragma unroll
        for (int st = 0; st < 16; ++st) {
            LAS unsigned char* buf = lds + (st & 1) * ABUF;
            { const unsigned ld_ = st < 8 ? ldstK : ldstV; *(LAS u32x4*)(buf + ld_) = R[st & 3][0]; *(LAS u32x4*)(buf + AHEAD + ld_) = R[st & 3][1]; }
            if (st + 3 < 16) {
#pragma unroll
                for (int i = 0; i < 2; ++i) R[(st + 3) & 3][i] = *(const u32x4*)ATT_SRC(item, st + 3, i);
            } else if (nitem >= 0) {
#pragma unroll
                for (int i = 0; i < 2; ++i) R[(st + 3) & 3][i] = *(const u32x4*)ATT_SRC(nitem, st + 3 - 16, i);
            }
            asm volatile("s_waitcnt lgkmcnt(0)" ::: "memory"); __builtin_amdgcn_s_barrier(); asm volatile("" ::: "memory");
            if (st == 0) nitem = __builtin_amdgcn_readfirstlane((int)MISC[21]);
            const LAS unsigned char* hb = buf + hsel * AHEAD;
            if (st < 8) {
                const int kr = st;
#pragma unroll
                for (int t = 0; t < 2; ++t) {
                    const LAS unsigned char* kp = hb + (wb + 16 * t + ql) * KROW + g4 * 16;
                    const bf16x8 k0 = *(const LAS bf16x8*)kp, k1 = *(const LAS bf16x8*)(kp + 64);
                    f32x4 acc = (f32x4){0.f, 0.f, 0.f, 0.f};
                    acc = __builtin_amdgcn_mfma_f32_16x16x32_bf16(k0, Qf[0], acc, 0, 0, 0);
                    acc = __builtin_amdgcn_mfma_f32_16x16x32_bf16(k1, Qf[1], acc, 0, 0, 0);
#pragma unroll
                    for (int e = 0; e < 4; ++e) { const int ck = wb + 16 * t + 4 * g4 + e;
                        const float bias = bl[kr * 31 + 16 * t + e];
                        acc[e] = (ck >= cs && ck < cs + 16) ? acc[e] + bias : -1e30f; }
                    S[kr][t] = acc; }
                if (st == 7) {
                    float mx = -1e30f;
#pragma unroll
                    for (int k2 = 0; k2 < 8; ++k2)
#pragma unroll
                        for (int t = 0; t < 2; ++t)
#pragma unroll
                            for (int e = 0; e < 4; ++e) mx = fmaxf(mx, S[k2][t][e]);
                    mx = fmaxf(mx, __shfl_xor(mx, 16)); mx = fmaxf(mx, __shfl_xor(mx, 32));
#pragma unroll
                    for (int k2 = 0; k2 < 8; ++k2) { f32x4 p0, p1;
#pragma unroll
                        for (int e = 0; e < 4; ++e) { p0[e] = fast_exp2((S[k2][0][e] - mx) * 1.44269504089f); p1[e] = fast_exp2((S[k2][1][e] - mx) * 1.44269504089f); sum += p0[e] + p1[e]; }
                        Pf[k2] = __builtin_bit_cast(bf16x8, pg8::pack8(p0, p1)); }
                    sum += __shfl_xor(sum, 16); sum += __shfl_xor(sum, 32);
                }
            } else {
                const int kr = st - 8;
                const LAS unsigned char* rp = hb + (wb + 4 * g4 + ((lane & 15) >> 2)) * AROW + (lane & 3) * 8;
#pragma unroll
                for (int dt = 0; dt < 4; ++dt) {
                    const s16x4 lo = __builtin_amdgcn_ds_read_tr16_b64_v4i16((LAS s16x4*)(rp + dt * 32));
                    const s16x4 hi = __builtin_amdgcn_ds_read_tr16_b64_v4i16((LAS s16x4*)(rp + 16 * AROW + dt * 32));
                    const bf16x8 av = (bf16x8){lo[0], lo[1], lo[2], lo[3], hi[0], hi[1], hi[2], hi[3]};
                    O[dt] = __builtin_amdgcn_mfma_f32_16x16x32_bf16(av, Pf[kr], O[dt], 0, 0, 0); }
            }
        }
        const float inv = fast_rcp(sum); float ssq_acc = 0.f;
        bf16_t* op = YAYS + tq * DM + 64 * h + 4 * g4;
#pragma unroll
        for (int dt = 0; dt < 4; ++dt) { const f32x4 o = O[dt] * inv; ssq_acc += (o[0] * o[0] + o[1] * o[1]) + (o[2] * o[2] + o[3] * o[3]);
            u32x2 w; w.x = cvt_pk_bf16(o[0], o[1]); w.y = cvt_pk_bf16(o[2], o[3]); *(u32x2*)(op + 16 * dt) = w; }
        ssq_acc += __shfl_xor(ssq_acc, 16); ssq_acc += __shfl_xor(ssq_acc, 32);
        if (g4 == 0) ssqa16[tq * 16 + h] = ssq_acc;
        item = nitem;
    }
#undef ATT_FETCH
#undef ATT_SRC
}

__device__ __forceinline__ void scan_phase(const Args& a, int vcu, int G, int tid) {
    asm volatile("" : "+v"(tid));
    if (tid >= 128) return;
    const float* E = (const float*)(a.ws + WS_E); bf16_t* A5 = (bf16_t*)(a.ws + WS_A5); const f32x2* LAML = (const f32x2*)(a.ws + WS_LAML);
    for (int idx = vcu * 128 + tid; idx < BATCH * SG * 2 * SP; idx += G * 128) {
        const int p = idx & 63, d = (idx >> 6) & 1, g = (idx >> 7) & 63, b = idx >> 13;
        const f32x2 lam = LAML[(g * 2 + d) * SP + p];
        float xr = 0.f, xi = 0.f;
#pragma unroll 8
        for (int kk = 0; kk < NCH; ++kk) { const int k = d == 0 ? kk : NCH - 1 - kk; const size_t R = (size_t)g * RCH + b * NCH + k;
            bf16_t* ap = A5 + R * KS5 + 512 + d * 128 + p; ap[0] = (bf16_t)(cvt_pk_bf16(xr, 0.f) & 0xffffu); ap[64] = (bf16_t)(cvt_pk_bf16(xi, 0.f) & 0xffffu);
            const float er = E[R * 256 + d * 128 + p], ei = E[R * 256 + d * 128 + 64 + p];
            const float nr = lam.x * xr - lam.y * xi + er, ni = lam.x * xi + lam.y * xr + ei; xr = nr; xi = ni; }
    }
}

__global__ void __launch_bounds__(512, 2) hymba_fwd(Args args) {
    extern __shared__ __attribute__((aligned(16))) unsigned char lds_raw[];
    LAS unsigned char* lds = (LAS unsigned char*)lds_raw;
    volatile LAS unsigned* MISC = (volatile LAS unsigned*)(lds + MISC_OFF);
    const int tid = threadIdx.x;
    const int G = gridDim.x; const int bx = blockIdx.x; const int vcu = (G % 8 == 0) ? (bx % 8) * (G / 8) + bx / 8 : bx;
    unsigned char* ws = args.ws;
    unsigned* ctl = (unsigned*)(ws + WS_CTL);
    for (int u = tid; u < (LDS_BYTES - MISC_OFF) / 4; u += 512) MISC[u] = 0u;
    __syncthreads();
    XcdBarrier bar; bar.bar = ctl + CW_BAR; bar.x = 0; bar.st = nullptr;
    if (MK_N_LAUNCHES == 1) bar = xcd_barrier_post(ctl + CW_BAR, MISC + 8);
    const int lo = args.ph_lo, hi = args.ph_hi;
#define IN(k) (lo <= (k) && (k) < hi)
#define SEAM(k) do { if (IN(k) && IN((k) + 1)) xcd_barrier(bar); } while (0)
    bf16_t* WIN = (bf16_t*)(ws + WS_WIN); bf16_t* WGLU = (bf16_t*)(ws + WS_WGLU); bf16_t* WOUT = (bf16_t*)(ws + WS_WOUT); bf16_t* WGU = (bf16_t*)(ws + WS_WGU); bf16_t* WD = (bf16_t*)(ws + WS_WD);
    bf16_t* WST = (bf16_t*)(ws + WS_WST); bf16_t* TW = (bf16_t*)(ws + WS_TW);
    bf16_t* XN = (bf16_t*)(ws + WS_XN); bf16_t* YG = (bf16_t*)(ws + WS_XN); bf16_t* XB = (bf16_t*)(ws + WS_XN);
    bf16_t* QKV = (bf16_t*)(ws + WS_BIG); bf16_t* A5 = (bf16_t*)(ws + WS_A5); float* E = (float*)(ws + WS_E); bf16_t* HB = (bf16_t*)(ws + WS_BIG);
    bf16_t* YAYS = (bf16_t*)(ws + WS_YAYS);
    float* ssqa16 = (float*)(ws + WS_SSQA16); float* ssqa = (float*)(ws + WS_SSQA); float* ssqs4 = (float*)(ws + WS_SSQS4); float* ssqx8 = (float*)(ws + WS_SSQX8);
    LAS float* XL = (LAS float*)(lds + RING_BYTES);

#define REP(k) _Pragma("unroll") for (int rep_ = (DUP_PHASE == (k)) ? 0 : 1; rep_ < 2; ++rep_)
#define ALPHA ((rep_ == 0 && args.dup >= 0) ? 0.0f : 1.0f)
    if (IN(0)) { REP(0) { p0_prologue(args, lds, vcu, G, tid); __syncthreads(); } SEAM(0); }
    if (IN(1)) {
        pg8::Gemm g{XN, WIN, DM, DM, DM, 0, 0}; pg8::StaticOrder S; S.init(M, INW, G, bx);
        pg8::EpiZ Ep{QKV, A5, args.in[I_QG], args.in[I_KG], XL};
        REP(1) pg8::gemm_phase(lds, g, S, Ep);
        SEAM(1);
    }
    if (IN(2)) {
        { pg8::Gemm g{A5, WST, KS5, 512, 512, (size_t)RCH * KS5, (size_t)256 * 512}; pg8::BatchOrder S; S.init(2, 1, SG * (DUP_PHASE == 2 ? 2 : 1), G, bx);
          pg8::EpiE Ep{E};
          pg8::gemm_phase(lds, g, S, Ep); }
        __syncthreads();
        attn_phase(args, lds, MISC, vcu, G, bx < 128 ? 1 : 0, tid);
        SEAM(2);
    }
    if (IN(3)) { REP(3) scan_phase(args, vcu, G, tid); SEAM(3); }
    if (IN(4)) {
        pg8::Gemm g{A5, TW, KS5, KS5, KS5, (size_t)RCH * KS5, (size_t)512 * KS5}; pg8::BatchOrder S; S.init(2, 2, SG * (DUP_PHASE == 4 ? 2 : 1), G, bx);
        pg8::EpiS5Out Ep{YG};
        pg8::gemm_phase(lds, g, S, Ep);
        SEAM(4);
    }
    if (IN(5)) {
        pg8::Gemm g{YG, WGLU, SW, SW, SW, 0, 0}; pg8::StaticOrder S; S.init(M, SW, G, bx);
        for (int t = vcu * 512 + tid; t < M; t += G * 512) { const f32x4* p = (const f32x4*)(ssqa16 + (size_t)t * 16); const f32x4 s0 = p[0], s1 = p[1], s2 = p[2], s3 = p[3];
            const f32x4 sv = (s0 + s1) + (s2 + s3); ssqa[t] = (sv[0] + sv[1]) + (sv[2] + sv[3]); }
        REP(5) { pg8::EpiGlu Ep{YG, args.in[I_BGLU], YAYS, ssqs4, XL}; pg8::gemm_phase(lds, g, S, Ep); }
        SEAM(5);
    }
    if (IN(6)) {
        pg8::Gemm g{YAYS, WOUT, DM, DM, AW, 0, 0}; pg8::SplitKOrder S; S.so.init(M, DM, G, bx);
        REP(6) { pg8::EpiRes1 Ep{args.in[I_X], XB, ssqa, ssqs4, ssqx8, XL}; pg8::gemm_phase(lds, g, S, Ep); }
        SEAM(6);
    }
    if (IN(7)) {
        pg8::Gemm g{XB, WGU, DM, DM, DM, 0, 0}; pg8::StaticOrder S; S.init(M, 2 * DFF, G, bx);
        pg8::EpiSwiGLU Ep{HB, ssqx8};
        REP(7) pg8::gemm_phase(lds, g, S, Ep);
        SEAM(7);
    }
    if (IN(8)) {
        pg8::Gemm g{HB, WD, DFF, DFF, DFF, 0, 0}; pg8::StaticOrder S; S.init(M, DM, G, bx);
        REP(8) { pg8::EpiRes2 Ep{args.out, XB}; pg8::gemm_phase(lds, g, S, Ep); }
    }
#undef IN
#undef SEAM
}

extern "C" void kernel_launch(void* const* d_in, const int* in_sizes, int n_in, void* d_out, int out_size, void* d_ws, size_t ws_size, hipStream_t stream) {
    static int grid = 0;
    if (grid == 0) {
        if (n_in != 23 || in_sizes[0] != M * DM || out_size != M * DM || ws_size < WS_END) { fprintf(stderr, "kernel_launch: unexpected shapes (n_in %d, in0 %d, out %d, ws %zu < %zu)\n", n_in, n_in > 0 ? in_sizes[0] : -1, out_size, ws_size, (size_t)WS_END); grid = -1; return; }
        int dev = 0, cus = 0, per_cu = 0;
        if (hipGetDevice(&dev) != hipSuccess || hipDeviceGetAttribute(&cus, hipDeviceAttributeMultiprocessorCount, dev) != hipSuccess) { grid = -1; return; }
        if (hipFuncSetAttribute((const void*)hymba_fwd, hipFuncAttributeMaxDynamicSharedMemorySize, LDS_BYTES) != hipSuccess) { fprintf(stderr, "kernel_launch: hipFuncSetAttribute failed\n"); grid = -1; return; }
        if (hipOccupancyMaxActiveBlocksPerMultiprocessor(&per_cu, (const void*)hymba_fwd, 512, LDS_BYTES) != hipSuccess || per_cu < 1) { fprintf(stderr, "kernel_launch: occupancy query says %d blocks per CU\n", per_cu); (void)hipGetLastError(); per_cu = 1; }
        grid = cus;
    }
    if (grid < 0) return;
    (void)hipMemsetAsync((char*)d_ws + WS_CTL, 0, CTL_ZERO_BYTES, stream);
    Args a{}; a.dup = DUP_PHASE;
    for (int i = 0; i < 23; ++i) a.in[i] = (const float*)d_in[i];
    a.out = (float*)d_out; a.ws = (unsigned char*)d_ws;
    if (MK_N_LAUNCHES == 1) {
        a.ph_lo = 0; a.ph_hi = NPHASE; a.li = 0;
        hipLaunchKernelGGL(hymba_fwd, dim3(grid), dim3(512), LDS_BYTES, stream, a);
    } else {
        for (int li = 0; li < NPHASE; ++li) { a.ph_lo = li; a.ph_hi = li + 1; a.li = li; hipLaunchKernelGGL(hymba_fwd, dim3(grid), dim3(512), LDS_BYTES, stream, a); }
    }
}
```

```cpp
#include <hip/hip_runtime.h>
#include <cstdio>
#include <cstdint>

#define DUP_PHASE (-1)
#ifndef MK_N_LAUNCHES
#define MK_N_LAUNCHES 1
#endif

#define GAS __attribute__((address_space(1)))
#define LAS __attribute__((address_space(3)))
typedef unsigned short bf16_t;
typedef short bf16x8 __attribute__((ext_vector_type(8)));
typedef short s16x4 __attribute__((ext_vector_type(4)));
typedef float f32x4 __attribute__((ext_vector_type(4)));
typedef float f32x2 __attribute__((ext_vector_type(2)));
typedef unsigned u32x4 __attribute__((ext_vector_type(4)));
typedef unsigned u32x2 __attribute__((ext_vector_type(2)));

constexpr int BATCH = 4, SEQ = 4096, DM = 2048, M = BATCH * SEQ;
constexpr int AW = 1024, SW = 1024, NH = 16, HD = 64, NQKV = 3 * AW, INW = 4096, DFF = 5632;
constexpr int GRIDW = 64, NROWS = SEQ / GRIDW;
constexpr int SG = 64, SC = 16, SP = 64;
constexpr int CL = 32, NCH = SEQ / CL, RCH = M / CL;
constexpr int KS5 = CL * SC + 256;
constexpr float RMS_EPS = 1e-6f;
constexpr int NPHASE = 7;

constexpr size_t MiB = 1u << 20;
constexpr size_t WS_CTL = 0, CTL_ZERO_BYTES = 65536;
constexpr size_t WS_WIN = 1 * MiB, WS_WGLU = 17 * MiB, WS_WOUT = 19 * MiB, WS_WGU = 27 * MiB, WS_WD = 71 * MiB;
constexpr size_t WS_WST = 93 * MiB, WS_TW = 109 * MiB, WS_LAML = 157 * MiB;
constexpr size_t WS_XN = 158 * MiB;
constexpr size_t WS_BIG = 222 * MiB;
constexpr size_t WS_A5 = WS_BIG + 96 * MiB, WS_E = WS_BIG + 144 * MiB;
constexpr size_t WS_YAYS = 398 * MiB, WS_SSQ = 462 * MiB, WS_END = 464 * MiB;
constexpr size_t WS_SSQA16 = WS_SSQ, WS_SSQA = WS_SSQ + 1 * MiB, WS_SSQS4 = WS_SSQA + 65536, WS_SSQX8 = WS_SSQS4 + 4 * 65536;
constexpr int CW_BAR = 4096;
static_assert((size_t)(CW_BAR + 3456) * 4 <= CTL_ZERO_BYTES, "ctl");

constexpr int RING_BYTES = 131072;
constexpr int MISC_OFF = 143360;
constexpr int LDS_BYTES = 147456;

__device__ __forceinline__ unsigned cvt_pk_bf16(float lo, float hi) { unsigned r; asm volatile("v_cvt_pk_bf16_f32 %0, %1, %2" : "=v"(r) : "v"(lo), "v"(hi)); return r; }
__device__ __forceinline__ float bf_lo(unsigned w) { return __uint_as_float(w << 16); }
__device__ __forceinline__ float bf_hi(unsigned w) { return __uint_as_float(w & 0xffff0000u); }
__device__ __forceinline__ float fast_rcp(float x) { return __builtin_amdgcn_rcpf(x); }
__device__ __forceinline__ float fast_exp2(float x) { return __builtin_amdgcn_exp2f(x); }
__device__ __forceinline__ float sigmoidf_(float x) { return fast_rcp(1.0f + fast_exp2(-1.44269504089f * x)); }
__device__ __forceinline__ float gelu_tanh(float x) { const float t = x * (1.0f + 0.044715f * x * x); return x * fast_rcp(1.0f + fast_exp2(-2.30220818f * t)); }
__device__ __forceinline__ float wave_sum(float v) {
#pragma unroll
    for (int o = 1; o < 64; o <<= 1) v += __shfl_xor(v, o);
    return v;
}

namespace pg8 {
constexpr int BM = 256, BK = 64, HALF = 128, HTB = HALF * BK * 2, NXCD = 8, WGM = 8;
__host__ __device__ __forceinline__ int lds_byte(int r, int c) { const int st = (r >> 4) * 2 + (c >> 5), rr = r & 15, cc = c & 31, ob = rr * 64 + cc * 2; return st * 1024 + (ob ^ (((ob >> 9) & 1) << 5)); }
__host__ __device__ __forceinline__ void stage_rc(int b, int& R, int& C) { const int st = b / 1024, sb = b % 1024, swz = sb ^ (((sb >> 9) & 1) << 5); R = (st >> 1) * 16 + swz / 64; C = (st & 1) * 32 + (swz % 64) / 2; }
__host__ __device__ __forceinline__ int perm32(int rho) { const int n = rho >> 4, i = rho & 15; return 8 * (i >> 2) + 4 * n + (i & 3); }

struct Unit { int pm, pn, g, kh; };
struct Gemm { const bf16_t* A; const bf16_t* Bt; int lda, ldb, K; size_t sA, sB; };

struct StaticOrder {
    int nM, nN, nwg, G, c;
    __device__ void init(int M_, int N_, int G_, int c_) { nM = M_ / BM; nN = N_ / BM; nwg = nM * nN; G = G_; c = c_; }
    __device__ bool next(int i, Unit& u) const {
        const long L = (long)i * G + c; if (L >= nwg) return false;
        int wgid = (int)L; { const int q = nwg / NXCD, r = nwg % NXCD, xcd = wgid % NXCD, off = wgid / NXCD; wgid = (xcd < r ? xcd * (q + 1) : r * (q + 1) + (xcd - r) * q) + off; }
        const int nig = WGM * nN, gid = wgid / nig, fm = gid * WGM, gsz = (nM - fm) < WGM ? (nM - fm) : WGM;
        u.pm = fm + ((wgid % nig) % gsz); u.pn = (wgid % nig) / gsz; u.g = 0; u.kh = 0; return true;
    }
};
struct SplitKOrder {
    StaticOrder so;
    __device__ bool next(int i, Unit& u) const { if (!so.next(i >> 1, u)) return false; u.kh = i & 1; return true; }
};
struct ListOrder {
    int n; Unit u0, u1;
    __device__ bool next(int i, Unit& u) const { if (i >= n) return false; u = i == 0 ? u0 : u1; return true; }
};
struct BatchOrder {
    int nM, nN, nwg, G, c;
    __device__ void init(int nM_, int nN_, int nb, int G_, int c_) { nM = nM_; nN = nN_; nwg = nM * nN * nb; G = G_; c = c_; }
    __device__ bool next(int i, Unit& u) const {
        const long L = (long)i * G + c; if (L >= nwg) return false;
        const int l = (int)L; u.pn = l % nN; u.pm = (l / nN) % nM; u.g = (l / (nN * nM)) % SG; u.kh = 0; return true;
    }
};

template <class Epi, class Sched>
__device__ __forceinline__ void gemm_phase(LAS unsigned char* lds, const Gemm g, const Sched& S, const Epi& E) {
    int tid = threadIdx.x; asm volatile("" : "+v"(tid));
    const int wid = __builtin_amdgcn_readfirstlane(tid >> 6), lane = tid & 63, wr = wid >> 2, wc = wid & 3, fr = lane & 15, fq = lane >> 4;
    const int K = g.K, nt = K / BK;
    unsigned voffA[2], voffB[2];
#pragma unroll
    for (int i = 0; i < 2; ++i) { int R, C; stage_rc(tid * 16 + i * 8192, R, C); const int Rb = Epi::PERM ? ((R & ~31) + perm32(R & 31)) : R;
        voffA[i] = (unsigned)(R * g.lda + C) * 2u; voffB[i] = (unsigned)(Rb * g.ldb + C) * 2u; }
    const size_t kstep = (size_t)(BK * 2);
    const size_t hstepA = (size_t)HALF * g.lda * 2, hstepB = (size_t)HALF * g.ldb * 2;
    const unsigned ldsw = (unsigned)wid * 1024u;
    const int aoff = lds_byte(wr * 64 + fr, fq * 8), boff = lds_byte(wc * 32 + fr, fq * 8);
#define PG8_SA(b, h) (((b) * 2 + (h)) * HTB)
#define PG8_SB(b, h) ((4 + (b) * 2 + (h)) * HTB)
#define PG8_STAGE(bufoff, gbase, voff) do { _Pragma("unroll") for (int _i = 0; _i < 2; ++_i) \
        __builtin_amdgcn_global_load_lds((const unsigned*)((const char*)(gbase) + (voff)[_i]), (LAS unsigned*)(lds + (bufoff) + ldsw + _i * 8192), 16, 0, 0); } while (0)
#define PG8_LDA(dst, b, h) do { _Pragma("unroll") for (int m = 0; m < 4; ++m) _Pragma("unroll") for (int k = 0; k < 2; ++k) dst[m][k] = *(const LAS bf16x8*)(lds + PG8_SA(b, h) + aoff + m * 2048 + k * 1024); } while (0)
#define PG8_LDB(dst, b, h) do { _Pragma("unroll") for (int n = 0; n < 2; ++n) _Pragma("unroll") for (int k = 0; k < 2; ++k) dst[n][k] = *(const LAS bf16x8*)(lds + PG8_SB(b, h) + boff + n * 2048 + k * 1024); } while (0)
#define PG8_MMA(ai, bj, At, Bt) do { __builtin_amdgcn_s_setprio(1); _Pragma("unroll") for (int m = 0; m < 4; ++m) _Pragma("unroll") for (int n = 0; n < 2; ++n) _Pragma("unroll") for (int k = 0; k < 2; ++k) \
        acc[ai][bj][m][n] = __builtin_amdgcn_mfma_f32_16x16x32_bf16(Bt[n][k], At[m][k], acc[ai][bj][m][n], 0, 0, 0); __builtin_amdgcn_s_setprio(0); } while (0)
#define PG8_WAIT_V(n) asm volatile("s_waitcnt vmcnt(" #n ")" ::: "memory")
#define PG8_WAIT_L(n) asm volatile("s_waitcnt lgkmcnt(" #n ")" ::: "memory")
#define PG8_BAR __builtin_amdgcn_s_barrier()
#define PG8_SCHED __builtin_amdgcn_sched_barrier(0)
    Unit cur, nxt; int ui = 0;
    if (!S.next(0, cur)) return;
    f32x4 acc[2][2][4][2];
#pragma unroll
    for (int a = 0; a < 2; ++a)
#pragma unroll
        for (int b = 0; b < 2; ++b)
#pragma unroll
            for (int m = 0; m < 4; ++m)
#pragma unroll
                for (int n = 0; n < 2; ++n) acc[a][b][m][n] = (f32x4){0.f, 0.f, 0.f, 0.f};
    bf16x8 At[4][2], B0[2][2], B1[2][2];
    const char* cA = (const char*)g.A + ((size_t)cur.g * g.sA + (size_t)cur.pm * BM * g.lda + (size_t)cur.kh * K) * 2;
    const char* cB = (const char*)g.Bt + ((size_t)cur.g * g.sB + (size_t)cur.pn * BM * g.ldb + (size_t)cur.kh * K) * 2;
    PG8_STAGE(PG8_SB(0, 0), cB, voffB); PG8_STAGE(PG8_SB(0, 1), cB + hstepB, voffB); PG8_STAGE(PG8_SA(0, 0), cA, voffA); PG8_STAGE(PG8_SA(0, 1), cA + hstepA, voffA);
    if (wr == 1) PG8_BAR;
    PG8_WAIT_V(2); PG8_BAR;
    PG8_STAGE(PG8_SB(1, 0), cB + kstep, voffB); PG8_STAGE(PG8_SA(1, 0), cA + kstep, voffA); PG8_STAGE(PG8_SB(1, 1), cB + hstepB + kstep, voffB);
    PG8_WAIT_V(6); PG8_BAR;
    for (;;) {
        const bool has_next = S.next(ui + 1, nxt);
        const char* nA = has_next ? (const char*)g.A + ((size_t)nxt.g * g.sA + (size_t)nxt.pm * BM * g.lda + (size_t)nxt.kh * K) * 2 : cA;
        const char* nB = has_next ? (const char*)g.Bt + ((size_t)nxt.g * g.sB + (size_t)nxt.pn * BM * g.ldb + (size_t)nxt.kh * K) * 2 : cB;
        for (int t = 0; t < nt; t += 2) {
            const bool last = (t == nt - 2);
            const char* a1 = cA + (size_t)(t + 1) * kstep;
            const char* a2 = last ? nA : cA + (size_t)(t + 2) * kstep; const char* b2 = last ? nB : cB + (size_t)(t + 2) * kstep;
            const char* a3 = a2 + kstep; const char* b3 = b2 + kstep;
            PG8_LDB(B0, 0, 0); PG8_LDB(B1, 0, 1); PG8_SCHED; PG8_LDA(At, 0, 0); PG8_STAGE(PG8_SA(1, 1), a1 + hstepA, voffA);
            PG8_WAIT_V(8); PG8_WAIT_L(0); PG8_BAR; PG8_MMA(0, 0, At, B0); PG8_MMA(0, 1, At, B1); PG8_BAR; PG8_SCHED;
            PG8_LDA(At, 0, 1); PG8_STAGE(PG8_SB(0, 0), b2, voffB); PG8_STAGE(PG8_SB(0, 1), b2 + hstepB, voffB); PG8_STAGE(PG8_SA(0, 0), a2, voffA);
            PG8_WAIT_V(8); PG8_WAIT_L(0); PG8_BAR; PG8_MMA(1, 0, At, B0); PG8_MMA(1, 1, At, B1); PG8_BAR; PG8_SCHED;
            PG8_LDB(B0, 1, 0); PG8_LDB(B1, 1, 1); PG8_SCHED; PG8_LDA(At, 1, 0); PG8_STAGE(PG8_SA(0, 1), a2 + hstepA, voffA);
            PG8_WAIT_V(8); PG8_WAIT_L(0); PG8_BAR; PG8_MMA(0, 0, At, B0); PG8_MMA(0, 1, At, B1); PG8_BAR; PG8_SCHED;
            PG8_LDA(At, 1, 1); PG8_STAGE(PG8_SB(1, 0), b3, voffB); PG8_STAGE(PG8_SB(1, 1), b3 + hstepB, voffB); PG8_STAGE(PG8_SA(1, 0), a3, voffA);
            PG8_WAIT_V(8); PG8_WAIT_L(0); PG8_BAR; PG8_MMA(1, 0, At, B0); PG8_MMA(1, 1, At, B1); PG8_BAR; PG8_SCHED;
        }
        if (wr == 0) PG8_BAR;
        E(acc, cur, wr, wc, fr, fq);
        if (!has_next) break;
        if (!(Epi::KSPLIT && cur.kh == 0)) {
#pragma unroll
        for (int a = 0; a < 2; ++a)
#pragma unroll
            for (int b = 0; b < 2; ++b)
#pragma unroll
                for (int m = 0; m < 4; ++m)
#pragma unroll
                    for (int n = 0; n < 2; ++n) acc[a][b][m][n] = (f32x4){0.f, 0.f, 0.f, 0.f};
        }
        cur = nxt; cA = nA; cB = nB; ++ui;
        if (wr == 1) PG8_BAR;
    }
    PG8_WAIT_V(0);
    PG8_BAR;
#undef PG8_SA
#undef PG8_SB
#undef PG8_STAGE
#undef PG8_LDA
#undef PG8_LDB
#undef PG8_MMA
#undef PG8_WAIT_V
#undef PG8_WAIT_L
#undef PG8_BAR
#undef PG8_SCHED
}

__device__ __forceinline__ u32x4 pack8(const f32x4 a, const f32x4 b) { u32x4 w; w.x = cvt_pk_bf16(a[0], a[1]); w.y = cvt_pk_bf16(a[2], a[3]); w.z = cvt_pk_bf16(b[0], b[1]); w.w = cvt_pk_bf16(b[2], b[3]); return w; }

struct EpiZ {
    static constexpr bool PERM = true, KSPLIT = false;
    bf16_t* QKV; bf16_t* A5; const float* qg; const float* kg; LAS float* X;
    __device__ __forceinline__ void operator()(f32x4 (&acc)[2][2][4][2], const Unit& u, int wr, int wc, int fr, int fq) const {
        if (u.pn < 8) {
#pragma unroll
            for (int ai = 0; ai < 2; ++ai)
#pragma unroll
                for (int m = 0; m < 4; ++m)
#pragma unroll
                    for (int bj = 0; bj < 2; ++bj) { const f32x4 a0 = acc[ai][bj][m][0], a1 = acc[ai][bj][m][1];
                        float ss = (a0[0] * a0[0] + a0[1] * a0[1]) + (a0[2] * a0[2] + a0[3] * a0[3]) + (a1[0] * a1[0] + a1[1] * a1[1]) + (a1[2] * a1[2] + a1[3] * a1[3]);
                        ss += __shfl_xor(ss, 16); ss += __shfl_xor(ss, 32);
                        if (fq == 0) X[(ai * HALF + wr * 64 + m * 16 + fr) * 8 + bj * 4 + wc] = ss; }
            asm volatile("s_waitcnt lgkmcnt(0)" ::: "memory"); __builtin_amdgcn_s_barrier(); asm volatile("" ::: "memory");
            const float* gp = (u.pn < 4 ? qg : kg) + ((wc & 1) * 32 + 8 * fq); const float gs = u.pn < 4 ? 0.125f : 1.0f;
            const f32x4 g0 = *(const f32x4*)gp * gs, g1 = *(const f32x4*)(gp + 4) * gs;
#pragma unroll
            for (int ai = 0; ai < 2; ++ai)
#pragma unroll
                for (int m = 0; m < 4; ++m) { const int rl = ai * HALF + wr * 64 + m * 16 + fr, row = u.pm * BM + rl;
#pragma unroll
                    for (int bj = 0; bj < 2; ++bj) { const f32x2 pr = *(const LAS f32x2*)(X + rl * 8 + bj * 4 + (wc & 2)); const float rn = __builtin_amdgcn_rsqf((pr.x + pr.y) * (1.0f / HD) + RMS_EPS);
                        const int c8 = u.pn * BM + bj * HALF + wc * 32 + 8 * fq;
                        *(u32x4*)(QKV + (size_t)row * NQKV + c8) = pack8(acc[ai][bj][m][0] * g0 * rn, acc[ai][bj][m][1] * g1 * rn); } }
            return;
        }
#pragma unroll
        for (int ai = 0; ai < 2; ++ai)
#pragma unroll
            for (int m = 0; m < 4; ++m) { const int row = u.pm * BM + ai * HALF + wr * 64 + m * 16 + fr;
#pragma unroll
                for (int bj = 0; bj < 2; ++bj) { const int c8 = u.pn * BM + bj * HALF + wc * 32 + 8 * fq; const u32x4 w = pack8(acc[ai][bj][m][0], acc[ai][bj][m][1]);
                    if (u.pn < 12) *(u32x4*)(QKV + (size_t)row * NQKV + c8) = w;
                    else { const int ch = c8 - NQKV, gg = ch >> 4, c0 = ch & 15, R = row >> 5, s = row & 31; *(u32x4*)(A5 + ((size_t)gg * RCH + R) * KS5 + s * SC + c0) = w; } } }
    }
};
struct EpiE {
    static constexpr bool PERM = false, KSPLIT = false;
    float* E;
    __device__ __forceinline__ void operator()(f32x4 (&acc)[2][2][4][2], const Unit& u, int wr, int wc, int fr, int fq) const {
#pragma unroll
        for (int ai = 0; ai < 2; ++ai)
#pragma unroll
            for (int m = 0; m < 4; ++m) { const int R = u.pm * BM + ai * HALF + wr * 64 + m * 16 + fr; float* rowp = E + ((size_t)u.g * RCH + R) * 256 + wc * 32 + 4 * fq;
#pragma unroll
                for (int bj = 0; bj < 2; ++bj)
#pragma unroll
                    for (int n = 0; n < 2; ++n) *(f32x4*)(rowp + bj * HALF + n * 16) = acc[ai][bj][m][n]; }
    }
};
struct EpiS5Out {
    static constexpr bool PERM = true, KSPLIT = false;
    bf16_t* Yg;
    __device__ __forceinline__ void operator()(f32x4 (&acc)[2][2][4][2], const Unit& u, int wr, int wc, int fr, int fq) const {
#pragma unroll
        for (int ai = 0; ai < 2; ++ai)
#pragma unroll
            for (int m = 0; m < 4; ++m) { const int R = u.pm * BM + ai * HALF + wr * 64 + m * 16 + fr;
#pragma unroll
                for (int bj = 0; bj < 2; ++bj) { const int n8 = u.pn * BM + bj * HALF + wc * 32 + 8 * fq, s = n8 >> 4, c0 = n8 & 15;
                    f32x4 v0 = acc[ai][bj][m][0], v1 = acc[ai][bj][m][1];
#pragma unroll
                    for (int e = 0; e < 4; ++e) { v0[e] = gelu_tanh(v0[e]); v1[e] = gelu_tanh(v1[e]); }
                    *(u32x4*)(Yg + (size_t)(R * CL + s) * SW + u.g * SC + c0) = pack8(v0, v1); } }
    }
};
struct EpiGlu {
    static constexpr bool PERM = true, KSPLIT = false;
    const bf16_t* Yg; const float* bias; bf16_t* YAYS; float* ssq4; LAS float* X;
    __device__ __forceinline__ void operator()(f32x4 (&acc)[2][2][4][2], const Unit& u, int wr, int wc, int fr, int fq) const {
        const int c8b = u.pn * BM + wc * 32 + 8 * fq;
        f32x4 bv[2][2];
#pragma unroll
        for (int bj = 0; bj < 2; ++bj)
#pragma unroll
            for (int n = 0; n < 2; ++n) bv[bj][n] = *(const f32x4*)(bias + c8b + bj * HALF + 4 * n);
#pragma unroll
        for (int ai = 0; ai < 2; ++ai) {
            u32x4 yv[4][2];
#pragma unroll
            for (int m = 0; m < 4; ++m)
#pragma unroll
                for (int bj = 0; bj < 2; ++bj) yv[m][bj] = *(const u32x4*)(Yg + (size_t)(u.pm * BM + ai * HALF + wr * 64 + m * 16 + fr) * SW + c8b + bj * HALF);
#pragma unroll
            for (int m = 0; m < 4; ++m) { const int row = u.pm * BM + ai * HALF + wr * 64 + m * 16 + fr; float ss = 0.f;
#pragma unroll
                for (int bj = 0; bj < 2; ++bj) { const int c8 = c8b + bj * HALF; const u32x4 y = yv[m][bj];
                    const f32x4 a0 = acc[ai][bj][m][0] + bv[bj][0], a1 = acc[ai][bj][m][1] + bv[bj][1];
                    f32x4 v0, v1;
                    v0[0] = bf_lo(y.x) * sigmoidf_(a0[0]); v0[1] = bf_hi(y.x) * sigmoidf_(a0[1]); v0[2] = bf_lo(y.y) * sigmoidf_(a0[2]); v0[3] = bf_hi(y.y) * sigmoidf_(a0[3]);
                    v1[0] = bf_lo(y.z) * sigmoidf_(a1[0]); v1[1] = bf_hi(y.z) * sigmoidf_(a1[1]); v1[2] = bf_lo(y.w) * sigmoidf_(a1[2]); v1[3] = bf_hi(y.w) * sigmoidf_(a1[3]);
#pragma unroll
                    for (int e = 0; e < 4; ++e) ss += v0[e] * v0[e] + v1[e] * v1[e];
                    *(u32x4*)(YAYS + (size_t)row * DM + AW + c8) = pack8(v0, v1); }
                ss += __shfl_xor(ss, 16); ss += __shfl_xor(ss, 32);
                if (fq == 0) X[(ai * HALF + wr * 64 + m * 16 + fr) * 4 + wc] = ss; }
            asm volatile("" ::: "memory"); }
        asm volatile("s_waitcnt lgkmcnt(0)" ::: "memory"); __builtin_amdgcn_s_barrier(); asm volatile("" ::: "memory");
        if (wc == 0 && fq == 0) {
#pragma unroll
            for (int ai = 0; ai < 2; ++ai)
#pragma unroll
                for (int m = 0; m < 4; ++m) { const int rl = ai * HALF + wr * 64 + m * 16 + fr; const f32x4 p = *(const LAS f32x4*)(X + rl * 4);
                    ssq4[(size_t)u.pn * M + u.pm * BM + rl] = (p[0] + p[1]) + (p[2] + p[3]); } }
    }
};
struct EpiRes1 {
    static constexpr bool PERM = true, KSPLIT = true;
    const float* x; bf16_t* XB; const float* ssqa; const float* ssqs4; float* ssqx8; LAS float* X;
    __device__ __forceinline__ void operator()(f32x4 (&acc)[2][2][4][2], const Unit& u, int wr, int wc, int fr, int fq) const {
        if (u.kh == 0) {
#pragma unroll
        for (int ai = 0; ai < 2; ++ai)
#pragma unroll
            for (int m = 0; m < 4; ++m) { const int row = u.pm * BM + ai * HALF + wr * 64 + m * 16 + fr;
                const float sq = (ssqs4[row] + ssqs4[M + row]) + (ssqs4[2 * M + row] + ssqs4[3 * M + row]);
                const float ra = __builtin_amdgcn_rsqf(ssqa[row] * (1.0f / AW) + RMS_EPS), rs = __builtin_amdgcn_rsqf(sq * (1.0f / SW) + RMS_EPS), f = ra * fast_rcp(rs);
#pragma unroll
                for (int bj = 0; bj < 2; ++bj)
#pragma unroll
                    for (int n = 0; n < 2; ++n) acc[ai][bj][m][n] *= f; }
        return; }
        float rsv[2][4];
#pragma unroll
        for (int ai = 0; ai < 2; ++ai)
#pragma unroll
            for (int m = 0; m < 4; ++m) { const int row = u.pm * BM + ai * HALF + wr * 64 + m * 16 + fr;
                const float sq = (ssqs4[row] + ssqs4[M + row]) + (ssqs4[2 * M + row] + ssqs4[3 * M + row]); rsv[ai][m] = __builtin_amdgcn_rsqf(sq * (1.0f / SW) + RMS_EPS); }
#pragma unroll
        for (int am = 0; am < 4; ++am) { const int ai = am >> 1, mb = (am & 1) * 2;
            f32x4 xv[2][2][2];
#pragma unroll
            for (int mm = 0; mm < 2; ++mm)
#pragma unroll
                for (int bj = 0; bj < 2; ++bj) { const float* xp = x + (size_t)(u.pm * BM + ai * HALF + wr * 64 + (mb + mm) * 16 + fr) * DM + u.pn * BM + bj * HALF + wc * 32 + 8 * fq; xv[mm][bj][0] = *(const f32x4*)xp; xv[mm][bj][1] = *(const f32x4*)(xp + 4); }
#pragma unroll
            for (int mm = 0; mm < 2; ++mm) { const int m = mb + mm; const int row = u.pm * BM + ai * HALF + wr * 64 + m * 16 + fr; float ss = 0.f; const float rs = rsv[ai][m];
#pragma unroll
                for (int bj = 0; bj < 2; ++bj) { const size_t off = (size_t)row * DM + u.pn * BM + bj * HALF + wc * 32 + 8 * fq;
                    const f32x4 v0 = xv[mm][bj][0] + acc[ai][bj][m][0] * rs, v1 = xv[mm][bj][1] + acc[ai][bj][m][1] * rs;
#pragma unroll
                    for (int e = 0; e < 4; ++e) ss += v0[e] * v0[e] + v1[e] * v1[e];
                    *(u32x4*)(XB + off) = pack8(v0, v1); }
                ss += __shfl_xor(ss, 16); ss += __shfl_xor(ss, 32);
                if (fq == 0) X[(ai * HALF + wr * 64 + m * 16 + fr) * 4 + wc] = ss; }
            asm volatile("" ::: "memory"); }
        asm volatile("s_waitcnt lgkmcnt(0)" ::: "memory"); __builtin_amdgcn_s_barrier(); asm volatile("" ::: "memory");
        if (wc == 0 && fq == 0) {
#pragma unroll
            for (int ai = 0; ai < 2; ++ai)
#pragma unroll
                for (int m = 0; m < 4; ++m) { const int rl = ai * HALF + wr * 64 + m * 16 + fr; const f32x4 p = *(const LAS f32x4*)(X + rl * 4);
                    ssqx8[(size_t)u.pn * M + u.pm * BM + rl] = (p[0] + p[1]) + (p[2] + p[3]); } }
    }
};
struct EpiSwiGLU {
    static constexpr bool PERM = true, KSPLIT = false;
    bf16_t* H; const float* ssqx8;
    __device__ __forceinline__ void operator()(f32x4 (&acc)[2][2][4][2], const Unit& u, int wr, int wc, int fr, int fq) const {
        float rsv[2][4];
#pragma unroll
        for (int ai = 0; ai < 2; ++ai)
#pragma unroll
            for (int m = 0; m < 4; ++m) { const int row = u.pm * BM + ai * HALF + wr * 64 + m * 16 + fr; float sq = 0.f;
#pragma unroll
                for (int t = 0; t < 8; ++t) sq += ssqx8[(size_t)t * M + row];
                rsv[ai][m] = __builtin_amdgcn_rsqf(sq * (1.0f / DM) + RMS_EPS); }
#pragma unroll
        for (int ai = 0; ai < 2; ++ai)
#pragma unroll
            for (int m = 0; m < 4; ++m) { const int row = u.pm * BM + ai * HALF + wr * 64 + m * 16 + fr; const float rs = rsv[ai][m];
                f32x4 h0, h1;
#pragma unroll
                for (int e = 0; e < 4; ++e) { const float g0 = acc[ai][0][m][0][e] * rs, u0 = acc[ai][1][m][0][e] * rs, g1 = acc[ai][0][m][1][e] * rs, u1 = acc[ai][1][m][1][e] * rs;
                    h0[e] = g0 * sigmoidf_(g0) * u0; h1[e] = g1 * sigmoidf_(g1) * u1; }
                *(u32x4*)(H + (size_t)row * DFF + u.pn * HALF + wc * 32 + 8 * fq) = pack8(h0, h1); }
    }
};
struct EpiRes2 {
    static constexpr bool PERM = true, KSPLIT = false;
    float* out; const bf16_t* XB;
    __device__ __forceinline__ void operator()(f32x4 (&acc)[2][2][4][2], const Unit& u, int wr, int wc, int fr, int fq) const {
#pragma unroll
        for (int ai = 0; ai < 2; ++ai) {
            u32x4 xb[4][2];
#pragma unroll
            for (int m = 0; m < 4; ++m)
#pragma unroll
                for (int bj = 0; bj < 2; ++bj) xb[m][bj] = *(const u32x4*)(XB + (size_t)(u.pm * BM + ai * HALF + wr * 64 + m * 16 + fr) * DM + u.pn * BM + wc * 32 + 8 * fq + bj * HALF);
#pragma unroll
            for (int m = 0; m < 4; ++m) { const size_t roff = (size_t)(u.pm * BM + ai * HALF + wr * 64 + m * 16 + fr) * DM + u.pn * BM + wc * 32 + 8 * fq;
#pragma unroll
                for (int bj = 0; bj < 2; ++bj) { const size_t off = roff + bj * HALF; const u32x4 x4 = xb[m][bj];
                    f32x4 v0, v1; v0[0] = bf_lo(x4.x); v0[1] = bf_hi(x4.x); v0[2] = bf_lo(x4.y); v0[3] = bf_hi(x4.y); v1[0] = bf_lo(x4.z); v1[1] = bf_hi(x4.z); v1[2] = bf_lo(x4.w); v1[3] = bf_hi(x4.w);
                    *(f32x4*)(out + off) = v0 + acc[ai][bj][m][0]; *(f32x4*)(out + off + 4) = v1 + acc[ai][bj][m][1]; } }
            asm volatile("" ::: "memory"); }
    }
};
}

#define RLX_AGENT __ATOMIC_RELAXED, __HIP_MEMORY_SCOPE_AGENT
#define XB_TMO      128
#define XB_XCNT(j)  (256  + 64 * (j))
#define XB_XSUB(j)  (1280 + 64 * (j))
#define XB_XGEN(j)  (2304 + 64 * (j))
#define XB_TOP      3328
#define XB_TOPGEN   3392
#define XCD_BAR_WORDS 3456
#define XB_SPIN_CAP (1u << 24)
__device__ __forceinline__ unsigned xb_ld(unsigned* p)              { return __hip_atomic_load(p, __ATOMIC_RELAXED, __HIP_MEMORY_SCOPE_AGENT); }
__device__ __forceinline__ unsigned xb_add(unsigned* p, unsigned v) { return __hip_atomic_fetch_add(p, v, __ATOMIC_RELAXED, __HIP_MEMORY_SCOPE_AGENT); }
__device__ __forceinline__ unsigned xb_xcc_id() { return (unsigned)__builtin_amdgcn_s_getreg((3 << 11) | 20) & 0xFu; }
#define XB_SPIN(cond, bar) do { unsigned _sp = 0; while (cond) { __builtin_amdgcn_s_sleep(1); \
    if ((++_sp & 255u) == 0u) { if (xb_ld(&(bar)[XB_TMO])) break; if (_sp > XB_SPIN_CAP) { atomicAdd(&(bar)[XB_TMO], 1u); break; } } } } while (0)
struct XcdBarrier { unsigned* bar; unsigned x; volatile LAS unsigned* st; };
__device__ __forceinline__ XcdBarrier xcd_barrier_post(unsigned* bar, volatile LAS unsigned* st) {
    XcdBarrier b; b.bar = bar; b.x = xb_xcc_id(); b.st = st;
    if (threadIdx.x == 0) (void)xb_add(&bar[XB_XCNT(b.x)], 1u);
    return b;
}
__device__ __forceinline__ void xcd_barrier_complete(unsigned* bar, unsigned x, unsigned& nloc, unsigned& nx) {
    const unsigned G = gridDim.x * gridDim.y * gridDim.z;
    unsigned sum, cnt, mine, sp = 0u;
    for (;;) {
        sum = 0u; cnt = 0u; mine = 0u;
#pragma unroll
        for (unsigned j = 0; j < 16; ++j) { const unsigned c = xb_ld(&bar[XB_XCNT(j)]); sum += c; cnt += (c > 0u) ? 1u : 0u; mine = (j == x) ? c : mine; }
        if (sum == G) break;
        __builtin_amdgcn_s_sleep(1);
        if ((++sp & 255u) == 0u) { if (xb_ld(&bar[XB_TMO])) break; if (sp > XB_SPIN_CAP) { atomicAdd(&bar[XB_TMO], 1u); break; } }
    }
    nloc = mine > 0u ? mine : 1u; nx = cnt > 0u ? cnt : 1u;
}
__device__ __forceinline__ void xcd_barrier(const XcdBarrier& b) {
    asm volatile("s_waitcnt vmcnt(0)" ::: "memory");
    __syncthreads();
    if (threadIdx.x == 0) {
        unsigned* bar = b.bar;
        __builtin_amdgcn_s_waitcnt(0);
        unsigned nloc = b.st[0], nx = b.st[1];
        if (nloc == 0u) { xcd_barrier_complete(bar, b.x, nloc, nx); b.st[0] = nloc; b.st[1] = nx; }
        const unsigned old = xb_add(&bar[XB_XSUB(b.x)], 1u);
        const unsigned gen = old / nloc;
        if (old + 1u == (gen + 1u) * nloc) {
            __builtin_amdgcn_fence(__ATOMIC_RELEASE, "agent");
            asm volatile("s_waitcnt vmcnt(0)" ::: "memory");
            const unsigned og = xb_add(&bar[XB_TOP], 1u);
            const unsigned tg = og / nx;
            if (og + 1u == (tg + 1u) * nx) xb_add(&bar[XB_TOPGEN], 1u);
            else XB_SPIN(xb_ld(&bar[XB_TOPGEN]) == tg, bar);
            __builtin_amdgcn_fence(__ATOMIC_ACQUIRE, "agent");
            xb_add(&bar[XB_XGEN(b.x)], 1u);
            asm volatile("s_waitcnt vmcnt(0)" ::: "memory");
        } else {
            XB_SPIN(xb_ld(&bar[XB_XGEN(b.x)]) == gen, bar);
            __builtin_amdgcn_fence(__ATOMIC_ACQUIRE, "agent");
            asm volatile("s_waitcnt vmcnt(0)" ::: "memory");
        }
    }
    __syncthreads();
}

struct Args { const float* in[23]; float* out; unsigned char* ws; int ph_lo, ph_hi, li, dup; };
enum { I_X = 0, I_GMIX, I_WIN, I_QG, I_KG, I_RPB, I_ARE, I_AIM, I_BRE, I_BIM, I_CRE, I_CIM, I_LS, I_D, I_WGLU, I_BGLU, I_GOA, I_GOS, I_WOUT, I_GFFN, I_WG, I_WU, I_WD };

#define LDS_WAIT() asm volatile("s_waitcnt lgkmcnt(0)" ::: "memory")

__device__ __forceinline__ void p0_transpose_item(const float* W, int N, const float* kscale, bf16_t* WT, int ldd, int drow0, int k0, int n0, int lane) {
    const int c = lane >> 3, n4 = (lane & 7) * 4;
    const float* src = W + (size_t)(k0 + 8 * c) * N + n0 + n4;
    f32x4 v[2][8];
#pragma unroll
    for (int h = 0; h < 2; ++h)
#pragma unroll
        for (int i = 0; i < 8; ++i) v[h][i] = __builtin_nontemporal_load((const f32x4*)(src + (size_t)i * N + 32 * h));
    if (kscale) { const f32x4 s0 = *(const f32x4*)(kscale + k0 + 8 * c), s1 = *(const f32x4*)(kscale + k0 + 8 * c + 4);
#pragma unroll
        for (int h = 0; h < 2; ++h)
#pragma unroll
            for (int i = 0; i < 8; ++i) v[h][i] *= (i < 4 ? s0[i & 3] : s1[i & 3]); }
#pragma unroll
    for (int h = 0; h < 2; ++h)
#pragma unroll
        for (int e = 0; e < 4; ++e) { u32x4 o; o.x = cvt_pk_bf16(v[h][0][e], v[h][1][e]); o.y = cvt_pk_bf16(v[h][2][e], v[h][3][e]); o.z = cvt_pk_bf16(v[h][4][e], v[h][5][e]); o.w = cvt_pk_bf16(v[h][6][e], v[h][7][e]);
            *(u32x4*)(WT + (size_t)(drow0 + 32 * h + n4 + e) * ldd + k0 + 8 * c) = o; }
}

__device__ __forceinline__ void dsincos(double a, double& s, double& c) {
    const double k = __builtin_rint(a * 0.63661977236758134308);
    double r = __builtin_fma(-k, 1.57079632679489655800e+00, a);
    r = __builtin_fma(-k, 6.12323399573676603587e-17, r);
    const double r2 = r * r;
    double sp = -7.6471637318198164759e-13; sp = sp * r2 + 1.6059043836821614599e-10; sp = sp * r2 - 2.5052108385441718775e-08; sp = sp * r2 + 2.7557319223985890653e-06;
    sp = sp * r2 - 1.9841269841269841270e-04; sp = sp * r2 + 8.3333333333333333333e-03; sp = sp * r2 - 1.6666666666666666667e-01; sp = sp * r2 * r + r;
    double cp = 4.7794773323873852974e-14; cp = cp * r2 - 1.1470745597729724714e-11; cp = cp * r2 + 2.0876756987868098979e-09; cp = cp * r2 - 2.7557319223985890653e-07;
    cp = cp * r2 + 2.4801587301587301587e-05; cp = cp * r2 - 1.3888888888888888889e-03; cp = cp * r2 + 4.1666666666666666667e-02; cp = cp * r2 - 0.5; cp = cp * r2 + 1.0;
    const int q = (int)((long long)k) & 3;
    s = (q == 0) ? sp : (q == 1) ? cp : (q == 2) ? -sp : -cp;
    c = (q == 0) ? cp : (q == 1) ? -sp : (q == 2) ? -cp : sp;
}

struct S5Params { f32x4 br4, bi4, cr4, ci4; float are, aim, ls; };
__device__ __forceinline__ void p0_s5_params(const Args& a, int g, int tid, S5Params& P) {
    const float* a_re = a.in[I_ARE]; const float* a_im = a.in[I_AIM]; const float* b_re = a.in[I_BRE]; const float* b_im = a.in[I_BIM];
    const float* c_re = a.in[I_CRE]; const float* c_im = a.in[I_CIM]; const float* lstep = a.in[I_LS];
#pragma unroll
    for (int j = 0; j < 4; ++j) { const int i = tid + 512 * j, c = i & 15, p = (i >> 4) & 63, d = i >> 10;
        const size_t bi = (((size_t)d * SG + g) * SP + p) * SC + c, ci = (((size_t)d * SG + g) * SC + c) * SP + p;
        P.br4[j] = b_re[bi]; P.bi4[j] = b_im[bi]; P.cr4[j] = c_re[ci]; P.ci4[j] = c_im[ci]; }
    { const int p = tid & 63, d = (tid >> 6) & 1; P.are = a_re[(d * SG + g) * SP + p]; P.aim = a_im[(d * SG + g) * SP + p]; P.ls = lstep[d * SG + g]; }
}
__device__ __forceinline__ void p0_s5_tables(const Args& a, LAS unsigned char* lds, int g, int q, int tid, const S5Params& P) {
    LAS f32x2* LP = (LAS f32x2*)lds;
    LAS float* Bb = (LAS float*)(lds + 33792);
    LAS f32x2* Cm = (LAS f32x2*)(lds + 50176);
    LAS float* Kt = (LAS float*)(lds + 66560);
    const float* dsk = a.in[I_D];
    unsigned char* ws = a.ws;
    __syncthreads();
    LAS f32x2* Fp = (LAS f32x2*)(Kt);
    if (tid < 128) { const int p = tid & 63, d = tid >> 6;
        const double lre = (double)fminf(P.are, -1e-4f), lim = (double)P.aim, dt = exp((double)P.ls);
        const double mag = exp(lre * dt); double sn, cs; dsincos(lim * dt, sn, cs);
        const double lr = mag * cs, li = mag * sn;
        const double nr = lr - 1.0, ni = li, den = 1.0 / (lre * lre + lim * lim);
        Fp[d * 64 + p] = (f32x2){(float)((nr * lre + ni * lim) * den), (float)((ni * lre - nr * lim) * den)};
        double wr_ = 1.0, wi_ = 0.0;
        for (int tau = 0; tau <= CL; ++tau) { LP[(d * 64 + p) * 33 + tau] = (f32x2){(float)wr_, (float)wi_}; const double t_ = wr_ * lr - wi_ * li; wi_ = wr_ * li + wi_ * lr; wr_ = t_; } }
    __syncthreads();
#pragma unroll
    for (int j = 0; j < 4; ++j) { const int i = tid + 512 * j, c = i & 15, p = (i >> 4) & 63, d = i >> 10; const f32x2 f = Fp[d * 64 + p];
        Bb[(d * 64 + p) * 32 + c] = f.x * P.br4[j] - f.y * P.bi4[j]; Bb[(d * 64 + p) * 32 + 16 + c] = f.x * P.bi4[j] + f.y * P.br4[j];
        Cm[i] = (f32x2){P.cr4[j], P.ci4[j]}; }
    __syncthreads();
    if (q == 0 && tid < 128) { const int p = tid & 63, d = tid >> 6; ((f32x2*)(ws + WS_LAML))[(g * 2 + d) * SP + p] = LP[(d * 64 + p) * 33 + CL]; }
    { const int wv = __builtin_amdgcn_readfirstlane(tid >> 6), l = tid & 63, c16 = l & 15, g4 = l >> 4;
#pragma unroll 1
      for (int d = 0; d < 2; ++d) {
        bf16x8 Bf[4];
#pragma unroll
        for (int ks = 0; ks < 4; ++ks) { float v[8];
#pragma unroll
            for (int j = 0; j < 8; ++j) v[j] = Bb[(d * 64 + 32 * (ks & 1) + 8 * g4 + j) * 32 + (ks >> 1) * 16 + c16];
            u32x4 w; w.x = cvt_pk_bf16(v[0], v[1]); w.y = cvt_pk_bf16(v[2], v[3]); w.z = cvt_pk_bf16(v[4], v[5]); w.w = cvt_pk_bf16(v[6], v[7]); Bf[ks] = __builtin_bit_cast(bf16x8, w); }
#pragma unroll 1
        for (int tt = 0; tt < 4; ++tt) { const int tau = wv + 8 * tt;
            f32x4 acc = (f32x4){0.f, 0.f, 0.f, 0.f};
#pragma unroll
            for (int ks = 0; ks < 2; ++ks) { float gr[8], gi[8];
#pragma unroll
                for (int j = 0; j < 8; ++j) { const int p = 32 * ks + 8 * g4 + j; const f32x2 cm = Cm[(d * 64 + p) * 16 + c16], lp = LP[(d * 64 + p) * 33 + tau];
                    gr[j] = cm.x * lp.x - cm.y * lp.y; gi[j] = -(cm.x * lp.y + cm.y * lp.x); }
                u32x4 wr_, wi_; wr_.x = cvt_pk_bf16(gr[0], gr[1]); wr_.y = cvt_pk_bf16(gr[2], gr[3]); wr_.z = cvt_pk_bf16(gr[4], gr[5]); wr_.w = cvt_pk_bf16(gr[6], gr[7]);
                wi_.x = cvt_pk_bf16(gi[0], gi[1]); wi_.y = cvt_pk_bf16(gi[2], gi[3]); wi_.z = cvt_pk_bf16(gi[4], gi[5]); wi_.w = cvt_pk_bf16(gi[6], gi[7]);
                acc = __builtin_amdgcn_mfma_f32_16x16x32_bf16(__builtin_bit_cast(bf16x8, wr_), Bf[ks], acc, 0, 0, 0);
                acc = __builtin_amdgcn_mfma_f32_16x16x32_bf16(__builtin_bit_cast(bf16x8, wi_), Bf[2 + ks], acc, 0, 0, 0); }
#pragma unroll
            for (int e = 0; e < 4; ++e) Kt[((d * 32 + tau) * 16 + 4 * g4 + e) * 16 + c16] = acc[e]; } } }
    __syncthreads();
    { const int d = q >> 1, ri = q & 1, p = tid >> 3, s0 = (tid & 7) * 4;
      bf16_t* dst = (bf16_t*)(ws + WS_WST) + ((size_t)g * 256 + q * 64 + p) * 512 + s0 * 16;
      float bx_[16], by_[16];
#pragma unroll
      for (int e = 0; e < 16; ++e) { bx_[e] = Bb[(d * 64 + p) * 32 + e]; by_[e] = Bb[(d * 64 + p) * 32 + 16 + e]; }
#pragma unroll
      for (int sp = 0; sp < 4; ++sp) { const int pw = d == 0 ? (CL - 1 - (s0 + sp)) : (s0 + sp); const f32x2 lp = LP[(d * 64 + p) * 33 + pw]; float v[16];
#pragma unroll
          for (int e = 0; e < 16; ++e) v[e] = ri == 0 ? (lp.x * bx_[e] - lp.y * by_[e]) : (lp.x * by_[e] + lp.y * bx_[e]);
          u32x4 w0, w1; w0.x = cvt_pk_bf16(v[0], v[1]); w0.y = cvt_pk_bf16(v[2], v[3]); w0.z = cvt_pk_bf16(v[4], v[5]); w0.w = cvt_pk_bf16(v[6], v[7]);
          w1.x = cvt_pk_bf16(v[8], v[9]); w1.y = cvt_pk_bf16(v[10], v[11]); w1.z = cvt_pk_bf16(v[12], v[13]); w1.w = cvt_pk_bf16(v[14], v[15]);
          *(u32x4*)(dst + sp * 16) = w0; *(u32x4*)(dst + sp * 16 + 8) = w1; } }
    { const int c = tid & 15, s = 8 * q + ((tid >> 4) & 7), hi2 = tid >> 7;
      bf16_t* dst = (bf16_t*)(ws + WS_TW) + ((size_t)g * 512 + s * 16 + c) * KS5;
      const float dsv = dsk[g * SC + c];
#pragma unroll 1
      for (int it = 0; it < 8; ++it) { const int sp = hi2 + 4 * it; f32x4 v[4];
          const LAS f32x4* k0 = (const LAS f32x4*)(Kt + ((sp <= s ? (s - sp) : (32 + sp - s)) * 16 + c) * 16);
#pragma unroll
          for (int e = 0; e < 4; ++e) v[e] = k0[e];
          if (sp == s) { const LAS f32x4* k1 = (const LAS f32x4*)(Kt + (32 * 16 + c) * 16);
#pragma unroll
              for (int e = 0; e < 4; ++e) v[e] += k1[e];
#pragma unroll
              for (int e = 0; e < 4; ++e)
#pragma unroll
                  for (int k = 0; k < 4; ++k) v[e][k] += (c == 4 * e + k) ? dsv : 0.f; }
          u32x4 w0, w1; w0.x = cvt_pk_bf16(v[0][0], v[0][1]); w0.y = cvt_pk_bf16(v[0][2], v[0][3]); w0.z = cvt_pk_bf16(v[1][0], v[1][1]); w0.w = cvt_pk_bf16(v[1][2], v[1][3]);
          w1.x = cvt_pk_bf16(v[2][0], v[2][1]); w1.y = cvt_pk_bf16(v[2][2], v[2][3]); w1.z = cvt_pk_bf16(v[3][0], v[3][1]); w1.w = cvt_pk_bf16(v[3][2], v[3][3]);
          *(u32x4*)(dst + sp * 16) = w0; *(u32x4*)(dst + sp * 16 + 8) = w1; }
      { const int d = hi2 >> 1, ri = hi2 & 1, pw = d == 0 ? (s + 1) : (CL - s);
#pragma unroll 1
        for (int pb = 0; pb < 8; ++pb) { float v[8];
#pragma unroll
            for (int e = 0; e < 8; ++e) { const int p = 8 * pb + e; const f32x2 cm = Cm[(d * 64 + p) * 16 + c], lp = LP[(d * 64 + p) * 33 + pw];
                v[e] = ri == 0 ? (cm.x * lp.x - cm.y * lp.y) : -(cm.x * lp.y + cm.y * lp.x); }
            u32x4 w; w.x = cvt_pk_bf16(v[0], v[1]); w.y = cvt_pk_bf16(v[2], v[3]); w.z = cvt_pk_bf16(v[4], v[5]); w.w = cvt_pk_bf16(v[6], v[7]);
            *(u32x4*)(dst + 512 + hi2 * 64 + 8 * pb) = w; } } }
    __syncthreads();
}

__device__ __forceinline__ void p0_prologue(const Args& a, LAS unsigned char* lds, int vcu, int G, int tid) {
    asm volatile("" : "+v"(tid));
    const int wave = __builtin_amdgcn_readfirstlane(tid >> 6), lane = tid & 63;
    unsigned char* ws = a.ws;
    S5Params P5; p0_s5_params(a, (vcu < SG * 4 ? vcu : SG * 4 - 1) >> 2, tid, P5);
    if (vcu & 1) { for (int it = vcu; it < SG * 4; it += G) { if (it != vcu) p0_s5_params(a, it >> 2, tid, P5); p0_s5_tables(a, lds, it >> 2, it & 3, tid, P5); } }
    const int gw = vcu * 8 + wave, NGW = G * 8;
    constexpr int I_IN = (DM / 64) * (INW / 64), I_GL = (SW / 64) * (SW / 64), I_OUT = (DM / 64) * (DM / 64), I_GU = (DM / 64) * (DFF / 64), I_DN = (DFF / 64) * (DM / 64);
    constexpr int NITEMS = I_IN + I_GL + I_OUT + 2 * I_GU + I_DN;
    for (int it = gw; it < NITEMS; it += NGW) {
        int r = it;
        if (r < I_IN) { const int nb = INW / 64, kb = r / nb, n0 = (r % nb) * 64; p0_transpose_item(a.in[I_WIN], INW, nullptr, (bf16_t*)(ws + WS_WIN), DM, n0, kb * 64, n0, lane); continue; } r -= I_IN;
        if (r < I_GL) { const int nb = SW / 64, kb = r / nb, n0 = (r % nb) * 64; p0_transpose_item(a.in[I_WGLU], SW, nullptr, (bf16_t*)(ws + WS_WGLU), SW, n0, kb * 64, n0, lane); continue; } r -= I_GL;
        if (r < I_OUT) { const int nb = DM / 64, kb = r / nb, n0 = (r % nb) * 64, k0 = kb * 64;
            p0_transpose_item(a.in[I_WOUT], DM, k0 < AW ? a.in[I_GOA] : a.in[I_GOS] - AW, (bf16_t*)(ws + WS_WOUT), DM, n0, k0, n0, lane); continue; } r -= I_OUT;
        if (r < 2 * I_GU) { const int up = r >= I_GU; if (up) r -= I_GU; const int nb = DFF / 64, kb = r / nb, n0 = (r % nb) * 64;
            p0_transpose_item(up ? a.in[I_WU] : a.in[I_WG], DFF, a.in[I_GFFN], (bf16_t*)(ws + WS_WGU), DM, 256 * (n0 >> 7) + (n0 & 127) + (up ? 128 : 0), kb * 64, n0, lane); continue; } r -= 2 * I_GU;
        { const int nb = DM / 64, kb = r / nb, n0 = (r % nb) * 64; p0_transpose_item(a.in[I_WD], DM, nullptr, (bf16_t*)(ws + WS_WD), DFF, n0, kb * 64, n0, lane); }
    }
    const float* x = a.in[I_X]; const float* gm = a.in[I_GMIX]; bf16_t* XN = (bf16_t*)(ws + WS_XN);
    for (int m = gw; m < M; m += 2 * NGW) { const int m1 = m + NGW < M ? m + NGW : m;
        const f32x4* xr0 = (const f32x4*)(x + (size_t)m * DM) + lane; const f32x4* xr1 = (const f32x4*)(x + (size_t)m1 * DM) + lane; f32x4 v0[8], v1[8]; float s0 = 0.f, s1 = 0.f;
#pragma unroll
        for (int j = 0; j < 8; ++j) { v0[j] = __builtin_nontemporal_load(xr0 + 64 * j); v1[j] = __builtin_nontemporal_load(xr1 + 64 * j); }
#pragma unroll
        for (int j = 0; j < 8; ++j) { s0 += (v0[j][0] * v0[j][0] + v0[j][1] * v0[j][1]) + (v0[j][2] * v0[j][2] + v0[j][3] * v0[j][3]); s1 += (v1[j][0] * v1[j][0] + v1[j][1] * v1[j][1]) + (v1[j][2] * v1[j][2] + v1[j][3] * v1[j][3]); }
        const float r0 = 1.0f / sqrtf(wave_sum(s0) * (1.0f / DM) + RMS_EPS), r1 = 1.0f / sqrtf(wave_sum(s1) * (1.0f / DM) + RMS_EPS);
        u32x2* o0 = (u32x2*)(XN + (size_t)m * DM) + lane; u32x2* o1 = (u32x2*)(XN + (size_t)m1 * DM) + lane;
#pragma unroll
        for (int j = 0; j < 8; ++j) { const f32x4 gq = ((const f32x4*)gm)[64 * j + lane]; u32x2 w; w.x = cvt_pk_bf16(v0[j][0] * r0 * gq[0], v0[j][1] * r0 * gq[1]); w.y = cvt_pk_bf16(v0[j][2] * r0 * gq[2], v0[j][3] * r0 * gq[3]); o0[64 * j] = w;
            u32x2 w2; w2.x = cvt_pk_bf16(v1[j][0] * r1 * gq[0], v1[j][1] * r1 * gq[1]); w2.y = cvt_pk_bf16(v1[j][2] * r1 * gq[2], v1[j][3] * r1 * gq[3]); o1[64 * j] = w2; }
    }
    if (!(vcu & 1)) { for (int it = vcu; it < SG * 4; it += G) { if (it != vcu) p0_s5_params(a, it >> 2, tid, P5); p0_s5_tables(a, lds, it >> 2, it & 3, tid, P5); } }
}

constexpr int KROW = 144, AROW = 160;
constexpr int AHEAD = 64 * AROW;
constexpr int ABUF = 2 * AHEAD;
constexpr int ATT_RPB_OFF = 2 * ABUF;
static_assert(ATT_RPB_OFF + 16 * 465 * 4 <= MISC_OFF, "attention LDS");

__device__ __forceinline__ void attn_phase(const Args& a, LAS unsigned char* lds, volatile LAS unsigned* MISC, int vcu, int G, int has_g2, int tid) {
    asm volatile("" : "+v"(tid));
    const int wave = __builtin_amdgcn_readfirstlane(tid >> 6), lane = tid & 63, ql = lane & 15, g4 = lane >> 4;
    const bf16_t* QKV = (const bf16_t*)(a.ws + WS_BIG); bf16_t* YAYS = (bf16_t*)(a.ws + WS_YAYS); float* ssqa16 = (float*)(a.ws + WS_SSQA16);
    LAS float* rpbL = (LAS float*)(lds + ATT_RPB_OFF);
    for (int i = tid; i < 16 * 465; i += 512) rpbL[i] = a.in[I_RPB][i];
    const int j = wave & 3, hsel = wave >> 2;
    const int cq = 16 * j + ql, cs = min(max(cq - 8, 0), GRIDW - 16), wb = (j == 0) ? 0 : (j == 1) ? 8 : (j == 2) ? 24 : 32;
    int it_lo, it_hi, it_step = 1;
    if (G == 256) { const int x_ = vcu >> 5, k_ = vcu & 31; if (has_g2) { it_lo = x_ * 256 + 2 * (k_ & 15); it_hi = it_lo + 2; } else { it_lo = x_ * 256 + 32 + 14 * (k_ & 15); it_hi = it_lo + 14; } }
    else { it_lo = vcu; it_hi = BATCH * NROWS * 8; it_step = G; }
#define ATT_FETCH(dst) do { if (tid == 0) { const int nx_ = ((dst) == 20) ? it_lo : item + it_step; MISC[dst] = (unsigned)(nx_ < it_hi ? nx_ : -1); } } while (0)
    int item = 0;
    ATT_FETCH(20);
    __syncthreads();
    item = __builtin_amdgcn_readfirstlane((int)MISC[20]);
    const int skey = tid >> 3, sch = tid & 7;
    const unsigned ldstK = (unsigned)(skey * KROW + sch * 16), ldstV = (unsigned)(skey * AROW + sch * 16);
    u32x4 R[4][2];
#define ATT_SRC(it_, st_, i_) (QKV + ((size_t)((it_) >> 9) * SEQ + 64 * (min(max((((it_) >> 3) & 63) - 4, 0), NROWS - 8) + ((st_) & 7)) + skey) * NQKV + ((st_) < 8 ? AW : 2 * AW) + 64 * (2 * ((it_) & 7) + (i_)) + 8 * sch)
    if (item >= 0) {
#pragma unroll
        for (int p = 0; p < 3; ++p)
#pragma unroll
            for (int i = 0; i < 2; ++i) R[p][i] = *(const u32x4*)ATT_SRC(item, p, i);
    }
    while (item >= 0) {
        const int b = item >> 9, r = (item >> 3) & 63, hp = item & 7, h = 2 * hp + hsel, row_start = min(max(r - 4, 0), NROWS - 8);
        ATT_FETCH(21);
        const size_t tq = (size_t)b * SEQ + 64 * r + cq;
        bf16x8 Qf[2];
        { const u32x4* qp = (const u32x4*)(QKV + tq * NQKV + 64 * h + 8 * g4); Qf[0] = __builtin_bit_cast(bf16x8, qp[0]); Qf[1] = __builtin_bit_cast(bf16x8, qp[4]); }
        const LAS float* bl = rpbL + h * 465 + (row_start - r + 7) * 31 + (wb + 4 * g4 - cq + 15);
        f32x4 S[8][2]; bf16x8 Pf[8]; f32x4 O[4]; float sum = 0.f; int nitem = -1;
#pragma unroll
        for (int dt = 0; dt < 4; ++dt) O[dt] = (f32x4){0.f, 0.f, 0.f, 0.f};
#pragma unroll
        for (int st = 0; st < 16; ++st) {
            LAS unsigned char* buf = lds + (st & 1) * ABUF;
            { const unsigned ld_ = st < 8 ? ldstK : ldstV; *(LAS u32x4*)(buf + ld_) = R[st & 3][0]; *(LAS u32x4*)(buf + AHEAD + ld_) = R[st & 3][1]; }
            if (st + 3 < 16) {
#pragma unroll
                for (int i = 0; i < 2; ++i) R[(st + 3) & 3][i] = *(const u32x4*)ATT_SRC(item, st + 3, i);
            } else if (nitem >= 0) {
#pragma unroll
                for (int i = 0; i < 2; ++i) R[(st + 3) & 3][i] = *(const u32x4*)ATT_SRC(nitem, st + 3 - 16, i);
            }
            asm volatile("s_waitcnt lgkmcnt(0)" ::: "memory"); __builtin_amdgcn_s_barrier(); asm volatile("" ::: "memory");
            if (st == 0) nitem = __builtin_amdgcn_readfirstlane((int)MISC[21]);
            const LAS unsigned char* hb = buf + hsel * AHEAD;
            if (st < 8) {
                const int kr = st;
#pragma unroll
                for (int t = 0; t < 2; ++t) {
                    const LAS unsigned char* kp = hb + (wb + 16 * t + ql) * KROW + g4 * 16;
                    const bf16x8 k0 = *(const LAS bf16x8*)kp, k1 = *(const LAS bf16x8*)(kp + 64);
                    f32x4 acc = (f32x4){0.f, 0.f, 0.f, 0.f};
                    acc = __builtin_amdgcn_mfma_f32_16x16x32_bf16(k0, Qf[0], acc, 0, 0, 0);
                    acc = __builtin_amdgcn_mfma_f32_16x16x32_bf16(k1, Qf[1], acc, 0, 0, 0);
#pragma unroll
                    for (int e = 0; e < 4; ++e) { const int ck = wb + 16 * t + 4 * g4 + e;
                        const float bias = bl[kr * 31 + 16 * t + e];
                        acc[e] = (ck >= cs && ck < cs + 16) ? acc[e] + bias : -1e30f; }
                    S[kr][t] = acc; }
                if (st == 7) {
                    float mx = -1e30f;
#pragma unroll
                    for (int k2 = 0; k2 < 8; ++k2)
#pragma unroll
                        for (int t = 0; t < 2; ++t)
#pragma unroll
                            for (int e = 0; e < 4; ++e) mx = fmaxf(mx, S[k2][t][e]);
                    mx = fmaxf(mx, __shfl_xor(mx, 16)); mx = fmaxf(mx, __shfl_xor(mx, 32));
#pragma unroll
                    for (int k2 = 0; k2 < 8; ++k2) { f32x4 p0, p1;
#pragma unroll
                        for (int e = 0; e < 4; ++e) { p0[e] = fast_exp2((S[k2][0][e] - mx) * 1.44269504089f); p1[e] = fast_exp2((S[k2][1][e] - mx) * 1.44269504089f); sum += p0[e] + p1[e]; }
                        Pf[k2] = __builtin_bit_cast(bf16x8, pg8::pack8(p0, p1)); }
                    sum += __shfl_xor(sum, 16); sum += __shfl_xor(sum, 32);
                }
            } else {
                const int kr = st - 8;
                const LAS unsigned char* rp = hb + (wb + 4 * g4 + ((lane & 15) >> 2)) * AROW + (lane & 3) * 8;
#pragma unroll
                for (int dt = 0; dt < 4; ++dt) {
                    const s16x4 lo = __builtin_amdgcn_ds_read_tr16_b64_v4i16((LAS s16x4*)(rp + dt * 32));
                    const s16x4 hi = __builtin_amdgcn_ds_read_tr16_b64_v4i16((LAS s16x4*)(rp + 16 * AROW + dt * 32));
                    const bf16x8 av = (bf16x8){lo[0], lo[1], lo[2], lo[3], hi[0], hi[1], hi[2], hi[3]};
                    O[dt] = __builtin_amdgcn_mfma_f32_16x16x32_bf16(av, Pf[kr], O[dt], 0, 0, 0); }
            }
        }
        const float inv = fast_rcp(sum); float ssq_acc = 0.f;
        bf16_t* op = YAYS + tq * DM + 64 * h + 4 * g4;
#pragma unroll
        for (int dt = 0; dt < 4; ++dt) { const f32x4 o = O[dt] * inv; ssq_acc += (o[0] * o[0] + o[1] * o[1]) + (o[2] * o[2] + o[3] * o[3]);
            u32x2 w; w.x = cvt_pk_bf16(o[0], o[1]); w.y = cvt_pk_bf16(o[2], o[3]); *(u32x2*)(op + 16 * dt) = w; }
        ssq_acc += __shfl_xor(ssq_acc, 16); ssq_acc += __shfl_xor(ssq_acc, 32);
        if (g4 == 0) ssqa16[tq * 16 + h] = ssq_acc;
        item = nitem;
    }
#undef ATT_FETCH
#undef ATT_SRC
}

__device__ __forceinline__ void scan_chain(const Args& a, int g, int pm, int tid) {
    asm volatile("" : "+v"(tid));
    if (tid >= 256) return;
    const float* E = (const float*)(a.ws + WS_E); bf16_t* A5 = (bf16_t*)(a.ws + WS_A5); const f32x2* LAML = (const f32x2*)(a.ws + WS_LAML);
    const int p = tid & 63, d = (tid >> 6) & 1, b = 2 * pm + (tid >> 7);
    const f32x2 lam = LAML[(g * 2 + d) * SP + p];
    float xr = 0.f, xi = 0.f;
#pragma unroll 16
    for (int kk = 0; kk < NCH; ++kk) { const int k = d == 0 ? kk : NCH - 1 - kk; const size_t R = (size_t)g * RCH + b * NCH + k;
        bf16_t* ap = A5 + R * KS5 + 512 + d * 128 + p; ap[0] = (bf16_t)(cvt_pk_bf16(xr, 0.f) & 0xffffu); ap[64] = (bf16_t)(cvt_pk_bf16(xi, 0.f) & 0xffffu);
        const float er = E[R * 256 + d * 128 + p], ei = E[R * 256 + d * 128 + 64 + p];
        const float nr = lam.x * xr - lam.y * xi + er, ni = lam.x * xi + lam.y * xr + ei; xr = nr; xi = ni; }
}

__global__ void __launch_bounds__(512, 2) hymba_fwd(Args args) {
    extern __shared__ __attribute__((aligned(16))) unsigned char lds_raw[];
    LAS unsigned char* lds = (LAS unsigned char*)lds_raw;
    volatile LAS unsigned* MISC = (volatile LAS unsigned*)(lds + MISC_OFF);
    const int tid = threadIdx.x;
    const int G = gridDim.x; const int bx = blockIdx.x; const int vcu = (G % 8 == 0) ? (bx % 8) * (G / 8) + bx / 8 : bx;
    unsigned char* ws = args.ws;
    unsigned* ctl = (unsigned*)(ws + WS_CTL);
    for (int u = tid; u < (LDS_BYTES - MISC_OFF) / 4; u += 512) MISC[u] = 0u;
    __syncthreads();
    XcdBarrier bar; bar.bar = ctl + CW_BAR; bar.x = 0; bar.st = nullptr;
    if (MK_N_LAUNCHES == 1) bar = xcd_barrier_post(ctl + CW_BAR, MISC + 8);
    const int lo = args.ph_lo, hi = args.ph_hi;
#define IN(k) (lo <= (k) && (k) < hi)
#define SEAM(k) do { if (IN(k) && IN((k) + 1)) xcd_barrier(bar); } while (0)
    bf16_t* WIN = (bf16_t*)(ws + WS_WIN); bf16_t* WGLU = (bf16_t*)(ws + WS_WGLU); bf16_t* WOUT = (bf16_t*)(ws + WS_WOUT); bf16_t* WGU = (bf16_t*)(ws + WS_WGU); bf16_t* WD = (bf16_t*)(ws + WS_WD);
    bf16_t* WST = (bf16_t*)(ws + WS_WST); bf16_t* TW = (bf16_t*)(ws + WS_TW);
    bf16_t* XN = (bf16_t*)(ws + WS_XN); bf16_t* YG = (bf16_t*)(ws + WS_XN); bf16_t* XB = (bf16_t*)(ws + WS_XN);
    bf16_t* QKV = (bf16_t*)(ws + WS_BIG); bf16_t* A5 = (bf16_t*)(ws + WS_A5); float* E = (float*)(ws + WS_E); bf16_t* HB = (bf16_t*)(ws + WS_BIG);
    bf16_t* YAYS = (bf16_t*)(ws + WS_YAYS);
    float* ssqa16 = (float*)(ws + WS_SSQA16); float* ssqa = (float*)(ws + WS_SSQA); float* ssqs4 = (float*)(ws + WS_SSQS4); float* ssqx8 = (float*)(ws + WS_SSQX8);
    LAS float* XL = (LAS float*)(lds + RING_BYTES);

#define REP(k) _Pragma("unroll") for (int rep_ = (DUP_PHASE == (k)) ? 0 : 1; rep_ < 2; ++rep_)
#define ALPHA ((rep_ == 0 && args.dup >= 0) ? 0.0f : 1.0f)
    if (IN(0)) { REP(0) { p0_prologue(args, lds, vcu, G, tid); __syncthreads(); } SEAM(0); }
    if (IN(1)) {
        pg8::Gemm g{XN, WIN, DM, DM, DM, 0, 0}; pg8::StaticOrder S; S.init(M, INW, G, bx);
        pg8::EpiZ Ep{QKV, A5, args.in[I_QG], args.in[I_KG], XL};
        REP(1) pg8::gemm_phase(lds, g, S, Ep);
        SEAM(1);
    }
    if (IN(2)) {
        for (int cidx = bx; cidx < 2 * SG; cidx += G) { const int g_ = cidx >> 1, pm_ = cidx & 1;
            { pg8::Gemm g{A5, WST, KS5, 512, 512, (size_t)RCH * KS5, (size_t)256 * 512}; pg8::ListOrder S; S.n = 1; S.u0.pm = pm_; S.u0.pn = 0; S.u0.g = g_; S.u0.kh = 0; S.u1 = S.u0;
              pg8::EpiE Ep{E};
              pg8::gemm_phase(lds, g, S, Ep); }
            asm volatile("s_waitcnt vmcnt(0)" ::: "memory"); __syncthreads();
            scan_chain(args, g_, pm_, tid);
            asm volatile("s_waitcnt vmcnt(0)" ::: "memory"); __syncthreads();
            { pg8::Gemm g{A5, TW, KS5, KS5, KS5, (size_t)RCH * KS5, (size_t)512 * KS5}; pg8::ListOrder S; S.n = 2; S.u0.pm = pm_; S.u0.pn = 0; S.u0.g = g_; S.u0.kh = 0; S.u1 = S.u0; S.u1.pn = 1;
              pg8::EpiS5Out Ep{YG};
              pg8::gemm_phase(lds, g, S, Ep); }
        }
        __syncthreads();
        attn_phase(args, lds, MISC, vcu, G, bx < 2 * SG ? 1 : 0, tid);
        SEAM(2);
    }
    if (IN(3)) {
        pg8::Gemm g{YG, WGLU, SW, SW, SW, 0, 0}; pg8::StaticOrder S; S.init(M, SW, G, bx);
        for (int t = vcu * 512 + tid; t < M; t += G * 512) { const f32x4* p = (const f32x4*)(ssqa16 + (size_t)t * 16); const f32x4 s0 = p[0], s1 = p[1], s2 = p[2], s3 = p[3];
            const f32x4 sv = (s0 + s1) + (s2 + s3); ssqa[t] = (sv[0] + sv[1]) + (sv[2] + sv[3]); }
        REP(3) { pg8::EpiGlu Ep{YG, args.in[I_BGLU], YAYS, ssqs4, XL}; pg8::gemm_phase(lds, g, S, Ep); }
        SEAM(3);
    }
    if (IN(4)) {
        pg8::Gemm g{YAYS, WOUT, DM, DM, AW, 0, 0}; pg8::SplitKOrder S; S.so.init(M, DM, G, bx);
        REP(4) { pg8::EpiRes1 Ep{args.in[I_X], XB, ssqa, ssqs4, ssqx8, XL}; pg8::gemm_phase(lds, g, S, Ep); }
        SEAM(4);
    }
    if (IN(5)) {
        pg8::Gemm g{XB, WGU, DM, DM, DM, 0, 0}; pg8::StaticOrder S; S.init(M, 2 * DFF, G, bx);
        pg8::EpiSwiGLU Ep{HB, ssqx8};
        REP(5) pg8::gemm_phase(lds, g, S, Ep);
        SEAM(5);
    }
    if (IN(6)) {
        pg8::Gemm g{HB, WD, DFF, DFF, DFF, 0, 0}; pg8::StaticOrder S; S.init(M, DM, G, bx);
        REP(6) { pg8::EpiRes2 Ep{args.out, XB}; pg8::gemm_phase(lds, g, S, Ep); }
    }
#undef IN
#undef SEAM
}

extern "C" void kernel_launch(void* const* d_in, const int* in_sizes, int n_in, void* d_out, int out_size, void* d_ws, size_t ws_size, hipStream_t stream) {
    static int grid = 0;
    if (grid == 0) {
        if (n_in != 23 || in_sizes[0] != M * DM || out_size != M * DM || ws_size < WS_END) { fprintf(stderr, "kernel_launch: unexpected shapes (n_in %d, in0 %d, out %d, ws %zu < %zu)\n", n_in, n_in > 0 ? in_sizes[0] : -1, out_size, ws_size, (size_t)WS_END); grid = -1; return; }
        int dev = 0, cus = 0, per_cu = 0;
        if (hipGetDevice(&dev) != hipSuccess || hipDeviceGetAttribute(&cus, hipDeviceAttributeMultiprocessorCount, dev) != hipSuccess) { grid = -1; return; }
        if (hipFuncSetAttribute((const void*)hymba_fwd, hipFuncAttributeMaxDynamicSharedMemorySize, LDS_BYTES) != hipSuccess) { fprintf(stderr, "kernel_launch: hipFuncSetAttribute failed\n"); grid = -1; return; }
        if (hipOccupancyMaxActiveBlocksPerMultiprocessor(&per_cu, (const void*)hymba_fwd, 512, LDS_BYTES) != hipSuccess || per_cu < 1) { fprintf(stderr, "kernel_launch: occupancy query says %d blocks per CU\n", per_cu); (void)hipGetLastError(); per_cu = 1; }
        grid = cus;
    }
    if (grid < 0) return;
    (void)hipMemsetAsync((char*)d_ws + WS_CTL, 0, CTL_ZERO_BYTES, stream);
    Args a{}; a.dup = DUP_PHASE;
    for (int i = 0; i < 23; ++i) a.in[i] = (const float*)d_in[i];
    a.out = (float*)d_out; a.ws = (unsigned char*)d_ws;
    if (MK_N_LAUNCHES == 1) {
        a.ph_lo = 0; a.ph_hi = NPHASE; a.li = 0;
        hipLaunchKernelGGL(hymba_fwd, dim3(grid), dim3(512), LDS_BYTES, stream, a);
    } else {
        for (int li = 0; li < NPHASE; ++li) { a.ph_lo = li; a.ph_hi = li + 1; a.li = li; hipLaunchKernelGGL(hymba_fwd, dim3(grid), dim3(512), LDS_BYTES, stream, a); }
    }
}
```

```cpp
#include <hip/hip_runtime.h>
#include <cstdio>
#include <cstdint>

#define DUP_PHASE (-1)
#ifndef MK_N_LAUNCHES
#define MK_N_LAUNCHES 1
#endif

#define GAS __attribute__((address_space(1)))
#define LAS __attribute__((address_space(3)))
typedef unsigned short bf16_t;
typedef short bf16x8 __attribute__((ext_vector_type(8)));
typedef short s16x4 __attribute__((ext_vector_type(4)));
typedef float f32x4 __attribute__((ext_vector_type(4)));
typedef float f32x2 __attribute__((ext_vector_type(2)));
typedef unsigned u32x4 __attribute__((ext_vector_type(4)));
typedef unsigned u32x2 __attribute__((ext_vector_type(2)));

constexpr int BATCH = 4, SEQ = 4096, DM = 2048, M = BATCH * SEQ;
constexpr int AW = 1024, SW = 1024, NH = 16, HD = 64, NQKV = 3 * AW, INW = 4096, DFF = 5632;
constexpr int GRIDW = 64, NROWS = SEQ / GRIDW;
constexpr int SG = 64, SC = 16, SP = 64;
constexpr int CL = 32, NCH = SEQ / CL, RCH = M / CL;
constexpr int KS5 = CL * SC + 256;
constexpr float RMS_EPS = 1e-6f;
constexpr int NPHASE = 7;

constexpr size_t MiB = 1u << 20;
constexpr size_t WS_CTL = 0, CTL_ZERO_BYTES = 65536;
constexpr size_t WS_WIN = 1 * MiB, WS_WGLU = 17 * MiB, WS_WOUT = 19 * MiB, WS_WGU = 27 * MiB, WS_WD = 71 * MiB;
constexpr size_t WS_WST = 93 * MiB, WS_TW = 109 * MiB, WS_LAML = 157 * MiB;
constexpr size_t WS_XN = 158 * MiB;
constexpr size_t WS_BIG = 222 * MiB;
constexpr size_t WS_A5 = WS_BIG + 96 * MiB, WS_E = WS_BIG + 144 * MiB;
constexpr size_t WS_YAYS = 398 * MiB, WS_SSQ = 462 * MiB, WS_END = 464 * MiB;
constexpr size_t WS_SSQA16 = WS_SSQ, WS_SSQA = WS_SSQ + 1 * MiB, WS_SSQS4 = WS_SSQA + 65536, WS_SSQX8 = WS_SSQS4 + 4 * 65536;
constexpr int CW_BAR = 4096;
static_assert((size_t)(CW_BAR + 3456) * 4 <= CTL_ZERO_BYTES, "ctl");

constexpr int RING_BYTES = 131072;
constexpr int MISC_OFF = 143360;
constexpr int LDS_BYTES = 147456;

__device__ __forceinline__ unsigned cvt_pk_bf16(float lo, float hi) { unsigned r; asm volatile("v_cvt_pk_bf16_f32 %0, %1, %2" : "=v"(r) : "v"(lo), "v"(hi)); return r; }
__device__ __forceinline__ float bf_lo(unsigned w) { return __uint_as_float(w << 16); }
__device__ __forceinline__ float bf_hi(unsigned w) { return __uint_as_float(w & 0xffff0000u); }
__device__ __forceinline__ float fast_rcp(float x) { return __builtin_amdgcn_rcpf(x); }
__device__ __forceinline__ float fast_exp2(float x) { return __builtin_amdgcn_exp2f(x); }
__device__ __forceinline__ float sigmoidf_(float x) { return fast_rcp(1.0f + fast_exp2(-1.44269504089f * x)); }
__device__ __forceinline__ float gelu_tanh(float x) { const float t = x * (1.0f + 0.044715f * x * x); return x * fast_rcp(1.0f + fast_exp2(-2.30220818f * t)); }
__device__ __forceinline__ float wave_sum(float v) {
#pragma unroll
    for (int o = 1; o < 64; o <<= 1) v += __shfl_xor(v, o);
    return v;
}

namespace pg8 {
constexpr int BM = 256, BK = 64, HALF = 128, HTB = HALF * BK * 2, NXCD = 8, WGM = 8;
__host__ __device__ __forceinline__ int lds_byte(int r, int c) { const int st = (r >> 4) * 2 + (c >> 5), rr = r & 15, cc = c & 31, ob = rr * 64 + cc * 2; return st * 1024 + (ob ^ (((ob >> 9) & 1) << 5)); }
__host__ __device__ __forceinline__ void stage_rc(int b, int& R, int& C) { const int st = b / 1024, sb = b % 1024, swz = sb ^ (((sb >> 9) & 1) << 5); R = (st >> 1) * 16 + swz / 64; C = (st & 1) * 32 + (swz % 64) / 2; }
__host__ __device__ __forceinline__ int perm32(int rho) { const int n = rho >> 4, i = rho & 15; return 8 * (i >> 2) + 4 * n + (i & 3); }

struct Unit { int pm, pn, g, kh; };
struct Gemm { const bf16_t* A; const bf16_t* Bt; int lda, ldb, K; size_t sA, sB; };

struct StaticOrder {
    int nM, nN, nwg, G, c;
    __device__ void init(int M_, int N_, int G_, int c_) { nM = M_ / BM; nN = N_ / BM; nwg = nM * nN; G = G_; c = c_; }
    __device__ bool next(int i, Unit& u) const {
        const long L = (long)i * G + c; if (L >= nwg) return false;
        int wgid = (int)L; { const int q = nwg / NXCD, r = nwg % NXCD, xcd = wgid % NXCD, off = wgid / NXCD; wgid = (xcd < r ? xcd * (q + 1) : r * (q + 1) + (xcd - r) * q) + off; }
        const int nig = WGM * nN, gid = wgid / nig, fm = gid * WGM, gsz = (nM - fm) < WGM ? (nM - fm) : WGM;
        u.pm = fm + ((wgid % nig) % gsz); u.pn = (wgid % nig) / gsz; u.g = 0; u.kh = 0; return true;
    }
};
struct SplitKOrder {
    StaticOrder so;
    __device__ bool next(int i, Unit& u) const { if (!so.next(i >> 1, u)) return false; u.kh = i & 1; return true; }
};
struct ListOrder {
    int n; Unit u0, u1;
    __device__ bool next(int i, Unit& u) const { if (i >= n) return false; u = i == 0 ? u0 : u1; return true; }
};
struct BatchOrder {
    int nM, nN, nwg, G, c;
    __device__ void init(int nM_, int nN_, int nb, int G_, int c_) { nM = nM_; nN = nN_; nwg = nM * nN * nb; G = G_; c = c_; }
    __device__ bool next(int i, Unit& u) const {
        const long L = (long)i * G + c; if (L >= nwg) return false;
        const int l = (int)L; u.pn = l % nN; u.pm = (l / nN) % nM; u.g = (l / (nN * nM)) % SG; u.kh = 0; return true;
    }
};

template <class Epi, class Sched>
__device__ __forceinline__ void gemm_phase(LAS unsigned char* lds, const Gemm g, const Sched& S, const Epi& E) {
    int tid = threadIdx.x; asm volatile("" : "+v"(tid));
    const int wid = __builtin_amdgcn_readfirstlane(tid >> 6), lane = tid & 63, wr = wid >> 2, wc = wid & 3, fr = lane & 15, fq = lane >> 4;
    const int K = g.K, nt = K / BK;
    unsigned voffA[2], voffB[2];
#pragma unroll
    for (int i = 0; i < 2; ++i) { int R, C; stage_rc(tid * 16 + i * 8192, R, C); const int Rb = Epi::PERM ? ((R & ~31) + perm32(R & 31)) : R;
        voffA[i] = (unsigned)(R * g.lda + C) * 2u; voffB[i] = (unsigned)(Rb * g.ldb + C) * 2u; }
    const size_t kstep = (size_t)(BK * 2);
    const size_t hstepA = (size_t)HALF * g.lda * 2, hstepB = (size_t)HALF * g.ldb * 2;
    const unsigned ldsw = (unsigned)wid * 1024u;
    const int aoff = lds_byte(wr * 64 + fr, fq * 8), boff = lds_byte(wc * 32 + fr, fq * 8);
#define PG8_SA(b, h) (((b) * 2 + (h)) * HTB)
#define PG8_SB(b, h) ((4 + (b) * 2 + (h)) * HTB)
#define PG8_STAGE(bufoff, gbase, voff) do { _Pragma("unroll") for (int _i = 0; _i < 2; ++_i) \
        __builtin_amdgcn_global_load_lds((const unsigned*)((const char*)(gbase) + (voff)[_i]), (LAS unsigned*)(lds + (bufoff) + ldsw + _i * 8192), 16, 0, 0); } while (0)
#define PG8_LDA(dst, b, h) do { _Pragma("unroll") for (int m = 0; m < 4; ++m) _Pragma("unroll") for (int k = 0; k < 2; ++k) dst[m][k] = *(const LAS bf16x8*)(lds + PG8_SA(b, h) + aoff + m * 2048 + k * 1024); } while (0)
#define PG8_LDB(dst, b, h) do { _Pragma("unroll") for (int n = 0; n < 2; ++n) _Pragma("unroll") for (int k = 0; k < 2; ++k) dst[n][k] = *(const LAS bf16x8*)(lds + PG8_SB(b, h) + boff + n * 2048 + k * 1024); } while (0)
#define PG8_MMA(ai, bj, At, Bt) do { __builtin_amdgcn_s_setprio(1); _Pragma("unroll") for (int m = 0; m < 4; ++m) _Pragma("unroll") for (int n = 0; n < 2; ++n) _Pragma("unroll") for (int k = 0; k < 2; ++k) \
        acc[ai][bj][m][n] = __builtin_amdgcn_mfma_f32_16x16x32_bf16(Bt[n][k], At[m][k], acc[ai][bj][m][n], 0, 0, 0); __builtin_amdgcn_s_setprio(0); } while (0)
#define PG8_WAIT_V(n) asm volatile("s_waitcnt vmcnt(" #n ")" ::: "memory")
#define PG8_WAIT_L(n) asm volatile("s_waitcnt lgkmcnt(" #n ")" ::: "memory")
#define PG8_BAR __builtin_amdgcn_s_barrier()
#define PG8_SCHED __builtin_amdgcn_sched_barrier(0)
    Unit cur, nxt; int ui = 0;
    if (!S.next(0, cur)) return;
    f32x4 acc[2][2][4][2];
#pragma unroll
    for (int a = 0; a < 2; ++a)
#pragma unroll
        for (int b = 0; b < 2; ++b)
#pragma unroll
            for (int m = 0; m < 4; ++m)
#pragma unroll
                for (int n = 0; n < 2; ++n) acc[a][b][m][n] = (f32x4){0.f, 0.f, 0.f, 0.f};
    bf16x8 At[4][2], B0[2][2], B1[2][2];
    const char* cA = (const char*)g.A + ((size_t)cur.g * g.sA + (size_t)cur.pm * BM * g.lda + (size_t)cur.kh * K) * 2;
    const char* cB = (const char*)g.Bt + ((size_t)cur.g * g.sB + (size_t)cur.pn * BM * g.ldb + (size_t)cur.kh * K) * 2;
    PG8_STAGE(PG8_SB(0, 0), cB, voffB); PG8_STAGE(PG8_SB(0, 1), cB + hstepB, voffB); PG8_STAGE(PG8_SA(0, 0), cA, voffA); PG8_STAGE(PG8_SA(0, 1), cA + hstepA, voffA);
    if (wr == 1) PG8_BAR;
    PG8_WAIT_V(2); PG8_BAR;
    PG8_STAGE(PG8_SB(1, 0), cB + kstep, voffB); PG8_STAGE(PG8_SA(1, 0), cA + kstep, voffA); PG8_STAGE(PG8_SB(1, 1), cB + hstepB + kstep, voffB);
    PG8_WAIT_V(6); PG8_BAR;
    for (;;) {
        const bool has_next = S.next(ui + 1, nxt);
        const char* nA = has_next ? (const char*)g.A + ((size_t)nxt.g * g.sA + (size_t)nxt.pm * BM * g.lda + (size_t)nxt.kh * K) * 2 : cA;
        const char* nB = has_next ? (const char*)g.Bt + ((size_t)nxt.g * g.sB + (size_t)nxt.pn * BM * g.ldb + (size_t)nxt.kh * K) * 2 : cB;
        for (int t = 0; t < nt; t += 2) {
            const bool last = (t == nt - 2);
            const char* a1 = cA + (size_t)(t + 1) * kstep;
            const char* a2 = last ? nA : cA + (size_t)(t + 2) * kstep; const char* b2 = last ? nB : cB + (size_t)(t + 2) * kstep;
            const char* a3 = a2 + kstep; const char* b3 = b2 + kstep;
            PG8_LDB(B0, 0, 0); PG8_LDB(B1, 0, 1); PG8_SCHED; PG8_LDA(At, 0, 0); PG8_STAGE(PG8_SA(1, 1), a1 + hstepA, voffA);
            PG8_WAIT_V(8); PG8_WAIT_L(0); PG8_BAR; PG8_MMA(0, 0, At, B0); PG8_MMA(0, 1, At, B1); PG8_BAR; PG8_SCHED;
            PG8_LDA(At, 0, 1); PG8_STAGE(PG8_SB(0, 0), b2, voffB); PG8_STAGE(PG8_SB(0, 1), b2 + hstepB, voffB); PG8_STAGE(PG8_SA(0, 0), a2, voffA);
            PG8_WAIT_V(8); PG8_WAIT_L(0); PG8_BAR; PG8_MMA(1, 0, At, B0); PG8_MMA(1, 1, At, B1); PG8_BAR; PG8_SCHED;
            PG8_LDB(B0, 1, 0); PG8_LDB(B1, 1, 1); PG8_SCHED; PG8_LDA(At, 1, 0); PG8_STAGE(PG8_SA(0, 1), a2 + hstepA, voffA);
            PG8_WAIT_V(8); PG8_WAIT_L(0); PG8_BAR; PG8_MMA(0, 0, At, B0); PG8_MMA(0, 1, At, B1); PG8_BAR; PG8_SCHED;
            PG8_LDA(At, 1, 1); PG8_STAGE(PG8_SB(1, 0), b3, voffB); PG8_STAGE(PG8_SB(1, 1), b3 + hstepB, voffB); PG8_STAGE(PG8_SA(1, 0), a3, voffA);
            PG8_WAIT_V(8); PG8_WAIT_L(0); PG8_BAR; PG8_MMA(1, 0, At, B0); PG8_MMA(1, 1, At, B1); PG8_BAR; PG8_SCHED;
        }
        if (wr == 0) PG8_BAR;
        E(acc, cur, wr, wc, fr, fq);
        if (!has_next) break;
        if (!(Epi::KSPLIT && cur.kh == 0)) {
#pragma unroll
        for (int a = 0; a < 2; ++a)
#pragma unroll
            for (int b = 0; b < 2; ++b)
#pragma unroll
                for (int m = 0; m < 4; ++m)
#pragma unroll
                    for (int n = 0; n < 2; ++n) acc[a][b][m][n] = (f32x4){0.f, 0.f, 0.f, 0.f};
        }
        cur = nxt; cA = nA; cB = nB; ++ui;
        if (wr == 1) PG8_BAR;
    }
    PG8_WAIT_V(0);
    PG8_BAR;
#undef PG8_SA
#undef PG8_SB
#undef PG8_STAGE
#undef PG8_LDA
#undef PG8_LDB
#undef PG8_MMA
#undef PG8_WAIT_V
#undef PG8_WAIT_L
#undef PG8_BAR
#undef PG8_SCHED
}

__device__ __forceinline__ u32x4 pack8(const f32x4 a, const f32x4 b) { u32x4 w; w.x = cvt_pk_bf16(a[0], a[1]); w.y = cvt_pk_bf16(a[2], a[3]); w.z = cvt_pk_bf16(b[0], b[1]); w.w = cvt_pk_bf16(b[2], b[3]); return w; }

struct EpiZ {
    static constexpr bool PERM = true, KSPLIT = false;
    bf16_t* QKV; bf16_t* A5; const float* qg; const float* kg; LAS float* X;
    __device__ __forceinline__ void operator()(f32x4 (&acc)[2][2][4][2], const Unit& u, int wr, int wc, int fr, int fq) const {
        if (u.pn < 8) {
#pragma unroll
            for (int ai = 0; ai < 2; ++ai)
#pragma unroll
                for (int m = 0; m < 4; ++m)
#pragma unroll
                    for (int bj = 0; bj < 2; ++bj) { const f32x4 a0 = acc[ai][bj][m][0], a1 = acc[ai][bj][m][1];
                        float ss = (a0[0] * a0[0] + a0[1] * a0[1]) + (a0[2] * a0[2] + a0[3] * a0[3]) + (a1[0] * a1[0] + a1[1] * a1[1]) + (a1[2] * a1[2] + a1[3] * a1[3]);
                        ss += __shfl_xor(ss, 16); ss += __shfl_xor(ss, 32);
                        if (fq == 0) X[(ai * HALF + wr * 64 + m * 16 + fr) * 8 + bj * 4 + wc] = ss; }
            asm volatile("s_waitcnt lgkmcnt(0)" ::: "memory"); __builtin_amdgcn_s_barrier(); asm volatile("" ::: "memory");
            const float* gp = (u.pn < 4 ? qg : kg) + ((wc & 1) * 32 + 8 * fq); const float gs = u.pn < 4 ? 0.125f : 1.0f;
            const f32x4 g0 = *(const f32x4*)gp * gs, g1 = *(const f32x4*)(gp + 4) * gs;
#pragma unroll
            for (int ai = 0; ai < 2; ++ai)
#pragma unroll
                for (int m = 0; m < 4; ++m) { const int rl = ai * HALF + wr * 64 + m * 16 + fr, row = u.pm * BM + rl;
#pragma unroll
                    for (int bj = 0; bj < 2; ++bj) { const f32x2 pr = *(const LAS f32x2*)(X + rl * 8 + bj * 4 + (wc & 2)); const float rn = __builtin_amdgcn_rsqf((pr.x + pr.y) * (1.0f / HD) + RMS_EPS);
                        const int c8 = u.pn * BM + bj * HALF + wc * 32 + 8 * fq;
                        *(u32x4*)(QKV + (size_t)row * NQKV + c8) = pack8(acc[ai][bj][m][0] * g0 * rn, acc[ai][bj][m][1] * g1 * rn); } }
            return;
        }
#pragma unroll
        for (int ai = 0; ai < 2; ++ai)
#pragma unroll
            for (int m = 0; m < 4; ++m) { const int row = u.pm * BM + ai * HALF + wr * 64 + m * 16 + fr;
#pragma unroll
                for (int bj = 0; bj < 2; ++bj) { const int c8 = u.pn * BM + bj * HALF + wc * 32 + 8 * fq; const u32x4 w = pack8(acc[ai][bj][m][0], acc[ai][bj][m][1]);
                    if (u.pn < 12) *(u32x4*)(QKV + (size_t)row * NQKV + c8) = w;
                    else { const int ch = c8 - NQKV, gg = ch >> 4, c0 = ch & 15, R = row >> 5, s = row & 31; *(u32x4*)(A5 + ((size_t)gg * RCH + R) * KS5 + s * SC + c0) = w; } } }
    }
};
struct EpiE {
    static constexpr bool PERM = false, KSPLIT = false;
    float* E;
    __device__ __forceinline__ void operator()(f32x4 (&acc)[2][2][4][2], const Unit& u, int wr, int wc, int fr, int fq) const {
#pragma unroll
        for (int ai = 0; ai < 2; ++ai)
#pragma unroll
            for (int m = 0; m < 4; ++m) { const int R = u.pm * BM + ai * HALF + wr * 64 + m * 16 + fr; float* rowp = E + ((size_t)u.g * RCH + R) * 256 + wc * 32 + 4 * fq;
#pragma unroll
                for (int bj = 0; bj < 2; ++bj)
#pragma unroll
                    for (int n = 0; n < 2; ++n) *(f32x4*)(rowp + bj * HALF + n * 16) = acc[ai][bj][m][n]; }
    }
};
struct EpiS5Out {
    static constexpr bool PERM = true, KSPLIT = false;
    bf16_t* Yg;
    __device__ __forceinline__ void operator()(f32x4 (&acc)[2][2][4][2], const Unit& u, int wr, int wc, int fr, int fq) const {
#pragma unroll
        for (int ai = 0; ai < 2; ++ai)
#pragma unroll
            for (int m = 0; m < 4; ++m) { const int R = u.pm * BM + ai * HALF + wr * 64 + m * 16 + fr;
#pragma unroll
                for (int bj = 0; bj < 2; ++bj) { const int n8 = u.pn * BM + bj * HALF + wc * 32 + 8 * fq, s = n8 >> 4, c0 = n8 & 15;
                    f32x4 v0 = acc[ai][bj][m][0], v1 = acc[ai][bj][m][1];
#pragma unroll
                    for (int e = 0; e < 4; ++e) { v0[e] = gelu_tanh(v0[e]); v1[e] = gelu_tanh(v1[e]); }
                    *(u32x4*)(Yg + (size_t)(R * CL + s) * SW + u.g * SC + c0) = pack8(v0, v1); } }
    }
};
struct EpiGlu {
    static constexpr bool PERM = true, KSPLIT = false;
    const bf16_t* Yg; const float* bias; bf16_t* YAYS; float* ssq4; LAS float* X;
    __device__ __forceinline__ void operator()(f32x4 (&acc)[2][2][4][2], const Unit& u, int wr, int wc, int fr, int fq) const {
        const int c8b = u.pn * BM + wc * 32 + 8 * fq;
        f32x4 bv[2][2];
#pragma unroll
        for (int bj = 0; bj < 2; ++bj)
#pragma unroll
            for (int n = 0; n < 2; ++n) bv[bj][n] = *(const f32x4*)(bias + c8b + bj * HALF + 4 * n);
#pragma unroll
        for (int ai = 0; ai < 2; ++ai) {
            u32x4 yv[4][2];
#pragma unroll
            for (int m = 0; m < 4; ++m)
#pragma unroll
                for (int bj = 0; bj < 2; ++bj) yv[m][bj] = *(const u32x4*)(Yg + (size_t)(u.pm * BM + ai * HALF + wr * 64 + m * 16 + fr) * SW + c8b + bj * HALF);
#pragma unroll
            for (int m = 0; m < 4; ++m) { const int row = u.pm * BM + ai * HALF + wr * 64 + m * 16 + fr; float ss = 0.f;
#pragma unroll
                for (int bj = 0; bj < 2; ++bj) { const int c8 = c8b + bj * HALF; const u32x4 y = yv[m][bj];
                    const f32x4 a0 = acc[ai][bj][m][0] + bv[bj][0], a1 = acc[ai][bj][m][1] + bv[bj][1];
                    f32x4 v0, v1;
                    v0[0] = bf_lo(y.x) * sigmoidf_(a0[0]); v0[1] = bf_hi(y.x) * sigmoidf_(a0[1]); v0[2] = bf_lo(y.y) * sigmoidf_(a0[2]); v0[3] = bf_hi(y.y) * sigmoidf_(a0[3]);
                    v1[0] = bf_lo(y.z) * sigmoidf_(a1[0]); v1[1] = bf_hi(y.z) * sigmoidf_(a1[1]); v1[2] = bf_lo(y.w) * sigmoidf_(a1[2]); v1[3] = bf_hi(y.w) * sigmoidf_(a1[3]);
#pragma unroll
                    for (int e = 0; e < 4; ++e) ss += v0[e] * v0[e] + v1[e] * v1[e];
                    *(u32x4*)(YAYS + (size_t)row * DM + AW + c8) = pack8(v0, v1); }
                ss += __shfl_xor(ss, 16); ss += __shfl_xor(ss, 32);
                if (fq == 0) X[(ai * HALF + wr * 64 + m * 16 + fr) * 4 + wc] = ss; }
            asm volatile("" ::: "memory"); }
        asm volatile("s_waitcnt lgkmcnt(0)" ::: "memory"); __builtin_amdgcn_s_barrier(); asm volatile("" ::: "memory");
        if (wc == 0 && fq == 0) {
#pragma unroll
            for (int ai = 0; ai < 2; ++ai)
#pragma unroll
                for (int m = 0; m < 4; ++m) { const int rl = ai * HALF + wr * 64 + m * 16 + fr; const f32x4 p = *(const LAS f32x4*)(X + rl * 4);
                    ssq4[(size_t)u.pn * M + u.pm * BM + rl] = (p[0] + p[1]) + (p[2] + p[3]); } }
    }
};
struct EpiRes1 {
    static constexpr bool PERM = true, KSPLIT = true;
    const float* x; bf16_t* XB; const float* ssqa; const float* ssqs4; float* ssqx8; LAS float* X;
    __device__ __forceinline__ void operator()(f32x4 (&acc)[2][2][4][2], const Unit& u, int wr, int wc, int fr, int fq) const {
        if (u.kh == 0) {
#pragma unroll
        for (int ai = 0; ai < 2; ++ai)
#pragma unroll
            for (int m = 0; m < 4; ++m) { const int row = u.pm * BM + ai * HALF + wr * 64 + m * 16 + fr;
                const float sq = (ssqs4[row] + ssqs4[M + row]) + (ssqs4[2 * M + row] + ssqs4[3 * M + row]);
                const float ra = __builtin_amdgcn_rsqf(ssqa[row] * (1.0f / AW) + RMS_EPS), rs = __builtin_amdgcn_rsqf(sq * (1.0f / SW) + RMS_EPS), f = ra * fast_rcp(rs);
#pragma unroll
                for (int bj = 0; bj < 2; ++bj)
#pragma unroll
                    for (int n = 0; n < 2; ++n) acc[ai][bj][m][n] *= f; }
        return; }
        float rsv[2][4];
#pragma unroll
        for (int ai = 0; ai < 2; ++ai)
#pragma unroll
            for (int m = 0; m < 4; ++m) { const int row = u.pm * BM + ai * HALF + wr * 64 + m * 16 + fr;
                const float sq = (ssqs4[row] + ssqs4[M + row]) + (ssqs4[2 * M + row] + ssqs4[3 * M + row]); rsv[ai][m] = __builtin_amdgcn_rsqf(sq * (1.0f / SW) + RMS_EPS); }
#pragma unroll
        for (int am = 0; am < 4; ++am) { const int ai = am >> 1, mb = (am & 1) * 2;
            f32x4 xv[2][2][2];
#pragma unroll
            for (int mm = 0; mm < 2; ++mm)
#pragma unroll
                for (int bj = 0; bj < 2; ++bj) { const float* xp = x + (size_t)(u.pm * BM + ai * HALF + wr * 64 + (mb + mm) * 16 + fr) * DM + u.pn * BM + bj * HALF + wc * 32 + 8 * fq; xv[mm][bj][0] = *(const f32x4*)xp; xv[mm][bj][1] = *(const f32x4*)(xp + 4); }
#pragma unroll
            for (int mm = 0; mm < 2; ++mm) { const int m = mb + mm; const int row = u.pm * BM + ai * HALF + wr * 64 + m * 16 + fr; float ss = 0.f; const float rs = rsv[ai][m];
#pragma unroll
                for (int bj = 0; bj < 2; ++bj) { const size_t off = (size_t)row * DM + u.pn * BM + bj * HALF + wc * 32 + 8 * fq;
                    const f32x4 v0 = xv[mm][bj][0] + acc[ai][bj][m][0] * rs, v1 = xv[mm][bj][1] + acc[ai][bj][m][1] * rs;
#pragma unroll
                    for (int e = 0; e < 4; ++e) ss += v0[e] * v0[e] + v1[e] * v1[e];
                    *(u32x4*)(XB + off) = pack8(v0, v1); }
                ss += __shfl_xor(ss, 16); ss += __shfl_xor(ss, 32);
                if (fq == 0) X[(ai * HALF + wr * 64 + m * 16 + fr) * 4 + wc] = ss; }
            asm volatile("" ::: "memory"); }
        asm volatile("s_waitcnt lgkmcnt(0)" ::: "memory"); __builtin_amdgcn_s_barrier(); asm volatile("" ::: "memory");
        if (wc == 0 && fq == 0) {
#pragma unroll
            for (int ai = 0; ai < 2; ++ai)
#pragma unroll
                for (int m = 0; m < 4; ++m) { const int rl = ai * HALF + wr * 64 + m * 16 + fr; const f32x4 p = *(const LAS f32x4*)(X + rl * 4);
                    ssqx8[(size_t)u.pn * M + u.pm * BM + rl] = (p[0] + p[1]) + (p[2] + p[3]); } }
    }
};
struct EpiSwiGLU {
    static constexpr bool PERM = true, KSPLIT = false;
    bf16_t* H; const float* ssqx8;
    __device__ __forceinline__ void operator()(f32x4 (&acc)[2][2][4][2], const Unit& u, int wr, int wc, int fr, int fq) const {
        float rsv[2][4];
#pragma unroll
        for (int ai = 0; ai < 2; ++ai)
#pragma unroll
            for (int m = 0; m < 4; ++m) { const int row = u.pm * BM + ai * HALF + wr * 64 + m * 16 + fr; float sq = 0.f;
#pragma unroll
                for (int t = 0; t < 8; ++t) sq += ssqx8[(size_t)t * M + row];
                rsv[ai][m] = __builtin_amdgcn_rsqf(sq * (1.0f / DM) + RMS_EPS); }
#pragma unroll
        for (int ai = 0; ai < 2; ++ai)
#pragma unroll
            for (int m = 0; m < 4; ++m) { const int row = u.pm * BM + ai * HALF + wr * 64 + m * 16 + fr; const float rs = rsv[ai][m];
                f32x4 h0, h1;
#pragma unroll
                for (int e = 0; e < 4; ++e) { const float g0 = acc[ai][0][m][0][e] * rs, u0 = acc[ai][1][m][0][e] * rs, g1 = acc[ai][0][m][1][e] * rs, u1 = acc[ai][1][m][1][e] * rs;
                    h0[e] = g0 * sigmoidf_(g0) * u0; h1[e] = g1 * sigmoidf_(g1) * u1; }
                *(u32x4*)(H + (size_t)row * DFF + u.pn * HALF + wc * 32 + 8 * fq) = pack8(h0, h1); }
    }
};
struct EpiRes2 {
    static constexpr bool PERM = true, KSPLIT = false;
    float* out; const bf16_t* XB;
    __device__ __forceinline__ void operator()(f32x4 (&acc)[2][2][4][2], const Unit& u, int wr, int wc, int fr, int fq) const {
#pragma unroll
        for (int ai = 0; ai < 2; ++ai) {
            u32x4 xb[4][2];
#pragma unroll
            for (int m = 0; m < 4; ++m)
#pragma unroll
                for (int bj = 0; bj < 2; ++bj) xb[m][bj] = *(const u32x4*)(XB + (size_t)(u.pm * BM + ai * HALF + wr * 64 + m * 16 + fr) * DM + u.pn * BM + wc * 32 + 8 * fq + bj * HALF);
#pragma unroll
            for (int m = 0; m < 4; ++m) { const size_t roff = (size_t)(u.pm * BM + ai * HALF + wr * 64 + m * 16 + fr) * DM + u.pn * BM + wc * 32 + 8 * fq;
#pragma unroll
                for (int bj = 0; bj < 2; ++bj) { const size_t off = roff + bj * HALF; const u32x4 x4 = xb[m][bj];
                    f32x4 v0, v1; v0[0] = bf_lo(x4.x); v0[1] = bf_hi(x4.x); v0[2] = bf_lo(x4.y); v0[3] = bf_hi(x4.y); v1[0] = bf_lo(x4.z); v1[1] = bf_hi(x4.z); v1[2] = bf_lo(x4.w); v1[3] = bf_hi(x4.w);
                    *(f32x4*)(out + off) = v0 + acc[ai][bj][m][0]; *(f32x4*)(out + off + 4) = v1 + acc[ai][bj][m][1]; } }
            asm volatile("" ::: "memory"); }
    }
};
}

#define RLX_AGENT __ATOMIC_RELAXED, __HIP_MEMORY_SCOPE_AGENT
#define XB_TMO      128
#define XB_XCNT(j)  (256  + 64 * (j))
#define XB_XSUB(j)  (1280 + 64 * (j))
#define XB_XGEN(j)  (2304 + 64 * (j))
#define XB_TOP      3328
#define XB_TOPGEN   3392
#define XCD_BAR_WORDS 3456
#define XB_SPIN_CAP (1u << 24)
__device__ __forceinline__ unsigned xb_ld(unsigned* p)              { return __hip_atomic_load(p, __ATOMIC_RELAXED, __HIP_MEMORY_SCOPE_AGENT); }
__device__ __forceinline__ unsigned xb_add(unsigned* p, unsigned v) { return __hip_atomic_fetch_add(p, v, __ATOMIC_RELAXED, __HIP_MEMORY_SCOPE_AGENT); }
__device__ __forceinline__ unsigned xb_xcc_id() { return (unsigned)__builtin_amdgcn_s_getreg((3 << 11) | 20) & 0xFu; }
#define XB_SPIN(cond, bar) do { unsigned _sp = 0; while (cond) { __builtin_amdgcn_s_sleep(1); \
    if ((++_sp & 255u) == 0u) { if (xb_ld(&(bar)[XB_TMO])) break; if (_sp > XB_SPIN_CAP) { atomicAdd(&(bar)[XB_TMO], 1u); break; } } } } while (0)
struct XcdBarrier { unsigned* bar; unsigned x; volatile LAS unsigned* st; };
__device__ __forceinline__ XcdBarrier xcd_barrier_post(unsigned* bar, volatile LAS unsigned* st) {
    XcdBarrier b; b.bar = bar; b.x = xb_xcc_id(); b.st = st;
    if (threadIdx.x == 0) (void)xb_add(&bar[XB_XCNT(b.x)], 1u);
    return b;
}
__device__ __forceinline__ void xcd_barrier_complete(unsigned* bar, unsigned x, unsigned& nloc, unsigned& nx) {
    const unsigned G = gridDim.x * gridDim.y * gridDim.z;
    unsigned sum, cnt, mine, sp = 0u;
    for (;;) {
        sum = 0u; cnt = 0u; mine = 0u;
#pragma unroll
        for (unsigned j = 0; j < 16; ++j) { const unsigned c = xb_ld(&bar[XB_XCNT(j)]); sum += c; cnt += (c > 0u) ? 1u : 0u; mine = (j == x) ? c : mine; }
        if (sum == G) break;
        __builtin_amdgcn_s_sleep(1);
        if ((++sp & 255u) == 0u) { if (xb_ld(&bar[XB_TMO])) break; if (sp > XB_SPIN_CAP) { atomicAdd(&bar[XB_TMO], 1u); break; } }
    }
    nloc = mine > 0u ? mine : 1u; nx = cnt > 0u ? cnt : 1u;
}
__device__ __forceinline__ void xcd_barrier(const XcdBarrier& b) {
    asm volatile("s_waitcnt vmcnt(0)" ::: "memory");
    __syncthreads();
    if (threadIdx.x == 0) {
        unsigned* bar = b.bar;
        __builtin_amdgcn_s_waitcnt(0);
        unsigned nloc = b.st[0], nx = b.st[1];
        if (nloc == 0u) { xcd_barrier_complete(bar, b.x, nloc, nx); b.st[0] = nloc; b.st[1] = nx; }
        const unsigned old = xb_add(&bar[XB_XSUB(b.x)], 1u);
        const unsigned gen = old / nloc;
        if (old + 1u == (gen + 1u) * nloc) {
            __builtin_amdgcn_fence(__ATOMIC_RELEASE, "agent");
            asm volatile("s_waitcnt vmcnt(0)" ::: "memory");
            const unsigned og = xb_add(&bar[XB_TOP], 1u);
            const unsigned tg = og / nx;
            if (og + 1u == (tg + 1u) * nx) xb_add(&bar[XB_TOPGEN], 1u);
            else XB_SPIN(xb_ld(&bar[XB_TOPGEN]) == tg, bar);
            __builtin_amdgcn_fence(__ATOMIC_ACQUIRE, "agent");
            xb_add(&bar[XB_XGEN(b.x)], 1u);
            asm volatile("s_waitcnt vmcnt(0)" ::: "memory");
        } else {
            XB_SPIN(xb_ld(&bar[XB_XGEN(b.x)]) == gen, bar);
            __builtin_amdgcn_fence(__ATOMIC_ACQUIRE, "agent");
            asm volatile("s_waitcnt vmcnt(0)" ::: "memory");
        }
    }
    __syncthreads();
}

struct Args { const float* in[23]; float* out; unsigned char* ws; int ph_lo, ph_hi, li, dup; };
enum { I_X = 0, I_GMIX, I_WIN, I_QG, I_KG, I_RPB, I_ARE, I_AIM, I_BRE, I_BIM, I_CRE, I_CIM, I_LS, I_D, I_WGLU, I_BGLU, I_GOA, I_GOS, I_WOUT, I_GFFN, I_WG, I_WU, I_WD };

#define LDS_WAIT() asm volatile("s_waitcnt lgkmcnt(0)" ::: "memory")

__device__ __forceinline__ void p0_transpose_item(const float* W, int N, const float* kscale, bf16_t* WT, int ldd, int drow0, int k0, int n0, int lane) {
    const int c = lane >> 3, n4 = (lane & 7) * 4;
    const float* src = W + (size_t)(k0 + 8 * c) * N + n0 + n4;
    f32x4 v[2][8];
#pragma unroll
    for (int h = 0; h < 2; ++h)
#pragma unroll
        for (int i = 0; i < 8; ++i) v[h][i] = __builtin_nontemporal_load((const f32x4*)(src + (size_t)i * N + 32 * h));
    if (kscale) { const f32x4 s0 = *(const f32x4*)(kscale + k0 + 8 * c), s1 = *(const f32x4*)(kscale + k0 + 8 * c + 4);
#pragma unroll
        for (int h = 0; h < 2; ++h)
#pragma unroll
            for (int i = 0; i < 8; ++i) v[h][i] *= (i < 4 ? s0[i & 3] : s1[i & 3]); }
#pragma unroll
    for (int h = 0; h < 2; ++h)
#pragma unroll
        for (int e = 0; e < 4; ++e) { u32x4 o; o.x = cvt_pk_bf16(v[h][0][e], v[h][1][e]); o.y = cvt_pk_bf16(v[h][2][e], v[h][3][e]); o.z = cvt_pk_bf16(v[h][4][e], v[h][5][e]); o.w = cvt_pk_bf16(v[h][6][e], v[h][7][e]);
            *(u32x4*)(WT + (size_t)(drow0 + 32 * h + n4 + e) * ldd + k0 + 8 * c) = o; }
}

__device__ __forceinline__ void dsincos(double a, double& s, double& c) {
    const double k = __builtin_rint(a * 0.63661977236758134308);
    double r = __builtin_fma(-k, 1.57079632679489655800e+00, a);
    r = __builtin_fma(-k, 6.12323399573676603587e-17, r);
    const double r2 = r * r;
    double sp = -7.6471637318198164759e-13; sp = sp * r2 + 1.6059043836821614599e-10; sp = sp * r2 - 2.5052108385441718775e-08; sp = sp * r2 + 2.7557319223985890653e-06;
    sp = sp * r2 - 1.9841269841269841270e-04; sp = sp * r2 + 8.3333333333333333333e-03; sp = sp * r2 - 1.6666666666666666667e-01; sp = sp * r2 * r + r;
    double cp = 4.7794773323873852974e-14; cp = cp * r2 - 1.1470745597729724714e-11; cp = cp * r2 + 2.0876756987868098979e-09; cp = cp * r2 - 2.7557319223985890653e-07;
    cp = cp * r2 + 2.4801587301587301587e-05; cp = cp * r2 - 1.3888888888888888889e-03; cp = cp * r2 + 4.1666666666666666667e-02; cp = cp * r2 - 0.5; cp = cp * r2 + 1.0;
    const int q = (int)((long long)k) & 3;
    s = (q == 0) ? sp : (q == 1) ? cp : (q == 2) ? -sp : -cp;
    c = (q == 0) ? cp : (q == 1) ? -sp : (q == 2) ? -cp : sp;
}

struct S5Params { f32x4 br4, bi4, cr4, ci4; float are, aim, ls; };
__device__ __forceinline__ void p0_s5_params(const Args& a, int g, int tid, S5Params& P) {
    const float* a_re = a.in[I_ARE]; const float* a_im = a.in[I_AIM]; const float* b_re = a.in[I_BRE]; const float* b_im = a.in[I_BIM];
    const float* c_re = a.in[I_CRE]; const float* c_im = a.in[I_CIM]; const float* lstep = a.in[I_LS];
#pragma unroll
    for (int j = 0; j < 4; ++j) { const int i = tid + 512 * j, c = i & 15, p = (i >> 4) & 63, d = i >> 10;
        const size_t bi = (((size_t)d * SG + g) * SP + p) * SC + c, ci = (((size_t)d * SG + g) * SC + c) * SP + p;
        P.br4[j] = b_re[bi]; P.bi4[j] = b_im[bi]; P.cr4[j] = c_re[ci]; P.ci4[j] = c_im[ci]; }
    { const int p = tid & 63, d = (tid >> 6) & 1; P.are = a_re[(d * SG + g) * SP + p]; P.aim = a_im[(d * SG + g) * SP + p]; P.ls = lstep[d * SG + g]; }
}
__device__ __forceinline__ void p0_s5_tables(const Args& a, LAS unsigned char* lds, int g, int q, int tid, const S5Params& P) {
    LAS f32x2* LP = (LAS f32x2*)lds;
    LAS float* Bb = (LAS float*)(lds + 33792);
    LAS f32x2* Cm = (LAS f32x2*)(lds + 50176);
    LAS float* Kt = (LAS float*)(lds + 66560);
    const float* dsk = a.in[I_D];
    unsigned char* ws = a.ws;
    __syncthreads();
    LAS f32x2* Fp = (LAS f32x2*)(Kt);
    if (tid < 128) { const int p = tid & 63, d = tid >> 6;
        const double lre = (double)fminf(P.are, -1e-4f), lim = (double)P.aim, dt = exp((double)P.ls);
        const double mag = exp(lre * dt); double sn, cs; dsincos(lim * dt, sn, cs);
        const double lr = mag * cs, li = mag * sn;
        const double nr = lr - 1.0, ni = li, den = 1.0 / (lre * lre + lim * lim);
        Fp[d * 64 + p] = (f32x2){(float)((nr * lre + ni * lim) * den), (float)((ni * lre - nr * lim) * den)};
        double wr_ = 1.0, wi_ = 0.0;
        for (int tau = 0; tau <= CL; ++tau) { LP[(d * 64 + p) * 33 + tau] = (f32x2){(float)wr_, (float)wi_}; const double t_ = wr_ * lr - wi_ * li; wi_ = wr_ * li + wi_ * lr; wr_ = t_; } }
    __syncthreads();
#pragma unroll
    for (int j = 0; j < 4; ++j) { const int i = tid + 512 * j, c = i & 15, p = (i >> 4) & 63, d = i >> 10; const f32x2 f = Fp[d * 64 + p];
        Bb[(d * 64 + p) * 32 + c] = f.x * P.br4[j] - f.y * P.bi4[j]; Bb[(d * 64 + p) * 32 + 16 + c] = f.x * P.bi4[j] + f.y * P.br4[j];
        Cm[i] = (f32x2){P.cr4[j], P.ci4[j]}; }
    __syncthreads();
    if (q == 0 && tid < 128) { const int p = tid & 63, d = tid >> 6; ((f32x2*)(ws + WS_LAML))[(g * 2 + d) * SP + p] = LP[(d * 64 + p) * 33 + CL]; }
    { const int wv = __builtin_amdgcn_readfirstlane(tid >> 6), l = tid & 63, c16 = l & 15, g4 = l >> 4;
#pragma unroll 1
      for (int d = 0; d < 2; ++d) {
        bf16x8 Bf[4];
#pragma unroll
        for (int ks = 0; ks < 4; ++ks) { float v[8];
#pragma unroll
            for (int j = 0; j < 8; ++j) v[j] = Bb[(d * 64 + 32 * (ks & 1) + 8 * g4 + j) * 32 + (ks >> 1) * 16 + c16];
            u32x4 w; w.x = cvt_pk_bf16(v[0], v[1]); w.y = cvt_pk_bf16(v[2], v[3]); w.z = cvt_pk_bf16(v[4], v[5]); w.w = cvt_pk_bf16(v[6], v[7]); Bf[ks] = __builtin_bit_cast(bf16x8, w); }
#pragma unroll 1
        for (int tt = 0; tt < 4; ++tt) { const int tau = wv + 8 * tt;
            f32x4 acc = (f32x4){0.f, 0.f, 0.f, 0.f};
#pragma unroll
            for (int ks = 0; ks < 2; ++ks) { float gr[8], gi[8];
#pragma unroll
                for (int j = 0; j < 8; ++j) { const int p = 32 * ks + 8 * g4 + j; const f32x2 cm = Cm[(d * 64 + p) * 16 + c16], lp = LP[(d * 64 + p) * 33 + tau];
                    gr[j] = cm.x * lp.x - cm.y * lp.y; gi[j] = -(cm.x * lp.y + cm.y * lp.x); }
                u32x4 wr_, wi_; wr_.x = cvt_pk_bf16(gr[0], gr[1]); wr_.y = cvt_pk_bf16(gr[2], gr[3]); wr_.z = cvt_pk_bf16(gr[4], gr[5]); wr_.w = cvt_pk_bf16(gr[6], gr[7]);
                wi_.x = cvt_pk_bf16(gi[0], gi[1]); wi_.y = cvt_pk_bf16(gi[2], gi[3]); wi_.z = cvt_pk_bf16(gi[4], gi[5]); wi_.w = cvt_pk_bf16(gi[6], gi[7]);
                acc = __builtin_amdgcn_mfma_f32_16x16x32_bf16(__builtin_bit_cast(bf16x8, wr_), Bf[ks], acc, 0, 0, 0);
                acc = __builtin_amdgcn_mfma_f32_16x16x32_bf16(__builtin_bit_cast(bf16x8, wi_), Bf[2 + ks], acc, 0, 0, 0); }
#pragma unroll
            for (int e = 0; e < 4; ++e) Kt[((d * 32 + tau) * 16 + 4 * g4 + e) * 16 + c16] = acc[e]; } } }
    __syncthreads();
    { const int d = q >> 1, ri = q & 1, p = tid >> 3, s0 = (tid & 7) * 4;
      bf16_t* dst = (bf16_t*)(ws + WS_WST) + ((size_t)g * 256 + q * 64 + p) * 512 + s0 * 16;
      float bx_[16], by_[16];
#pragma unroll
      for (int e = 0; e < 16; ++e) { bx_[e] = Bb[(d * 64 + p) * 32 + e]; by_[e] = Bb[(d * 64 + p) * 32 + 16 + e]; }
#pragma unroll
      for (int sp = 0; sp < 4; ++sp) { const int pw = d == 0 ? (CL - 1 - (s0 + sp)) : (s0 + sp); const f32x2 lp = LP[(d * 64 + p) * 33 + pw]; float v[16];
#pragma unroll
          for (int e = 0; e < 16; ++e) v[e] = ri == 0 ? (lp.x * bx_[e] - lp.y * by_[e]) : (lp.x * by_[e] + lp.y * bx_[e]);
          u32x4 w0, w1; w0.x = cvt_pk_bf16(v[0], v[1]); w0.y = cvt_pk_bf16(v[2], v[3]); w0.z = cvt_pk_bf16(v[4], v[5]); w0.w = cvt_pk_bf16(v[6], v[7]);
          w1.x = cvt_pk_bf16(v[8], v[9]); w1.y = cvt_pk_bf16(v[10], v[11]); w1.z = cvt_pk_bf16(v[12], v[13]); w1.w = cvt_pk_bf16(v[14], v[15]);
          *(u32x4*)(dst + sp * 16) = w0; *(u32x4*)(dst + sp * 16 + 8) = w1; } }
    { const int c = tid & 15, s = 8 * q + ((tid >> 4) & 7), hi2 = tid >> 7;
      bf16_t* dst = (bf16_t*)(ws + WS_TW) + ((size_t)g * 512 + s * 16 + c) * KS5;
      const float dsv = dsk[g * SC + c];
#pragma unroll 1
      for (int it = 0; it < 8; ++it) { const int sp = hi2 + 4 * it; f32x4 v[4];
          const LAS f32x4* k0 = (const LAS f32x4*)(Kt + ((sp <= s ? (s - sp) : (32 + sp - s)) * 16 + c) * 16);
#pragma unroll
          for (int e = 0; e < 4; ++e) v[e] = k0[e];
          if (sp == s) { const LAS f32x4* k1 = (const LAS f32x4*)(Kt + (32 * 16 + c) * 16);
#pragma unroll
              for (int e = 0; e < 4; ++e) v[e] += k1[e];
#pragma unroll
              for (int e = 0; e < 4; ++e)
#pragma unroll
                  for (int k = 0; k < 4; ++k) v[e][k] += (c == 4 * e + k) ? dsv : 0.f; }
          u32x4 w0, w1; w0.x = cvt_pk_bf16(v[0][0], v[0][1]); w0.y = cvt_pk_bf16(v[0][2], v[0][3]); w0.z = cvt_pk_bf16(v[1][0], v[1][1]); w0.w = cvt_pk_bf16(v[1][2], v[1][3]);
          w1.x = cvt_pk_bf16(v[2][0], v[2][1]); w1.y = cvt_pk_bf16(v[2][2], v[2][3]); w1.z = cvt_pk_bf16(v[3][0], v[3][1]); w1.w = cvt_pk_bf16(v[3][2], v[3][3]);
          *(u32x4*)(dst + sp * 16) = w0; *(u32x4*)(dst + sp * 16 + 8) = w1; }
      { const int d = hi2 >> 1, ri = hi2 & 1, pw = d == 0 ? (s + 1) : (CL - s);
#pragma unroll 1
        for (int pb = 0; pb < 8; ++pb) { float v[8];
#pragma unroll
            for (int e = 0; e < 8; ++e) { const int p = 8 * pb + e; const f32x2 cm = Cm[(d * 64 + p) * 16 + c], lp = LP[(d * 64 + p) * 33 + pw];
                v[e] = ri == 0 ? (cm.x * lp.x - cm.y * lp.y) : -(cm.x * lp.y + cm.y * lp.x); }
            u32x4 w; w.x = cvt_pk_bf16(v[0], v[1]); w.y = cvt_pk_bf16(v[2], v[3]); w.z = cvt_pk_bf16(v[4], v[5]); w.w = cvt_pk_bf16(v[6], v[7]);
            *(u32x4*)(dst + 512 + hi2 * 64 + 8 * pb) = w; } } }
    __syncthreads();
}

__device__ __forceinline__ void p0_prologue(const Args& a, LAS unsigned char* lds, int vcu, int G, int tid) {
    asm volatile("" : "+v"(tid));
    const int wave = __builtin_amdgcn_readfirstlane(tid >> 6), lane = tid & 63;
    unsigned char* ws = a.ws;
    S5Params P5; p0_s5_params(a, (vcu < SG * 4 ? vcu : SG * 4 - 1) >> 2, tid, P5);
    if (vcu & 1) { for (int it = vcu; it < SG * 4; it += G) { if (it != vcu) p0_s5_params(a, it >> 2, tid, P5); p0_s5_tables(a, lds, it >> 2, it & 3, tid, P5); } }
    const int gw = vcu * 8 + wave, NGW = G * 8;
    constexpr int I_IN = (DM / 64) * (INW / 64), I_GL = (SW / 64) * (SW / 64), I_OUT = (DM / 64) * (DM / 64), I_GU = (DM / 64) * (DFF / 64), I_DN = (DFF / 64) * (DM / 64);
    constexpr int NITEMS = I_IN + I_GL + I_OUT + 2 * I_GU + I_DN;
    for (int it = gw; it < NITEMS; it += NGW) {
        int r = it;
        if (r < I_IN) { const int nb = INW / 64, kb = r / nb, n0 = (r % nb) * 64; p0_transpose_item(a.in[I_WIN], INW, nullptr, (bf16_t*)(ws + WS_WIN), DM, n0, kb * 64, n0, lane); continue; } r -= I_IN;
        if (r < I_GL) { const int nb = SW / 64, kb = r / nb, n0 = (r % nb) * 64; p0_transpose_item(a.in[I_WGLU], SW, nullptr, (bf16_t*)(ws + WS_WGLU), SW, n0, kb * 64, n0, lane); continue; } r -= I_GL;
        if (r < I_OUT) { const int nb = DM / 64, kb = r / nb, n0 = (r % nb) * 64, k0 = kb * 64;
            p0_transpose_item(a.in[I_WOUT], DM, k0 < AW ? a.in[I_GOA] : a.in[I_GOS] - AW, (bf16_t*)(ws + WS_WOUT), DM, n0, k0, n0, lane); continue; } r -= I_OUT;
        if (r < 2 * I_GU) { const int up = r >= I_GU; if (up) r -= I_GU; const int nb = DFF / 64, kb = r / nb, n0 = (r % nb) * 64;
            p0_transpose_item(up ? a.in[I_WU] : a.in[I_WG], DFF, a.in[I_GFFN], (bf16_t*)(ws + WS_WGU), DM, 256 * (n0 >> 7) + (n0 & 127) + (up ? 128 : 0), kb * 64, n0, lane); continue; } r -= 2 * I_GU;
        { const int nb = DM / 64, kb = r / nb, n0 = (r % nb) * 64; p0_transpose_item(a.in[I_WD], DM, nullptr, (bf16_t*)(ws + WS_WD), DFF, n0, kb * 64, n0, lane); }
    }
    const float* x = a.in[I_X]; const float* gm = a.in[I_GMIX]; bf16_t* XN = (bf16_t*)(ws + WS_XN);
    for (int m = gw; m < M; m += 2 * NGW) { const int m1 = m + NGW < M ? m + NGW : m;
        const f32x4* xr0 = (const f32x4*)(x + (size_t)m * DM) + lane; const f32x4* xr1 = (const f32x4*)(x + (size_t)m1 * DM) + lane; f32x4 v0[8], v1[8]; float s0 = 0.f, s1 = 0.f;
#pragma unroll
        for (int j = 0; j < 8; ++j) { v0[j] = __builtin_nontemporal_load(xr0 + 64 * j); v1[j] = __builtin_nontemporal_load(xr1 + 64 * j); }
#pragma unroll
        for (int j = 0; j < 8; ++j) { s0 += (v0[j][0] * v0[j][0] + v0[j][1] * v0[j][1]) + (v0[j][2] * v0[j][2] + v0[j][3] * v0[j][3]); s1 += (v1[j][0] * v1[j][0] + v1[j][1] * v1[j][1]) + (v1[j][2] * v1[j][2] + v1[j][3] * v1[j][3]); }
        const float r0 = 1.0f / sqrtf(wave_sum(s0) * (1.0f / DM) + RMS_EPS), r1 = 1.0f / sqrtf(wave_sum(s1) * (1.0f / DM) + RMS_EPS);
        u32x2* o0 = (u32x2*)(XN + (size_t)m * DM) + lane; u32x2* o1 = (u32x2*)(XN + (size_t)m1 * DM) + lane;
#pragma unroll
        for (int j = 0; j < 8; ++j) { const f32x4 gq = ((const f32x4*)gm)[64 * j + lane]; u32x2 w; w.x = cvt_pk_bf16(v0[j][0] * r0 * gq[0], v0[j][1] * r0 * gq[1]); w.y = cvt_pk_bf16(v0[j][2] * r0 * gq[2], v0[j][3] * r0 * gq[3]); o0[64 * j] = w;
            u32x2 w2; w2.x = cvt_pk_bf16(v1[j][0] * r1 * gq[0], v1[j][1] * r1 * gq[1]); w2.y = cvt_pk_bf16(v1[j][2] * r1 * gq[2], v1[j][3] * r1 * gq[3]); o1[64 * j] = w2; }
    }
    if (!(vcu & 1)) { for (int it = vcu; it < SG * 4; it += G) { if (it != vcu) p0_s5_params(a, it >> 2, tid, P5); p0_s5_tables(a, lds, it >> 2, it & 3, tid, P5); } }
}

constexpr int KROW = 144, AROW = 160;
constexpr int AHEAD = 64 * AROW;
constexpr int ABUF = 2 * AHEAD;
constexpr int ATT_RPB_OFF = 2 * ABUF;
static_assert(ATT_RPB_OFF + 16 * 465 * 4 <= MISC_OFF, "attention LDS");

__device__ __forceinline__ void attn_phase(const Args& a, LAS unsigned char* lds, volatile LAS unsigned* MISC, int vcu, int G, int has_g2, int tid) {
    asm volatile("" : "+v"(tid));
    const int wave = __builtin_amdgcn_readfirstlane(tid >> 6), lane = tid & 63, ql = lane & 15, g4 = lane >> 4;
    const bf16_t* QKV = (const bf16_t*)(a.ws + WS_BIG); bf16_t* YAYS = (bf16_t*)(a.ws + WS_YAYS); float* ssqa16 = (float*)(a.ws + WS_SSQA16);
    LAS float* rpbL = (LAS float*)(lds + ATT_RPB_OFF);
    for (int i = tid; i < 16 * 465; i += 512) rpbL[i] = a.in[I_RPB][i];
    const int j = wave & 3, hsel = wave >> 2;
    const int cq = 16 * j + ql, cs = min(max(cq - 8, 0), GRIDW - 16), wb = (j == 0) ? 0 : (j == 1) ? 8 : (j == 2) ? 24 : 32;
    int it_lo, it_hi, it_step = 1;
    if (G == 256) { const int x_ = vcu >> 5, k_ = vcu & 31; if (has_g2) { it_lo = x_ * 256 + 3 * (k_ & 15); it_hi = it_lo + 3; } else { it_lo = x_ * 256 + 48 + 13 * (k_ & 15); it_hi = it_lo + 13; } }
    else { it_lo = vcu; it_hi = BATCH * NROWS * 8; it_step = G; }
#define ATT_FETCH(dst) do { if (tid == 0) { const int nx_ = ((dst) == 20) ? it_lo : item + it_step; MISC[dst] = (unsigned)(nx_ < it_hi ? nx_ : -1); } } while (0)
    int item = 0;
    ATT_FETCH(20);
    __syncthreads();
    item = __builtin_amdgcn_readfirstlane((int)MISC[20]);
    const int skey = tid >> 3, sch = tid & 7;
    const unsigned ldstK = (unsigned)(skey * KROW + sch * 16), ldstV = (unsigned)(skey * AROW + sch * 16);
    u32x4 R[4][2];
#define ATT_SRC(it_, st_, i_) (QKV + ((size_t)((it_) >> 9) * SEQ + 64 * (min(max((((it_) >> 3) & 63) - 4, 0), NROWS - 8) + ((st_) & 7)) + skey) * NQKV + ((st_) < 8 ? AW : 2 * AW) + 64 * (2 * ((it_) & 7) + (i_)) + 8 * sch)
    if (item >= 0) {
#pragma unroll
        for (int p = 0; p < 3; ++p)
#pragma unroll
            for (int i = 0; i < 2; ++i) R[p][i] = *(const u32x4*)ATT_SRC(item, p, i);
    }
    while (item >= 0) {
        const int b = item >> 9, r = (item >> 3) & 63, hp = item & 7, h = 2 * hp + hsel, row_start = min(max(r - 4, 0), NROWS - 8);
        ATT_FETCH(21);
        const size_t tq = (size_t)b * SEQ + 64 * r + cq;
        bf16x8 Qf[2];
        { const u32x4* qp = (const u32x4*)(QKV + tq * NQKV + 64 * h + 8 * g4); Qf[0] = __builtin_bit_cast(bf16x8, qp[0]); Qf[1] = __builtin_bit_cast(bf16x8, qp[4]); }
        const LAS float* bl = rpbL + h * 465 + (row_start - r + 7) * 31 + (wb + 4 * g4 - cq + 15);
        f32x4 S[8][2]; bf16x8 Pf[8]; f32x4 O[4]; float sum = 0.f; int nitem = -1;
#pragma unroll
        for (int dt = 0; dt < 4; ++dt) O[dt] = (f32x4){0.f, 0.f, 0.f, 0.f};
#pragma unroll
        for (int st = 0; st < 16; ++st) {
            LAS unsigned char* buf = lds + (st & 1) * ABUF;
            { const unsigned ld_ = st < 8 ? ldstK : ldstV; *(LAS u32x4*)(buf + ld_) = R[st & 3][0]; *(LAS u32x4*)(buf + AHEAD + ld_) = R[st & 3][1]; }
            if (st + 3 < 16) {
#pragma unroll
                for (int i = 0; i < 2; ++i) R[(st + 3) & 3][i] = *(const u32x4*)ATT_SRC(item, st + 3, i);
            } else if (nitem >= 0) {
#pragma unroll
                for (int i = 0; i < 2; ++i) R[(st + 3) & 3][i] = *(const u32x4*)ATT_SRC(nitem, st + 3 - 16, i);
            }
            asm volatile("s_waitcnt lgkmcnt(0)" ::: "memory"); __builtin_amdgcn_s_barrier(); asm volatile("" ::: "memory");
            if (st == 0) nitem = __builtin_amdgcn_readfirstlane((int)MISC[21]);
            const LAS unsigned char* hb = buf + hsel * AHEAD;
            if (st < 8) {
                const int kr = st;
#pragma unroll
                for (int t = 0; t < 2; ++t) {
                    const LAS unsigned char* kp = hb + (wb + 16 * t + ql) * KROW + g4 * 16;
                    const bf16x8 k0 = *(const LAS bf16x8*)kp, k1 = *(const LAS bf16x8*)(kp + 64);
                    f32x4 acc = (f32x4){0.f, 0.f, 0.f, 0.f};
                    acc = __builtin_amdgcn_mfma_f32_16x16x32_bf16(k0, Qf[0], acc, 0, 0, 0);
                    acc = __builtin_amdgcn_mfma_f32_16x16x32_bf16(k1, Qf[1], acc, 0, 0, 0);
#pragma unroll
                    for (int e = 0; e < 4; ++e) { const int ck = wb + 16 * t + 4 * g4 + e;
                        const float bias = bl[kr * 31 + 16 * t + e];
                        acc[e] = (ck >= cs && ck < cs + 16) ? acc[e] + bias : -1e30f; }
                    S[kr][t] = acc; }
                if (st == 7) {
                    float mx = -1e30f;
#pragma unroll
                    for (int k2 = 0; k2 < 8; ++k2)
#pragma unroll
                        for (int t = 0; t < 2; ++t)
#pragma unroll
                            for (int e = 0; e < 4; ++e) mx = fmaxf(mx, S[k2][t][e]);
                    mx = fmaxf(mx, __shfl_xor(mx, 16)); mx = fmaxf(mx, __shfl_xor(mx, 32));
#pragma unroll
                    for (int k2 = 0; k2 < 8; ++k2) { f32x4 p0, p1;
#pragma unroll
                        for (int e = 0; e < 4; ++e) { p0[e] = fast_exp2((S[k2][0][e] - mx) * 1.44269504089f); p1[e] = fast_exp2((S[k2][1][e] - mx) * 1.44269504089f); sum += p0[e] + p1[e]; }
                        Pf[k2] = __builtin_bit_cast(bf16x8, pg8::pack8(p0, p1)); }
                    sum += __shfl_xor(sum, 16); sum += __shfl_xor(sum, 32);
                }
            } else {
                const int kr = st - 8;
                const LAS unsigned char* rp = hb + (wb + 4 * g4 + ((lane & 15) >> 2)) * AROW + (lane & 3) * 8;
#pragma unroll
                for (int dt = 0; dt < 4; ++dt) {
                    const s16x4 lo = __builtin_amdgcn_ds_read_tr16_b64_v4i16((LAS s16x4*)(rp + dt * 32));
                    const s16x4 hi = __builtin_amdgcn_ds_read_tr16_b64_v4i16((LAS s16x4*)(rp + 16 * AROW + dt * 32));
                    const bf16x8 av = (bf16x8){lo[0], lo[1], lo[2], lo[3], hi[0], hi[1], hi[2], hi[3]};
                    O[dt] = __builtin_amdgcn_mfma_f32_16x16x32_bf16(av, Pf[kr], O[dt], 0, 0, 0); }
            }
        }
        const float inv = fast_rcp(sum); float ssq_acc = 0.f;
        bf16_t* op = YAYS + tq * DM + 64 * h + 4 * g4;
#pragma unroll
        for (int dt = 0; dt < 4; ++dt) { const f32x4 o = O[dt] * inv; ssq_acc += (o[0] * o[0] + o[1] * o[1]) + (o[2] * o[2] + o[3] * o[3]);
            u32x2 w; w.x = cvt_pk_bf16(o[0], o[1]); w.y = cvt_pk_bf16(o[2], o[3]); *(u32x2*)(op + 16 * dt) = w; }
        ssq_acc += __shfl_xor(ssq_acc, 16); ssq_acc += __shfl_xor(ssq_acc, 32);
        if (g4 == 0) ssqa16[tq * 16 + h] = ssq_acc;
        item = nitem;
    }
#undef ATT_FETCH
#undef ATT_SRC
}

__device__ __forceinline__ void scan_chain(const Args& a, int g, int pm, int tid) {
    asm volatile("" : "+v"(tid));
    if (tid >= 256) return;
    const float* E = (const float*)(a.ws + WS_E); bf16_t* A5 = (bf16_t*)(a.ws + WS_A5); const f32x2* LAML = (const f32x2*)(a.ws + WS_LAML);
    const int p = tid & 63, d = (tid >> 6) & 1, b = 2 * pm + (tid >> 7);
    const f32x2 lam = LAML[(g * 2 + d) * SP + p];
    float xr = 0.f, xi = 0.f;
    const size_t R0 = (size_t)g * RCH + b * NCH;
#pragma unroll 1
    for (int rd = 0; rd < NCH / 32; ++rd) { float er[32], ei[32];
#pragma unroll
        for (int j = 0; j < 32; ++j) { const int kk = rd * 32 + j, k = d == 0 ? kk : NCH - 1 - kk; const float* ep = E + (R0 + k) * 256 + d * 128 + p; er[j] = ep[0]; ei[j] = ep[64]; }
#pragma unroll
        for (int j = 0; j < 32; ++j) { const int kk = rd * 32 + j, k = d == 0 ? kk : NCH - 1 - kk;
            bf16_t* ap = A5 + (R0 + k) * KS5 + 512 + d * 128 + p; ap[0] = (bf16_t)(cvt_pk_bf16(xr, 0.f) & 0xffffu); ap[64] = (bf16_t)(cvt_pk_bf16(xi, 0.f) & 0xffffu);
            const float nr = lam.x * xr - lam.y * xi + er[j], ni = lam.x * xi + lam.y * xr + ei[j]; xr = nr; xi = ni; } }
}

__global__ void __launch_bounds__(512, 2) hymba_fwd(Args args) {
    extern __shared__ __attribute__((aligned(16))) unsigned char lds_raw[];
    LAS unsigned char* lds = (LAS unsigned char*)lds_raw;
    volatile LAS unsigned* MISC = (volatile LAS unsigned*)(lds + MISC_OFF);
    const int tid = threadIdx.x;
    const int G = gridDim.x; const int bx = blockIdx.x; const int vcu = (G % 8 == 0) ? (bx % 8) * (G / 8) + bx / 8 : bx;
    unsigned char* ws = args.ws;
    unsigned* ctl = (unsigned*)(ws + WS_CTL);
    for (int u = tid; u < (LDS_BYTES - MISC_OFF) / 4; u += 512) MISC[u] = 0u;
    __syncthreads();
    XcdBarrier bar; bar.bar = ctl + CW_BAR; bar.x = 0; bar.st = nullptr;
    if (MK_N_LAUNCHES == 1) bar = xcd_barrier_post(ctl + CW_BAR, MISC + 8);
    const int lo = args.ph_lo, hi = args.ph_hi;
#define IN(k) (lo <= (k) && (k) < hi)
#define SEAM(k) do { if (IN(k) && IN((k) + 1)) xcd_barrier(bar); } while (0)
    bf16_t* WIN = (bf16_t*)(ws + WS_WIN); bf16_t* WGLU = (bf16_t*)(ws + WS_WGLU); bf16_t* WOUT = (bf16_t*)(ws + WS_WOUT); bf16_t* WGU = (bf16_t*)(ws + WS_WGU); bf16_t* WD = (bf16_t*)(ws + WS_WD);
    bf16_t* WST = (bf16_t*)(ws + WS_WST); bf16_t* TW = (bf16_t*)(ws + WS_TW);
    bf16_t* XN = (bf16_t*)(ws + WS_XN); bf16_t* YG = (bf16_t*)(ws + WS_XN); bf16_t* XB = (bf16_t*)(ws + WS_XN);
    bf16_t* QKV = (bf16_t*)(ws + WS_BIG); bf16_t* A5 = (bf16_t*)(ws + WS_A5); float* E = (float*)(ws + WS_E); bf16_t* HB = (bf16_t*)(ws + WS_BIG);
    bf16_t* YAYS = (bf16_t*)(ws + WS_YAYS);
    float* ssqa16 = (float*)(ws + WS_SSQA16); float* ssqa = (float*)(ws + WS_SSQA); float* ssqs4 = (float*)(ws + WS_SSQS4); float* ssqx8 = (float*)(ws + WS_SSQX8);
    LAS float* XL = (LAS float*)(lds + RING_BYTES);

#define REP(k) _Pragma("unroll") for (int rep_ = (DUP_PHASE == (k)) ? 0 : 1; rep_ < 2; ++rep_)
#define ALPHA ((rep_ == 0 && args.dup >= 0) ? 0.0f : 1.0f)
    if (IN(0)) { REP(0) { p0_prologue(args, lds, vcu, G, tid); __syncthreads(); } SEAM(0); }
    if (IN(1)) {
        pg8::Gemm g{XN, WIN, DM, DM, DM, 0, 0}; pg8::StaticOrder S; S.init(M, INW, G, bx);
        pg8::EpiZ Ep{QKV, A5, args.in[I_QG], args.in[I_KG], XL};
        REP(1) pg8::gemm_phase(lds, g, S, Ep);
        SEAM(1);
    }
    if (IN(2)) {
        for (int cidx = bx; cidx < 2 * SG; cidx += G) { const int g_ = cidx >> 1, pm_ = cidx & 1;
            { pg8::Gemm g{A5, WST, KS5, 512, 512, (size_t)RCH * KS5, (size_t)256 * 512}; pg8::ListOrder S; S.n = 1; S.u0.pm = pm_; S.u0.pn = 0; S.u0.g = g_; S.u0.kh = 0; S.u1 = S.u0;
              pg8::EpiE Ep{E};
              pg8::gemm_phase(lds, g, S, Ep); }
            asm volatile("s_waitcnt vmcnt(0)" ::: "memory"); __syncthreads();
            scan_chain(args, g_, pm_, tid);
            asm volatile("s_waitcnt vmcnt(0)" ::: "memory"); __syncthreads();
            { pg8::Gemm g{A5, TW, KS5, KS5, KS5, (size_t)RCH * KS5, (size_t)512 * KS5}; pg8::ListOrder S; S.n = 2; S.u0.pm = pm_; S.u0.pn = 0; S.u0.g = g_; S.u0.kh = 0; S.u1 = S.u0; S.u1.pn = 1;
              pg8::EpiS5Out Ep{YG};
              pg8::gemm_phase(lds, g, S, Ep); }
        }
        __syncthreads();
        attn_phase(args, lds, MISC, vcu, G, bx < 2 * SG ? 1 : 0, tid);
        SEAM(2);
    }
    if (IN(3)) {
        pg8::Gemm g{YG, WGLU, SW, SW, SW, 0, 0}; pg8::StaticOrder S; S.init(M, SW, G, bx);
        for (int t = vcu * 512 + tid; t < M; t += G * 512) { const f32x4* p = (const f32x4*)(ssqa16 + (size_t)t * 16); const f32x4 s0 = p[0], s1 = p[1], s2 = p[2], s3 = p[3];
            const f32x4 sv = (s0 + s1) + (s2 + s3); ssqa[t] = (sv[0] + sv[1]) + (sv[2] + sv[3]); }
        REP(3) { pg8::EpiGlu Ep{YG, args.in[I_BGLU], YAYS, ssqs4, XL}; pg8::gemm_phase(lds, g, S, Ep); }
        SEAM(3);
    }
    if (IN(4)) {
        pg8::Gemm g{YAYS, WOUT, DM, DM, AW, 0, 0}; pg8::SplitKOrder S; S.so.init(M, DM, G, bx);
        REP(4) { pg8::EpiRes1 Ep{args.in[I_X], XB, ssqa, ssqs4, ssqx8, XL}; pg8::gemm_phase(lds, g, S, Ep); }
        SEAM(4);
    }
    if (IN(5)) {
        pg8::Gemm g{XB, WGU, DM, DM, DM, 0, 0}; pg8::StaticOrder S; S.init(M, 2 * DFF, G, bx);
        pg8::EpiSwiGLU Ep{HB, ssqx8};
        REP(5) pg8::gemm_phase(lds, g, S, Ep);
        SEAM(5);
    }
    if (IN(6)) {
        pg8::Gemm g{HB, WD, DFF, DFF, DFF, 0, 0}; pg8::StaticOrder S; S.init(M, DM, G, bx);
        REP(6) { pg8::EpiRes2 Ep{args.out, XB}; pg8::gemm_phase(lds, g, S, Ep); }
    }
#undef IN
#undef SEAM
}

extern "C" void kernel_launch(void* const* d_in, const int* in_sizes, int n_in, void* d_out, int out_size, void* d_ws, size_t ws_size, hipStream_t stream) {
    static int grid = 0;
    if (grid == 0) {
        if (n_in != 23 || in_sizes[0] != M * DM || out_size != M * DM || ws_size < WS_END) { fprintf(stderr, "kernel_launch: unexpected shapes (n_in %d, in0 %d, out %d, ws %zu < %zu)\n", n_in, n_in > 0 ? in_sizes[0] : -1, out_size, ws_size, (size_t)WS_END); grid = -1; return; }
        int dev = 0, cus = 0, per_cu = 0;
        if (hipGetDevice(&dev) != hipSuccess || hipDeviceGetAttribute(&cus, hipDeviceAttributeMultiprocessorCount, dev) != hipSuccess) { grid = -1; return; }
        if (hipFuncSetAttribute((const void*)hymba_fwd, hipFuncAttributeMaxDynamicSharedMemorySize, LDS_BYTES) != hipSuccess) { fprintf(stderr, "kernel_launch: hipFuncSetAttribute failed\n"); grid = -1; return; }
        if (hipOccupancyMaxActiveBlocksPerMultiprocessor(&per_cu, (const void*)hymba_fwd, 512, LDS_BYTES) != hipSuccess || per_cu < 1) { fprintf(stderr, "kernel_launch: occupancy query says %d blocks per CU\n", per_cu); (void)hipGetLastError(); per_cu = 1; }
        grid = cus;
    }
    if (grid < 0) return;
    (void)hipMemsetAsync((char*)d_ws + WS_CTL, 0, CTL_ZERO_BYTES, stream);
    Args a{}; a.dup = DUP_PHASE;
    for (int i = 0; i < 23; ++i) a.in[i] = (const float*)d_in[i];
    a.out = (float*)d_out; a.ws = (unsigned char*)d_ws;
    if (MK_N_LAUNCHES == 1) {
        a.ph_lo = 0; a.ph_hi = NPHASE; a.li = 0;
        hipLaunchKernelGGL(hymba_fwd, dim3(grid), dim3(512), LDS_BYTES, stream, a);
    } else {
        for (int li = 0; li < NPHASE; ++li) { a.ph_lo = li; a.ph_hi = li + 1; a.li = li; hipLaunchKernelGGL(hymba_fwd, dim3(grid), dim3(512), LDS_BYTES, stream, a); }
    }
}
```

```cpp
#include <hip/hip_runtime.h>
#include <cstdio>
#include <cstdint>

#define DUP_PHASE (-1)
#ifndef MK_N_LAUNCHES
#define MK_N_LAUNCHES 1
#endif

#define GAS __attribute__((address_space(1)))
#define LAS __attribute__((address_space(3)))
typedef unsigned short bf16_t;
typedef short bf16x8 __attribute__((ext_vector_type(8)));
typedef short s16x4 __attribute__((ext_vector_type(4)));
typedef float f32x4 __attribute__((ext_vector_type(4)));
typedef float f32x2 __attribute__((ext_vector_type(2)));
typedef unsigned u32x4 __attribute__((ext_vector_type(4)));
typedef unsigned u32x2 __attribute__((ext_vector_type(2)));

constexpr int BATCH = 4, SEQ = 4096, DM = 2048, M = BATCH * SEQ;
constexpr int AW = 1024, SW = 1024, NH = 16, HD = 64, NQKV = 3 * AW, INW = 4096, DFF = 5632;
constexpr int GRIDW = 64, NROWS = SEQ / GRIDW;
constexpr int SG = 64, SC = 16, SP = 64;
constexpr int CL = 32, NCH = SEQ / CL, RCH = M / CL;
constexpr int KS5 = CL * SC + 256;
constexpr float RMS_EPS = 1e-6f;
constexpr int NPHASE = 7;

constexpr size_t MiB = 1u << 20;
constexpr size_t WS_CTL = 0, CTL_ZERO_BYTES = 65536;
constexpr size_t WS_WIN = 1 * MiB, WS_WGLU = 17 * MiB, WS_WOUT = 19 * MiB, WS_WGU = 27 * MiB, WS_WD = 71 * MiB;
constexpr size_t WS_WST = 93 * MiB, WS_TW = 109 * MiB, WS_LAML = 157 * MiB;
constexpr size_t WS_XN = 158 * MiB;
constexpr size_t WS_BIG = 222 * MiB;
constexpr size_t WS_A5 = WS_BIG + 96 * MiB, WS_E = WS_BIG + 144 * MiB;
constexpr size_t WS_YAYS = 398 * MiB, WS_SSQ = 462 * MiB, WS_END = 464 * MiB;
constexpr size_t WS_SSQA16 = WS_SSQ, WS_SSQA = WS_SSQ + 1 * MiB, WS_SSQS4 = WS_SSQA + 65536, WS_SSQX8 = WS_SSQS4 + 4 * 65536;
constexpr int CW_BAR = 4096;
static_assert((size_t)(CW_BAR + 3456) * 4 <= CTL_ZERO_BYTES, "ctl");

constexpr int RING_BYTES = 131072;
constexpr int MISC_OFF = 143360;
constexpr int LDS_BYTES = 147456;

__device__ __forceinline__ unsigned cvt_pk_bf16(float lo, float hi) { unsigned r; asm volatile("v_cvt_pk_bf16_f32 %0, %1, %2" : "=v"(r) : "v"(lo), "v"(hi)); return r; }
__device__ __forceinline__ float bf_lo(unsigned w) { return __uint_as_float(w << 16); }
__device__ __forceinline__ float bf_hi(unsigned w) { return __uint_as_float(w & 0xffff0000u); }
__device__ __forceinline__ float fast_rcp(float x) { return __builtin_amdgcn_rcpf(x); }
__device__ __forceinline__ float fast_exp2(float x) { return __builtin_amdgcn_exp2f(x); }
__device__ __forceinline__ float sigmoidf_(float x) { return fast_rcp(1.0f + fast_exp2(-1.44269504089f * x)); }
__device__ __forceinline__ float gelu_tanh(float x) { const float t = x * (1.0f + 0.044715f * x * x); return x * fast_rcp(1.0f + fast_exp2(-2.30220818f * t)); }
__device__ __forceinline__ float wave_sum(float v) {
#pragma unroll
    for (int o = 1; o < 64; o <<= 1) v += __shfl_xor(v, o);
    return v;
}

namespace pg8 {
constexpr int BM = 256, BK = 64, HALF = 128, HTB = HALF * BK * 2, NXCD = 8, WGM = 8;
__host__ __device__ __forceinline__ int lds_byte(int r, int c) { const int st = (r >> 4) * 2 + (c >> 5), rr = r & 15, cc = c & 31, ob = rr * 64 + cc * 2; return st * 1024 + (ob ^ (((ob >> 9) & 1) << 5)); }
__host__ __device__ __forceinline__ void stage_rc(int b, int& R, int& C) { const int st = b / 1024, sb = b % 1024, swz = sb ^ (((sb >> 9) & 1) << 5); R = (st >> 1) * 16 + swz / 64; C = (st & 1) * 32 + (swz % 64) / 2; }
__host__ __device__ __forceinline__ int perm32(int rho) { const int n = rho >> 4, i = rho & 15; return 8 * (i >> 2) + 4 * n + (i & 3); }

struct Unit { int pm, pn, g, kh; };
struct Gemm { const bf16_t* A; const bf16_t* Bt; int lda, ldb, K; size_t sA, sB; };

struct StaticOrder {
    int nM, nN, nwg, G, c;
    __device__ void init(int M_, int N_, int G_, int c_) { nM = M_ / BM; nN = N_ / BM; nwg = nM * nN; G = G_; c = c_; }
    __device__ bool next(int i, Unit& u) const {
        const long L = (long)i * G + c; if (L >= nwg) return false;
        int wgid = (int)L; { const int q = nwg / NXCD, r = nwg % NXCD, xcd = wgid % NXCD, off = wgid / NXCD; wgid = (xcd < r ? xcd * (q + 1) : r * (q + 1) + (xcd - r) * q) + off; }
        const int nig = WGM * nN, gid = wgid / nig, fm = gid * WGM, gsz = (nM - fm) < WGM ? (nM - fm) : WGM;
        u.pm = fm + ((wgid % nig) % gsz); u.pn = (wgid % nig) / gsz; u.g = 0; u.kh = 0; return true;
    }
};
struct SplitKOrder {
    StaticOrder so;
    __device__ bool next(int i, Unit& u) const { if (!so.next(i >> 1, u)) return false; u.kh = i & 1; return true; }
};
struct ListOrder {
    int n; Unit u0, u1;
    __device__ bool next(int i, Unit& u) const { if (i >= n) return false; u = i == 0 ? u0 : u1; return true; }
};
struct BatchOrder {
    int nM, nN, nwg, G, c;
    __device__ void init(int nM_, int nN_, int nb, int G_, int c_) { nM = nM_; nN = nN_; nwg = nM * nN * nb; G = G_; c = c_; }
    __device__ bool next(int i, Unit& u) const {
        const long L = (long)i * G + c; if (L >= nwg) return false;
        const int l = (int)L; u.pn = l % nN; u.pm = (l / nN) % nM; u.g = (l / (nN * nM)) % SG; u.kh = 0; return true;
    }
};

template <class Epi, class Sched>
__device__ __forceinline__ void gemm_phase(LAS unsigned char* lds, const Gemm g, const Sched& S, const Epi& E) {
    int tid = threadIdx.x; asm volatile("" : "+v"(tid));
    const int wid = __builtin_amdgcn_readfirstlane(tid >> 6), lane = tid & 63, wr = wid >> 2, wc = wid & 3, fr = lane & 15, fq = lane >> 4;
    const int K = g.K, nt = K / BK;
    unsigned voffA[2], voffB[2];
#pragma unroll
    for (int i = 0; i < 2; ++i) { int R, C; stage_rc(tid * 16 + i * 8192, R, C); const int Rb = Epi::PERM ? ((R & ~31) + perm32(R & 31)) : R;
        voffA[i] = (unsigned)(R * g.lda + C) * 2u; voffB[i] = (unsigned)(Rb * g.ldb + C) * 2u; }
    const size_t kstep = (size_t)(BK * 2);
    const size_t hstepA = (size_t)HALF * g.lda * 2, hstepB = (size_t)HALF * g.ldb * 2;
    const unsigned ldsw = (unsigned)wid * 1024u;
    const int aoff = lds_byte(wr * 64 + fr, fq * 8), boff = lds_byte(wc * 32 + fr, fq * 8);
#define PG8_SA(b, h) (((b) * 2 + (h)) * HTB)
#define PG8_SB(b, h) ((4 + (b) * 2 + (h)) * HTB)
#define PG8_STAGE(bufoff, gbase, voff) do { _Pragma("unroll") for (int _i = 0; _i < 2; ++_i) \
        __builtin_amdgcn_global_load_lds((const unsigned*)((const char*)(gbase) + (voff)[_i]), (LAS unsigned*)(lds + (bufoff) + ldsw + _i * 8192), 16, 0, 0); } while (0)
#define PG8_LDA(dst, b, h) do { _Pragma("unroll") for (int m = 0; m < 4; ++m) _Pragma("unroll") for (int k = 0; k < 2; ++k) dst[m][k] = *(const LAS bf16x8*)(lds + PG8_SA(b, h) + aoff + m * 2048 + k * 1024); } while (0)
#define PG8_LDB(dst, b, h) do { _Pragma("unroll") for (int n = 0; n < 2; ++n) _Pragma("unroll") for (int k = 0; k < 2; ++k) dst[n][k] = *(const LAS bf16x8*)(lds + PG8_SB(b, h) + boff + n * 2048 + k * 1024); } while (0)
#define PG8_MMA(ai, bj, At, Bt) do { __builtin_amdgcn_s_setprio(1); _Pragma("unroll") for (int m = 0; m < 4; ++m) _Pragma("unroll") for (int n = 0; n < 2; ++n) _Pragma("unroll") for (int k = 0; k < 2; ++k) \
        acc[ai][bj][m][n] = __builtin_amdgcn_mfma_f32_16x16x32_bf16(Bt[n][k], At[m][k], acc[ai][bj][m][n], 0, 0, 0); __builtin_amdgcn_s_setprio(0); } while (0)
#define PG8_WAIT_V(n) asm volatile("s_waitcnt vmcnt(" #n ")" ::: "memory")
#define PG8_WAIT_L(n) asm volatile("s_waitcnt lgkmcnt(" #n ")" ::: "memory")
#define PG8_BAR __builtin_amdgcn_s_barrier()
#define PG8_SCHED __builtin_amdgcn_sched_barrier(0)
    Unit cur, nxt; int ui = 0;
    if (!S.next(0, cur)) return;
    f32x4 acc[2][2][4][2];
#pragma unroll
    for (int a = 0; a < 2; ++a)
#pragma unroll
        for (int b = 0; b < 2; ++b)
#pragma unroll
            for (int m = 0; m < 4; ++m)
#pragma unroll
                for (int n = 0; n < 2; ++n) acc[a][b][m][n] = (f32x4){0.f, 0.f, 0.f, 0.f};
    bf16x8 At[4][2], B0[2][2], B1[2][2];
    const char* cA = (const char*)g.A + ((size_t)cur.g * g.sA + (size_t)cur.pm * BM * g.lda + (size_t)cur.kh * K) * 2;
    const char* cB = (const char*)g.Bt + ((size_t)cur.g * g.sB + (size_t)cur.pn * BM * g.ldb + (size_t)cur.kh * K) * 2;
    PG8_STAGE(PG8_SB(0, 0), cB, voffB); PG8_STAGE(PG8_SB(0, 1), cB + hstepB, voffB); PG8_STAGE(PG8_SA(0, 0), cA, voffA); PG8_STAGE(PG8_SA(0, 1), cA + hstepA, voffA);
    if (wr == 1) PG8_BAR;
    PG8_WAIT_V(2); PG8_BAR;
    PG8_STAGE(PG8_SB(1, 0), cB + kstep, voffB); PG8_STAGE(PG8_SA(1, 0), cA + kstep, voffA); PG8_STAGE(PG8_SB(1, 1), cB + hstepB + kstep, voffB);
    PG8_WAIT_V(6); PG8_BAR;
    for (;;) {
        const bool has_next = S.next(ui + 1, nxt);
        const char* nA = has_next ? (const char*)g.A + ((size_t)nxt.g * g.sA + (size_t)nxt.pm * BM * g.lda + (size_t)nxt.kh * K) * 2 : cA;
        const char* nB = has_next ? (const char*)g.Bt + ((size_t)nxt.g * g.sB + (size_t)nxt.pn * BM * g.ldb + (size_t)nxt.kh * K) * 2 : cB;
        for (int t = 0; t < nt; t += 2) {
            const bool last = (t == nt - 2);
            const char* a1 = cA + (size_t)(t + 1) * kstep;
            const char* a2 = last ? nA : cA + (size_t)(t + 2) * kstep; const char* b2 = last ? nB : cB + (size_t)(t + 2) * kstep;
            const char* a3 = a2 + kstep; const char* b3 = b2 + kstep;
            PG8_LDB(B0, 0, 0); PG8_LDB(B1, 0, 1); PG8_SCHED; PG8_LDA(At, 0, 0); PG8_STAGE(PG8_SA(1, 1), a1 + hstepA, voffA);
            PG8_WAIT_V(8); PG8_WAIT_L(0); PG8_BAR; PG8_MMA(0, 0, At, B0); PG8_MMA(0, 1, At, B1); PG8_BAR; PG8_SCHED;
            PG8_LDA(At, 0, 1); PG8_STAGE(PG8_SB(0, 0), b2, voffB); PG8_STAGE(PG8_SB(0, 1), b2 + hstepB, voffB); PG8_STAGE(PG8_SA(0, 0), a2, voffA);
            PG8_WAIT_V(8); PG8_WAIT_L(0); PG8_BAR; PG8_MMA(1, 0, At, B0); PG8_MMA(1, 1, At, B1); PG8_BAR; PG8_SCHED;
            PG8_LDB(B0, 1, 0); PG8_LDB(B1, 1, 1); PG8_SCHED; PG8_LDA(At, 1, 0); PG8_STAGE(PG8_SA(0, 1), a2 + hstepA, voffA);
            PG8_WAIT_V(8); PG8_WAIT_L(0); PG8_BAR; PG8_MMA(0, 0, At, B0); PG8_MMA(0, 1, At, B1); PG8_BAR; PG8_SCHED;
            PG8_LDA(At, 1, 1); PG8_STAGE(PG8_SB(1, 0), b3, voffB); PG8_STAGE(PG8_SB(1, 1), b3 + hstepB, voffB); PG8_STAGE(PG8_SA(1, 0), a3, voffA);
            PG8_WAIT_V(8); PG8_WAIT_L(0); PG8_BAR; PG8_MMA(1, 0, At, B0); PG8_MMA(1, 1, At, B1); PG8_BAR; PG8_SCHED;
        }
        if (wr == 0) PG8_BAR;
        E(acc, cur, wr, wc, fr, fq);
        if (!has_next) break;
        if (!(Epi::KSPLIT && cur.kh == 0)) {
#pragma unroll
        for (int a = 0; a < 2; ++a)
#pragma unroll
            for (int b = 0; b < 2; ++b)
#pragma unroll
                for (int m = 0; m < 4; ++m)
#pragma unroll
                    for (int n = 0; n < 2; ++n) acc[a][b][m][n] = (f32x4){0.f, 0.f, 0.f, 0.f};
        }
        cur = nxt; cA = nA; cB = nB; ++ui;
        if (wr == 1) PG8_BAR;
    }
    PG8_WAIT_V(0);
    PG8_BAR;
#undef PG8_SA
#undef PG8_SB
#undef PG8_STAGE
#undef PG8_LDA
#undef PG8_LDB
#undef PG8_MMA
#undef PG8_WAIT_V
#undef PG8_WAIT_L
#undef PG8_BAR
#undef PG8_SCHED
}

__device__ __forceinline__ u32x4 pack8(const f32x4 a, const f32x4 b) { u32x4 w; w.x = cvt_pk_bf16(a[0], a[1]); w.y = cvt_pk_bf16(a[2], a[3]); w.z = cvt_pk_bf16(b[0], b[1]); w.w = cvt_pk_bf16(b[2], b[3]); return w; }

struct EpiZ {
    static constexpr bool PERM = true, KSPLIT = false;
    bf16_t* QKV; bf16_t* A5; const float* qg; const float* kg; LAS float* X;
    __device__ __forceinline__ void operator()(f32x4 (&acc)[2][2][4][2], const Unit& u, int wr, int wc, int fr, int fq) const {
        if (u.pn < 8) {
#pragma unroll
            for (int ai = 0; ai < 2; ++ai)
#pragma unroll
                for (int m = 0; m < 4; ++m)
#pragma unroll
                    for (int bj = 0; bj < 2; ++bj) { const f32x4 a0 = acc[ai][bj][m][0], a1 = acc[ai][bj][m][1];
                        float ss = (a0[0] * a0[0] + a0[1] * a0[1]) + (a0[2] * a0[2] + a0[3] * a0[3]) + (a1[0] * a1[0] + a1[1] * a1[1]) + (a1[2] * a1[2] + a1[3] * a1[3]);
                        ss += __shfl_xor(ss, 16); ss += __shfl_xor(ss, 32);
                        if (fq == 0) X[(ai * HALF + wr * 64 + m * 16 + fr) * 8 + bj * 4 + wc] = ss; }
            asm volatile("s_waitcnt lgkmcnt(0)" ::: "memory"); __builtin_amdgcn_s_barrier(); asm volatile("" ::: "memory");
            const float* gp = (u.pn < 4 ? qg : kg) + ((wc & 1) * 32 + 8 * fq); const float gs = u.pn < 4 ? 0.125f * 1.44269504089f : 1.0f;
            const f32x4 g0 = *(const f32x4*)gp * gs, g1 = *(const f32x4*)(gp + 4) * gs;
#pragma unroll
            for (int ai = 0; ai < 2; ++ai)
#pragma unroll
                for (int m = 0; m < 4; ++m) { const int rl = ai * HALF + wr * 64 + m * 16 + fr, row = u.pm * BM + rl;
#pragma unroll
                    for (int bj = 0; bj < 2; ++bj) { const f32x2 pr = *(const LAS f32x2*)(X + rl * 8 + bj * 4 + (wc & 2)); const float rn = __builtin_amdgcn_rsqf((pr.x + pr.y) * (1.0f / HD) + RMS_EPS);
                        const int c8 = u.pn * BM + bj * HALF + wc * 32 + 8 * fq;
                        *(u32x4*)(QKV + (size_t)row * NQKV + c8) = pack8(acc[ai][bj][m][0] * g0 * rn, acc[ai][bj][m][1] * g1 * rn); } }
            return;
        }
#pragma unroll
        for (int ai = 0; ai < 2; ++ai)
#pragma unroll
            for (int m = 0; m < 4; ++m) { const int row = u.pm * BM + ai * HALF + wr * 64 + m * 16 + fr;
#pragma unroll
                for (int bj = 0; bj < 2; ++bj) { const int c8 = u.pn * BM + bj * HALF + wc * 32 + 8 * fq; const u32x4 w = pack8(acc[ai][bj][m][0], acc[ai][bj][m][1]);
                    if (u.pn < 12) *(u32x4*)(QKV + (size_t)row * NQKV + c8) = w;
                    else { const int ch = c8 - NQKV, gg = ch >> 4, c0 = ch & 15, R = row >> 5, s = row & 31; *(u32x4*)(A5 + ((size_t)gg * RCH + R) * KS5 + s * SC + c0) = w; } } }
    }
};
struct EpiE {
    static constexpr bool PERM = false, KSPLIT = false;
    float* E;
    __device__ __forceinline__ void operator()(f32x4 (&acc)[2][2][4][2], const Unit& u, int wr, int wc, int fr, int fq) const {
#pragma unroll
        for (int ai = 0; ai < 2; ++ai)
#pragma unroll
            for (int m = 0; m < 4; ++m) { const int R = u.pm * BM + ai * HALF + wr * 64 + m * 16 + fr; float* rowp = E + ((size_t)u.g * RCH + R) * 256 + wc * 32 + 4 * fq;
#pragma unroll
                for (int bj = 0; bj < 2; ++bj)
#pragma unroll
                    for (int n = 0; n < 2; ++n) *(f32x4*)(rowp + bj * HALF + n * 16) = acc[ai][bj][m][n]; }
    }
};
struct EpiS5Out {
    static constexpr bool PERM = true, KSPLIT = false;
    bf16_t* Yg;
    __device__ __forceinline__ void operator()(f32x4 (&acc)[2][2][4][2], const Unit& u, int wr, int wc, int fr, int fq) const {
#pragma unroll
        for (int ai = 0; ai < 2; ++ai)
#pragma unroll
            for (int m = 0; m < 4; ++m) { const int R = u.pm * BM + ai * HALF + wr * 64 + m * 16 + fr;
#pragma unroll
                for (int bj = 0; bj < 2; ++bj) { const int n8 = u.pn * BM + bj * HALF + wc * 32 + 8 * fq, s = n8 >> 4, c0 = n8 & 15;
                    f32x4 v0 = acc[ai][bj][m][0], v1 = acc[ai][bj][m][1];
#pragma unroll
                    for (int e = 0; e < 4; ++e) { v0[e] = gelu_tanh(v0[e]); v1[e] = gelu_tanh(v1[e]); }
                    *(u32x4*)(Yg + (size_t)(R * CL + s) * SW + u.g * SC + c0) = pack8(v0, v1); } }
    }
};
struct EpiGlu {
    static constexpr bool PERM = true, KSPLIT = false;
    const bf16_t* Yg; const float* bias; bf16_t* YAYS; float* ssq4; LAS float* X;
    __device__ __forceinline__ void operator()(f32x4 (&acc)[2][2][4][2], const Unit& u, int wr, int wc, int fr, int fq) const {
        const int c8b = u.pn * BM + wc * 32 + 8 * fq;
        f32x4 bv[2][2];
#pragma unroll
        for (int bj = 0; bj < 2; ++bj)
#pragma unroll
            for (int n = 0; n < 2; ++n) bv[bj][n] = *(const f32x4*)(bias + c8b + bj * HALF + 4 * n);
#pragma unroll
        for (int ai = 0; ai < 2; ++ai) {
            u32x4 yv[4][2];
#pragma unroll
            for (int m = 0; m < 4; ++m)
#pragma unroll
                for (int bj = 0; bj < 2; ++bj) yv[m][bj] = *(const u32x4*)(Yg + (size_t)(u.pm * BM + ai * HALF + wr * 64 + m * 16 + fr) * SW + c8b + bj * HALF);
#pragma unroll
            for (int m = 0; m < 4; ++m) { const int row = u.pm * BM + ai * HALF + wr * 64 + m * 16 + fr; float ss = 0.f;
#pragma unroll
                for (int bj = 0; bj < 2; ++bj) { const int c8 = c8b + bj * HALF; const u32x4 y = yv[m][bj];
                    const f32x4 a0 = acc[ai][bj][m][0] + bv[bj][0], a1 = acc[ai][bj][m][1] + bv[bj][1];
                    f32x4 v0, v1;
                    v0[0] = bf_lo(y.x) * sigmoidf_(a0[0]); v0[1] = bf_hi(y.x) * sigmoidf_(a0[1]); v0[2] = bf_lo(y.y) * sigmoidf_(a0[2]); v0[3] = bf_hi(y.y) * sigmoidf_(a0[3]);
                    v1[0] = bf_lo(y.z) * sigmoidf_(a1[0]); v1[1] = bf_hi(y.z) * sigmoidf_(a1[1]); v1[2] = bf_lo(y.w) * sigmoidf_(a1[2]); v1[3] = bf_hi(y.w) * sigmoidf_(a1[3]);
#pragma unroll
                    for (int e = 0; e < 4; ++e) ss += v0[e] * v0[e] + v1[e] * v1[e];
                    *(u32x4*)(YAYS + (size_t)row * DM + AW + c8) = pack8(v0, v1); }
                ss += __shfl_xor(ss, 16); ss += __shfl_xor(ss, 32);
                if (fq == 0) X[(ai * HALF + wr * 64 + m * 16 + fr) * 4 + wc] = ss; }
            asm volatile("" ::: "memory"); }
        asm volatile("s_waitcnt lgkmcnt(0)" ::: "memory"); __builtin_amdgcn_s_barrier(); asm volatile("" ::: "memory");
        if (wc == 0 && fq == 0) {
#pragma unroll
            for (int ai = 0; ai < 2; ++ai)
#pragma unroll
                for (int m = 0; m < 4; ++m) { const int rl = ai * HALF + wr * 64 + m * 16 + fr; const f32x4 p = *(const LAS f32x4*)(X + rl * 4);
                    ssq4[(size_t)u.pn * M + u.pm * BM + rl] = (p[0] + p[1]) + (p[2] + p[3]); } }
    }
};
struct EpiRes1 {
    static constexpr bool PERM = true, KSPLIT = true;
    const float* x; bf16_t* XB; const float* ssqa; const float* ssqs4; float* ssqx8; LAS float* X;
    __device__ __forceinline__ void operator()(f32x4 (&acc)[2][2][4][2], const Unit& u, int wr, int wc, int fr, int fq) const {
        if (u.kh == 0) {
#pragma unroll
        for (int ai = 0; ai < 2; ++ai)
#pragma unroll
            for (int m = 0; m < 4; ++m) { const int row = u.pm * BM + ai * HALF + wr * 64 + m * 16 + fr;
                const float sq = (ssqs4[row] + ssqs4[M + row]) + (ssqs4[2 * M + row] + ssqs4[3 * M + row]);
                const float ra = __builtin_amdgcn_rsqf(ssqa[row] * (1.0f / AW) + RMS_EPS), rs = __builtin_amdgcn_rsqf(sq * (1.0f / SW) + RMS_EPS), f = ra * fast_rcp(rs);
#pragma unroll
                for (int bj = 0; bj < 2; ++bj)
#pragma unroll
                    for (int n = 0; n < 2; ++n) acc[ai][bj][m][n] *= f; }
        return; }
        float rsv[2][4];
#pragma unroll
        for (int ai = 0; ai < 2; ++ai)
#pragma unroll
            for (int m = 0; m < 4; ++m) { const int row = u.pm * BM + ai * HALF + wr * 64 + m * 16 + fr;
                const float sq = (ssqs4[row] + ssqs4[M + row]) + (ssqs4[2 * M + row] + ssqs4[3 * M + row]); rsv[ai][m] = __builtin_amdgcn_rsqf(sq * (1.0f / SW) + RMS_EPS); }
#pragma unroll
        for (int am = 0; am < 4; ++am) { const int ai = am >> 1, mb = (am & 1) * 2;
            f32x4 xv[2][2][2];
#pragma unroll
            for (int mm = 0; mm < 2; ++mm)
#pragma unroll
                for (int bj = 0; bj < 2; ++bj) { const float* xp = x + (size_t)(u.pm * BM + ai * HALF + wr * 64 + (mb + mm) * 16 + fr) * DM + u.pn * BM + bj * HALF + wc * 32 + 8 * fq; xv[mm][bj][0] = *(const f32x4*)xp; xv[mm][bj][1] = *(const f32x4*)(xp + 4); }
#pragma unroll
            for (int mm = 0; mm < 2; ++mm) { const int m = mb + mm; const int row = u.pm * BM + ai * HALF + wr * 64 + m * 16 + fr; float ss = 0.f; const float rs = rsv[ai][m];
#pragma unroll
                for (int bj = 0; bj < 2; ++bj) { const size_t off = (size_t)row * DM + u.pn * BM + bj * HALF + wc * 32 + 8 * fq;
                    const f32x4 v0 = xv[mm][bj][0] + acc[ai][bj][m][0] * rs, v1 = xv[mm][bj][1] + acc[ai][bj][m][1] * rs;
#pragma unroll
                    for (int e = 0; e < 4; ++e) ss += v0[e] * v0[e] + v1[e] * v1[e];
                    *(u32x4*)(XB + off) = pack8(v0, v1); }
                ss += __shfl_xor(ss, 16); ss += __shfl_xor(ss, 32);
                if (fq == 0) X[(ai * HALF + wr * 64 + m * 16 + fr) * 4 + wc] = ss; }
            asm volatile("" ::: "memory"); }
        asm volatile("s_waitcnt lgkmcnt(0)" ::: "memory"); __builtin_amdgcn_s_barrier(); asm volatile("" ::: "memory");
        if (wc == 0 && fq == 0) {
#pragma unroll
            for (int ai = 0; ai < 2; ++ai)
#pragma unroll
                for (int m = 0; m < 4; ++m) { const int rl = ai * HALF + wr * 64 + m * 16 + fr; const f32x4 p = *(const LAS f32x4*)(X + rl * 4);
                    ssqx8[(size_t)u.pn * M + u.pm * BM + rl] = (p[0] + p[1]) + (p[2] + p[3]); } }
    }
};
struct EpiSwiGLU {
    static constexpr bool PERM = true, KSPLIT = false;
    bf16_t* H; const float* ssqx8;
    __device__ __forceinline__ void operator()(f32x4 (&acc)[2][2][4][2], const Unit& u, int wr, int wc, int fr, int fq) const {
        float rsv[2][4];
#pragma unroll
        for (int ai = 0; ai < 2; ++ai)
#pragma unroll
            for (int m = 0; m < 4; ++m) { const int row = u.pm * BM + ai * HALF + wr * 64 + m * 16 + fr; float sq = 0.f;
#pragma unroll
                for (int t = 0; t < 8; ++t) sq += ssqx8[(size_t)t * M + row];
                rsv[ai][m] = __builtin_amdgcn_rsqf(sq * (1.0f / DM) + RMS_EPS); }
#pragma unroll
        for (int ai = 0; ai < 2; ++ai)
#pragma unroll
            for (int m = 0; m < 4; ++m) { const int row = u.pm * BM + ai * HALF + wr * 64 + m * 16 + fr; const float rs = rsv[ai][m];
                f32x4 h0, h1;
#pragma unroll
                for (int e = 0; e < 4; ++e) { const float g0 = acc[ai][0][m][0][e] * rs, u0 = acc[ai][1][m][0][e] * rs, g1 = acc[ai][0][m][1][e] * rs, u1 = acc[ai][1][m][1][e] * rs;
                    h0[e] = g0 * sigmoidf_(g0) * u0; h1[e] = g1 * sigmoidf_(g1) * u1; }
                *(u32x4*)(H + (size_t)row * DFF + u.pn * HALF + wc * 32 + 8 * fq) = pack8(h0, h1); }
    }
};
struct EpiRes2 {
    static constexpr bool PERM = true, KSPLIT = false;
    float* out; const bf16_t* XB;
    __device__ __forceinline__ void operator()(f32x4 (&acc)[2][2][4][2], const Unit& u, int wr, int wc, int fr, int fq) const {
#pragma unroll
        for (int ai = 0; ai < 2; ++ai) {
            u32x4 xb[4][2];
#pragma unroll
            for (int m = 0; m < 4; ++m)
#pragma unroll
                for (int bj = 0; bj < 2; ++bj) xb[m][bj] = *(const u32x4*)(XB + (size_t)(u.pm * BM + ai * HALF + wr * 64 + m * 16 + fr) * DM + u.pn * BM + wc * 32 + 8 * fq + bj * HALF);
#pragma unroll
            for (int m = 0; m < 4; ++m) { const size_t roff = (size_t)(u.pm * BM + ai * HALF + wr * 64 + m * 16 + fr) * DM + u.pn * BM + wc * 32 + 8 * fq;
#pragma unroll
                for (int bj = 0; bj < 2; ++bj) { const size_t off = roff + bj * HALF; const u32x4 x4 = xb[m][bj];
                    f32x4 v0, v1; v0[0] = bf_lo(x4.x); v0[1] = bf_hi(x4.x); v0[2] = bf_lo(x4.y); v0[3] = bf_hi(x4.y); v1[0] = bf_lo(x4.z); v1[1] = bf_hi(x4.z); v1[2] = bf_lo(x4.w); v1[3] = bf_hi(x4.w);
                    *(f32x4*)(out + off) = v0 + acc[ai][bj][m][0]; *(f32x4*)(out + off + 4) = v1 + acc[ai][bj][m][1]; } }
            asm volatile("" ::: "memory"); }
    }
};
}

#define RLX_AGENT __ATOMIC_RELAXED, __HIP_MEMORY_SCOPE_AGENT
#define XB_TMO      128
#define XB_XCNT(j)  (256  + 64 * (j))
#define XB_XSUB(j)  (1280 + 64 * (j))
#define XB_XGEN(j)  (2304 + 64 * (j))
#define XB_TOP      3328
#define XB_TOPGEN   3392
#define XCD_BAR_WORDS 3456
#define XB_SPIN_CAP (1u << 24)
__device__ __forceinline__ unsigned xb_ld(unsigned* p)              { return __hip_atomic_load(p, __ATOMIC_RELAXED, __HIP_MEMORY_SCOPE_AGENT); }
__device__ __forceinline__ unsigned xb_add(unsigned* p, unsigned v) { return __hip_atomic_fetch_add(p, v, __ATOMIC_RELAXED, __HIP_MEMORY_SCOPE_AGENT); }
__device__ __forceinline__ unsigned xb_xcc_id() { return (unsigned)__builtin_amdgcn_s_getreg((3 << 11) | 20) & 0xFu; }
#define XB_SPIN(cond, bar) do { unsigned _sp = 0; while (cond) { __builtin_amdgcn_s_sleep(1); \
    if ((++_sp & 255u) == 0u) { if (xb_ld(&(bar)[XB_TMO])) break; if (_sp > XB_SPIN_CAP) { atomicAdd(&(bar)[XB_TMO], 1u); break; } } } } while (0)
struct XcdBarrier { unsigned* bar; unsigned x; volatile LAS unsigned* st; };
__device__ __forceinline__ XcdBarrier xcd_barrier_post(unsigned* bar, volatile LAS unsigned* st) {
    XcdBarrier b; b.bar = bar; b.x = xb_xcc_id(); b.st = st;
    if (threadIdx.x == 0) (void)xb_add(&bar[XB_XCNT(b.x)], 1u);
    return b;
}
__device__ __forceinline__ void xcd_barrier_complete(unsigned* bar, unsigned x, unsigned& nloc, unsigned& nx) {
    const unsigned G = gridDim.x * gridDim.y * gridDim.z;
    unsigned sum, cnt, mine, sp = 0u;
    for (;;) {
        sum = 0u; cnt = 0u; mine = 0u;
#pragma unroll
        for (unsigned j = 0; j < 16; ++j) { const unsigned c = xb_ld(&bar[XB_XCNT(j)]); sum += c; cnt += (c > 0u) ? 1u : 0u; mine = (j == x) ? c : mine; }
        if (sum == G) break;
        __builtin_amdgcn_s_sleep(1);
        if ((++sp & 255u) == 0u) { if (xb_ld(&bar[XB_TMO])) break; if (sp > XB_SPIN_CAP) { atomicAdd(&bar[XB_TMO], 1u); break; } }
    }
    nloc = mine > 0u ? mine : 1u; nx = cnt > 0u ? cnt : 1u;
}
__device__ __forceinline__ void xcd_barrier(const XcdBarrier& b) {
    asm volatile("s_waitcnt vmcnt(0)" ::: "memory");
    __syncthreads();
    if (threadIdx.x == 0) {
        unsigned* bar = b.bar;
        __builtin_amdgcn_s_waitcnt(0);
        unsigned nloc = b.st[0], nx = b.st[1];
        if (nloc == 0u) { xcd_barrier_complete(bar, b.x, nloc, nx); b.st[0] = nloc; b.st[1] = nx; }
        const unsigned old = xb_add(&bar[XB_XSUB(b.x)], 1u);
        const unsigned gen = old / nloc;
        if (old + 1u == (gen + 1u) * nloc) {
            __builtin_amdgcn_fence(__ATOMIC_RELEASE, "agent");
            asm volatile("s_waitcnt vmcnt(0)" ::: "memory");
            const unsigned og = xb_add(&bar[XB_TOP], 1u);
            const unsigned tg = og / nx;
            if (og + 1u == (tg + 1u) * nx) xb_add(&bar[XB_TOPGEN], 1u);
            else XB_SPIN(xb_ld(&bar[XB_TOPGEN]) == tg, bar);
            __builtin_amdgcn_fence(__ATOMIC_ACQUIRE, "agent");
            xb_add(&bar[XB_XGEN(b.x)], 1u);
            asm volatile("s_waitcnt vmcnt(0)" ::: "memory");
        } else {
            XB_SPIN(xb_ld(&bar[XB_XGEN(b.x)]) == gen, bar);
            __builtin_amdgcn_fence(__ATOMIC_ACQUIRE, "agent");
            asm volatile("s_waitcnt vmcnt(0)" ::: "memory");
        }
    }
    __syncthreads();
}

struct Args { const float* in[23]; float* out; unsigned char* ws; int ph_lo, ph_hi, li, dup; };
enum { I_X = 0, I_GMIX, I_WIN, I_QG, I_KG, I_RPB, I_ARE, I_AIM, I_BRE, I_BIM, I_CRE, I_CIM, I_LS, I_D, I_WGLU, I_BGLU, I_GOA, I_GOS, I_WOUT, I_GFFN, I_WG, I_WU, I_WD };

#define LDS_WAIT() asm volatile("s_waitcnt lgkmcnt(0)" ::: "memory")

__device__ __forceinline__ void p0_transpose_item(const float* W, int N, const float* kscale, bf16_t* WT, int ldd, int drow0, int k0, int n0, int lane) {
    const int c = lane >> 3, n4 = (lane & 7) * 4;
    const float* src = W + (size_t)(k0 + 8 * c) * N + n0 + n4;
    f32x4 v[2][8];
#pragma unroll
    for (int h = 0; h < 2; ++h)
#pragma unroll
        for (int i = 0; i < 8; ++i) v[h][i] = __builtin_nontemporal_load((const f32x4*)(src + (size_t)i * N + 32 * h));
    if (kscale) { const f32x4 s0 = *(const f32x4*)(kscale + k0 + 8 * c), s1 = *(const f32x4*)(kscale + k0 + 8 * c + 4);
#pragma unroll
        for (int h = 0; h < 2; ++h)
#pragma unroll
            for (int i = 0; i < 8; ++i) v[h][i] *= (i < 4 ? s0[i & 3] : s1[i & 3]); }
#pragma unroll
    for (int h = 0; h < 2; ++h)
#pragma unroll
        for (int e = 0; e < 4; ++e) { u32x4 o; o.x = cvt_pk_bf16(v[h][0][e], v[h][1][e]); o.y = cvt_pk_bf16(v[h][2][e], v[h][3][e]); o.z = cvt_pk_bf16(v[h][4][e], v[h][5][e]); o.w = cvt_pk_bf16(v[h][6][e], v[h][7][e]);
            *(u32x4*)(WT + (size_t)(drow0 + 32 * h + n4 + e) * ldd + k0 + 8 * c) = o; }
}

__device__ __forceinline__ void dsincos(double a, double& s, double& c) {
    const double k = __builtin_rint(a * 0.63661977236758134308);
    double r = __builtin_fma(-k, 1.57079632679489655800e+00, a);
    r = __builtin_fma(-k, 6.12323399573676603587e-17, r);
    const double r2 = r * r;
    double sp = -7.6471637318198164759e-13; sp = sp * r2 + 1.6059043836821614599e-10; sp = sp * r2 - 2.5052108385441718775e-08; sp = sp * r2 + 2.7557319223985890653e-06;
    sp = sp * r2 - 1.9841269841269841270e-04; sp = sp * r2 + 8.3333333333333333333e-03; sp = sp * r2 - 1.6666666666666666667e-01; sp = sp * r2 * r + r;
    double cp = 4.7794773323873852974e-14; cp = cp * r2 - 1.1470745597729724714e-11; cp = cp * r2 + 2.0876756987868098979e-09; cp = cp * r2 - 2.7557319223985890653e-07;
    cp = cp * r2 + 2.4801587301587301587e-05; cp = cp * r2 - 1.3888888888888888889e-03; cp = cp * r2 + 4.1666666666666666667e-02; cp = cp * r2 - 0.5; cp = cp * r2 + 1.0;
    const int q = (int)((long long)k) & 3;
    s = (q == 0) ? sp : (q == 1) ? cp : (q == 2) ? -sp : -cp;
    c = (q == 0) ? cp : (q == 1) ? -sp : (q == 2) ? -cp : sp;
}

struct S5Params { f32x4 br4, bi4, cr4, ci4; float are, aim, ls; };
__device__ __forceinline__ void p0_s5_params(const Args& a, int g, int tid, S5Params& P) {
    const float* a_re = a.in[I_ARE]; const float* a_im = a.in[I_AIM]; const float* b_re = a.in[I_BRE]; const float* b_im = a.in[I_BIM];
    const float* c_re = a.in[I_CRE]; const float* c_im = a.in[I_CIM]; const float* lstep = a.in[I_LS];
#pragma unroll
    for (int j = 0; j < 4; ++j) { const int i = tid + 512 * j, c = i & 15, p = (i >> 4) & 63, d = i >> 10;
        const size_t bi = (((size_t)d * SG + g) * SP + p) * SC + c, ci = (((size_t)d * SG + g) * SC + c) * SP + p;
        P.br4[j] = b_re[bi]; P.bi4[j] = b_im[bi]; P.cr4[j] = c_re[ci]; P.ci4[j] = c_im[ci]; }
    { const int p = tid & 63, d = (tid >> 6) & 1; P.are = a_re[(d * SG + g) * SP + p]; P.aim = a_im[(d * SG + g) * SP + p]; P.ls = lstep[d * SG + g]; }
}
__device__ __forceinline__ void p0_s5_tables(const Args& a, LAS unsigned char* lds, int g, int q, int tid, const S5Params& P) {
    LAS f32x2* LP = (LAS f32x2*)lds;
    LAS float* Bb = (LAS float*)(lds + 33792);
    LAS f32x2* Cm = (LAS f32x2*)(lds + 50176);
    LAS float* Kt = (LAS float*)(lds + 66560);
    const float* dsk = a.in[I_D];
    unsigned char* ws = a.ws;
    __syncthreads();
    LAS f32x2* Fp = (LAS f32x2*)(Kt);
    if (tid < 128) { const int p = tid & 63, d = tid >> 6;
        const double lre = (double)fminf(P.are, -1e-4f), lim = (double)P.aim, dt = exp((double)P.ls);
        const double mag = exp(lre * dt); double sn, cs; dsincos(lim * dt, sn, cs);
        const double lr = mag * cs, li = mag * sn;
        const double nr = lr - 1.0, ni = li, den = 1.0 / (lre * lre + lim * lim);
        Fp[d * 64 + p] = (f32x2){(float)((nr * lre + ni * lim) * den), (float)((ni * lre - nr * lim) * den)};
        double wr_ = 1.0, wi_ = 0.0;
        for (int tau = 0; tau <= CL; ++tau) { LP[(d * 64 + p) * 33 + tau] = (f32x2){(float)wr_, (float)wi_}; const double t_ = wr_ * lr - wi_ * li; wi_ = wr_ * li + wi_ * lr; wr_ = t_; } }
    __syncthreads();
#pragma unroll
    for (int j = 0; j < 4; ++j) { const int i = tid + 512 * j, c = i & 15, p = (i >> 4) & 63, d = i >> 10; const f32x2 f = Fp[d * 64 + p];
        Bb[(d * 64 + p) * 32 + c] = f.x * P.br4[j] - f.y * P.bi4[j]; Bb[(d * 64 + p) * 32 + 16 + c] = f.x * P.bi4[j] + f.y * P.br4[j];
        Cm[i] = (f32x2){P.cr4[j], P.ci4[j]}; }
    __syncthreads();
    if (q == 0 && tid < 128) { const int p = tid & 63, d = tid >> 6; ((f32x2*)(ws + WS_LAML))[(g * 2 + d) * SP + p] = LP[(d * 64 + p) * 33 + CL]; }
    { const int wv = __builtin_amdgcn_readfirstlane(tid >> 6), l = tid & 63, c16 = l & 15, g4 = l >> 4;
#pragma unroll 1
      for (int d = 0; d < 2; ++d) {
        bf16x8 Bf[4];
#pragma unroll
        for (int ks = 0; ks < 4; ++ks) { float v[8];
#pragma unroll
            for (int j = 0; j < 8; ++j) v[j] = Bb[(d * 64 + 32 * (ks & 1) + 8 * g4 + j) * 32 + (ks >> 1) * 16 + c16];
            u32x4 w; w.x = cvt_pk_bf16(v[0], v[1]); w.y = cvt_pk_bf16(v[2], v[3]); w.z = cvt_pk_bf16(v[4], v[5]); w.w = cvt_pk_bf16(v[6], v[7]); Bf[ks] = __builtin_bit_cast(bf16x8, w); }
#pragma unroll 1
        for (int tt = 0; tt < 4; ++tt) { const int tau = wv + 8 * tt;
            f32x4 acc = (f32x4){0.f, 0.f, 0.f, 0.f};
#pragma unroll
            for (int ks = 0; ks < 2; ++ks) { float gr[8], gi[8];
#pragma unroll
                for (int j = 0; j < 8; ++j) { const int p = 32 * ks + 8 * g4 + j; const f32x2 cm = Cm[(d * 64 + p) * 16 + c16], lp = LP[(d * 64 + p) * 33 + tau];
                    gr[j] = cm.x * lp.x - cm.y * lp.y; gi[j] = -(cm.x * lp.y + cm.y * lp.x); }
                u32x4 wr_, wi_; wr_.x = cvt_pk_bf16(gr[0], gr[1]); wr_.y = cvt_pk_bf16(gr[2], gr[3]); wr_.z = cvt_pk_bf16(gr[4], gr[5]); wr_.w = cvt_pk_bf16(gr[6], gr[7]);
                wi_.x = cvt_pk_bf16(gi[0], gi[1]); wi_.y = cvt_pk_bf16(gi[2], gi[3]); wi_.z = cvt_pk_bf16(gi[4], gi[5]); wi_.w = cvt_pk_bf16(gi[6], gi[7]);
                acc = __builtin_amdgcn_mfma_f32_16x16x32_bf16(__builtin_bit_cast(bf16x8, wr_), Bf[ks], acc, 0, 0, 0);
                acc = __builtin_amdgcn_mfma_f32_16x16x32_bf16(__builtin_bit_cast(bf16x8, wi_), Bf[2 + ks], acc, 0, 0, 0); }
#pragma unroll
            for (int e = 0; e < 4; ++e) Kt[((d * 32 + tau) * 16 + 4 * g4 + e) * 16 + c16] = acc[e]; } } }
    __syncthreads();
    { const int d = q >> 1, ri = q & 1, p = tid >> 3, s0 = (tid & 7) * 4;
      bf16_t* dst = (bf16_t*)(ws + WS_WST) + ((size_t)g * 256 + q * 64 + p) * 512 + s0 * 16;
      float bx_[16], by_[16];
#pragma unroll
      for (int e = 0; e < 16; ++e) { bx_[e] = Bb[(d * 64 + p) * 32 + e]; by_[e] = Bb[(d * 64 + p) * 32 + 16 + e]; }
#pragma unroll
      for (int sp = 0; sp < 4; ++sp) { const int pw = d == 0 ? (CL - 1 - (s0 + sp)) : (s0 + sp); const f32x2 lp = LP[(d * 64 + p) * 33 + pw]; float v[16];
#pragma unroll
          for (int e = 0; e < 16; ++e) v[e] = ri == 0 ? (lp.x * bx_[e] - lp.y * by_[e]) : (lp.x * by_[e] + lp.y * bx_[e]);
          u32x4 w0, w1; w0.x = cvt_pk_bf16(v[0], v[1]); w0.y = cvt_pk_bf16(v[2], v[3]); w0.z = cvt_pk_bf16(v[4], v[5]); w0.w = cvt_pk_bf16(v[6], v[7]);
          w1.x = cvt_pk_bf16(v[8], v[9]); w1.y = cvt_pk_bf16(v[10], v[11]); w1.z = cvt_pk_bf16(v[12], v[13]); w1.w = cvt_pk_bf16(v[14], v[15]);
          *(u32x4*)(dst + sp * 16) = w0; *(u32x4*)(dst + sp * 16 + 8) = w1; } }
    { const int c = tid & 15, s = 8 * q + ((tid >> 4) & 7), hi2 = tid >> 7;
      bf16_t* dst = (bf16_t*)(ws + WS_TW) + ((size_t)g * 512 + s * 16 + c) * KS5;
      const float dsv = dsk[g * SC + c];
#pragma unroll 1
      for (int it = 0; it < 8; ++it) { const int sp = hi2 + 4 * it; f32x4 v[4];
          const LAS f32x4* k0 = (const LAS f32x4*)(Kt + ((sp <= s ? (s - sp) : (32 + sp - s)) * 16 + c) * 16);
#pragma unroll
          for (int e = 0; e < 4; ++e) v[e] = k0[e];
          if (sp == s) { const LAS f32x4* k1 = (const LAS f32x4*)(Kt + (32 * 16 + c) * 16);
#pragma unroll
              for (int e = 0; e < 4; ++e) v[e] += k1[e];
#pragma unroll
              for (int e = 0; e < 4; ++e)
#pragma unroll
                  for (int k = 0; k < 4; ++k) v[e][k] += (c == 4 * e + k) ? dsv : 0.f; }
          u32x4 w0, w1; w0.x = cvt_pk_bf16(v[0][0], v[0][1]); w0.y = cvt_pk_bf16(v[0][2], v[0][3]); w0.z = cvt_pk_bf16(v[1][0], v[1][1]); w0.w = cvt_pk_bf16(v[1][2], v[1][3]);
          w1.x = cvt_pk_bf16(v[2][0], v[2][1]); w1.y = cvt_pk_bf16(v[2][2], v[2][3]); w1.z = cvt_pk_bf16(v[3][0], v[3][1]); w1.w = cvt_pk_bf16(v[3][2], v[3][3]);
          *(u32x4*)(dst + sp * 16) = w0; *(u32x4*)(dst + sp * 16 + 8) = w1; }
      { const int d = hi2 >> 1, ri = hi2 & 1, pw = d == 0 ? (s + 1) : (CL - s);
#pragma unroll 1
        for (int pb = 0; pb < 8; ++pb) { float v[8];
#pragma unroll
            for (int e = 0; e < 8; ++e) { const int p = 8 * pb + e; const f32x2 cm = Cm[(d * 64 + p) * 16 + c], lp = LP[(d * 64 + p) * 33 + pw];
                v[e] = ri == 0 ? (cm.x * lp.x - cm.y * lp.y) : -(cm.x * lp.y + cm.y * lp.x); }
            u32x4 w; w.x = cvt_pk_bf16(v[0], v[1]); w.y = cvt_pk_bf16(v[2], v[3]); w.z = cvt_pk_bf16(v[4], v[5]); w.w = cvt_pk_bf16(v[6], v[7]);
            *(u32x4*)(dst + 512 + hi2 * 64 + 8 * pb) = w; } } }
    __syncthreads();
}

__device__ __forceinline__ void p0_prologue(const Args& a, LAS unsigned char* lds, int vcu, int G, int tid) {
    asm volatile("" : "+v"(tid));
    const int wave = __builtin_amdgcn_readfirstlane(tid >> 6), lane = tid & 63;
    unsigned char* ws = a.ws;
    S5Params P5; p0_s5_params(a, (vcu < SG * 4 ? vcu : SG * 4 - 1) >> 2, tid, P5);
    if (vcu & 1) { for (int it = vcu; it < SG * 4; it += G) { if (it != vcu) p0_s5_params(a, it >> 2, tid, P5); p0_s5_tables(a, lds, it >> 2, it & 3, tid, P5); } }
    const int gw = vcu * 8 + wave, NGW = G * 8;
    constexpr int I_IN = (DM / 64) * (INW / 64), I_GL = (SW / 64) * (SW / 64), I_OUT = (DM / 64) * (DM / 64), I_GU = (DM / 64) * (DFF / 64), I_DN = (DFF / 64) * (DM / 64);
    constexpr int NITEMS = I_IN + I_GL + I_OUT + 2 * I_GU + I_DN;
    for (int it = gw; it < NITEMS; it += NGW) {
        int r = it;
        if (r < I_IN) { const int nb = INW / 64, kb = r / nb, n0 = (r % nb) * 64; p0_transpose_item(a.in[I_WIN], INW, nullptr, (bf16_t*)(ws + WS_WIN), DM, n0, kb * 64, n0, lane); continue; } r -= I_IN;
        if (r < I_GL) { const int nb = SW / 64, kb = r / nb, n0 = (r % nb) * 64; p0_transpose_item(a.in[I_WGLU], SW, nullptr, (bf16_t*)(ws + WS_WGLU), SW, n0, kb * 64, n0, lane); continue; } r -= I_GL;
        if (r < I_OUT) { const int nb = DM / 64, kb = r / nb, n0 = (r % nb) * 64, k0 = kb * 64;
            p0_transpose_item(a.in[I_WOUT], DM, k0 < AW ? a.in[I_GOA] : a.in[I_GOS] - AW, (bf16_t*)(ws + WS_WOUT), DM, n0, k0, n0, lane); continue; } r -= I_OUT;
        if (r < 2 * I_GU) { const int up = r >= I_GU; if (up) r -= I_GU; const int nb = DFF / 64, kb = r / nb, n0 = (r % nb) * 64;
            p0_transpose_item(up ? a.in[I_WU] : a.in[I_WG], DFF, a.in[I_GFFN], (bf16_t*)(ws + WS_WGU), DM, 256 * (n0 >> 7) + (n0 & 127) + (up ? 128 : 0), kb * 64, n0, lane); continue; } r -= 2 * I_GU;
        { const int nb = DM / 64, kb = r / nb, n0 = (r % nb) * 64; p0_transpose_item(a.in[I_WD], DM, nullptr, (bf16_t*)(ws + WS_WD), DFF, n0, kb * 64, n0, lane); }
    }
    const float* x = a.in[I_X]; const float* gm = a.in[I_GMIX]; bf16_t* XN = (bf16_t*)(ws + WS_XN);
    for (int m = gw; m < M; m += 2 * NGW) { const int m1 = m + NGW < M ? m + NGW : m;
        const f32x4* xr0 = (const f32x4*)(x + (size_t)m * DM) + lane; const f32x4* xr1 = (const f32x4*)(x + (size_t)m1 * DM) + lane; f32x4 v0[8], v1[8]; float s0 = 0.f, s1 = 0.f;
#pragma unroll
        for (int j = 0; j < 8; ++j) { v0[j] = __builtin_nontemporal_load(xr0 + 64 * j); v1[j] = __builtin_nontemporal_load(xr1 + 64 * j); }
#pragma unroll
        for (int j = 0; j < 8; ++j) { s0 += (v0[j][0] * v0[j][0] + v0[j][1] * v0[j][1]) + (v0[j][2] * v0[j][2] + v0[j][3] * v0[j][3]); s1 += (v1[j][0] * v1[j][0] + v1[j][1] * v1[j][1]) + (v1[j][2] * v1[j][2] + v1[j][3] * v1[j][3]); }
        const float r0 = 1.0f / sqrtf(wave_sum(s0) * (1.0f / DM) + RMS_EPS), r1 = 1.0f / sqrtf(wave_sum(s1) * (1.0f / DM) + RMS_EPS);
        u32x2* o0 = (u32x2*)(XN + (size_t)m * DM) + lane; u32x2* o1 = (u32x2*)(XN + (size_t)m1 * DM) + lane;
#pragma unroll
        for (int j = 0; j < 8; ++j) { const f32x4 gq = ((const f32x4*)gm)[64 * j + lane]; u32x2 w; w.x = cvt_pk_bf16(v0[j][0] * r0 * gq[0], v0[j][1] * r0 * gq[1]); w.y = cvt_pk_bf16(v0[j][2] * r0 * gq[2], v0[j][3] * r0 * gq[3]); o0[64 * j] = w;
            u32x2 w2; w2.x = cvt_pk_bf16(v1[j][0] * r1 * gq[0], v1[j][1] * r1 * gq[1]); w2.y = cvt_pk_bf16(v1[j][2] * r1 * gq[2], v1[j][3] * r1 * gq[3]); o1[64 * j] = w2; }
    }
    if (!(vcu & 1)) { for (int it = vcu; it < SG * 4; it += G) { if (it != vcu) p0_s5_params(a, it >> 2, tid, P5); p0_s5_tables(a, lds, it >> 2, it & 3, tid, P5); } }
}

constexpr int ATT_PF = 6;
constexpr int KROW = 144, AROW = 160;
constexpr int AHEAD = 64 * AROW;
constexpr int ABUF = 2 * AHEAD;
constexpr int ATT_RPB_OFF = 4 * ABUF;
static_assert(ATT_RPB_OFF + 16 * 465 * 4 <= MISC_OFF, "attention LDS");

__device__ __forceinline__ void attn_phase(const Args& a, LAS unsigned char* lds, volatile LAS unsigned* MISC, int vcu, int G, int has_g2, int tid) {
    asm volatile("" : "+v"(tid));
    const int wave = __builtin_amdgcn_readfirstlane(tid >> 6), lane = tid & 63, ql = lane & 15, g4 = lane >> 4;
    const bf16_t* QKV = (const bf16_t*)(a.ws + WS_BIG); bf16_t* YAYS = (bf16_t*)(a.ws + WS_YAYS); float* ssqa16 = (float*)(a.ws + WS_SSQA16);
    LAS float* rpbL = (LAS float*)(lds + ATT_RPB_OFF);
    for (int i = tid; i < 16 * 465; i += 512) rpbL[i] = a.in[I_RPB][i] * 1.44269504089f;
    const int j = wave & 3, hsel = wave >> 2;
    const int cq = 16 * j + ql, cs = min(max(cq - 8, 0), GRIDW - 16), wb = (j == 0) ? 0 : (j == 1) ? 8 : (j == 2) ? 24 : 32;
    int it_lo, it_hi, it_step;
    if (G == 256) { const int x_ = vcu >> 5, k_ = vcu & 15; it_step = 16; if (has_g2) { it_lo = x_ * 256 + 208 + k_; it_hi = x_ * 256 + 256; } else { it_lo = x_ * 256 + k_; it_hi = x_ * 256 + 208; } }
    else { it_lo = vcu; it_hi = BATCH * NROWS * 8; it_step = G; }
#define ATT_FETCH(dst) do { if (tid == 0) { const int nx_ = ((dst) == 20) ? it_lo : item + it_step; MISC[dst] = (unsigned)(nx_ < it_hi ? nx_ : -1); } } while (0)
    int item = 0;
    ATT_FETCH(20);
    __syncthreads();
    item = __builtin_amdgcn_readfirstlane((int)MISC[20]);
    const int skey = tid >> 3, sch = tid & 7;
    const unsigned ldstK = (unsigned)(skey * KROW + sch * 16), ldstV = (unsigned)(skey * AROW + sch * 16);
    u32x4 R[8][2];
#define ATT_UN(it_) ((((it_) >> 8) << 5) | ((it_) & 31))
#define ATT_HP(it_) (((it_) >> 5) & 7)
#define ATT_BASE(it_) (QKV + ((size_t)(ATT_UN(it_) >> 6) * SEQ + 64 * min(max((ATT_UN(it_) & 63) - 4, 0), NROWS - 8) + skey) * NQKV + AW + 128 * ATT_HP(it_) + 8 * sch)
#define ATT_SRCB(base_, st_, i_) ((base_) + (size_t)((st_) & 7) * 64 * NQKV + ((st_) < 8 ? 0 : AW) + 64 * (i_))
    if (item >= 0) {
#pragma unroll
        for (int p = 0; p <= ATT_PF; ++p)
#pragma unroll
            for (int i = 0; i < 2; ++i) R[p][i] = *(const u32x4*)ATT_SRCB(ATT_BASE(item), p, i);
        *(LAS u32x4*)(lds + ldstK) = R[0][0]; *(LAS u32x4*)(lds + AHEAD + ldstK) = R[0][1];
    }
    while (item >= 0) {
        const int un_ = ATT_UN(item), b = un_ >> 6, r = un_ & 63, hp = ATT_HP(item), h = 2 * hp + hsel, row_start = min(max(r - 4, 0), NROWS - 8);
        ATT_FETCH(21);
        const size_t tq = (size_t)b * SEQ + 64 * r + cq;
        bf16x8 Qf[2];
        { const u32x4* qp = (const u32x4*)(QKV + tq * NQKV + 64 * h + 8 * g4); Qf[0] = __builtin_bit_cast(bf16x8, qp[0]); Qf[1] = __builtin_bit_cast(bf16x8, qp[4]); }
        const LAS float* bl = rpbL + h * 465 + (row_start - r + 7) * 31 + (wb + 4 * g4 - cq + 15);
        f32x4 S[8][2]; bf16x8 Pf[8]; f32x4 O[4]; float sum = 0.f; int nitem = -1;
        const bf16_t* kcur = ATT_BASE(item); const bf16_t* knxt = kcur;
#pragma unroll
        for (int dt = 0; dt < 4; ++dt) O[dt] = (f32x4){0.f, 0.f, 0.f, 0.f};
#pragma unroll
        for (int st = 0; st < 16; ++st) {
            LAS unsigned char* buf = lds + (st & 3) * ABUF;
            { LAS unsigned char* wb_ = lds + ((st + 1) & 3) * ABUF; const unsigned ld_ = ((st + 1) & 15) < 8 ? ldstK : ldstV;
              *(LAS u32x4*)(wb_ + ld_) = R[(st + 1) & 7][0]; *(LAS u32x4*)(wb_ + AHEAD + ld_) = R[(st + 1) & 7][1]; }
            if (st + 1 + ATT_PF < 16) {
#pragma unroll
                for (int i = 0; i < 2; ++i) R[(st + 1 + ATT_PF) & 7][i] = *(const u32x4*)ATT_SRCB(kcur, st + 1 + ATT_PF, i);
            } else {
#pragma unroll
                for (int i = 0; i < 2; ++i) R[(st + 1 + ATT_PF) & 7][i] = *(const u32x4*)ATT_SRCB(knxt, st + 1 + ATT_PF - 16, i);
            }
            asm volatile("s_waitcnt lgkmcnt(0)" ::: "memory"); __builtin_amdgcn_s_barrier(); asm volatile("" ::: "memory");
            if (st == 0) { nitem = __builtin_amdgcn_readfirstlane((int)MISC[21]); const int ni_ = nitem >= 0 ? nitem : item; knxt = ATT_BASE(ni_); }
            const LAS unsigned char* hb = buf + hsel * AHEAD;
            if (st < 8) {
                const int kr = st;
#pragma unroll
                for (int t = 0; t < 2; ++t) {
                    const LAS unsigned char* kp = hb + (wb + 16 * t + ql) * KROW + g4 * 16;
                    const bf16x8 k0 = *(const LAS bf16x8*)kp, k1 = *(const LAS bf16x8*)(kp + 64);
                    f32x4 acc = (f32x4){0.f, 0.f, 0.f, 0.f};
                    acc = __builtin_amdgcn_mfma_f32_16x16x32_bf16(k0, Qf[0], acc, 0, 0, 0);
                    acc = __builtin_amdgcn_mfma_f32_16x16x32_bf16(k1, Qf[1], acc, 0, 0, 0);
#pragma unroll
                    for (int e = 0; e < 4; ++e) { const int ck = wb + 16 * t + 4 * g4 + e;
                        const float bias = bl[kr * 31 + 16 * t + e];
                        acc[e] = (ck >= cs && ck < cs + 16) ? acc[e] + bias : -1e30f; }
                    S[kr][t] = acc; }
                if (st == 7) {
#pragma unroll
                    for (int k2 = 0; k2 < 8; ++k2) { f32x4 p0, p1;
#pragma unroll
                        for (int e = 0; e < 4; ++e) { p0[e] = fast_exp2(S[k2][0][e]); p1[e] = fast_exp2(S[k2][1][e]); sum += p0[e] + p1[e]; }
                        Pf[k2] = __builtin_bit_cast(bf16x8, pg8::pack8(p0, p1)); }
                    sum += __shfl_xor(sum, 16); sum += __shfl_xor(sum, 32);
                }
            } else {
                const int kr = st - 8;
                const LAS unsigned char* rp = hb + (wb + 4 * g4 + ((lane & 15) >> 2)) * AROW + (lane & 3) * 8;
#pragma unroll
                for (int dt = 0; dt < 4; ++dt) {
                    const s16x4 lo = __builtin_amdgcn_ds_read_tr16_b64_v4i16((LAS s16x4*)(rp + dt * 32));
                    const s16x4 hi = __builtin_amdgcn_ds_read_tr16_b64_v4i16((LAS s16x4*)(rp + 16 * AROW + dt * 32));
                    const bf16x8 av = (bf16x8){lo[0], lo[1], lo[2], lo[3], hi[0], hi[1], hi[2], hi[3]};
                    O[dt] = __builtin_amdgcn_mfma_f32_16x16x32_bf16(av, Pf[kr], O[dt], 0, 0, 0); }
            }
        }
        const float inv = fast_rcp(sum); float ssq_acc = 0.f;
        bf16_t* op = YAYS + tq * DM + 64 * h + 4 * g4;
#pragma unroll
        for (int dt = 0; dt < 4; ++dt) { const f32x4 o = O[dt] * inv; ssq_acc += (o[0] * o[0] + o[1] * o[1]) + (o[2] * o[2] + o[3] * o[3]);
            u32x2 w; w.x = cvt_pk_bf16(o[0], o[1]); w.y = cvt_pk_bf16(o[2], o[3]); *(u32x2*)(op + 16 * dt) = w; }
        ssq_acc += __shfl_xor(ssq_acc, 16); ssq_acc += __shfl_xor(ssq_acc, 32);
        if (g4 == 0) ssqa16[tq * 16 + h] = ssq_acc;
        item = nitem;
    }
#undef ATT_FETCH
#undef ATT_BASE
#undef ATT_SRCB
#undef ATT_UN
#undef ATT_HP
}

__device__ __forceinline__ void scan_chain(const Args& a, int g, int pm, int tid) {
    asm volatile("" : "+v"(tid));
    if (tid >= 256) return;
    const float* E = (const float*)(a.ws + WS_E); bf16_t* A5 = (bf16_t*)(a.ws + WS_A5); const f32x2* LAML = (const f32x2*)(a.ws + WS_LAML);
    const int p = tid & 63, d = (tid >> 6) & 1, b = 2 * pm + (tid >> 7);
    const f32x2 lam = LAML[(g * 2 + d) * SP + p];
    float xr = 0.f, xi = 0.f;
    const size_t R0 = (size_t)g * RCH + b * NCH;
#pragma unroll 1
    for (int rd = 0; rd < NCH / 32; ++rd) { float er[32], ei[32];
#pragma unroll
        for (int j = 0; j < 32; ++j) { const int kk = rd * 32 + j, k = d == 0 ? kk : NCH - 1 - kk; const float* ep = E + (R0 + k) * 256 + d * 128 + p; er[j] = ep[0]; ei[j] = ep[64]; }
#pragma unroll
        for (int j = 0; j < 32; ++j) { const int kk = rd * 32 + j, k = d == 0 ? kk : NCH - 1 - kk;
            bf16_t* ap = A5 + (R0 + k) * KS5 + 512 + d * 128 + p; ap[0] = (bf16_t)(cvt_pk_bf16(xr, 0.f) & 0xffffu); ap[64] = (bf16_t)(cvt_pk_bf16(xi, 0.f) & 0xffffu);
            const float nr = lam.x * xr - lam.y * xi + er[j], ni = lam.x * xi + lam.y * xr + ei[j]; xr = nr; xi = ni; } }
}

__global__ void __launch_bounds__(512, 2) hymba_fwd(Args args) {
    extern __shared__ __attribute__((aligned(16))) unsigned char lds_raw[];
    LAS unsigned char* lds = (LAS unsigned char*)lds_raw;
    volatile LAS unsigned* MISC = (volatile LAS unsigned*)(lds + MISC_OFF);
    const int tid = threadIdx.x;
    const int G = gridDim.x; const int bx = blockIdx.x; const int vcu = (G % 8 == 0) ? (bx % 8) * (G / 8) + bx / 8 : bx;
    unsigned char* ws = args.ws;
    unsigned* ctl = (unsigned*)(ws + WS_CTL);
    for (int u = tid; u < (LDS_BYTES - MISC_OFF) / 4; u += 512) MISC[u] = 0u;
    __syncthreads();
    XcdBarrier bar; bar.bar = ctl + CW_BAR; bar.x = 0; bar.st = nullptr;
    if (MK_N_LAUNCHES == 1) bar = xcd_barrier_post(ctl + CW_BAR, MISC + 8);
    const int lo = args.ph_lo, hi = args.ph_hi;
#define IN(k) (lo <= (k) && (k) < hi)
#define SEAM(k) do { if (IN(k) && IN((k) + 1)) xcd_barrier(bar); } while (0)
    bf16_t* WIN = (bf16_t*)(ws + WS_WIN); bf16_t* WGLU = (bf16_t*)(ws + WS_WGLU); bf16_t* WOUT = (bf16_t*)(ws + WS_WOUT); bf16_t* WGU = (bf16_t*)(ws + WS_WGU); bf16_t* WD = (bf16_t*)(ws + WS_WD);
    bf16_t* WST = (bf16_t*)(ws + WS_WST); bf16_t* TW = (bf16_t*)(ws + WS_TW);
    bf16_t* XN = (bf16_t*)(ws + WS_XN); bf16_t* YG = (bf16_t*)(ws + WS_XN); bf16_t* XB = (bf16_t*)(ws + WS_XN);
    bf16_t* QKV = (bf16_t*)(ws + WS_BIG); bf16_t* A5 = (bf16_t*)(ws + WS_A5); float* E = (float*)(ws + WS_E); bf16_t* HB = (bf16_t*)(ws + WS_BIG);
    bf16_t* YAYS = (bf16_t*)(ws + WS_YAYS);
    float* ssqa16 = (float*)(ws + WS_SSQA16); float* ssqa = (float*)(ws + WS_SSQA); float* ssqs4 = (float*)(ws + WS_SSQS4); float* ssqx8 = (float*)(ws + WS_SSQX8);
    LAS float* XL = (LAS float*)(lds + RING_BYTES);

#define REP(k) _Pragma("unroll") for (int rep_ = (DUP_PHASE == (k)) ? 0 : 1; rep_ < 2; ++rep_)
#define ALPHA ((rep_ == 0 && args.dup >= 0) ? 0.0f : 1.0f)
    if (IN(0)) { REP(0) { p0_prologue(args, lds, vcu, G, tid); __syncthreads(); } SEAM(0); }
    if (IN(1)) {
        pg8::Gemm g{XN, WIN, DM, DM, DM, 0, 0}; pg8::StaticOrder S; S.init(M, INW, G, bx);
        pg8::EpiZ Ep{QKV, A5, args.in[I_QG], args.in[I_KG], XL};
        REP(1) pg8::gemm_phase(lds, g, S, Ep);
        SEAM(1);
    }
    if (IN(2)) {
        for (int cidx = bx; cidx < 2 * SG; cidx += G) { const int g_ = cidx >> 1, pm_ = cidx & 1;
            { pg8::Gemm g{A5, WST, KS5, 512, 512, (size_t)RCH * KS5, (size_t)256 * 512}; pg8::ListOrder S; S.n = 1; S.u0.pm = pm_; S.u0.pn = 0; S.u0.g = g_; S.u0.kh = 0; S.u1 = S.u0;
              pg8::EpiE Ep{E};
              pg8::gemm_phase(lds, g, S, Ep); }
            asm volatile("s_waitcnt vmcnt(0)" ::: "memory"); __syncthreads();
            scan_chain(args, g_, pm_, tid);
            asm volatile("s_waitcnt vmcnt(0)" ::: "memory"); __syncthreads();
            { pg8::Gemm g{A5, TW, KS5, KS5, KS5, (size_t)RCH * KS5, (size_t)512 * KS5}; pg8::ListOrder S; S.n = 2; S.u0.pm = pm_; S.u0.pn = 0; S.u0.g = g_; S.u0.kh = 0; S.u1 = S.u0; S.u1.pn = 1;
              pg8::EpiS5Out Ep{YG};
              pg8::gemm_phase(lds, g, S, Ep); }
        }
        __syncthreads();
        attn_phase(args, lds, MISC, vcu, G, bx < 2 * SG ? 1 : 0, tid);
        SEAM(2);
    }
    if (IN(3)) {
        pg8::Gemm g{YG, WGLU, SW, SW, SW, 0, 0}; pg8::StaticOrder S; S.init(M, SW, G, bx);
        for (int t = vcu * 512 + tid; t < M; t += G * 512) { const f32x4* p = (const f32x4*)(ssqa16 + (size_t)t * 16); const f32x4 s0 = p[0], s1 = p[1], s2 = p[2], s3 = p[3];
            const f32x4 sv = (s0 + s1) + (s2 + s3); ssqa[t] = (sv[0] + sv[1]) + (sv[2] + sv[3]); }
        REP(3) { pg8::EpiGlu Ep{YG, args.in[I_BGLU], YAYS, ssqs4, XL}; pg8::gemm_phase(lds, g, S, Ep); }
        SEAM(3);
    }
    if (IN(4)) {
        pg8::Gemm g{YAYS, WOUT, DM, DM, AW, 0, 0}; pg8::SplitKOrder S; S.so.init(M, DM, G, bx);
        REP(4) { pg8::EpiRes1 Ep{args.in[I_X], XB, ssqa, ssqs4, ssqx8, XL}; pg8::gemm_phase(lds, g, S, Ep); }
        SEAM(4);
    }
    if (IN(5)) {
        pg8::Gemm g{XB, WGU, DM, DM, DM, 0, 0}; pg8::StaticOrder S; S.init(M, 2 * DFF, G, bx);
        pg8::EpiSwiGLU Ep{HB, ssqx8};
        REP(5) pg8::gemm_phase(lds, g, S, Ep);
        SEAM(5);
    }
    if (IN(6)) {
        pg8::Gemm g{HB, WD, DFF, DFF, DFF, 0, 0}; pg8::StaticOrder S; S.init(M, DM, G, bx);
        REP(6) { pg8::EpiRes2 Ep{args.out, XB}; pg8::gemm_phase(lds, g, S, Ep); }
    }
#undef IN
#undef SEAM
}

extern "C" void kernel_launch(void* const* d_in, const int* in_sizes, int n_in, void* d_out, int out_size, void* d_ws, size_t ws_size, hipStream_t stream) {
    static int grid = 0;
    if (grid == 0) {
        if (n_in != 23 || in_sizes[0] != M * DM || out_size != M * DM || ws_size < WS_END) { fprintf(stderr, "kernel_launch: unexpected shapes (n_in %d, in0 %d, out %d, ws %zu < %zu)\n", n_in, n_in > 0 ? in_sizes[0] : -1, out_size, ws_size, (size_t)WS_END); grid = -1; return; }
        int dev = 0, cus = 0, per_cu = 0;
        if (hipGetDevice(&dev) != hipSuccess || hipDeviceGetAttribute(&cus, hipDeviceAttributeMultiprocessorCount, dev) != hipSuccess) { grid = -1; return; }
        if (hipFuncSetAttribute((const void*)hymba_fwd, hipFuncAttributeMaxDynamicSharedMemorySize, LDS_BYTES) != hipSuccess) { fprintf(stderr, "kernel_launch: hipFuncSetAttribute failed\n"); grid = -1; return; }
        if (hipOccupancyMaxActiveBlocksPerMultiprocessor(&per_cu, (const void*)hymba_fwd, 512, LDS_BYTES) != hipSuccess || per_cu < 1) { fprintf(stderr, "kernel_launch: occupancy query says %d blocks per CU\n", per_cu); (void)hipGetLastError(); per_cu = 1; }
        grid = cus;
    }
    if (grid < 0) return;
    (void)hipMemsetAsync((char*)d_ws + WS_CTL, 0, CTL_ZERO_BYTES, stream);
    Args a{}; a.dup = DUP_PHASE;
    for (int i = 0; i < 23; ++i) a.in[i] = (const float*)d_in[i];
    a.out = (float*)d_out; a.ws = (unsigned char*)d_ws;
    if (MK_N_LAUNCHES == 1) {
        a.ph_lo = 0; a.ph_hi = NPHASE; a.li = 0;
        hipLaunchKernelGGL(hymba_fwd, dim3(grid), dim3(512), LDS_BYTES, stream, a);
    } else {
        for (int li = 0; li < NPHASE; ++li) { a.ph_lo = li; a.ph_hi = li + 1; a.li = li; hipLaunchKernelGGL(hymba_fwd, dim3(grid), dim3(512), LDS_BYTES, stream, a); }
    }
}
```

```cpp
#include <hip/hip_runtime.h>
#include <cstdio>
#include <cstdint>

#define DUP_PHASE (-1)
#ifndef MK_N_LAUNCHES
#define MK_N_LAUNCHES 1
#endif

#define GAS __attribute__((address_space(1)))
#define LAS __attribute__((address_space(3)))
typedef unsigned short bf16_t;
typedef short bf16x8 __attribute__((ext_vector_type(8)));
typedef short s16x4 __attribute__((ext_vector_type(4)));
typedef float f32x4 __attribute__((ext_vector_type(4)));
typedef float f32x2 __attribute__((ext_vector_type(2)));
typedef unsigned u32x4 __attribute__((ext_vector_type(4)));
typedef unsigned u32x2 __attribute__((ext_vector_type(2)));

constexpr int BATCH = 4, SEQ = 4096, DM = 2048, M = BATCH * SEQ;
constexpr int AW = 1024, SW = 1024, NH = 16, HD = 64, NQKV = 3 * AW, INW = 4096, DFF = 5632;
constexpr int GRIDW = 64, NROWS = SEQ / GRIDW;
constexpr int SG = 64, SC = 16, SP = 64;
constexpr int CL = 32, NCH = SEQ / CL, RCH = M / CL;
constexpr int KS5 = CL * SC + 256;
constexpr float RMS_EPS = 1e-6f;
constexpr int NPHASE = 7;

constexpr size_t MiB = 1u << 20;
constexpr size_t WS_CTL = 0, CTL_ZERO_BYTES = 65536;
constexpr size_t WS_WIN = 1 * MiB, WS_WGLU = 17 * MiB, WS_WOUT = 19 * MiB, WS_WGU = 27 * MiB, WS_WD = 71 * MiB;
constexpr size_t WS_WST = 93 * MiB, WS_TW = 109 * MiB, WS_LAML = 157 * MiB;
constexpr size_t WS_XN = 158 * MiB;
constexpr size_t WS_BIG = 222 * MiB;
constexpr size_t WS_A5 = WS_BIG + 96 * MiB, WS_E = WS_BIG + 144 * MiB;
constexpr size_t WS_YAYS = 398 * MiB, WS_SSQ = 462 * MiB, WS_YG = 464 * MiB, WS_END = 496 * MiB;
constexpr size_t WS_SSQA16 = WS_SSQ, WS_SSQA = WS_SSQ + 1 * MiB, WS_SSQS4 = WS_SSQA + 65536, WS_SSQX8 = WS_SSQS4 + 4 * 65536, WS_SSQ0 = WS_SSQX8 + 8 * 65536;
static_assert(WS_SSQ0 + 65536 <= WS_END, "ssq");
constexpr int CW_BAR = 4096;
static_assert((size_t)(CW_BAR + 3456) * 4 <= CTL_ZERO_BYTES, "ctl");

constexpr int RING_BYTES = 131072;
constexpr int MISC_OFF = 143360;
constexpr int LDS_BYTES = 147456;

__device__ __forceinline__ unsigned cvt_pk_bf16(float lo, float hi) { unsigned r; asm volatile("v_cvt_pk_bf16_f32 %0, %1, %2" : "=v"(r) : "v"(lo), "v"(hi)); return r; }
__device__ __forceinline__ float bf_lo(unsigned w) { return __uint_as_float(w << 16); }
__device__ __forceinline__ float bf_hi(unsigned w) { return __uint_as_float(w & 0xffff0000u); }
__device__ __forceinline__ float fast_rcp(float x) { return __builtin_amdgcn_rcpf(x); }
__device__ __forceinline__ float fast_exp2(float x) { return __builtin_amdgcn_exp2f(x); }
__device__ __forceinline__ float sigmoidf_(float x) { return fast_rcp(1.0f + fast_exp2(-1.44269504089f * x)); }
__device__ __forceinline__ float gelu_tanh(float x) { const float t = x * (1.0f + 0.044715f * x * x); return x * fast_rcp(1.0f + fast_exp2(-2.30220818f * t)); }
__device__ __forceinline__ float wave_sum(float v) {
#pragma unroll
    for (int o = 1; o < 64; o <<= 1) v += __shfl_xor(v, o);
    return v;
}

namespace pg8 {
constexpr int BM = 256, BK = 64, HALF = 128, HTB = HALF * BK * 2, NXCD = 8, WGM = 8;
__host__ __device__ __forceinline__ int lds_byte(int r, int c) { const int st = (r >> 4) * 2 + (c >> 5), rr = r & 15, cc = c & 31, ob = rr * 64 + cc * 2; return st * 1024 + (ob ^ (((ob >> 9) & 1) << 5)); }
__host__ __device__ __forceinline__ void stage_rc(int b, int& R, int& C) { const int st = b / 1024, sb = b % 1024, swz = sb ^ (((sb >> 9) & 1) << 5); R = (st >> 1) * 16 + swz / 64; C = (st & 1) * 32 + (swz % 64) / 2; }
__host__ __device__ __forceinline__ int perm32(int rho) { const int n = rho >> 4, i = rho & 15; return 8 * (i >> 2) + 4 * n + (i & 3); }

struct Unit { int pm, pn, g, kh; };
struct Gemm { const bf16_t* A; const bf16_t* Bt; int lda, ldb, K; size_t sA, sB; };

struct StaticOrder {
    int nM, nN, nwg, G, c;
    __device__ void init(int M_, int N_, int G_, int c_) { nM = M_ / BM; nN = N_ / BM; nwg = nM * nN; G = G_; c = c_; }
    __device__ bool next(int i, Unit& u) const {
        const long L = (long)i * G + c; if (L >= nwg) return false;
        int wgid = (int)L; { const int q = nwg / NXCD, r = nwg % NXCD, xcd = wgid % NXCD, off = wgid / NXCD; wgid = (xcd < r ? xcd * (q + 1) : r * (q + 1) + (xcd - r) * q) + off; }
        const int nig = WGM * nN, gid = wgid / nig, fm = gid * WGM, gsz = (nM - fm) < WGM ? (nM - fm) : WGM;
        u.pm = fm + ((wgid % nig) % gsz); u.pn = (wgid % nig) / gsz; u.g = 0; u.kh = 0; return true;
    }
};
struct SplitKOrder {
    StaticOrder so;
    __device__ bool next(int i, Unit& u) const { if (!so.next(i >> 1, u)) return false; u.kh = i & 1; return true; }
};
struct ListOrder {
    int n; Unit u0, u1;
    __device__ bool next(int i, Unit& u) const { if (i >= n) return false; u = i == 0 ? u0 : u1; return true; }
};
struct BatchOrder {
    int nM, nN, nwg, G, c;
    __device__ void init(int nM_, int nN_, int nb, int G_, int c_) { nM = nM_; nN = nN_; nwg = nM * nN * nb; G = G_; c = c_; }
    __device__ bool next(int i, Unit& u) const {
        const long L = (long)i * G + c; if (L >= nwg) return false;
        const int l = (int)L; u.pn = l % nN; u.pm = (l / nN) % nM; u.g = (l / (nN * nM)) % SG; u.kh = 0; return true;
    }
};

template <class Epi, class Sched>
__device__ __forceinline__ void gemm_phase(LAS unsigned char* lds, const Gemm g, const Sched& S, const Epi& E) {
    int tid = threadIdx.x; asm volatile("" : "+v"(tid));
    const int wid = __builtin_amdgcn_readfirstlane(tid >> 6), lane = tid & 63, wr = wid >> 2, wc = wid & 3, fr = lane & 15, fq = lane >> 4;
    const int K = g.K, nt = K / BK;
    unsigned voffA[2], voffB[2];
#pragma unroll
    for (int i = 0; i < 2; ++i) { int R, C; stage_rc(tid * 16 + i * 8192, R, C); const int Rb = Epi::PERM ? ((R & ~31) + perm32(R & 31)) : R;
        voffA[i] = (unsigned)(R * g.lda + C) * 2u; voffB[i] = (unsigned)(Rb * g.ldb + C) * 2u; }
    const size_t kstep = (size_t)(BK * 2);
    const size_t hstepA = (size_t)HALF * g.lda * 2, hstepB = (size_t)HALF * g.ldb * 2;
    const unsigned ldsw = (unsigned)wid * 1024u;
    const int aoff = lds_byte(wr * 64 + fr, fq * 8), boff = lds_byte(wc * 32 + fr, fq * 8);
#define PG8_SA(b, h) (((b) * 2 + (h)) * HTB)
#define PG8_SB(b, h) ((4 + (b) * 2 + (h)) * HTB)
#define PG8_STAGE(bufoff, gbase, voff) do { _Pragma("unroll") for (int _i = 0; _i < 2; ++_i) \
        __builtin_amdgcn_global_load_lds((const unsigned*)((const char*)(gbase) + (voff)[_i]), (LAS unsigned*)(lds + (bufoff) + ldsw + _i * 8192), 16, 0, 0); } while (0)
#define PG8_LDA(dst, b, h) do { _Pragma("unroll") for (int m = 0; m < 4; ++m) _Pragma("unroll") for (int k = 0; k < 2; ++k) dst[m][k] = *(const LAS bf16x8*)(lds + PG8_SA(b, h) + aoff + m * 2048 + k * 1024); } while (0)
#define PG8_LDB(dst, b, h) do { _Pragma("unroll") for (int n = 0; n < 2; ++n) _Pragma("unroll") for (int k = 0; k < 2; ++k) dst[n][k] = *(const LAS bf16x8*)(lds + PG8_SB(b, h) + boff + n * 2048 + k * 1024); } while (0)
#define PG8_MMA(ai, bj, At, Bt) do { __builtin_amdgcn_s_setprio(1); _Pragma("unroll") for (int m = 0; m < 4; ++m) _Pragma("unroll") for (int n = 0; n < 2; ++n) _Pragma("unroll") for (int k = 0; k < 2; ++k) \
        acc[ai][bj][m][n] = __builtin_amdgcn_mfma_f32_16x16x32_bf16(Bt[n][k], At[m][k], acc[ai][bj][m][n], 0, 0, 0); __builtin_amdgcn_s_setprio(0); } while (0)
#define PG8_WAIT_V(n) asm volatile("s_waitcnt vmcnt(" #n ")" ::: "memory")
#define PG8_WAIT_L(n) asm volatile("s_waitcnt lgkmcnt(" #n ")" ::: "memory")
#define PG8_BAR __builtin_amdgcn_s_barrier()
#define PG8_SCHED __builtin_amdgcn_sched_barrier(0)
    Unit cur, nxt; int ui = 0;
    if (!S.next(0, cur)) return;
    f32x4 acc[2][2][4][2];
#pragma unroll
    for (int a = 0; a < 2; ++a)
#pragma unroll
        for (int b = 0; b < 2; ++b)
#pragma unroll
            for (int m = 0; m < 4; ++m)
#pragma unroll
                for (int n = 0; n < 2; ++n) acc[a][b][m][n] = (f32x4){0.f, 0.f, 0.f, 0.f};
    bf16x8 At[4][2], B0[2][2], B1[2][2];
    const char* cA = (const char*)g.A + ((size_t)cur.g * g.sA + (size_t)cur.pm * BM * g.lda + (size_t)cur.kh * K) * 2;
    const char* cB = (const char*)g.Bt + ((size_t)cur.g * g.sB + (size_t)cur.pn * BM * g.ldb + (size_t)cur.kh * K) * 2;
    PG8_STAGE(PG8_SB(0, 0), cB, voffB); PG8_STAGE(PG8_SB(0, 1), cB + hstepB, voffB); PG8_STAGE(PG8_SA(0, 0), cA, voffA); PG8_STAGE(PG8_SA(0, 1), cA + hstepA, voffA);
    if (wr == 1) PG8_BAR;
    PG8_WAIT_V(2); PG8_BAR;
    PG8_STAGE(PG8_SB(1, 0), cB + kstep, voffB); PG8_STAGE(PG8_SA(1, 0), cA + kstep, voffA); PG8_STAGE(PG8_SB(1, 1), cB + hstepB + kstep, voffB);
    PG8_WAIT_V(6); PG8_BAR;
    for (;;) {
        const bool has_next = S.next(ui + 1, nxt);
        const char* nA = has_next ? (const char*)g.A + ((size_t)nxt.g * g.sA + (size_t)nxt.pm * BM * g.lda + (size_t)nxt.kh * K) * 2 : cA;
        const char* nB = has_next ? (const char*)g.Bt + ((size_t)nxt.g * g.sB + (size_t)nxt.pn * BM * g.ldb + (size_t)nxt.kh * K) * 2 : cB;
        for (int t = 0; t < nt; t += 2) {
            const bool last = (t == nt - 2);
            const char* a1 = cA + (size_t)(t + 1) * kstep;
            const char* a2 = last ? nA : cA + (size_t)(t + 2) * kstep; const char* b2 = last ? nB : cB + (size_t)(t + 2) * kstep;
            const char* a3 = a2 + kstep; const char* b3 = b2 + kstep;
            PG8_LDB(B0, 0, 0); PG8_LDB(B1, 0, 1); PG8_SCHED; PG8_LDA(At, 0, 0); PG8_STAGE(PG8_SA(1, 1), a1 + hstepA, voffA);
            PG8_WAIT_V(8); PG8_WAIT_L(0); PG8_BAR; PG8_MMA(0, 0, At, B0); PG8_MMA(0, 1, At, B1); PG8_BAR; PG8_SCHED;
            PG8_LDA(At, 0, 1); PG8_STAGE(PG8_SB(0, 0), b2, voffB); PG8_STAGE(PG8_SB(0, 1), b2 + hstepB, voffB); PG8_STAGE(PG8_SA(0, 0), a2, voffA);
            PG8_WAIT_V(8); PG8_WAIT_L(0); PG8_BAR; PG8_MMA(1, 0, At, B0); PG8_MMA(1, 1, At, B1); PG8_BAR; PG8_SCHED;
            PG8_LDB(B0, 1, 0); PG8_LDB(B1, 1, 1); PG8_SCHED; PG8_LDA(At, 1, 0); PG8_STAGE(PG8_SA(0, 1), a2 + hstepA, voffA);
            PG8_WAIT_V(8); PG8_WAIT_L(0); PG8_BAR; PG8_MMA(0, 0, At, B0); PG8_MMA(0, 1, At, B1); PG8_BAR; PG8_SCHED;
            PG8_LDA(At, 1, 1); PG8_STAGE(PG8_SB(1, 0), b3, voffB); PG8_STAGE(PG8_SB(1, 1), b3 + hstepB, voffB); PG8_STAGE(PG8_SA(1, 0), a3, voffA);
            PG8_WAIT_V(8); PG8_WAIT_L(0); PG8_BAR; PG8_MMA(1, 0, At, B0); PG8_MMA(1, 1, At, B1); PG8_BAR; PG8_SCHED;
        }
        if (wr == 0) PG8_BAR;
        E(acc, cur, wr, wc, fr, fq);
        if (!has_next) break;
        if (!(Epi::KSPLIT && cur.kh == 0)) {
#pragma unroll
        for (int a = 0; a < 2; ++a)
#pragma unroll
            for (int b = 0; b < 2; ++b)
#pragma unroll
                for (int m = 0; m < 4; ++m)
#pragma unroll
                    for (int n = 0; n < 2; ++n) acc[a][b][m][n] = (f32x4){0.f, 0.f, 0.f, 0.f};
        }
        cur = nxt; cA = nA; cB = nB; ++ui;
        if (wr == 1) PG8_BAR;
    }
    PG8_WAIT_V(0);
    PG8_BAR;
#undef PG8_SA
#undef PG8_SB
#undef PG8_STAGE
#undef PG8_LDA
#undef PG8_LDB
#undef PG8_MMA
#undef PG8_WAIT_V
#undef PG8_WAIT_L
#undef PG8_BAR
#undef PG8_SCHED
}

__device__ __forceinline__ u32x4 pack8(const f32x4 a, const f32x4 b) { u32x4 w; w.x = cvt_pk_bf16(a[0], a[1]); w.y = cvt_pk_bf16(a[2], a[3]); w.z = cvt_pk_bf16(b[0], b[1]); w.w = cvt_pk_bf16(b[2], b[3]); return w; }

struct EpiZ {
    static constexpr bool PERM = true, KSPLIT = false;
    bf16_t* QKV; bf16_t* A5; const float* qg; const float* kg; LAS float* X; const float* ssq0;
    __device__ __forceinline__ void operator()(f32x4 (&acc)[2][2][4][2], const Unit& u, int wr, int wc, int fr, int fq) const {
        float rs0[2][4];
#pragma unroll
        for (int ai = 0; ai < 2; ++ai)
#pragma unroll
            for (int m = 0; m < 4; ++m) rs0[ai][m] = __builtin_amdgcn_rsqf(ssq0[u.pm * BM + ai * HALF + wr * 64 + m * 16 + fr] * (1.0f / DM) + RMS_EPS);
        if (u.pn < 8) {
#pragma unroll
            for (int ai = 0; ai < 2; ++ai)
#pragma unroll
                for (int m = 0; m < 4; ++m)
#pragma unroll
                    for (int bj = 0; bj < 2; ++bj) { const f32x4 a0 = acc[ai][bj][m][0], a1 = acc[ai][bj][m][1];
                        float ss = (a0[0] * a0[0] + a0[1] * a0[1]) + (a0[2] * a0[2] + a0[3] * a0[3]) + (a1[0] * a1[0] + a1[1] * a1[1]) + (a1[2] * a1[2] + a1[3] * a1[3]);
                        ss += __shfl_xor(ss, 16); ss += __shfl_xor(ss, 32);
                        if (fq == 0) X[(ai * HALF + wr * 64 + m * 16 + fr) * 8 + bj * 4 + wc] = ss; }
            asm volatile("s_waitcnt lgkmcnt(0)" ::: "memory"); __builtin_amdgcn_s_barrier(); asm volatile("" ::: "memory");
            const float* gp = (u.pn < 4 ? qg : kg) + ((wc & 1) * 32 + 8 * fq); const float gs = u.pn < 4 ? 0.125f * 1.44269504089f : 1.0f;
            const f32x4 g0 = *(const f32x4*)gp * gs, g1 = *(const f32x4*)(gp + 4) * gs;
#pragma unroll
            for (int ai = 0; ai < 2; ++ai)
#pragma unroll
                for (int m = 0; m < 4; ++m) { const int rl = ai * HALF + wr * 64 + m * 16 + fr, row = u.pm * BM + rl;
#pragma unroll
                    for (int bj = 0; bj < 2; ++bj) { const f32x2 pr = *(const LAS f32x2*)(X + rl * 8 + bj * 4 + (wc & 2)); const float r0 = rs0[ai][m], rn = r0 * __builtin_amdgcn_rsqf((pr.x + pr.y) * (r0 * r0) * (1.0f / HD) + RMS_EPS);
                        const int c8 = u.pn * BM + bj * HALF + wc * 32 + 8 * fq;
                        *(u32x4*)(QKV + (size_t)row * NQKV + c8) = pack8(acc[ai][bj][m][0] * g0 * rn, acc[ai][bj][m][1] * g1 * rn); } }
            return;
        }
#pragma unroll
        for (int ai = 0; ai < 2; ++ai)
#pragma unroll
            for (int m = 0; m < 4; ++m) { const int row = u.pm * BM + ai * HALF + wr * 64 + m * 16 + fr;
#pragma unroll
                for (int bj = 0; bj < 2; ++bj) { const int c8 = u.pn * BM + bj * HALF + wc * 32 + 8 * fq; const u32x4 w = pack8(acc[ai][bj][m][0] * rs0[ai][m], acc[ai][bj][m][1] * rs0[ai][m]);
                    if (u.pn < 12) *(u32x4*)(QKV + (size_t)row * NQKV + c8) = w;
                    else { const int ch = c8 - NQKV, gg = ch >> 4, c0 = ch & 15, R = row >> 5, s = row & 31; *(u32x4*)(A5 + ((size_t)gg * RCH + R) * KS5 + s * SC + c0) = w; } } }
    }
};
struct EpiE {
    static constexpr bool PERM = false, KSPLIT = false;
    float* E;
    __device__ __forceinline__ void operator()(f32x4 (&acc)[2][2][4][2], const Unit& u, int wr, int wc, int fr, int fq) const {
#pragma unroll
        for (int ai = 0; ai < 2; ++ai)
#pragma unroll
            for (int m = 0; m < 4; ++m) { const int R = u.pm * BM + ai * HALF + wr * 64 + m * 16 + fr; float* rowp = E + ((size_t)u.g * RCH + R) * 256 + wc * 32 + 4 * fq;
#pragma unroll
                for (int bj = 0; bj < 2; ++bj)
#pragma unroll
                    for (int n = 0; n < 2; ++n) *(f32x4*)(rowp + bj * HALF + n * 16) = acc[ai][bj][m][n]; }
    }
};
struct EpiS5Out {
    static constexpr bool PERM = true, KSPLIT = false;
    bf16_t* Yg;
    __device__ __forceinline__ void operator()(f32x4 (&acc)[2][2][4][2], const Unit& u, int wr, int wc, int fr, int fq) const {
#pragma unroll
        for (int ai = 0; ai < 2; ++ai)
#pragma unroll
            for (int m = 0; m < 4; ++m) { const int R = u.pm * BM + ai * HALF + wr * 64 + m * 16 + fr;
#pragma unroll
                for (int bj = 0; bj < 2; ++bj) { const int n8 = u.pn * BM + bj * HALF + wc * 32 + 8 * fq, s = n8 >> 4, c0 = n8 & 15;
                    f32x4 v0 = acc[ai][bj][m][0], v1 = acc[ai][bj][m][1];
#pragma unroll
                    for (int e = 0; e < 4; ++e) { v0[e] = gelu_tanh(v0[e]); v1[e] = gelu_tanh(v1[e]); }
                    *(u32x4*)(Yg + (size_t)(R * CL + s) * SW + u.g * SC + c0) = pack8(v0, v1); } }
    }
};
struct EpiGlu {
    static constexpr bool PERM = true, KSPLIT = false;
    const bf16_t* Yg; const float* bias; bf16_t* YAYS; float* ssq4; LAS float* X;
    __device__ __forceinline__ void operator()(f32x4 (&acc)[2][2][4][2], const Unit& u, int wr, int wc, int fr, int fq) const {
        const int c8b = u.pn * BM + wc * 32 + 8 * fq;
        f32x4 bv[2][2];
#pragma unroll
        for (int bj = 0; bj < 2; ++bj)
#pragma unroll
            for (int n = 0; n < 2; ++n) bv[bj][n] = *(const f32x4*)(bias + c8b + bj * HALF + 4 * n);
#pragma unroll
        for (int ai = 0; ai < 2; ++ai) {
            u32x4 yv[4][2];
#pragma unroll
            for (int m = 0; m < 4; ++m)
#pragma unroll
                for (int bj = 0; bj < 2; ++bj) yv[m][bj] = *(const u32x4*)(Yg + (size_t)(u.pm * BM + ai * HALF + wr * 64 + m * 16 + fr) * SW + c8b + bj * HALF);
#pragma unroll
            for (int m = 0; m < 4; ++m) { const int row = u.pm * BM + ai * HALF + wr * 64 + m * 16 + fr; float ss = 0.f;
#pragma unroll
                for (int bj = 0; bj < 2; ++bj) { const int c8 = c8b + bj * HALF; const u32x4 y = yv[m][bj];
                    const f32x4 a0 = acc[ai][bj][m][0] + bv[bj][0], a1 = acc[ai][bj][m][1] + bv[bj][1];
                    f32x4 v0, v1;
                    v0[0] = bf_lo(y.x) * sigmoidf_(a0[0]); v0[1] = bf_hi(y.x) * sigmoidf_(a0[1]); v0[2] = bf_lo(y.y) * sigmoidf_(a0[2]); v0[3] = bf_hi(y.y) * sigmoidf_(a0[3]);
                    v1[0] = bf_lo(y.z) * sigmoidf_(a1[0]); v1[1] = bf_hi(y.z) * sigmoidf_(a1[1]); v1[2] = bf_lo(y.w) * sigmoidf_(a1[2]); v1[3] = bf_hi(y.w) * sigmoidf_(a1[3]);
#pragma unroll
                    for (int e = 0; e < 4; ++e) ss += v0[e] * v0[e] + v1[e] * v1[e];
                    *(u32x4*)(YAYS + (size_t)row * DM + AW + c8) = pack8(v0, v1); }
                ss += __shfl_xor(ss, 16); ss += __shfl_xor(ss, 32);
                if (fq == 0) X[(ai * HALF + wr * 64 + m * 16 + fr) * 4 + wc] = ss; }
            asm volatile("" ::: "memory"); }
        asm volatile("s_waitcnt lgkmcnt(0)" ::: "memory"); __builtin_amdgcn_s_barrier(); asm volatile("" ::: "memory");
        if (wc == 0 && fq == 0) {
#pragma unroll
            for (int ai = 0; ai < 2; ++ai)
#pragma unroll
                for (int m = 0; m < 4; ++m) { const int rl = ai * HALF + wr * 64 + m * 16 + fr; const f32x4 p = *(const LAS f32x4*)(X + rl * 4);
                    ssq4[(size_t)u.pn * M + u.pm * BM + rl] = (p[0] + p[1]) + (p[2] + p[3]); } }
    }
};
struct EpiRes1 {
    static constexpr bool PERM = true, KSPLIT = true;
    const bf16_t* xb; bf16_t* XB; const float* ssqa; const float* ssqs4; float* ssqx8; LAS float* X;
    __device__ __forceinline__ void operator()(f32x4 (&acc)[2][2][4][2], const Unit& u, int wr, int wc, int fr, int fq) const {
        if (u.kh == 0) {
#pragma unroll
        for (int ai = 0; ai < 2; ++ai)
#pragma unroll
            for (int m = 0; m < 4; ++m) { const int row = u.pm * BM + ai * HALF + wr * 64 + m * 16 + fr;
                const float sq = (ssqs4[row] + ssqs4[M + row]) + (ssqs4[2 * M + row] + ssqs4[3 * M + row]);
                const float ra = __builtin_amdgcn_rsqf(ssqa[row] * (1.0f / AW) + RMS_EPS), rs = __builtin_amdgcn_rsqf(sq * (1.0f / SW) + RMS_EPS), f = ra * fast_rcp(rs);
#pragma unroll
                for (int bj = 0; bj < 2; ++bj)
#pragma unroll
                    for (int n = 0; n < 2; ++n) acc[ai][bj][m][n] *= f; }
        return; }
        float rsv[2][4];
#pragma unroll
        for (int ai = 0; ai < 2; ++ai)
#pragma unroll
            for (int m = 0; m < 4; ++m) { const int row = u.pm * BM + ai * HALF + wr * 64 + m * 16 + fr;
                const float sq = (ssqs4[row] + ssqs4[M + row]) + (ssqs4[2 * M + row] + ssqs4[3 * M + row]); rsv[ai][m] = __builtin_amdgcn_rsqf(sq * (1.0f / SW) + RMS_EPS); }
#pragma unroll
        for (int am = 0; am < 4; ++am) { const int ai = am >> 1, mb = (am & 1) * 2;
            u32x4 xv[2][2];
#pragma unroll
            for (int mm = 0; mm < 2; ++mm)
#pragma unroll
                for (int bj = 0; bj < 2; ++bj) xv[mm][bj] = *(const u32x4*)(xb + (size_t)(u.pm * BM + ai * HALF + wr * 64 + (mb + mm) * 16 + fr) * DM + u.pn * BM + bj * HALF + wc * 32 + 8 * fq);
#pragma unroll
            for (int mm = 0; mm < 2; ++mm) { const int m = mb + mm; const int row = u.pm * BM + ai * HALF + wr * 64 + m * 16 + fr; float ss = 0.f; const float rs = rsv[ai][m];
#pragma unroll
                for (int bj = 0; bj < 2; ++bj) { const size_t off = (size_t)row * DM + u.pn * BM + bj * HALF + wc * 32 + 8 * fq;
                    const u32x4 x4 = xv[mm][bj]; f32x4 x0, x1; x0[0] = bf_lo(x4.x); x0[1] = bf_hi(x4.x); x0[2] = bf_lo(x4.y); x0[3] = bf_hi(x4.y); x1[0] = bf_lo(x4.z); x1[1] = bf_hi(x4.z); x1[2] = bf_lo(x4.w); x1[3] = bf_hi(x4.w);
                    const f32x4 v0 = x0 + acc[ai][bj][m][0] * rs, v1 = x1 + acc[ai][bj][m][1] * rs;
#pragma unroll
                    for (int e = 0; e < 4; ++e) ss += v0[e] * v0[e] + v1[e] * v1[e];
                    *(u32x4*)(XB + off) = pack8(v0, v1); }
                ss += __shfl_xor(ss, 16); ss += __shfl_xor(ss, 32);
                if (fq == 0) X[(ai * HALF + wr * 64 + m * 16 + fr) * 4 + wc] = ss; }
            asm volatile("" ::: "memory"); }
        asm volatile("s_waitcnt lgkmcnt(0)" ::: "memory"); __builtin_amdgcn_s_barrier(); asm volatile("" ::: "memory");
        if (wc == 0 && fq == 0) {
#pragma unroll
            for (int ai = 0; ai < 2; ++ai)
#pragma unroll
                for (int m = 0; m < 4; ++m) { const int rl = ai * HALF + wr * 64 + m * 16 + fr; const f32x4 p = *(const LAS f32x4*)(X + rl * 4);
                    ssqx8[(size_t)u.pn * M + u.pm * BM + rl] = (p[0] + p[1]) + (p[2] + p[3]); } }
    }
};
struct EpiSwiGLU {
    static constexpr bool PERM = true, KSPLIT = false;
    bf16_t* H; const float* ssqx8;
    __device__ __forceinline__ void operator()(f32x4 (&acc)[2][2][4][2], const Unit& u, int wr, int wc, int fr, int fq) const {
        float rsv[2][4];
#pragma unroll
        for (int ai = 0; ai < 2; ++ai)
#pragma unroll
            for (int m = 0; m < 4; ++m) { const int row = u.pm * BM + ai * HALF + wr * 64 + m * 16 + fr; float sq = 0.f;
#pragma unroll
                for (int t = 0; t < 8; ++t) sq += ssqx8[(size_t)t * M + row];
                rsv[ai][m] = __builtin_amdgcn_rsqf(sq * (1.0f / DM) + RMS_EPS); }
#pragma unroll
        for (int ai = 0; ai < 2; ++ai)
#pragma unroll
            for (int m = 0; m < 4; ++m) { const int row = u.pm * BM + ai * HALF + wr * 64 + m * 16 + fr; const float rs = rsv[ai][m];
                const float nrs = rs * -1.44269504089f, rs2 = rs * rs; f32x4 hv[2];
#pragma unroll
                for (int n = 0; n < 2; ++n)
#pragma unroll
                    for (int hf = 0; hf < 2; ++hf) { const f32x2 ga = (f32x2){acc[ai][0][m][n][2 * hf], acc[ai][0][m][n][2 * hf + 1]}, ua = (f32x2){acc[ai][1][m][n][2 * hf], acc[ai][1][m][n][2 * hf + 1]};
                        const f32x2 t = ga * nrs; f32x2 ev; ev.x = fast_exp2(t.x); ev.y = fast_exp2(t.y);
                        const f32x2 dv = ev + 1.0f; f32x2 rv; rv.x = fast_rcp(dv.x); rv.y = fast_rcp(dv.y);
                        const f32x2 hh = ((ga * ua) * rs2) * rv; hv[n][2 * hf] = hh.x; hv[n][2 * hf + 1] = hh.y; }
                *(u32x4*)(H + (size_t)row * DFF + u.pn * HALF + wc * 32 + 8 * fq) = pack8(hv[0], hv[1]); }
    }
};
struct EpiRes2 {
    static constexpr bool PERM = true, KSPLIT = false;
    float* out; const bf16_t* XB;
    __device__ __forceinline__ void operator()(f32x4 (&acc)[2][2][4][2], const Unit& u, int wr, int wc, int fr, int fq) const {
#pragma unroll
        for (int ai = 0; ai < 2; ++ai) {
            u32x4 xb[4][2];
#pragma unroll
            for (int m = 0; m < 4; ++m)
#pragma unroll
                for (int bj = 0; bj < 2; ++bj) xb[m][bj] = *(const u32x4*)(XB + (size_t)(u.pm * BM + ai * HALF + wr * 64 + m * 16 + fr) * DM + u.pn * BM + wc * 32 + 8 * fq + bj * HALF);
#pragma unroll
            for (int m = 0; m < 4; ++m) { const size_t roff = (size_t)(u.pm * BM + ai * HALF + wr * 64 + m * 16 + fr) * DM + u.pn * BM + wc * 32 + 8 * fq;
#pragma unroll
                for (int bj = 0; bj < 2; ++bj) { const size_t off = roff + bj * HALF; const u32x4 x4 = xb[m][bj];
                    f32x4 v0, v1; v0[0] = bf_lo(x4.x); v0[1] = bf_hi(x4.x); v0[2] = bf_lo(x4.y); v0[3] = bf_hi(x4.y); v1[0] = bf_lo(x4.z); v1[1] = bf_hi(x4.z); v1[2] = bf_lo(x4.w); v1[3] = bf_hi(x4.w);
                    *(f32x4*)(out + off) = v0 + acc[ai][bj][m][0]; *(f32x4*)(out + off + 4) = v1 + acc[ai][bj][m][1]; } }
            asm volatile("" ::: "memory"); }
    }
};
}

#define RLX_AGENT __ATOMIC_RELAXED, __HIP_MEMORY_SCOPE_AGENT
#define XB_TMO      128
#define XB_XCNT(j)  (256  + 64 * (j))
#define XB_XSUB(j)  (1280 + 64 * (j))
#define XB_XGEN(j)  (2304 + 64 * (j))
#define XB_TOP      3328
#define XB_TOPGEN   3392
#define XCD_BAR_WORDS 3456
#define XB_SPIN_CAP (1u << 24)
__device__ __forceinline__ unsigned xb_ld(unsigned* p)              { return __hip_atomic_load(p, __ATOMIC_RELAXED, __HIP_MEMORY_SCOPE_AGENT); }
__device__ __forceinline__ unsigned xb_add(unsigned* p, unsigned v) { return __hip_atomic_fetch_add(p, v, __ATOMIC_RELAXED, __HIP_MEMORY_SCOPE_AGENT); }
__device__ __forceinline__ unsigned xb_xcc_id() { return (unsigned)__builtin_amdgcn_s_getreg((3 << 11) | 20) & 0xFu; }
#define XB_SPIN(cond, bar) do { unsigned _sp = 0; while (cond) { __builtin_amdgcn_s_sleep(1); \
    if ((++_sp & 255u) == 0u) { if (xb_ld(&(bar)[XB_TMO])) break; if (_sp > XB_SPIN_CAP) { atomicAdd(&(bar)[XB_TMO], 1u); break; } } } } while (0)
struct XcdBarrier { unsigned* bar; unsigned x; volatile LAS unsigned* st; };
__device__ __forceinline__ XcdBarrier xcd_barrier_post(unsigned* bar, volatile LAS unsigned* st) {
    XcdBarrier b; b.bar = bar; b.x = xb_xcc_id(); b.st = st;
    if (threadIdx.x == 0) (void)xb_add(&bar[XB_XCNT(b.x)], 1u);
    return b;
}
__device__ __forceinline__ void xcd_barrier_complete(unsigned* bar, unsigned x, unsigned& nloc, unsigned& nx) {
    const unsigned G = gridDim.x * gridDim.y * gridDim.z;
    unsigned sum, cnt, mine, sp = 0u;
    for (;;) {
        sum = 0u; cnt = 0u; mine = 0u;
#pragma unroll
        for (unsigned j = 0; j < 16; ++j) { const unsigned c = xb_ld(&bar[XB_XCNT(j)]); sum += c; cnt += (c > 0u) ? 1u : 0u; mine = (j == x) ? c : mine; }
        if (sum == G) break;
        __builtin_amdgcn_s_sleep(1);
        if ((++sp & 255u) == 0u) { if (xb_ld(&bar[XB_TMO])) break; if (sp > XB_SPIN_CAP) { atomicAdd(&bar[XB_TMO], 1u); break; } }
    }
    nloc = mine > 0u ? mine : 1u; nx = cnt > 0u ? cnt : 1u;
}
__device__ __forceinline__ void xcd_barrier(const XcdBarrier& b) {
    asm volatile("s_waitcnt vmcnt(0)" ::: "memory");
    __syncthreads();
    if (threadIdx.x == 0) {
        unsigned* bar = b.bar;
        __builtin_amdgcn_s_waitcnt(0);
        unsigned nloc = b.st[0], nx = b.st[1];
        if (nloc == 0u) { xcd_barrier_complete(bar, b.x, nloc, nx); b.st[0] = nloc; b.st[1] = nx; }
        const unsigned old = xb_add(&bar[XB_XSUB(b.x)], 1u);
        const unsigned gen = old / nloc;
        if (old + 1u == (gen + 1u) * nloc) {
            __builtin_amdgcn_fence(__ATOMIC_RELEASE, "agent");
            asm volatile("s_waitcnt vmcnt(0)" ::: "memory");
            const unsigned og = xb_add(&bar[XB_TOP], 1u);
            const unsigned tg = og / nx;
            if (og + 1u == (tg + 1u) * nx) xb_add(&bar[XB_TOPGEN], 1u);
            else XB_SPIN(xb_ld(&bar[XB_TOPGEN]) == tg, bar);
            __builtin_amdgcn_fence(__ATOMIC_ACQUIRE, "agent");
            xb_add(&bar[XB_XGEN(b.x)], 1u);
            asm volatile("s_waitcnt vmcnt(0)" ::: "memory");
        } else {
            XB_SPIN(xb_ld(&bar[XB_XGEN(b.x)]) == gen, bar);
            __builtin_amdgcn_fence(__ATOMIC_ACQUIRE, "agent");
            asm volatile("s_waitcnt vmcnt(0)" ::: "memory");
        }
    }
    __syncthreads();
}

struct Args { const float* in[23]; float* out; unsigned char* ws; int ph_lo, ph_hi, li, dup; };
enum { I_X = 0, I_GMIX, I_WIN, I_QG, I_KG, I_RPB, I_ARE, I_AIM, I_BRE, I_BIM, I_CRE, I_CIM, I_LS, I_D, I_WGLU, I_BGLU, I_GOA, I_GOS, I_WOUT, I_GFFN, I_WG, I_WU, I_WD };

#define LDS_WAIT() asm volatile("s_waitcnt lgkmcnt(0)" ::: "memory")

__device__ __forceinline__ void p0_transpose_item(const float* W, int N, const float* kscale, bf16_t* WT, int ldd, int drow0, int k0, int n0, int lane) {
    const int c = lane >> 3, n4 = (lane & 7) * 4;
    const float* src = W + (size_t)(k0 + 8 * c) * N + n0 + n4;
    f32x4 v[2][8];
#pragma unroll
    for (int h = 0; h < 2; ++h)
#pragma unroll
        for (int i = 0; i < 8; ++i) v[h][i] = __builtin_nontemporal_load((const f32x4*)(src + (size_t)i * N + 32 * h));
    if (kscale) { const f32x4 s0 = *(const f32x4*)(kscale + k0 + 8 * c), s1 = *(const f32x4*)(kscale + k0 + 8 * c + 4);
#pragma unroll
        for (int h = 0; h < 2; ++h)
#pragma unroll
            for (int i = 0; i < 8; ++i) v[h][i] *= (i < 4 ? s0[i & 3] : s1[i & 3]); }
#pragma unroll
    for (int h = 0; h < 2; ++h)
#pragma unroll
        for (int e = 0; e < 4; ++e) { u32x4 o; o.x = cvt_pk_bf16(v[h][0][e], v[h][1][e]); o.y = cvt_pk_bf16(v[h][2][e], v[h][3][e]); o.z = cvt_pk_bf16(v[h][4][e], v[h][5][e]); o.w = cvt_pk_bf16(v[h][6][e], v[h][7][e]);
            *(u32x4*)(WT + (size_t)(drow0 + 32 * h + n4 + e) * ldd + k0 + 8 * c) = o; }
}

__device__ __forceinline__ void dsincos(double a, double& s, double& c) {
    const double k = __builtin_rint(a * 0.63661977236758134308);
    double r = __builtin_fma(-k, 1.57079632679489655800e+00, a);
    r = __builtin_fma(-k, 6.12323399573676603587e-17, r);
    const double r2 = r * r;
    double sp = -7.6471637318198164759e-13; sp = sp * r2 + 1.6059043836821614599e-10; sp = sp * r2 - 2.5052108385441718775e-08; sp = sp * r2 + 2.7557319223985890653e-06;
    sp = sp * r2 - 1.9841269841269841270e-04; sp = sp * r2 + 8.3333333333333333333e-03; sp = sp * r2 - 1.6666666666666666667e-01; sp = sp * r2 * r + r;
    double cp = 4.7794773323873852974e-14; cp = cp * r2 - 1.1470745597729724714e-11; cp = cp * r2 + 2.0876756987868098979e-09; cp = cp * r2 - 2.7557319223985890653e-07;
    cp = cp * r2 + 2.4801587301587301587e-05; cp = cp * r2 - 1.3888888888888888889e-03; cp = cp * r2 + 4.1666666666666666667e-02; cp = cp * r2 - 0.5; cp = cp * r2 + 1.0;
    const int q = (int)((long long)k) & 3;
    s = (q == 0) ? sp : (q == 1) ? cp : (q == 2) ? -sp : -cp;
    c = (q == 0) ? cp : (q == 1) ? -sp : (q == 2) ? -cp : sp;
}

struct S5Params { f32x4 br4, bi4, cr4, ci4; float are, aim, ls; };
__device__ __forceinline__ void p0_s5_params(const Args& a, int g, int tid, S5Params& P) {
    const float* a_re = a.in[I_ARE]; const float* a_im = a.in[I_AIM]; const float* b_re = a.in[I_BRE]; const float* b_im = a.in[I_BIM];
    const float* c_re = a.in[I_CRE]; const float* c_im = a.in[I_CIM]; const float* lstep = a.in[I_LS];
#pragma unroll
    for (int j = 0; j < 4; ++j) { const int i = tid + 512 * j, c = i & 15, p = (i >> 4) & 63, d = i >> 10;
        const size_t bi = (((size_t)d * SG + g) * SP + p) * SC + c, ci = (((size_t)d * SG + g) * SC + c) * SP + p;
        P.br4[j] = b_re[bi]; P.bi4[j] = b_im[bi]; P.cr4[j] = c_re[ci]; P.ci4[j] = c_im[ci]; }
    { const int p = tid & 63, d = (tid >> 6) & 1; P.are = a_re[(d * SG + g) * SP + p]; P.aim = a_im[(d * SG + g) * SP + p]; P.ls = lstep[d * SG + g]; }
}
__device__ __forceinline__ void p0_s5_tables(const Args& a, LAS unsigned char* lds, int g, int q, int tid, const S5Params& P) {
    LAS f32x2* LP = (LAS f32x2*)lds;
    LAS float* Bb = (LAS float*)(lds + 33792);
    LAS f32x2* Cm = (LAS f32x2*)(lds + 50176);
    LAS float* Kt = (LAS float*)(lds + 66560);
    const float* dsk = a.in[I_D];
    unsigned char* ws = a.ws;
    __syncthreads();
    LAS f32x2* Fp = (LAS f32x2*)(Kt);
    if (tid < 128) { const int p = tid & 63, d = tid >> 6;
        const double lre = (double)fminf(P.are, -1e-4f), lim = (double)P.aim, dt = exp((double)P.ls);
        const double mag = exp(lre * dt); double sn, cs; dsincos(lim * dt, sn, cs);
        const double lr = mag * cs, li = mag * sn;
        const double nr = lr - 1.0, ni = li, den = 1.0 / (lre * lre + lim * lim);
        Fp[d * 64 + p] = (f32x2){(float)((nr * lre + ni * lim) * den), (float)((ni * lre - nr * lim) * den)};
        double wr_ = 1.0, wi_ = 0.0;
        for (int tau = 0; tau <= CL; ++tau) { LP[(d * 64 + p) * 33 + tau] = (f32x2){(float)wr_, (float)wi_}; const double t_ = wr_ * lr - wi_ * li; wi_ = wr_ * li + wi_ * lr; wr_ = t_; } }
    __syncthreads();
#pragma unroll
    for (int j = 0; j < 4; ++j) { const int i = tid + 512 * j, c = i & 15, p = (i >> 4) & 63, d = i >> 10; const f32x2 f = Fp[d * 64 + p];
        Bb[(d * 64 + p) * 32 + c] = f.x * P.br4[j] - f.y * P.bi4[j]; Bb[(d * 64 + p) * 32 + 16 + c] = f.x * P.bi4[j] + f.y * P.br4[j];
        Cm[i] = (f32x2){P.cr4[j], P.ci4[j]}; }
    __syncthreads();
    if (q == 0 && tid < 128) { const int p = tid & 63, d = tid >> 6; ((f32x2*)(ws + WS_LAML))[(g * 2 + d) * SP + p] = LP[(d * 64 + p) * 33 + CL]; }
    { const int wv = __builtin_amdgcn_readfirstlane(tid >> 6), l = tid & 63, c16 = l & 15, g4 = l >> 4;
#pragma unroll 1
      for (int d = 0; d < 2; ++d) {
        bf16x8 Bf[4];
#pragma unroll
        for (int ks = 0; ks < 4; ++ks) { float v[8];
#pragma unroll
            for (int j = 0; j < 8; ++j) v[j] = Bb[(d * 64 + 32 * (ks & 1) + 8 * g4 + j) * 32 + (ks >> 1) * 16 + c16];
            u32x4 w; w.x = cvt_pk_bf16(v[0], v[1]); w.y = cvt_pk_bf16(v[2], v[3]); w.z = cvt_pk_bf16(v[4], v[5]); w.w = cvt_pk_bf16(v[6], v[7]); Bf[ks] = __builtin_bit_cast(bf16x8, w); }
#pragma unroll 1
        for (int tt = 0; tt < 4; ++tt) { const int tau = wv + 8 * tt;
            f32x4 acc = (f32x4){0.f, 0.f, 0.f, 0.f};
#pragma unroll
            for (int ks = 0; ks < 2; ++ks) { float gr[8], gi[8];
#pragma unroll
                for (int j = 0; j < 8; ++j) { const int p = 32 * ks + 8 * g4 + j; const f32x2 cm = Cm[(d * 64 + p) * 16 + c16], lp = LP[(d * 64 + p) * 33 + tau];
                    gr[j] = cm.x * lp.x - cm.y * lp.y; gi[j] = -(cm.x * lp.y + cm.y * lp.x); }
                u32x4 wr_, wi_; wr_.x = cvt_pk_bf16(gr[0], gr[1]); wr_.y = cvt_pk_bf16(gr[2], gr[3]); wr_.z = cvt_pk_bf16(gr[4], gr[5]); wr_.w = cvt_pk_bf16(gr[6], gr[7]);
                wi_.x = cvt_pk_bf16(gi[0], gi[1]); wi_.y = cvt_pk_bf16(gi[2], gi[3]); wi_.z = cvt_pk_bf16(gi[4], gi[5]); wi_.w = cvt_pk_bf16(gi[6], gi[7]);
                acc = __builtin_amdgcn_mfma_f32_16x16x32_bf16(__builtin_bit_cast(bf16x8, wr_), Bf[ks], acc, 0, 0, 0);
                acc = __builtin_amdgcn_mfma_f32_16x16x32_bf16(__builtin_bit_cast(bf16x8, wi_), Bf[2 + ks], acc, 0, 0, 0); }
#pragma unroll
            for (int e = 0; e < 4; ++e) Kt[((d * 32 + tau) * 16 + 4 * g4 + e) * 16 + c16] = acc[e]; } } }
    __syncthreads();
    { const int d = q >> 1, ri = q & 1, p = tid >> 3, s0 = (tid & 7) * 4;
      bf16_t* dst = (bf16_t*)(ws + WS_WST) + ((size_t)g * 256 + q * 64 + p) * 512 + s0 * 16;
      float bx_[16], by_[16];
#pragma unroll
      for (int e = 0; e < 16; ++e) { bx_[e] = Bb[(d * 64 + p) * 32 + e]; by_[e] = Bb[(d * 64 + p) * 32 + 16 + e]; }
#pragma unroll
      for (int sp = 0; sp < 4; ++sp) { const int pw = d == 0 ? (CL - 1 - (s0 + sp)) : (s0 + sp); const f32x2 lp = LP[(d * 64 + p) * 33 + pw]; float v[16];
#pragma unroll
          for (int e = 0; e < 16; ++e) v[e] = ri == 0 ? (lp.x * bx_[e] - lp.y * by_[e]) : (lp.x * by_[e] + lp.y * bx_[e]);
          u32x4 w0, w1; w0.x = cvt_pk_bf16(v[0], v[1]); w0.y = cvt_pk_bf16(v[2], v[3]); w0.z = cvt_pk_bf16(v[4], v[5]); w0.w = cvt_pk_bf16(v[6], v[7]);
          w1.x = cvt_pk_bf16(v[8], v[9]); w1.y = cvt_pk_bf16(v[10], v[11]); w1.z = cvt_pk_bf16(v[12], v[13]); w1.w = cvt_pk_bf16(v[14], v[15]);
          *(u32x4*)(dst + sp * 16) = w0; *(u32x4*)(dst + sp * 16 + 8) = w1; } }
    { const int c = tid & 15, s = 8 * q + ((tid >> 4) & 7), hi2 = tid >> 7;
      bf16_t* dst = (bf16_t*)(ws + WS_TW) + ((size_t)g * 512 + s * 16 + c) * KS5;
      const float dsv = dsk[g * SC + c];
#pragma unroll 1
      for (int it = 0; it < 8; ++it) { const int sp = hi2 + 4 * it; f32x4 v[4];
          const LAS f32x4* k0 = (const LAS f32x4*)(Kt + ((sp <= s ? (s - sp) : (32 + sp - s)) * 16 + c) * 16);
#pragma unroll
          for (int e = 0; e < 4; ++e) v[e] = k0[e];
          if (sp == s) { const LAS f32x4* k1 = (const LAS f32x4*)(Kt + (32 * 16 + c) * 16);
#pragma unroll
              for (int e = 0; e < 4; ++e) v[e] += k1[e];
#pragma unroll
              for (int e = 0; e < 4; ++e)
#pragma unroll
                  for (int k = 0; k < 4; ++k) v[e][k] += (c == 4 * e + k) ? dsv : 0.f; }
          u32x4 w0, w1; w0.x = cvt_pk_bf16(v[0][0], v[0][1]); w0.y = cvt_pk_bf16(v[0][2], v[0][3]); w0.z = cvt_pk_bf16(v[1][0], v[1][1]); w0.w = cvt_pk_bf16(v[1][2], v[1][3]);
          w1.x = cvt_pk_bf16(v[2][0], v[2][1]); w1.y = cvt_pk_bf16(v[2][2], v[2][3]); w1.z = cvt_pk_bf16(v[3][0], v[3][1]); w1.w = cvt_pk_bf16(v[3][2], v[3][3]);
          *(u32x4*)(dst + sp * 16) = w0; *(u32x4*)(dst + sp * 16 + 8) = w1; }
      { const int d = hi2 >> 1, ri = hi2 & 1, pw = d == 0 ? (s + 1) : (CL - s);
#pragma unroll 1
        for (int pb = 0; pb < 8; ++pb) { float v[8];
#pragma unroll
            for (int e = 0; e < 8; ++e) { const int p = 8 * pb + e; const f32x2 cm = Cm[(d * 64 + p) * 16 + c], lp = LP[(d * 64 + p) * 33 + pw];
                v[e] = ri == 0 ? (cm.x * lp.x - cm.y * lp.y) : -(cm.x * lp.y + cm.y * lp.x); }
            u32x4 w; w.x = cvt_pk_bf16(v[0], v[1]); w.y = cvt_pk_bf16(v[2], v[3]); w.z = cvt_pk_bf16(v[4], v[5]); w.w = cvt_pk_bf16(v[6], v[7]);
            *(u32x4*)(dst + 512 + hi2 * 64 + 8 * pb) = w; } } }
    __syncthreads();
}

__device__ __forceinline__ void p0_prologue(const Args& a, LAS unsigned char* lds, int vcu, int G, int tid) {
    asm volatile("" : "+v"(tid));
    const int wave = __builtin_amdgcn_readfirstlane(tid >> 6), lane = tid & 63;
    unsigned char* ws = a.ws;
    S5Params P5; p0_s5_params(a, (vcu < SG * 4 ? vcu : SG * 4 - 1) >> 2, tid, P5);
    if (vcu & 1) { for (int it = vcu; it < SG * 4; it += G) { if (it != vcu) p0_s5_params(a, it >> 2, tid, P5); p0_s5_tables(a, lds, it >> 2, it & 3, tid, P5); } }
    const int gw = vcu * 8 + wave, NGW = G * 8;
    constexpr int I_IN = (DM / 64) * (INW / 64), I_GL = (SW / 64) * (SW / 64), I_OUT = (DM / 64) * (DM / 64), I_GU = (DM / 64) * (DFF / 64), I_DN = (DFF / 64) * (DM / 64);
    constexpr int NITEMS = I_IN + I_GL + I_OUT + 2 * I_GU + I_DN;
    for (int it = gw; it < NITEMS; it += NGW) {
        int r = it;
        if (r < I_IN) { const int nb = INW / 64, kb = r / nb, n0 = (r % nb) * 64; p0_transpose_item(a.in[I_WIN], INW, a.in[I_GMIX], (bf16_t*)(ws + WS_WIN), DM, n0, kb * 64, n0, lane); continue; } r -= I_IN;
        if (r < I_GL) { const int nb = SW / 64, kb = r / nb, n0 = (r % nb) * 64; p0_transpose_item(a.in[I_WGLU], SW, nullptr, (bf16_t*)(ws + WS_WGLU), SW, n0, kb * 64, n0, lane); continue; } r -= I_GL;
        if (r < I_OUT) { const int nb = DM / 64, kb = r / nb, n0 = (r % nb) * 64, k0 = kb * 64;
            p0_transpose_item(a.in[I_WOUT], DM, k0 < AW ? a.in[I_GOA] : a.in[I_GOS] - AW, (bf16_t*)(ws + WS_WOUT), DM, n0, k0, n0, lane); continue; } r -= I_OUT;
        if (r < 2 * I_GU) { const int up = r >= I_GU; if (up) r -= I_GU; const int nb = DFF / 64, kb = r / nb, n0 = (r % nb) * 64;
            p0_transpose_item(up ? a.in[I_WU] : a.in[I_WG], DFF, a.in[I_GFFN], (bf16_t*)(ws + WS_WGU), DM, 256 * (n0 >> 7) + (n0 & 127) + (up ? 128 : 0), kb * 64, n0, lane); continue; } r -= 2 * I_GU;
        { const int nb = DM / 64, kb = r / nb, n0 = (r % nb) * 64; p0_transpose_item(a.in[I_WD], DM, nullptr, (bf16_t*)(ws + WS_WD), DFF, n0, kb * 64, n0, lane); }
    }
    const float* x = a.in[I_X]; bf16_t* XN = (bf16_t*)(ws + WS_XN); float* ssq0 = (float*)(ws + WS_SSQ0);
    for (int m = gw; m < M; m += 2 * NGW) { const int m1 = m + NGW < M ? m + NGW : m;
        const f32x4* xr0 = (const f32x4*)(x + (size_t)m * DM) + lane; const f32x4* xr1 = (const f32x4*)(x + (size_t)m1 * DM) + lane; f32x4 v0[8], v1[8]; float s0 = 0.f, s1 = 0.f;
#pragma unroll
        for (int j = 0; j < 8; ++j) { v0[j] = __builtin_nontemporal_load(xr0 + 64 * j); v1[j] = __builtin_nontemporal_load(xr1 + 64 * j); }
        u32x2* o0 = (u32x2*)(XN + (size_t)m * DM) + lane; u32x2* o1 = (u32x2*)(XN + (size_t)m1 * DM) + lane;
#pragma unroll
        for (int j = 0; j < 8; ++j) { s0 += (v0[j][0] * v0[j][0] + v0[j][1] * v0[j][1]) + (v0[j][2] * v0[j][2] + v0[j][3] * v0[j][3]); s1 += (v1[j][0] * v1[j][0] + v1[j][1] * v1[j][1]) + (v1[j][2] * v1[j][2] + v1[j][3] * v1[j][3]);
            u32x2 w; w.x = cvt_pk_bf16(v0[j][0], v0[j][1]); w.y = cvt_pk_bf16(v0[j][2], v0[j][3]); o0[64 * j] = w;
            u32x2 w2; w2.x = cvt_pk_bf16(v1[j][0], v1[j][1]); w2.y = cvt_pk_bf16(v1[j][2], v1[j][3]); o1[64 * j] = w2; }
        s0 = wave_sum(s0); s1 = wave_sum(s1);
        if (lane == 0) { ssq0[m] = s0; ssq0[m1] = s1; }
    }
    if (!(vcu & 1)) { for (int it = vcu; it < SG * 4; it += G) { if (it != vcu) p0_s5_params(a, it >> 2, tid, P5); p0_s5_tables(a, lds, it >> 2, it & 3, tid, P5); } }
}

constexpr int ATT_PF = 6;
constexpr int KROW = 144, AROW = 160;
constexpr int AHEAD = 64 * AROW;
constexpr int ABUF = 2 * AHEAD;
constexpr int ABUF2 = 2 * ABUF;
constexpr int ATT_RPB_OFF = 2 * ABUF2;
static_assert(ATT_RPB_OFF + 16 * 465 * 4 <= MISC_OFF, "attention LDS");

__device__ __forceinline__ void attn_phase(const Args& a, LAS unsigned char* lds, volatile LAS unsigned* MISC, int vcu, int G, int has_g2, int tid) {
    asm volatile("" : "+v"(tid));
    const int wave = __builtin_amdgcn_readfirstlane(tid >> 6), lane = tid & 63, ql = lane & 15, g4 = lane >> 4;
    const bf16_t* QKV = (const bf16_t*)(a.ws + WS_BIG); bf16_t* YAYS = (bf16_t*)(a.ws + WS_YAYS); float* ssqa16 = (float*)(a.ws + WS_SSQA16);
    LAS float* rpbL = (LAS float*)(lds + ATT_RPB_OFF);
    for (int i = tid; i < 16 * 465; i += 512) rpbL[i] = a.in[I_RPB][i] * 1.44269504089f;
    const int j = wave & 3, hsel = wave >> 2;
    const int cq = 16 * j + ql, cs = min(max(cq - 8, 0), GRIDW - 16), wb = (j == 0) ? 0 : (j == 1) ? 8 : (j == 2) ? 24 : 32;
    int it_lo, it_hi, it_step;
    if (G == 256) { const int x_ = vcu >> 5, k_ = vcu & 15; it_step = 16; if (has_g2) { it_lo = x_ * 256 + 208 + k_; it_hi = x_ * 256 + 256; } else { it_lo = x_ * 256 + k_; it_hi = x_ * 256 + 208; } }
    else { it_lo = vcu; it_hi = BATCH * NROWS * 8; it_step = G; }
#define ATT_FETCH(dst) do { if (tid == 0) { const int nx_ = ((dst) == 20) ? it_lo : item + it_step; MISC[dst] = (unsigned)(nx_ < it_hi ? nx_ : -1); } } while (0)
    int item = 0;
    ATT_FETCH(20);
    __syncthreads();
    item = __builtin_amdgcn_readfirstlane((int)MISC[20]);
    const int skey = tid >> 3, sch = tid & 7;
    const unsigned ldstK = (unsigned)(skey * KROW + sch * 16), ldstV = (unsigned)(skey * AROW + sch * 16);
    u32x4 R[4][4];
#define ATT_UN(it_) ((((it_) >> 8) << 5) | ((it_) & 31))
#define ATT_HP(it_) (((it_) >> 5) & 7)
#define ATT_BASE(it_) (QKV + ((size_t)(ATT_UN(it_) >> 6) * SEQ + 64 * min(max((ATT_UN(it_) & 63) - 4, 0), NROWS - 8) + skey) * NQKV + AW + 128 * ATT_HP(it_) + 8 * sch)
#define ATT_SRC2(base_, s_, rr_, i_) ((base_) + (size_t)((((s_) & 3) * 2) + (rr_)) * 64 * NQKV + ((s_) < 4 ? 0 : AW) + 64 * (i_))
#define ATT_LOAD(slot_, base_, s_) do { _Pragma("unroll") for (int rr_ = 0; rr_ < 2; ++rr_) _Pragma("unroll") for (int i_ = 0; i_ < 2; ++i_) R[slot_][rr_ * 2 + i_] = *(const u32x4*)ATT_SRC2(base_, s_, rr_, i_); } while (0)
    if (item >= 0) { const bf16_t* kb0 = ATT_BASE(item);
#pragma unroll
        for (int p = 0; p < 3; ++p) ATT_LOAD(p, kb0, p);
    }
    while (item >= 0) {
        const int un_ = ATT_UN(item), b = un_ >> 6, r = un_ & 63, hp = ATT_HP(item), h = 2 * hp + hsel, row_start = min(max(r - 4, 0), NROWS - 8);
        ATT_FETCH(21);
        const size_t tq = (size_t)b * SEQ + 64 * r + cq;
        bf16x8 Qf[2];
        { const u32x4* qp = (const u32x4*)(QKV + tq * NQKV + 64 * h + 8 * g4); Qf[0] = __builtin_bit_cast(bf16x8, qp[0]); Qf[1] = __builtin_bit_cast(bf16x8, qp[4]); }
        const LAS float* bl = rpbL + h * 465 + (row_start - r + 7) * 31 + (wb + 4 * g4 - cq + 15);
        f32x4 S[8][2]; bf16x8 Pf[8]; f32x4 O[4]; float sum = 0.f; int nitem = -1;
        const bf16_t* kcur = ATT_BASE(item); const bf16_t* knxt = kcur;
#pragma unroll
        for (int dt = 0; dt < 4; ++dt) O[dt] = (f32x4){0.f, 0.f, 0.f, 0.f};
#pragma unroll
        for (int st = 0; st < 8; ++st) {
            LAS unsigned char* buf = lds + (st & 1) * ABUF2;
            { const unsigned ld_ = st < 4 ? ldstK : ldstV;
#pragma unroll
              for (int rr = 0; rr < 2; ++rr) { *(LAS u32x4*)(buf + rr * ABUF + ld_) = R[st & 3][rr * 2]; *(LAS u32x4*)(buf + rr * ABUF + AHEAD + ld_) = R[st & 3][rr * 2 + 1]; } }
            if (st + 3 < 8) ATT_LOAD((st + 3) & 3, kcur, st + 3); else ATT_LOAD((st + 3) & 3, knxt, st + 3 - 8);
            asm volatile("s_waitcnt lgkmcnt(0)" ::: "memory"); __builtin_amdgcn_s_barrier(); asm volatile("" ::: "memory");
            if (st == 0) { nitem = __builtin_amdgcn_readfirstlane((int)MISC[21]); const int ni_ = nitem >= 0 ? nitem : item; knxt = ATT_BASE(ni_); }
#pragma unroll
            for (int rr = 0; rr < 2; ++rr) {
                const LAS unsigned char* hb = buf + rr * ABUF + hsel * AHEAD;
                if (st < 4) {
                    const int kr = 2 * st + rr;
#pragma unroll
                    for (int t = 0; t < 2; ++t) {
                        const LAS unsigned char* kp = hb + (wb + 16 * t + ql) * KROW + g4 * 16;
                        const bf16x8 k0 = *(const LAS bf16x8*)kp, k1 = *(const LAS bf16x8*)(kp + 64);
                        f32x4 acc = (f32x4){0.f, 0.f, 0.f, 0.f};
                        acc = __builtin_amdgcn_mfma_f32_16x16x32_bf16(k0, Qf[0], acc, 0, 0, 0);
                        acc = __builtin_amdgcn_mfma_f32_16x16x32_bf16(k1, Qf[1], acc, 0, 0, 0);
#pragma unroll
                        for (int e = 0; e < 4; ++e) { const int ck = wb + 16 * t + 4 * g4 + e;
                            const float bias = bl[kr * 31 + 16 * t + e];
                            acc[e] = (ck >= cs && ck < cs + 16) ? acc[e] + bias : -1e30f; }
                        S[kr][t] = acc; }
                } else {
                    const int kr = 2 * (st - 4) + rr;
                    const LAS unsigned char* rp = hb + (wb + 4 * g4 + ((lane & 15) >> 2)) * AROW + (lane & 3) * 8;
#pragma unroll
                    for (int dt = 0; dt < 4; ++dt) {
                        const s16x4 lo = __builtin_amdgcn_ds_read_tr16_b64_v4i16((LAS s16x4*)(rp + dt * 32));
                        const s16x4 hi = __builtin_amdgcn_ds_read_tr16_b64_v4i16((LAS s16x4*)(rp + 16 * AROW + dt * 32));
                        const bf16x8 av = (bf16x8){lo[0], lo[1], lo[2], lo[3], hi[0], hi[1], hi[2], hi[3]};
                        O[dt] = __builtin_amdgcn_mfma_f32_16x16x32_bf16(av, Pf[kr], O[dt], 0, 0, 0); }
                }
            }
            if (st == 3) {
#pragma unroll
                for (int k2 = 0; k2 < 8; ++k2) { f32x4 p0, p1;
#pragma unroll
                    for (int e = 0; e < 4; ++e) { p0[e] = fast_exp2(S[k2][0][e]); p1[e] = fast_exp2(S[k2][1][e]); sum += p0[e] + p1[e]; }
                    Pf[k2] = __builtin_bit_cast(bf16x8, pg8::pack8(p0, p1)); }
                sum += __shfl_xor(sum, 16); sum += __shfl_xor(sum, 32);
            }
        }
        const float inv = fast_rcp(sum); float ssq_acc = 0.f;
        bf16_t* op = YAYS + tq * DM + 64 * h + 4 * g4;
#pragma unroll
        for (int dt = 0; dt < 4; ++dt) { const f32x4 o = O[dt] * inv; ssq_acc += (o[0] * o[0] + o[1] * o[1]) + (o[2] * o[2] + o[3] * o[3]);
            u32x2 w; w.x = cvt_pk_bf16(o[0], o[1]); w.y = cvt_pk_bf16(o[2], o[3]); *(u32x2*)(op + 16 * dt) = w; }
        ssq_acc += __shfl_xor(ssq_acc, 16); ssq_acc += __shfl_xor(ssq_acc, 32);
        if (g4 == 0) ssqa16[tq * 16 + h] = ssq_acc;
        item = nitem;
    }
#undef ATT_FETCH
#undef ATT_BASE
#undef ATT_SRC2
#undef ATT_LOAD
#undef ATT_UN
#undef ATT_HP
}

__device__ __forceinline__ void scan_chain(const Args& a, int g, int pm, int tid) {
    asm volatile("" : "+v"(tid));
    if (tid >= 256) return;
    const float* E = (const float*)(a.ws + WS_E); bf16_t* A5 = (bf16_t*)(a.ws + WS_A5); const f32x2* LAML = (const f32x2*)(a.ws + WS_LAML);
    const int p = tid & 63, d = (tid >> 6) & 1, b = 2 * pm + (tid >> 7);
    const f32x2 lam = LAML[(g * 2 + d) * SP + p];
    float xr = 0.f, xi = 0.f;
    const size_t R0 = (size_t)g * RCH + b * NCH;
#pragma unroll 1
    for (int rd = 0; rd < NCH / 32; ++rd) { float er[32], ei[32];
#pragma unroll
        for (int j = 0; j < 32; ++j) { const int kk = rd * 32 + j, k = d == 0 ? kk : NCH - 1 - kk; const float* ep = E + (R0 + k) * 256 + d * 128 + p; er[j] = ep[0]; ei[j] = ep[64]; }
#pragma unroll
        for (int j = 0; j < 32; ++j) { const int kk = rd * 32 + j, k = d == 0 ? kk : NCH - 1 - kk;
            bf16_t* ap = A5 + (R0 + k) * KS5 + 512 + d * 128 + p; ap[0] = (bf16_t)(cvt_pk_bf16(xr, 0.f) & 0xffffu); ap[64] = (bf16_t)(cvt_pk_bf16(xi, 0.f) & 0xffffu);
            const float nr = lam.x * xr - lam.y * xi + er[j], ni = lam.x * xi + lam.y * xr + ei[j]; xr = nr; xi = ni; } }
}

__global__ void __launch_bounds__(512, 2) hymba_fwd(Args args) {
    extern __shared__ __attribute__((aligned(16))) unsigned char lds_raw[];
    LAS unsigned char* lds = (LAS unsigned char*)lds_raw;
    volatile LAS unsigned* MISC = (volatile LAS unsigned*)(lds + MISC_OFF);
    const int tid = threadIdx.x;
    const int G = gridDim.x; const int bx = blockIdx.x; const int vcu = (G % 8 == 0) ? (bx % 8) * (G / 8) + bx / 8 : bx;
    unsigned char* ws = args.ws;
    unsigned* ctl = (unsigned*)(ws + WS_CTL);
    for (int u = tid; u < (LDS_BYTES - MISC_OFF) / 4; u += 512) MISC[u] = 0u;
    __syncthreads();
    XcdBarrier bar; bar.bar = ctl + CW_BAR; bar.x = 0; bar.st = nullptr;
    if (MK_N_LAUNCHES == 1) bar = xcd_barrier_post(ctl + CW_BAR, MISC + 8);
    const int lo = args.ph_lo, hi = args.ph_hi;
#define IN(k) (lo <= (k) && (k) < hi)
#define SEAM(k) do { if (IN(k) && IN((k) + 1)) xcd_barrier(bar); } while (0)
    bf16_t* WIN = (bf16_t*)(ws + WS_WIN); bf16_t* WGLU = (bf16_t*)(ws + WS_WGLU); bf16_t* WOUT = (bf16_t*)(ws + WS_WOUT); bf16_t* WGU = (bf16_t*)(ws + WS_WGU); bf16_t* WD = (bf16_t*)(ws + WS_WD);
    bf16_t* WST = (bf16_t*)(ws + WS_WST); bf16_t* TW = (bf16_t*)(ws + WS_TW);
    bf16_t* XN = (bf16_t*)(ws + WS_XN); bf16_t* YG = (bf16_t*)(ws + WS_YG); bf16_t* XB = (bf16_t*)(ws + WS_XN);
    bf16_t* QKV = (bf16_t*)(ws + WS_BIG); bf16_t* A5 = (bf16_t*)(ws + WS_A5); float* E = (float*)(ws + WS_E); bf16_t* HB = (bf16_t*)(ws + WS_BIG);
    bf16_t* YAYS = (bf16_t*)(ws + WS_YAYS);
    float* ssqa16 = (float*)(ws + WS_SSQA16); float* ssqa = (float*)(ws + WS_SSQA); float* ssqs4 = (float*)(ws + WS_SSQS4); float* ssqx8 = (float*)(ws + WS_SSQX8);
    LAS float* XL = (LAS float*)(lds + RING_BYTES);

#define REP(k) _Pragma("unroll") for (int rep_ = (DUP_PHASE == (k)) ? 0 : 1; rep_ < 2; ++rep_)
#define ALPHA ((rep_ == 0 && args.dup >= 0) ? 0.0f : 1.0f)
    if (IN(0)) { REP(0) { p0_prologue(args, lds, vcu, G, tid); __syncthreads(); } SEAM(0); }
    if (IN(1)) {
        pg8::Gemm g{XN, WIN, DM, DM, DM, 0, 0}; pg8::StaticOrder S; S.init(M, INW, G, bx);
        pg8::EpiZ Ep{QKV, A5, args.in[I_QG], args.in[I_KG], XL, (const float*)(ws + WS_SSQ0)};
        REP(1) pg8::gemm_phase(lds, g, S, Ep);
        SEAM(1);
    }
    if (IN(2)) {
        for (int cidx = bx; cidx < 2 * SG; cidx += G) { const int g_ = cidx >> 1, pm_ = cidx & 1;
            { pg8::Gemm g{A5, WST, KS5, 512, 512, (size_t)RCH * KS5, (size_t)256 * 512}; pg8::ListOrder S; S.n = 1; S.u0.pm = pm_; S.u0.pn = 0; S.u0.g = g_; S.u0.kh = 0; S.u1 = S.u0;
              pg8::EpiE Ep{E};
              pg8::gemm_phase(lds, g, S, Ep); }
            asm volatile("s_waitcnt vmcnt(0)" ::: "memory"); __syncthreads();
            scan_chain(args, g_, pm_, tid);
            asm volatile("s_waitcnt vmcnt(0)" ::: "memory"); __syncthreads();
            { pg8::Gemm g{A5, TW, KS5, KS5, KS5, (size_t)RCH * KS5, (size_t)512 * KS5}; pg8::ListOrder S; S.n = 2; S.u0.pm = pm_; S.u0.pn = 0; S.u0.g = g_; S.u0.kh = 0; S.u1 = S.u0; S.u1.pn = 1;
              pg8::EpiS5Out Ep{YG};
              pg8::gemm_phase(lds, g, S, Ep); }
        }
        __syncthreads();
        attn_phase(args, lds, MISC, vcu, G, bx < 2 * SG ? 1 : 0, tid);
        SEAM(2);
    }
    if (IN(3)) {
        pg8::Gemm g{YG, WGLU, SW, SW, SW, 0, 0}; pg8::StaticOrder S; S.init(M, SW, G, bx);
        for (int t = vcu * 512 + tid; t < M; t += G * 512) { const f32x4* p = (const f32x4*)(ssqa16 + (size_t)t * 16); const f32x4 s0 = p[0], s1 = p[1], s2 = p[2], s3 = p[3];
            const f32x4 sv = (s0 + s1) + (s2 + s3); ssqa[t] = (sv[0] + sv[1]) + (sv[2] + sv[3]); }
        REP(3) { pg8::EpiGlu Ep{YG, args.in[I_BGLU], YAYS, ssqs4, XL}; pg8::gemm_phase(lds, g, S, Ep); }
        SEAM(3);
    }
    if (IN(4)) {
        pg8::Gemm g{YAYS, WOUT, DM, DM, AW, 0, 0}; pg8::SplitKOrder S; S.so.init(M, DM, G, bx);
        REP(4) { pg8::EpiRes1 Ep{XN, XB, ssqa, ssqs4, ssqx8, XL}; pg8::gemm_phase(lds, g, S, Ep); }
        SEAM(4);
    }
    if (IN(5)) {
        pg8::Gemm g{XB, WGU, DM, DM, DM, 0, 0}; pg8::StaticOrder S; S.init(M, 2 * DFF, G, bx);
        pg8::EpiSwiGLU Ep{HB, ssqx8};
        REP(5) pg8::gemm_phase(lds, g, S, Ep);
        SEAM(5);
    }
    if (IN(6)) {
        pg8::Gemm g{HB, WD, DFF, DFF, DFF, 0, 0}; pg8::StaticOrder S; S.init(M, DM, G, bx);
        REP(6) { pg8::EpiRes2 Ep{args.out, XB}; pg8::gemm_phase(lds, g, S, Ep); }
    }
#undef IN
#undef SEAM
}

extern "C" void kernel_launch(void* const* d_in, const int* in_sizes, int n_in, void* d_out, int out_size, void* d_ws, size_t ws_size, hipStream_t stream) {
    static int grid = 0;
    if (grid == 0) {
        if (n_in != 23 || in_sizes[0] != M * DM || out_size != M * DM || ws_size < WS_END) { fprintf(stderr, "kernel_launch: unexpected shapes (n_in %d, in0 %d, out %d, ws %zu < %zu)\n", n_in, n_in > 0 ? in_sizes[0] : -1, out_size, ws_size, (size_t)WS_END); grid = -1; return; }
        int dev = 0, cus = 0, per_cu = 0;
        if (hipGetDevice(&dev) != hipSuccess || hipDeviceGetAttribute(&cus, hipDeviceAttributeMultiprocessorCount, dev) != hipSuccess) { grid = -1; return; }
        if (hipFuncSetAttribute((const void*)hymba_fwd, hipFuncAttributeMaxDynamicSharedMemorySize, LDS_BYTES) != hipSuccess) { fprintf(stderr, "kernel_launch: hipFuncSetAttribute failed\n"); grid = -1; return; }
        if (hipOccupancyMaxActiveBlocksPerMultiprocessor(&per_cu, (const void*)hymba_fwd, 512, LDS_BYTES) != hipSuccess || per_cu < 1) { fprintf(stderr, "kernel_launch: occupancy query says %d blocks per CU\n", per_cu); (void)hipGetLastError(); per_cu = 1; }
        grid = cus;
    }
    if (grid < 0) return;
    (void)hipMemsetAsync((char*)d_ws + WS_CTL, 0, CTL_ZERO_BYTES, stream);
    Args a{}; a.dup = DUP_PHASE;
    for (int i = 0; i < 23; ++i) a.in[i] = (const float*)d_in[i];
    a.out = (float*)d_out; a.ws = (unsigned char*)d_ws;
    if (MK_N_LAUNCHES == 1) {
        a.ph_lo = 0; a.ph_hi = NPHASE; a.li = 0;
        hipLaunchKernelGGL(hymba_fwd, dim3(grid), dim3(512), LDS_BYTES, stream, a);
    } else {
        for (int li = 0; li < NPHASE; ++li) { a.ph_lo = li; a.ph_hi = li + 1; a.li = li; hipLaunchKernelGGL(hymba_fwd, dim3(grid), dim3(512), LDS_BYTES, stream, a); }
    }
}
```

```cpp
#include <hip/hip_runtime.h>
#include <cstdio>
#include <cstdint>

#define DUP_PHASE (-1)
#ifndef MK_N_LAUNCHES
#define MK_N_LAUNCHES 1
#endif

#define GAS __attribute__((address_space(1)))
#define LAS __attribute__((address_space(3)))
typedef unsigned short bf16_t;
typedef short bf16x8 __attribute__((ext_vector_type(8)));
typedef short s16x4 __attribute__((ext_vector_type(4)));
typedef float f32x4 __attribute__((ext_vector_type(4)));
typedef float f32x2 __attribute__((ext_vector_type(2)));
typedef unsigned u32x4 __attribute__((ext_vector_type(4)));
typedef unsigned u32x2 __attribute__((ext_vector_type(2)));

constexpr int BATCH = 4, SEQ = 4096, DM = 2048, M = BATCH * SEQ;
constexpr int AW = 1024, SW = 1024, NH = 16, HD = 64, NQKV = 3 * AW, INW = 4096, DFF = 5632;
constexpr int GRIDW = 64, NROWS = SEQ / GRIDW;
constexpr int SG = 64, SC = 16, SP = 64;
constexpr int CL = 32, NCH = SEQ / CL, RCH = M / CL;
constexpr int KS5 = CL * SC + 256;
constexpr float RMS_EPS = 1e-6f;
constexpr int NPHASE = 7;

constexpr size_t MiB = 1u << 20;
constexpr size_t WS_CTL = 0, CTL_ZERO_BYTES = 262144;
constexpr size_t WS_WIN = 1 * MiB, WS_WGLU = 17 * MiB, WS_WOUT = 19 * MiB, WS_WGU = 27 * MiB, WS_WD = 71 * MiB;
constexpr size_t WS_WST = 93 * MiB, WS_KB = 109 * MiB, WS_WO = 111 * MiB, WS_LAML = 157 * MiB;
constexpr size_t WS_XN = 158 * MiB;
constexpr size_t WS_BIG = 222 * MiB;
constexpr size_t WS_A5 = WS_BIG + 96 * MiB, WS_E = WS_BIG + 144 * MiB;
constexpr size_t WS_YAYS = 398 * MiB, WS_SSQ = 462 * MiB, WS_YG = 464 * MiB, WS_END = 496 * MiB;
constexpr size_t WS_SSQA16 = WS_SSQ, WS_SSQA = WS_SSQ + 1 * MiB, WS_SSQS4 = WS_SSQA + 65536, WS_SSQX8 = WS_SSQS4 + 4 * 65536, WS_SSQ0 = WS_SSQX8 + 8 * 65536;
static_assert(WS_SSQ0 + 65536 <= WS_END, "ssq");
constexpr int CW_BAR = 4096;
constexpr int CW_GBAR = 8192;
static_assert((size_t)(CW_GBAR + 8 * 3456) * 4 <= CTL_ZERO_BYTES, "ctl");

constexpr int RING_BYTES = 131072;
constexpr int MISC_OFF = 143360;
constexpr int LDS_BYTES = 147456;

__device__ __forceinline__ unsigned cvt_pk_bf16(float lo, float hi) { unsigned r; asm volatile("v_cvt_pk_bf16_f32 %0, %1, %2" : "=v"(r) : "v"(lo), "v"(hi)); return r; }
__device__ __forceinline__ float bf_lo(unsigned w) { return __uint_as_float(w << 16); }
__device__ __forceinline__ float bf_hi(unsigned w) { return __uint_as_float(w & 0xffff0000u); }
__device__ __forceinline__ float fast_rcp(float x) { return __builtin_amdgcn_rcpf(x); }
__device__ __forceinline__ float fast_exp2(float x) { return __builtin_amdgcn_exp2f(x); }
__device__ __forceinline__ float sigmoidf_(float x) { return fast_rcp(1.0f + fast_exp2(-1.44269504089f * x)); }
__device__ __forceinline__ float gelu_tanh(float x) { const float t = x * (1.0f + 0.044715f * x * x); return x * fast_rcp(1.0f + fast_exp2(-2.30220818f * t)); }
__device__ __forceinline__ float wave_sum(float v) {
#pragma unroll
    for (int o = 1; o < 64; o <<= 1) v += __shfl_xor(v, o);
    return v;
}

namespace pg8 {
constexpr int BM = 256, BK = 64, HALF = 128, HTB = HALF * BK * 2, NXCD = 8, WGM = 8;
__host__ __device__ __forceinline__ int lds_byte(int r, int c) { const int st = (r >> 4) * 2 + (c >> 5), rr = r & 15, cc = c & 31, ob = rr * 64 + cc * 2; return st * 1024 + (ob ^ (((ob >> 9) & 1) << 5)); }
__host__ __device__ __forceinline__ void stage_rc(int b, int& R, int& C) { const int st = b / 1024, sb = b % 1024, swz = sb ^ (((sb >> 9) & 1) << 5); R = (st >> 1) * 16 + swz / 64; C = (st & 1) * 32 + (swz % 64) / 2; }
__host__ __device__ __forceinline__ int perm32(int rho) { const int n = rho >> 4, i = rho & 15; return 8 * (i >> 2) + 4 * n + (i & 3); }

struct Unit { int pm, pn, g, kh; };
struct Gemm { const bf16_t* A; const bf16_t* Bt; int lda, ldb, K; size_t sA, sB; const bf16_t* Bt2; };

struct StaticOrder {
    int nM, nN, nwg, G, c;
    __device__ void init(int M_, int N_, int G_, int c_) { nM = M_ / BM; nN = N_ / BM; nwg = nM * nN; G = G_; c = c_; }
    __device__ bool next(int i, Unit& u) const {
        const long L = (long)i * G + c; if (L >= nwg) return false;
        int wgid = (int)L; { const int q = nwg / NXCD, r = nwg % NXCD, xcd = wgid % NXCD, off = wgid / NXCD; wgid = (xcd < r ? xcd * (q + 1) : r * (q + 1) + (xcd - r) * q) + off; }
        const int nig = WGM * nN, gid = wgid / nig, fm = gid * WGM, gsz = (nM - fm) < WGM ? (nM - fm) : WGM;
        u.pm = fm + ((wgid % nig) % gsz); u.pn = (wgid % nig) / gsz; u.g = 0; u.kh = 0; return true;
    }
};
struct SplitKOrder {
    StaticOrder so;
    __device__ bool next(int i, Unit& u) const { if (!so.next(i >> 1, u)) return false; u.kh = i & 1; return true; }
};
struct ListOrder {
    int n; Unit u0, u1;
    __device__ bool next(int i, Unit& u) const { if (i >= n) return false; u = i == 0 ? u0 : u1; return true; }
};
struct BatchOrder {
    int nM, nN, nwg, G, c;
    __device__ void init(int nM_, int nN_, int nb, int G_, int c_) { nM = nM_; nN = nN_; nwg = nM * nN * nb; G = G_; c = c_; }
    __device__ bool next(int i, Unit& u) const {
        const long L = (long)i * G + c; if (L >= nwg) return false;
        const int l = (int)L; u.pn = l % nN; u.pm = (l / nN) % nM; u.g = (l / (nN * nM)) % SG; u.kh = 0; return true;
    }
};

template <class Epi, class Sched>
__device__ __forceinline__ void gemm_phase(LAS unsigned char* lds, const Gemm g, const Sched& S, const Epi& E) {
    int tid = threadIdx.x; asm volatile("" : "+v"(tid));
    const int wid = __builtin_amdgcn_readfirstlane(tid >> 6), lane = tid & 63, wr = wid >> 2, wc = wid & 3, fr = lane & 15, fq = lane >> 4;
    const int K = g.K, nt = K / BK;
    unsigned voffA[2], voffB[2], voffT[2], voffS[2];
#pragma unroll
    for (int i = 0; i < 2; ++i) { int R, C; stage_rc(tid * 16 + i * 8192, R, C); const int Rb = Epi::PERM ? ((R & ~31) + perm32(R & 31)) : R;
        voffA[i] = (unsigned)(R * g.lda + C) * 2u; voffB[i] = (unsigned)(Rb * g.ldb + C) * 2u;
        voffT[i] = (unsigned)((((Rb >> 4) - (C >> 4) + 3) * 256 + (Rb & 15) * 16 + (C & 15)) * 2); voffS[i] = (unsigned)(Rb * 256 + C) * 2u; }
    const size_t kstep = (size_t)(BK * 2);
    const size_t hstepA = (size_t)HALF * g.lda * 2, hstepB = (size_t)HALF * g.ldb * 2;
    const unsigned ldsw = (unsigned)wid * 1024u;
    const int aoff = lds_byte(wr * 64 + fr, fq * 8), boff = lds_byte(wc * 32 + fr, fq * 8);
#define PG8_SA(b, h) (((b) * 2 + (h)) * HTB)
#define PG8_SB(b, h) ((4 + (b) * 2 + (h)) * HTB)
#define PG8_STAGE(bufoff, gbase, voff) do { _Pragma("unroll") for (int _i = 0; _i < 2; ++_i) \
        __builtin_amdgcn_global_load_lds((const unsigned*)((const char*)(gbase) + (voff)[_i]), (LAS unsigned*)(lds + (bufoff) + ldsw + _i * 8192), 16, 0, 0); } while (0)
#define PG8_LDA(dst, b, h) do { _Pragma("unroll") for (int m = 0; m < 4; ++m) _Pragma("unroll") for (int k = 0; k < 2; ++k) dst[m][k] = *(const LAS bf16x8*)(lds + PG8_SA(b, h) + aoff + m * 2048 + k * 1024); } while (0)
#define PG8_LDB(dst, b, h) do { _Pragma("unroll") for (int n = 0; n < 2; ++n) _Pragma("unroll") for (int k = 0; k < 2; ++k) dst[n][k] = *(const LAS bf16x8*)(lds + PG8_SB(b, h) + boff + n * 2048 + k * 1024); } while (0)
#define PG8_MMA(ai, bj, At, Bt) do { __builtin_amdgcn_s_setprio(1); _Pragma("unroll") for (int m = 0; m < 4; ++m) _Pragma("unroll") for (int n = 0; n < 2; ++n) _Pragma("unroll") for (int k = 0; k < 2; ++k) \
        acc[ai][bj][m][n] = __builtin_amdgcn_mfma_f32_16x16x32_bf16(Bt[n][k], At[m][k], acc[ai][bj][m][n], 0, 0, 0); __builtin_amdgcn_s_setprio(0); } while (0)
#define PG8_WAIT_V(n) asm volatile("s_waitcnt vmcnt(" #n ")" ::: "memory")
#define PG8_WAIT_L(n) asm volatile("s_waitcnt lgkmcnt(" #n ")" ::: "memory")
#define PG8_BAR __builtin_amdgcn_s_barrier()
#define PG8_SCHED __builtin_amdgcn_sched_barrier(0)
    Unit cur, nxt; int ui = 0;
    if (!S.next(0, cur)) return;
    f32x4 acc[2][2][4][2];
#pragma unroll
    for (int a = 0; a < 2; ++a)
#pragma unroll
        for (int b = 0; b < 2; ++b)
#pragma unroll
            for (int m = 0; m < 4; ++m)
#pragma unroll
                for (int n = 0; n < 2; ++n) acc[a][b][m][n] = (f32x4){0.f, 0.f, 0.f, 0.f};
    bf16x8 At[4][2], B0[2][2], B1[2][2];
    const char* cA = (const char*)g.A + ((size_t)cur.g * g.sA + (size_t)cur.pm * BM * g.lda + (size_t)cur.kh * K) * 2;
    const char* cB = (const char*)g.Bt + ((size_t)cur.g * g.sB + (size_t)cur.pn * BM * g.ldb + (size_t)cur.kh * K) * 2;
#define PG8_TBASE(u_) ((const char*)g.Bt + ((size_t)(u_).g * 64 * 256 + (size_t)(28 + 16 * (u_).pn) * 256) * 2)
#define PG8_SBASE(u_) ((const char*)g.Bt2 + ((size_t)(u_).g * 512 * 256 + (size_t)(u_).pn * BM * 256) * 2)
    const char* cT = PG8_TBASE(cur); const char* cS = PG8_SBASE(cur);
#define PG8_STAGE_B(bufoff, ub_, ut_, us_, tile_, half_) do { \
        if constexpr (Epi::TOEP) { const int tl_ = (tile_); const bool tz_ = tl_ < 8; \
            const char* bp_ = tz_ ? (ut_) - (size_t)tl_ * 2048 + (size_t)(half_) * 4096 : (us_) + (size_t)(tl_ - 8) * 128 + (size_t)(half_) * (HALF * 256 * 2); \
            unsigned vo_[2]; vo_[0] = tz_ ? voffT[0] : voffS[0]; vo_[1] = tz_ ? voffT[1] : voffS[1]; PG8_STAGE(bufoff, bp_, vo_); } \
        else PG8_STAGE(bufoff, (ub_) + (size_t)(tile_) * kstep + (size_t)(half_) * hstepB, voffB); } while (0)
    PG8_STAGE_B(PG8_SB(0, 0), cB, cT, cS, 0, 0); PG8_STAGE_B(PG8_SB(0, 1), cB, cT, cS, 0, 1); PG8_STAGE(PG8_SA(0, 0), cA, voffA); PG8_STAGE(PG8_SA(0, 1), cA + hstepA, voffA);
    if (wr == 1) PG8_BAR;
    PG8_WAIT_V(2); PG8_BAR;
    PG8_STAGE_B(PG8_SB(1, 0), cB, cT, cS, 1, 0); PG8_STAGE(PG8_SA(1, 0), cA + kstep, voffA); PG8_STAGE_B(PG8_SB(1, 1), cB, cT, cS, 1, 1);
    PG8_WAIT_V(6); PG8_BAR;
    for (;;) {
        const bool has_next = S.next(ui + 1, nxt);
        const char* nA = has_next ? (const char*)g.A + ((size_t)nxt.g * g.sA + (size_t)nxt.pm * BM * g.lda + (size_t)nxt.kh * K) * 2 : cA;
        const char* nB = has_next ? (const char*)g.Bt + ((size_t)nxt.g * g.sB + (size_t)nxt.pn * BM * g.ldb + (size_t)nxt.kh * K) * 2 : cB;
        const char* nT = has_next ? PG8_TBASE(nxt) : cT; const char* nS = has_next ? PG8_SBASE(nxt) : cS;
        for (int t = 0; t < nt; t += 2) {
            const bool last = (t == nt - 2);
            const char* a1 = cA + (size_t)(t + 1) * kstep;
            const char* a2 = last ? nA : cA + (size_t)(t + 2) * kstep; const char* a3 = a2 + kstep;
            const char* ub2 = last ? nB : cB; const char* ut2 = last ? nT : cT; const char* us2 = last ? nS : cS; const int ti2 = last ? 0 : t + 2;
            PG8_LDB(B0, 0, 0); PG8_LDB(B1, 0, 1); PG8_SCHED; PG8_LDA(At, 0, 0); PG8_STAGE(PG8_SA(1, 1), a1 + hstepA, voffA);
            PG8_WAIT_V(8); PG8_WAIT_L(0); PG8_BAR; PG8_MMA(0, 0, At, B0); PG8_MMA(0, 1, At, B1); PG8_BAR; PG8_SCHED;
            PG8_LDA(At, 0, 1); PG8_STAGE_B(PG8_SB(0, 0), ub2, ut2, us2, ti2, 0); PG8_STAGE_B(PG8_SB(0, 1), ub2, ut2, us2, ti2, 1); PG8_STAGE(PG8_SA(0, 0), a2, voffA);
            PG8_WAIT_V(8); PG8_WAIT_L(0); PG8_BAR; PG8_MMA(1, 0, At, B0); PG8_MMA(1, 1, At, B1); PG8_BAR; PG8_SCHED;
            PG8_LDB(B0, 1, 0); PG8_LDB(B1, 1, 1); PG8_SCHED; PG8_LDA(At, 1, 0); PG8_STAGE(PG8_SA(0, 1), a2 + hstepA, voffA);
            PG8_WAIT_V(8); PG8_WAIT_L(0); PG8_BAR; PG8_MMA(0, 0, At, B0); PG8_MMA(0, 1, At, B1); PG8_BAR; PG8_SCHED;
            PG8_LDA(At, 1, 1); PG8_STAGE_B(PG8_SB(1, 0), ub2, ut2, us2, ti2 + 1, 0); PG8_STAGE_B(PG8_SB(1, 1), ub2, ut2, us2, ti2 + 1, 1); PG8_STAGE(PG8_SA(1, 0), a3, voffA);
            PG8_WAIT_V(8); PG8_WAIT_L(0); PG8_BAR; PG8_MMA(1, 0, At, B0); PG8_MMA(1, 1, At, B1); PG8_BAR; PG8_SCHED;
        }
        if (wr == 0) PG8_BAR;
        E(acc, cur, wr, wc, fr, fq);
        if (!has_next) break;
        if (!(Epi::KSPLIT && cur.kh == 0)) {
#pragma unroll
        for (int a = 0; a < 2; ++a)
#pragma unroll
            for (int b = 0; b < 2; ++b)
#pragma unroll
                for (int m = 0; m < 4; ++m)
#pragma unroll
                    for (int n = 0; n < 2; ++n) acc[a][b][m][n] = (f32x4){0.f, 0.f, 0.f, 0.f};
        }
        cur = nxt; cA = nA; cB = nB; cT = nT; cS = nS; ++ui;
        if (wr == 1) PG8_BAR;
    }
    PG8_WAIT_V(0);
    PG8_BAR;
#undef PG8_SA
#undef PG8_SB
#undef PG8_STAGE
#undef PG8_STAGE_B
#undef PG8_TBASE
#undef PG8_SBASE
#undef PG8_LDA
#undef PG8_LDB
#undef PG8_MMA
#undef PG8_WAIT_V
#undef PG8_WAIT_L
#undef PG8_BAR
#undef PG8_SCHED
}

__device__ __forceinline__ u32x4 pack8(const f32x4 a, const f32x4 b) { u32x4 w; w.x = cvt_pk_bf16(a[0], a[1]); w.y = cvt_pk_bf16(a[2], a[3]); w.z = cvt_pk_bf16(b[0], b[1]); w.w = cvt_pk_bf16(b[2], b[3]); return w; }

struct EpiZ {
    static constexpr bool PERM = true, KSPLIT = false, TOEP = false;
    bf16_t* QKV; bf16_t* A5; const float* qg; const float* kg; LAS float* X; const float* ssq0;
    __device__ __forceinline__ void operator()(f32x4 (&acc)[2][2][4][2], const Unit& u, int wr, int wc, int fr, int fq) const {
        float rs0[2][4];
#pragma unroll
        for (int ai = 0; ai < 2; ++ai)
#pragma unroll
            for (int m = 0; m < 4; ++m) rs0[ai][m] = __builtin_amdgcn_rsqf(ssq0[u.pm * BM + ai * HALF + wr * 64 + m * 16 + fr] * (1.0f / DM) + RMS_EPS);
        if (u.pn < 8) {
#pragma unroll
            for (int ai = 0; ai < 2; ++ai)
#pragma unroll
                for (int m = 0; m < 4; ++m)
#pragma unroll
                    for (int bj = 0; bj < 2; ++bj) { const f32x4 a0 = acc[ai][bj][m][0], a1 = acc[ai][bj][m][1];
                        float ss = (a0[0] * a0[0] + a0[1] * a0[1]) + (a0[2] * a0[2] + a0[3] * a0[3]) + (a1[0] * a1[0] + a1[1] * a1[1]) + (a1[2] * a1[2] + a1[3] * a1[3]);
                        ss += __shfl_xor(ss, 16); ss += __shfl_xor(ss, 32);
                        if (fq == 0) X[(ai * HALF + wr * 64 + m * 16 + fr) * 8 + bj * 4 + wc] = ss; }
            asm volatile("s_waitcnt lgkmcnt(0)" ::: "memory"); __builtin_amdgcn_s_barrier(); asm volatile("" ::: "memory");
            const float* gp = (u.pn < 4 ? qg : kg) + ((wc & 1) * 32 + 8 * fq); const float gs = u.pn < 4 ? 0.125f * 1.44269504089f : 1.0f;
            const f32x4 g0 = *(const f32x4*)gp * gs, g1 = *(const f32x4*)(gp + 4) * gs;
#pragma unroll
            for (int ai = 0; ai < 2; ++ai)
#pragma unroll
                for (int m = 0; m < 4; ++m) { const int rl = ai * HALF + wr * 64 + m * 16 + fr, row = u.pm * BM + rl;
#pragma unroll
                    for (int bj = 0; bj < 2; ++bj) { const f32x2 pr = *(const LAS f32x2*)(X + rl * 8 + bj * 4 + (wc & 2)); const float r0 = rs0[ai][m], rn = r0 * __builtin_amdgcn_rsqf((pr.x + pr.y) * (r0 * r0) * (1.0f / HD) + RMS_EPS);
                        const int c8 = u.pn * BM + bj * HALF + wc * 32 + 8 * fq;
                        *(u32x4*)(QKV + (size_t)row * NQKV + c8) = pack8(acc[ai][bj][m][0] * g0 * rn, acc[ai][bj][m][1] * g1 * rn); } }
            return;
        }
#pragma unroll
        for (int ai = 0; ai < 2; ++ai)
#pragma unroll
            for (int m = 0; m < 4; ++m) { const int row = u.pm * BM + ai * HALF + wr * 64 + m * 16 + fr;
#pragma unroll
                for (int bj = 0; bj < 2; ++bj) { const int c8 = u.pn * BM + bj * HALF + wc * 32 + 8 * fq; const u32x4 w = pack8(acc[ai][bj][m][0] * rs0[ai][m], acc[ai][bj][m][1] * rs0[ai][m]);
                    if (u.pn < 12) *(u32x4*)(QKV + (size_t)row * NQKV + c8) = w;
                    else { const int ch = c8 - NQKV, gg = ch >> 4, c0 = ch & 15, R = row >> 5, s = row & 31; *(u32x4*)(A5 + ((size_t)gg * RCH + R) * KS5 + s * SC + c0) = w; } } }
    }
};
struct EpiE {
    static constexpr bool PERM = false, KSPLIT = false, TOEP = false;
    float* E;
    __device__ __forceinline__ void operator()(f32x4 (&acc)[2][2][4][2], const Unit& u, int wr, int wc, int fr, int fq) const {
#pragma unroll
        for (int ai = 0; ai < 2; ++ai)
#pragma unroll
            for (int m = 0; m < 4; ++m) { const int R = u.pm * BM + ai * HALF + wr * 64 + m * 16 + fr; float* rowp = E + ((size_t)u.g * RCH + R) * 256 + wc * 32 + 4 * fq;
#pragma unroll
                for (int bj = 0; bj < 2; ++bj)
#pragma unroll
                    for (int n = 0; n < 2; ++n) *(f32x4*)(rowp + bj * HALF + n * 16) = acc[ai][bj][m][n]; }
    }
};
struct EpiS5Out {
    static constexpr bool PERM = true, KSPLIT = false, TOEP = true;
    bf16_t* Yg;
    __device__ __forceinline__ void operator()(f32x4 (&acc)[2][2][4][2], const Unit& u, int wr, int wc, int fr, int fq) const {
#pragma unroll
        for (int ai = 0; ai < 2; ++ai)
#pragma unroll
            for (int m = 0; m < 4; ++m) { const int R = u.pm * BM + ai * HALF + wr * 64 + m * 16 + fr;
#pragma unroll
                for (int bj = 0; bj < 2; ++bj) { const int n8 = u.pn * BM + bj * HALF + wc * 32 + 8 * fq, s = n8 >> 4, c0 = n8 & 15;
                    f32x4 vv[2];
#pragma unroll
                    for (int n = 0; n < 2; ++n)
#pragma unroll
                        for (int hf = 0; hf < 2; ++hf) { const f32x2 xv = (f32x2){acc[ai][bj][m][n][2 * hf], acc[ai][bj][m][n][2 * hf + 1]};
                            const f32x2 t = (xv * -2.30220818f) * ((xv * xv) * 0.044715f + 1.0f); f32x2 ev; ev.x = fast_exp2(t.x); ev.y = fast_exp2(t.y);
                            const f32x2 dv = ev + 1.0f; f32x2 rv; rv.x = fast_rcp(dv.x); rv.y = fast_rcp(dv.y);
                            const f32x2 yv = xv * rv; vv[n][2 * hf] = yv.x; vv[n][2 * hf + 1] = yv.y; }
                    *(u32x4*)(Yg + (size_t)(R * CL + s) * SW + u.g * SC + c0) = pack8(vv[0], vv[1]); } }
    }
};
struct EpiGlu {
    static constexpr bool PERM = true, KSPLIT = false, TOEP = false;
    const bf16_t* Yg; const float* bias; bf16_t* YAYS; float* ssq4; LAS float* X;
    __device__ __forceinline__ void operator()(f32x4 (&acc)[2][2][4][2], const Unit& u, int wr, int wc, int fr, int fq) const {
        const int c8b = u.pn * BM + wc * 32 + 8 * fq;
        f32x4 bv[2][2];
#pragma unroll
        for (int bj = 0; bj < 2; ++bj)
#pragma unroll
            for (int n = 0; n < 2; ++n) bv[bj][n] = *(const f32x4*)(bias + c8b + bj * HALF + 4 * n);
#pragma unroll
        for (int ai = 0; ai < 2; ++ai) {
            u32x4 yv[4][2];
#pragma unroll
            for (int m = 0; m < 4; ++m)
#pragma unroll
                for (int bj = 0; bj < 2; ++bj) yv[m][bj] = *(const u32x4*)(Yg + (size_t)(u.pm * BM + ai * HALF + wr * 64 + m * 16 + fr) * SW + c8b + bj * HALF);
#pragma unroll
            for (int m = 0; m < 4; ++m) { const int row = u.pm * BM + ai * HALF + wr * 64 + m * 16 + fr; float ss = 0.f;
#pragma unroll
                for (int bj = 0; bj < 2; ++bj) { const int c8 = c8b + bj * HALF; const u32x4 y = yv[m][bj];
                    const f32x4 a0 = acc[ai][bj][m][0] + bv[bj][0], a1 = acc[ai][bj][m][1] + bv[bj][1];
                    f32x4 v0, v1;
                    { const unsigned yw[4] = {y.x, y.y, y.z, y.w};
#pragma unroll
                      for (int hf = 0; hf < 4; ++hf) { const f32x2 av = hf < 2 ? (f32x2){a0[2 * hf], a0[2 * hf + 1]} : (f32x2){a1[2 * hf - 4], a1[2 * hf - 3]};
                          const f32x2 t = av * -1.44269504089f; f32x2 ev; ev.x = fast_exp2(t.x); ev.y = fast_exp2(t.y);
                          const f32x2 dv = ev + 1.0f; f32x2 rv; rv.x = fast_rcp(dv.x); rv.y = fast_rcp(dv.y);
                          const f32x2 yv = (f32x2){bf_lo(yw[hf]), bf_hi(yw[hf])} * rv;
                          if (hf < 2) { v0[2 * hf] = yv.x; v0[2 * hf + 1] = yv.y; } else { v1[2 * hf - 4] = yv.x; v1[2 * hf - 3] = yv.y; } } }
#pragma unroll
                    for (int e = 0; e < 4; ++e) ss += v0[e] * v0[e] + v1[e] * v1[e];
                    *(u32x4*)(YAYS + (size_t)row * DM + AW + c8) = pack8(v0, v1); }
                ss += __shfl_xor(ss, 16); ss += __shfl_xor(ss, 32);
                if (fq == 0) X[(ai * HALF + wr * 64 + m * 16 + fr) * 4 + wc] = ss; }
            asm volatile("" ::: "memory"); }
        asm volatile("s_waitcnt lgkmcnt(0)" ::: "memory"); __builtin_amdgcn_s_barrier(); asm volatile("" ::: "memory");
        if (wc == 0 && fq == 0) {
#pragma unroll
            for (int ai = 0; ai < 2; ++ai)
#pragma unroll
                for (int m = 0; m < 4; ++m) { const int rl = ai * HALF + wr * 64 + m * 16 + fr; const f32x4 p = *(const LAS f32x4*)(X + rl * 4);
                    ssq4[(size_t)u.pn * M + u.pm * BM + rl] = (p[0] + p[1]) + (p[2] + p[3]); } }
    }
};
struct EpiRes1 {
    static constexpr bool PERM = true, KSPLIT = true, TOEP = false;
    const bf16_t* xb; bf16_t* XB; const float* ssqa16; const float* ssqs4; float* ssqx8; LAS float* X;
    __device__ __forceinline__ void operator()(f32x4 (&acc)[2][2][4][2], const Unit& u, int wr, int wc, int fr, int fq) const {
        if (u.kh == 0) {
#pragma unroll
        for (int ai = 0; ai < 2; ++ai)
#pragma unroll
            for (int m = 0; m < 4; ++m) { const int row = u.pm * BM + ai * HALF + wr * 64 + m * 16 + fr;
                const float sq = (ssqs4[row] + ssqs4[M + row]) + (ssqs4[2 * M + row] + ssqs4[3 * M + row]);
                const f32x4* pa = (const f32x4*)(ssqa16 + (size_t)row * 16); const f32x4 sa4 = (pa[0] + pa[1]) + (pa[2] + pa[3]); const float sa = (sa4[0] + sa4[1]) + (sa4[2] + sa4[3]);
                const float ra = __builtin_amdgcn_rsqf(sa * (1.0f / AW) + RMS_EPS), rs = __builtin_amdgcn_rsqf(sq * (1.0f / SW) + RMS_EPS), f = ra * fast_rcp(rs);
#pragma unroll
                for (int bj = 0; bj < 2; ++bj)
#pragma unroll
                    for (int n = 0; n < 2; ++n) acc[ai][bj][m][n] *= f; }
        return; }
        float rsv[2][4];
#pragma unroll
        for (int ai = 0; ai < 2; ++ai)
#pragma unroll
            for (int m = 0; m < 4; ++m) { const int row = u.pm * BM + ai * HALF + wr * 64 + m * 16 + fr;
                const float sq = (ssqs4[row] + ssqs4[M + row]) + (ssqs4[2 * M + row] + ssqs4[3 * M + row]); rsv[ai][m] = __builtin_amdgcn_rsqf(sq * (1.0f / SW) + RMS_EPS); }
#pragma unroll
        for (int am = 0; am < 4; ++am) { const int ai = am >> 1, mb = (am & 1) * 2;
            u32x4 xv[2][2];
#pragma unroll
            for (int mm = 0; mm < 2; ++mm)
#pragma unroll
                for (int bj = 0; bj < 2; ++bj) xv[mm][bj] = *(const u32x4*)(xb + (size_t)(u.pm * BM + ai * HALF + wr * 64 + (mb + mm) * 16 + fr) * DM + u.pn * BM + bj * HALF + wc * 32 + 8 * fq);
#pragma unroll
            for (int mm = 0; mm < 2; ++mm) { const int m = mb + mm; const int row = u.pm * BM + ai * HALF + wr * 64 + m * 16 + fr; float ss = 0.f; const float rs = rsv[ai][m];
#pragma unroll
                for (int bj = 0; bj < 2; ++bj) { const size_t off = (size_t)row * DM + u.pn * BM + bj * HALF + wc * 32 + 8 * fq;
                    const u32x4 x4 = xv[mm][bj]; f32x4 x0, x1; x0[0] = bf_lo(x4.x); x0[1] = bf_hi(x4.x); x0[2] = bf_lo(x4.y); x0[3] = bf_hi(x4.y); x1[0] = bf_lo(x4.z); x1[1] = bf_hi(x4.z); x1[2] = bf_lo(x4.w); x1[3] = bf_hi(x4.w);
                    const f32x4 v0 = x0 + acc[ai][bj][m][0] * rs, v1 = x1 + acc[ai][bj][m][1] * rs;
#pragma unroll
                    for (int e = 0; e < 4; ++e) ss += v0[e] * v0[e] + v1[e] * v1[e];
                    *(u32x4*)(XB + off) = pack8(v0, v1); }
                ss += __shfl_xor(ss, 16); ss += __shfl_xor(ss, 32);
                if (fq == 0) X[(ai * HALF + wr * 64 + m * 16 + fr) * 4 + wc] = ss; }
            asm volatile("" ::: "memory"); }
        asm volatile("s_waitcnt lgkmcnt(0)" ::: "memory"); __builtin_amdgcn_s_barrier(); asm volatile("" ::: "memory");
        if (wc == 0 && fq == 0) {
#pragma unroll
            for (int ai = 0; ai < 2; ++ai)
#pragma unroll
                for (int m = 0; m < 4; ++m) { const int rl = ai * HALF + wr * 64 + m * 16 + fr; const f32x4 p = *(const LAS f32x4*)(X + rl * 4);
                    ssqx8[(size_t)u.pn * M + u.pm * BM + rl] = (p[0] + p[1]) + (p[2] + p[3]); } }
    }
};
struct EpiSwiGLU {
    static constexpr bool PERM = true, KSPLIT = false, TOEP = false;
    bf16_t* H; const float* ssqx8; mutable float rsv[2][4]; mutable int cpm;
    __device__ __forceinline__ void operator()(f32x4 (&acc)[2][2][4][2], const Unit& u, int wr, int wc, int fr, int fq) const {
        if (u.pm != cpm) { cpm = u.pm;
#pragma unroll
        for (int ai = 0; ai < 2; ++ai)
#pragma unroll
            for (int m = 0; m < 4; ++m) { const int row = u.pm * BM + ai * HALF + wr * 64 + m * 16 + fr; float sq = 0.f;
#pragma unroll
                for (int t = 0; t < 8; ++t) sq += ssqx8[(size_t)t * M + row];
                rsv[ai][m] = __builtin_amdgcn_rsqf(sq * (1.0f / DM) + RMS_EPS); } }
#pragma unroll
        for (int ai = 0; ai < 2; ++ai)
#pragma unroll
            for (int m = 0; m < 4; ++m) { const int row = u.pm * BM + ai * HALF + wr * 64 + m * 16 + fr; const float rs = rsv[ai][m];
                const float nrs = rs * -1.44269504089f, rs2 = rs * rs; f32x4 hv[2];
#pragma unroll
                for (int n = 0; n < 2; ++n)
#pragma unroll
                    for (int hf = 0; hf < 2; ++hf) { const f32x2 ga = (f32x2){acc[ai][0][m][n][2 * hf], acc[ai][0][m][n][2 * hf + 1]}, ua = (f32x2){acc[ai][1][m][n][2 * hf], acc[ai][1][m][n][2 * hf + 1]};
                        const f32x2 t = ga * nrs; f32x2 ev; ev.x = fast_exp2(t.x); ev.y = fast_exp2(t.y);
                        const f32x2 dv = ev + 1.0f; f32x2 rv; rv.x = fast_rcp(dv.x); rv.y = fast_rcp(dv.y);
                        const f32x2 hh = ((ga * ua) * rs2) * rv; hv[n][2 * hf] = hh.x; hv[n][2 * hf + 1] = hh.y; }
                *(u32x4*)(H + (size_t)row * DFF + u.pn * HALF + wc * 32 + 8 * fq) = pack8(hv[0], hv[1]); }
    }
};
struct EpiRes2 {
    static constexpr bool PERM = true, KSPLIT = false, TOEP = false;
    float* out; const bf16_t* XB;
    __device__ __forceinline__ void operator()(f32x4 (&acc)[2][2][4][2], const Unit& u, int wr, int wc, int fr, int fq) const {
#pragma unroll
        for (int ai = 0; ai < 2; ++ai) {
            u32x4 xb[4][2];
#pragma unroll
            for (int m = 0; m < 4; ++m)
#pragma unroll
                for (int bj = 0; bj < 2; ++bj) xb[m][bj] = *(const u32x4*)(XB + (size_t)(u.pm * BM + ai * HALF + wr * 64 + m * 16 + fr) * DM + u.pn * BM + wc * 32 + 8 * fq + bj * HALF);
#pragma unroll
            for (int m = 0; m < 4; ++m) { const size_t roff = (size_t)(u.pm * BM + ai * HALF + wr * 64 + m * 16 + fr) * DM + u.pn * BM + wc * 32 + 8 * fq;
#pragma unroll
                for (int bj = 0; bj < 2; ++bj) { const size_t off = roff + bj * HALF; const u32x4 x4 = xb[m][bj];
                    f32x4 v0, v1; v0[0] = bf_lo(x4.x); v0[1] = bf_hi(x4.x); v0[2] = bf_lo(x4.y); v0[3] = bf_hi(x4.y); v1[0] = bf_lo(x4.z); v1[1] = bf_hi(x4.z); v1[2] = bf_lo(x4.w); v1[3] = bf_hi(x4.w);
                    *(f32x4*)(out + off) = v0 + acc[ai][bj][m][0]; *(f32x4*)(out + off + 4) = v1 + acc[ai][bj][m][1]; } }
            asm volatile("" ::: "memory"); }
    }
};
}

#define RLX_AGENT __ATOMIC_RELAXED, __HIP_MEMORY_SCOPE_AGENT
#define XB_TMO      128
#define XB_XCNT(j)  (256  + 64 * (j))
#define XB_XSUB(j)  (1280 + 64 * (j))
#define XB_XGEN(j)  (2304 + 64 * (j))
#define XB_TOP      3328
#define XB_TOPGEN   3392
#define XCD_BAR_WORDS 3456
#define XB_SPIN_CAP (1u << 24)
__device__ __forceinline__ unsigned xb_ld(unsigned* p)              { return __hip_atomic_load(p, __ATOMIC_RELAXED, __HIP_MEMORY_SCOPE_AGENT); }
__device__ __forceinline__ unsigned xb_add(unsigned* p, unsigned v) { return __hip_atomic_fetch_add(p, v, __ATOMIC_RELAXED, __HIP_MEMORY_SCOPE_AGENT); }
__device__ __forceinline__ unsigned xb_xcc_id() { return (unsigned)__builtin_amdgcn_s_getreg((3 << 11) | 20) & 0xFu; }
#define XB_SPIN(cond, bar) do { unsigned _sp = 0; while (cond) { __builtin_amdgcn_s_sleep(1); \
    if ((++_sp & 255u) == 0u) { if (xb_ld(&(bar)[XB_TMO])) break; if (_sp > XB_SPIN_CAP) { atomicAdd(&(bar)[XB_TMO], 1u); break; } } } } while (0)
struct XcdBarrier { unsigned* bar; unsigned x; volatile LAS unsigned* st; unsigned nwg; };
__device__ __forceinline__ XcdBarrier xcd_barrier_post(unsigned* bar, volatile LAS unsigned* st, unsigned nwg) {
    XcdBarrier b; b.bar = bar; b.x = xb_xcc_id(); b.st = st; b.nwg = nwg;
    if (threadIdx.x == 0) (void)xb_add(&bar[XB_XCNT(b.x)], 1u);
    return b;
}
__device__ __forceinline__ void xcd_barrier_complete(unsigned* bar, unsigned x, unsigned& nloc, unsigned& nx, unsigned G) {
    unsigned sum, cnt, mine, sp = 0u;
    for (;;) {
        sum = 0u; cnt = 0u; mine = 0u;
#pragma unroll
        for (unsigned j = 0; j < 16; ++j) { const unsigned c = xb_ld(&bar[XB_XCNT(j)]); sum += c; cnt += (c > 0u) ? 1u : 0u; mine = (j == x) ? c : mine; }
        if (sum == G) break;
        __builtin_amdgcn_s_sleep(1);
        if ((++sp & 255u) == 0u) { if (xb_ld(&bar[XB_TMO])) break; if (sp > XB_SPIN_CAP) { atomicAdd(&bar[XB_TMO], 1u); break; } }
    }
    nloc = mine > 0u ? mine : 1u; nx = cnt > 0u ? cnt : 1u;
}
__device__ __forceinline__ void xcd_barrier(const XcdBarrier& b) {
    asm volatile("s_waitcnt vmcnt(0)" ::: "memory");
    __syncthreads();
    if (threadIdx.x == 0) {
        unsigned* bar = b.bar;
        __builtin_amdgcn_s_waitcnt(0);
        unsigned nloc = b.st[0], nx = b.st[1];
        if (nloc == 0u) { xcd_barrier_complete(bar, b.x, nloc, nx, b.nwg); b.st[0] = nloc; b.st[1] = nx; }
        const unsigned old = xb_add(&bar[XB_XSUB(b.x)], 1u);
        const unsigned gen = old / nloc;
        if (old + 1u == (gen + 1u) * nloc) {
            __builtin_amdgcn_fence(__ATOMIC_RELEASE, "agent");
            asm volatile("s_waitcnt vmcnt(0)" ::: "memory");
            const unsigned og = xb_add(&bar[XB_TOP], 1u);
            const unsigned tg = og / nx;
            if (og + 1u == (tg + 1u) * nx) xb_add(&bar[XB_TOPGEN], 1u);
            else XB_SPIN(xb_ld(&bar[XB_TOPGEN]) == tg, bar);
            __builtin_amdgcn_fence(__ATOMIC_ACQUIRE, "agent");
            xb_add(&bar[XB_XGEN(b.x)], 1u);
            asm volatile("s_waitcnt vmcnt(0)" ::: "memory");
        } else {
            XB_SPIN(xb_ld(&bar[XB_XGEN(b.x)]) == gen, bar);
            __builtin_amdgcn_fence(__ATOMIC_ACQUIRE, "agent");
            asm volatile("s_waitcnt vmcnt(0)" ::: "memory");
        }
    }
    __syncthreads();
}

struct Args { const float* in[23]; float* out; unsigned char* ws; int ph_lo, ph_hi, li, dup; };
enum { I_X = 0, I_GMIX, I_WIN, I_QG, I_KG, I_RPB, I_ARE, I_AIM, I_BRE, I_BIM, I_CRE, I_CIM, I_LS, I_D, I_WGLU, I_BGLU, I_GOA, I_GOS, I_WOUT, I_GFFN, I_WG, I_WU, I_WD };

#define LDS_WAIT() asm volatile("s_waitcnt lgkmcnt(0)" ::: "memory")

__device__ __forceinline__ void p0_transpose_item(const float* W, int N, const float* kscale, bf16_t* WT, int ldd, int drow0, int k0, int n0, int lane) {
    const int c = lane >> 3, n4 = (lane & 7) * 4;
    const float* src = W + (size_t)(k0 + 8 * c) * N + n0 + n4;
    f32x4 v[2][8];
#pragma unroll
    for (int h = 0; h < 2; ++h)
#pragma unroll
        for (int i = 0; i < 8; ++i) v[h][i] = __builtin_nontemporal_load((const f32x4*)(src + (size_t)i * N + 32 * h));
    if (kscale) { const f32x4 s0 = *(const f32x4*)(kscale + k0 + 8 * c), s1 = *(const f32x4*)(kscale + k0 + 8 * c + 4);
#pragma unroll
        for (int h = 0; h < 2; ++h)
#pragma unroll
            for (int i = 0; i < 8; ++i) v[h][i] *= (i < 4 ? s0[i & 3] : s1[i & 3]); }
#pragma unroll
    for (int h = 0; h < 2; ++h)
#pragma unroll
        for (int e = 0; e < 4; ++e) { u32x4 o; o.x = cvt_pk_bf16(v[h][0][e], v[h][1][e]); o.y = cvt_pk_bf16(v[h][2][e], v[h][3][e]); o.z = cvt_pk_bf16(v[h][4][e], v[h][5][e]); o.w = cvt_pk_bf16(v[h][6][e], v[h][7][e]);
            *(u32x4*)(WT + (size_t)(drow0 + 32 * h + n4 + e) * ldd + k0 + 8 * c) = o; }
}

__device__ __forceinline__ void dsincos(double a, double& s, double& c) {
    const double k = __builtin_rint(a * 0.63661977236758134308);
    double r = __builtin_fma(-k, 1.57079632679489655800e+00, a);
    r = __builtin_fma(-k, 6.12323399573676603587e-17, r);
    const double r2 = r * r;
    double sp = -7.6471637318198164759e-13; sp = sp * r2 + 1.6059043836821614599e-10; sp = sp * r2 - 2.5052108385441718775e-08; sp = sp * r2 + 2.7557319223985890653e-06;
    sp = sp * r2 - 1.9841269841269841270e-04; sp = sp * r2 + 8.3333333333333333333e-03; sp = sp * r2 - 1.6666666666666666667e-01; sp = sp * r2 * r + r;
    double cp = 4.7794773323873852974e-14; cp = cp * r2 - 1.1470745597729724714e-11; cp = cp * r2 + 2.0876756987868098979e-09; cp = cp * r2 - 2.7557319223985890653e-07;
    cp = cp * r2 + 2.4801587301587301587e-05; cp = cp * r2 - 1.3888888888888888889e-03; cp = cp * r2 + 4.1666666666666666667e-02; cp = cp * r2 - 0.5; cp = cp * r2 + 1.0;
    const int q = (int)((long long)k) & 3;
    s = (q == 0) ? sp : (q == 1) ? cp : (q == 2) ? -sp : -cp;
    c = (q == 0) ? cp : (q == 1) ? -sp : (q == 2) ? -cp : sp;
}

struct S5Params { f32x4 br4, bi4, cr4, ci4; float are, aim, ls; };
__device__ __forceinline__ void p0_s5_params(const Args& a, int g, int tid, S5Params& P) {
    const float* a_re = a.in[I_ARE]; const float* a_im = a.in[I_AIM]; const float* b_re = a.in[I_BRE]; const float* b_im = a.in[I_BIM];
    const float* c_re = a.in[I_CRE]; const float* c_im = a.in[I_CIM]; const float* lstep = a.in[I_LS];
#pragma unroll
    for (int j = 0; j < 4; ++j) { const int i = tid + 512 * j, c = i & 15, p = (i >> 4) & 63, d = i >> 10;
        const size_t bi = (((size_t)d * SG + g) * SP + p) * SC + c, ci = (((size_t)d * SG + g) * SC + c) * SP + p;
        P.br4[j] = b_re[bi]; P.bi4[j] = b_im[bi]; P.cr4[j] = c_re[ci]; P.ci4[j] = c_im[ci]; }
    { const int p = tid & 63, d = (tid >> 6) & 1; P.are = a_re[(d * SG + g) * SP + p]; P.aim = a_im[(d * SG + g) * SP + p]; P.ls = lstep[d * SG + g]; }
}
__device__ __forceinline__ void p0_s5_tables(const Args& a, LAS unsigned char* lds, int g, int q, int tid, const S5Params& P) {
    LAS f32x2* LP = (LAS f32x2*)lds;
    LAS float* Bb = (LAS float*)(lds + 33792);
    LAS f32x2* Cm = (LAS f32x2*)(lds + 50176);
    LAS float* Kt = (LAS float*)(lds + 66560);
    const float* dsk = a.in[I_D];
    unsigned char* ws = a.ws;
    __syncthreads();
    LAS f32x2* Fp = (LAS f32x2*)(Kt);
    if (tid < 128) { const int p = tid & 63, d = tid >> 6;
        const double lre = (double)fminf(P.are, -1e-4f), lim = (double)P.aim, dt = exp((double)P.ls);
        const double mag = exp(lre * dt); double sn, cs; dsincos(lim * dt, sn, cs);
        const double lr = mag * cs, li = mag * sn;
        const double nr = lr - 1.0, ni = li, den = 1.0 / (lre * lre + lim * lim);
        Fp[d * 64 + p] = (f32x2){(float)((nr * lre + ni * lim) * den), (float)((ni * lre - nr * lim) * den)};
        double wr_ = 1.0, wi_ = 0.0;
        for (int tau = 0; tau <= CL; ++tau) { LP[(d * 64 + p) * 33 + tau] = (f32x2){(float)wr_, (float)wi_}; const double t_ = wr_ * lr - wi_ * li; wi_ = wr_ * li + wi_ * lr; wr_ = t_; } }
    __syncthreads();
#pragma unroll
    for (int j = 0; j < 4; ++j) { const int i = tid + 512 * j, c = i & 15, p = (i >> 4) & 63, d = i >> 10; const f32x2 f = Fp[d * 64 + p];
        Bb[(d * 64 + p) * 32 + c] = f.x * P.br4[j] - f.y * P.bi4[j]; Bb[(d * 64 + p) * 32 + 16 + c] = f.x * P.bi4[j] + f.y * P.br4[j];
        Cm[i] = (f32x2){P.cr4[j], P.ci4[j]}; }
    __syncthreads();
    if (q == 0 && tid < 128) { const int p = tid & 63, d = tid >> 6; ((f32x2*)(ws + WS_LAML))[(g * 2 + d) * SP + p] = LP[(d * 64 + p) * 33 + CL]; }
    { const int wv = __builtin_amdgcn_readfirstlane(tid >> 6), l = tid & 63, c16 = l & 15, g4 = l >> 4;
#pragma unroll 1
      for (int d = 0; d < 2; ++d) {
        bf16x8 Bf[4];
#pragma unroll
        for (int ks = 0; ks < 4; ++ks) { float v[8];
#pragma unroll
            for (int j = 0; j < 8; ++j) v[j] = Bb[(d * 64 + 32 * (ks & 1) + 8 * g4 + j) * 32 + (ks >> 1) * 16 + c16];
            u32x4 w; w.x = cvt_pk_bf16(v[0], v[1]); w.y = cvt_pk_bf16(v[2], v[3]); w.z = cvt_pk_bf16(v[4], v[5]); w.w = cvt_pk_bf16(v[6], v[7]); Bf[ks] = __builtin_bit_cast(bf16x8, w); }
#pragma unroll 1
        for (int tt = 0; tt < 4; ++tt) { const int tau = wv + 8 * tt;
            f32x4 acc = (f32x4){0.f, 0.f, 0.f, 0.f};
#pragma unroll
            for (int ks = 0; ks < 2; ++ks) { float gr[8], gi[8];
#pragma unroll
                for (int j = 0; j < 8; ++j) { const int p = 32 * ks + 8 * g4 + j; const f32x2 cm = Cm[(d * 64 + p) * 16 + c16], lp = LP[(d * 64 + p) * 33 + tau];
                    gr[j] = cm.x * lp.x - cm.y * lp.y; gi[j] = -(cm.x * lp.y + cm.y * lp.x); }
                u32x4 wr_, wi_; wr_.x = cvt_pk_bf16(gr[0], gr[1]); wr_.y = cvt_pk_bf16(gr[2], gr[3]); wr_.z = cvt_pk_bf16(gr[4], gr[5]); wr_.w = cvt_pk_bf16(gr[6], gr[7]);
                wi_.x = cvt_pk_bf16(gi[0], gi[1]); wi_.y = cvt_pk_bf16(gi[2], gi[3]); wi_.z = cvt_pk_bf16(gi[4], gi[5]); wi_.w = cvt_pk_bf16(gi[6], gi[7]);
                acc = __builtin_amdgcn_mfma_f32_16x16x32_bf16(__builtin_bit_cast(bf16x8, wr_), Bf[ks], acc, 0, 0, 0);
                acc = __builtin_amdgcn_mfma_f32_16x16x32_bf16(__builtin_bit_cast(bf16x8, wi_), Bf[2 + ks], acc, 0, 0, 0); }
#pragma unroll
            for (int e = 0; e < 4; ++e) Kt[((d * 32 + tau) * 16 + 4 * g4 + e) * 16 + c16] = acc[e]; } } }
    __syncthreads();
    { const int d = q >> 1, ri = q & 1, p = tid >> 3, s0 = (tid & 7) * 4;
      bf16_t* dst = (bf16_t*)(ws + WS_WST) + ((size_t)g * 256 + q * 64 + p) * 512 + s0 * 16;
      float bx_[16], by_[16];
#pragma unroll
      for (int e = 0; e < 16; ++e) { bx_[e] = Bb[(d * 64 + p) * 32 + e]; by_[e] = Bb[(d * 64 + p) * 32 + 16 + e]; }
#pragma unroll
      for (int sp = 0; sp < 4; ++sp) { const int pw = d == 0 ? (CL - 1 - (s0 + sp)) : (s0 + sp); const f32x2 lp = LP[(d * 64 + p) * 33 + pw]; float v[16];
#pragma unroll
          for (int e = 0; e < 16; ++e) v[e] = ri == 0 ? (lp.x * bx_[e] - lp.y * by_[e]) : (lp.x * by_[e] + lp.y * bx_[e]);
          u32x4 w0, w1; w0.x = cvt_pk_bf16(v[0], v[1]); w0.y = cvt_pk_bf16(v[2], v[3]); w0.z = cvt_pk_bf16(v[4], v[5]); w0.w = cvt_pk_bf16(v[6], v[7]);
          w1.x = cvt_pk_bf16(v[8], v[9]); w1.y = cvt_pk_bf16(v[10], v[11]); w1.z = cvt_pk_bf16(v[12], v[13]); w1.w = cvt_pk_bf16(v[14], v[15]);
          *(u32x4*)(dst + sp * 16) = w0; *(u32x4*)(dst + sp * 16 + 8) = w1; } }
    { const int L = 16 * q + (tid >> 5), c = (tid >> 1) & 15, c0 = (tid & 1) * 8;
      if (L < 63) { const float dsv = dsk[g * SC + c]; float v[8];
          const LAS float* k0 = Kt + ((L >= 31 ? (L - 31) : (32 + 31 - L)) * 16 + c) * 16 + c0;
#pragma unroll
          for (int e = 0; e < 8; ++e) v[e] = k0[e];
          if (L == 31) { const LAS float* k1 = Kt + (32 * 16 + c) * 16 + c0;
#pragma unroll
              for (int e = 0; e < 8; ++e) v[e] += k1[e] + ((c == c0 + e) ? dsv : 0.f); }
          u32x4 w; w.x = cvt_pk_bf16(v[0], v[1]); w.y = cvt_pk_bf16(v[2], v[3]); w.z = cvt_pk_bf16(v[4], v[5]); w.w = cvt_pk_bf16(v[6], v[7]);
          *(u32x4*)((bf16_t*)(ws + WS_KB) + (((size_t)g * 64 + L) * 16 + c) * 16 + c0) = w; } }
    { const int c = tid & 15, s = 8 * q + ((tid >> 4) & 7), hi2 = tid >> 7;
      bf16_t* dst = (bf16_t*)(ws + WS_WO) + ((size_t)g * 512 + s * 16 + c) * 256;
      { const int d = hi2 >> 1, ri = hi2 & 1, pw = d == 0 ? (s + 1) : (CL - s);
#pragma unroll 1
        for (int pb = 0; pb < 8; ++pb) { float v[8];
#pragma unroll
            for (int e = 0; e < 8; ++e) { const int p = 8 * pb + e; const f32x2 cm = Cm[(d * 64 + p) * 16 + c], lp = LP[(d * 64 + p) * 33 + pw];
                v[e] = ri == 0 ? (cm.x * lp.x - cm.y * lp.y) : -(cm.x * lp.y + cm.y * lp.x); }
            u32x4 w; w.x = cvt_pk_bf16(v[0], v[1]); w.y = cvt_pk_bf16(v[2], v[3]); w.z = cvt_pk_bf16(v[4], v[5]); w.w = cvt_pk_bf16(v[6], v[7]);
            *(u32x4*)(dst + hi2 * 64 + 8 * pb) = w; } } }
    __syncthreads();
}

__device__ __forceinline__ void p0_prologue(const Args& a, LAS unsigned char* lds, int vcu, int G, int tid) {
    asm volatile("" : "+v"(tid));
    const int wave = __builtin_amdgcn_readfirstlane(tid >> 6), lane = tid & 63;
    unsigned char* ws = a.ws;
    S5Params P5; p0_s5_params(a, (vcu < SG * 4 ? vcu : SG * 4 - 1) >> 2, tid, P5);
    const int gw = vcu * 8 + wave, NGW = G * 8;
    constexpr int I_IN = (DM / 64) * (INW / 64), I_GL = (SW / 64) * (SW / 64), I_OUT = (DM / 64) * (DM / 64), I_GU = (DM / 64) * (DFF / 64), I_DN = (DFF / 64) * (DM / 64);
    constexpr int NITEMS = I_IN + I_GL + I_OUT + 2 * I_GU + I_DN;
    const float* x = a.in[I_X]; bf16_t* XN = (bf16_t*)(ws + WS_XN); float* ssq0 = (float*)(ws + WS_SSQ0);
    const int n_tr = (NITEMS + NGW - 1) / NGW, n_xn = (M + 2 * NGW - 1) / (2 * NGW), n_steps = n_tr + n_xn, tstep = vcu % n_steps;
    for (int st = 0; st < n_steps; ++st) {
        if (st == tstep) { for (int it = vcu; it < SG * 4; it += G) { if (it != vcu) p0_s5_params(a, it >> 2, tid, P5); p0_s5_tables(a, lds, it >> 2, it & 3, tid, P5); } }
        if (st < n_tr) {
            int r = gw + st * NGW; if (r >= NITEMS) continue;
            if (r < I_IN) { const int nb = INW / 64, kb = r / nb, n0 = (r % nb) * 64; p0_transpose_item(a.in[I_WIN], INW, a.in[I_GMIX], (bf16_t*)(ws + WS_WIN), DM, n0, kb * 64, n0, lane); continue; } r -= I_IN;
            if (r < I_GL) { const int nb = SW / 64, kb = r / nb, n0 = (r % nb) * 64; p0_transpose_item(a.in[I_WGLU], SW, nullptr, (bf16_t*)(ws + WS_WGLU), SW, n0, kb * 64, n0, lane); continue; } r -= I_GL;
            if (r < I_OUT) { const int nb = DM / 64, kb = r / nb, n0 = (r % nb) * 64, k0 = kb * 64;
                p0_transpose_item(a.in[I_WOUT], DM, k0 < AW ? a.in[I_GOA] : a.in[I_GOS] - AW, (bf16_t*)(ws + WS_WOUT), DM, n0, k0, n0, lane); continue; } r -= I_OUT;
            if (r < 2 * I_GU) { const int up = r >= I_GU; if (up) r -= I_GU; const int nb = DFF / 64, kb = r / nb, n0 = (r % nb) * 64;
                p0_transpose_item(up ? a.in[I_WU] : a.in[I_WG], DFF, a.in[I_GFFN], (bf16_t*)(ws + WS_WGU), DM, 256 * (n0 >> 7) + (n0 & 127) + (up ? 128 : 0), kb * 64, n0, lane); continue; } r -= 2 * I_GU;
            { const int nb = DM / 64, kb = r / nb, n0 = (r % nb) * 64; p0_transpose_item(a.in[I_WD], DM, nullptr, (bf16_t*)(ws + WS_WD), DFF, n0, kb * 64, n0, lane); }
            continue; }
        { const int m = gw + (st - n_tr) * 2 * NGW; if (m >= M) continue; const int m1 = m + NGW < M ? m + NGW : m;
        const f32x4* xr0 = (const f32x4*)(x + (size_t)m * DM) + lane; const f32x4* xr1 = (const f32x4*)(x + (size_t)m1 * DM) + lane; f32x4 v0[8], v1[8]; float s0 = 0.f, s1 = 0.f;
#pragma unroll
        for (int j = 0; j < 8; ++j) { v0[j] = __builtin_nontemporal_load(xr0 + 64 * j); v1[j] = __builtin_nontemporal_load(xr1 + 64 * j); }
        u32x2* o0 = (u32x2*)(XN + (size_t)m * DM) + lane; u32x2* o1 = (u32x2*)(XN + (size_t)m1 * DM) + lane;
#pragma unroll
        for (int j = 0; j < 8; ++j) { s0 += (v0[j][0] * v0[j][0] + v0[j][1] * v0[j][1]) + (v0[j][2] * v0[j][2] + v0[j][3] * v0[j][3]); s1 += (v1[j][0] * v1[j][0] + v1[j][1] * v1[j][1]) + (v1[j][2] * v1[j][2] + v1[j][3] * v1[j][3]);
            u32x2 w; w.x = cvt_pk_bf16(v0[j][0], v0[j][1]); w.y = cvt_pk_bf16(v0[j][2], v0[j][3]); o0[64 * j] = w;
            u32x2 w2; w2.x = cvt_pk_bf16(v1[j][0], v1[j][1]); w2.y = cvt_pk_bf16(v1[j][2], v1[j][3]); o1[64 * j] = w2; }
        s0 = wave_sum(s0); s1 = wave_sum(s1);
        if (lane == 0) { ssq0[m] = s0; ssq0[m1] = s1; } }
    }
}

constexpr int ATT_PF = 6;
constexpr int KROW = 144, AROW = 160;
constexpr int AHEAD = 64 * AROW;
constexpr int ABUF = 2 * AHEAD;
constexpr int ABUF2 = 2 * ABUF;
constexpr int ATT_RPB_OFF = 2 * ABUF2;
static_assert(ATT_RPB_OFF + 16 * 465 * 4 <= MISC_OFF, "attention LDS");

__device__ __forceinline__ void attn_phase(const Args& a, LAS unsigned char* lds, volatile LAS unsigned* MISC, int vcu, int G, int has_g2, int tid) {
    asm volatile("" : "+v"(tid));
    const int wave = __builtin_amdgcn_readfirstlane(tid >> 6), lane = tid & 63, ql = lane & 15, g4 = lane >> 4;
    const bf16_t* QKV = (const bf16_t*)(a.ws + WS_BIG); bf16_t* YAYS = (bf16_t*)(a.ws + WS_YAYS); float* ssqa16 = (float*)(a.ws + WS_SSQA16);
    LAS float* rpbL = (LAS float*)(lds + ATT_RPB_OFF);
    for (int i = tid; i < 16 * 465; i += 512) rpbL[i] = a.in[I_RPB][i] * 1.44269504089f;
    const int j = wave & 3, hsel = wave >> 2;
    const int cq = 16 * j + ql, cs = min(max(cq - 8, 0), GRIDW - 16), wb = (j == 0) ? 0 : (j == 1) ? 8 : (j == 2) ? 24 : 32;
    int it_lo, it_hi, it_step;
    if (G == 256) { const int x_ = vcu >> 5, k_ = vcu & 15; it_step = 16; if (has_g2) { it_lo = x_ * 256 + 208 + k_; it_hi = x_ * 256 + 256; } else { it_lo = x_ * 256 + k_; it_hi = x_ * 256 + 208; } }
    else { it_lo = vcu; it_hi = BATCH * NROWS * 8; it_step = G; }
#define ATT_FETCH(dst) do { if (tid == 0) { const int nx_ = ((dst) == 20) ? it_lo : item + it_step; MISC[dst] = (unsigned)(nx_ < it_hi ? nx_ : -1); } } while (0)
    int item = 0;
    ATT_FETCH(20);
    __syncthreads();
    item = __builtin_amdgcn_readfirstlane((int)MISC[20]);
    const int skey = tid >> 3, sch = tid & 7;
    const unsigned ldstK = (unsigned)(skey * KROW + sch * 16), ldstV = (unsigned)(skey * AROW + sch * 16);
    u32x4 R[4][4];
#define ATT_UN(it_) ((((it_) >> 8) << 5) | ((it_) & 31))
#define ATT_HP(it_) (((it_) >> 5) & 7)
#define ATT_BASE(it_) (QKV + ((size_t)(ATT_UN(it_) >> 6) * SEQ + 64 * min(max((ATT_UN(it_) & 63) - 4, 0), NROWS - 8) + skey) * NQKV + AW + 128 * ATT_HP(it_) + 8 * sch)
#define ATT_SRC2(base_, s_, rr_, i_) ((base_) + (size_t)((((s_) & 3) * 2) + (rr_)) * 64 * NQKV + ((s_) < 4 ? 0 : AW) + 64 * (i_))
#define ATT_LOAD(slot_, base_, s_) do { _Pragma("unroll") for (int rr_ = 0; rr_ < 2; ++rr_) _Pragma("unroll") for (int i_ = 0; i_ < 2; ++i_) R[slot_][rr_ * 2 + i_] = *(const u32x4*)ATT_SRC2(base_, s_, rr_, i_); } while (0)
    if (item >= 0) { const bf16_t* kb0 = ATT_BASE(item);
#pragma unroll
        for (int p = 0; p < 3; ++p) ATT_LOAD(p, kb0, p);
    }
    while (item >= 0) {
        const int un_ = ATT_UN(item), b = un_ >> 6, r = un_ & 63, hp = ATT_HP(item), h = 2 * hp + hsel, row_start = min(max(r - 4, 0), NROWS - 8);
        ATT_FETCH(21);
        const size_t tq = (size_t)b * SEQ + 64 * r + cq;
        bf16x8 Qf[2];
        { const u32x4* qp = (const u32x4*)(QKV + tq * NQKV + 64 * h + 8 * g4); Qf[0] = __builtin_bit_cast(bf16x8, qp[0]); Qf[1] = __builtin_bit_cast(bf16x8, qp[4]); }
        const LAS float* bl = rpbL + h * 465 + (row_start - r + 7) * 31 + (wb + 4 * g4 - cq + 15);
        f32x4 S[8][2]; bf16x8 Pf[8]; f32x4 O[4]; float sum = 0.f; int nitem = -1;
        const bf16_t* kcur = ATT_BASE(item); const bf16_t* knxt = kcur;
#pragma unroll
        for (int dt = 0; dt < 4; ++dt) O[dt] = (f32x4){0.f, 0.f, 0.f, 0.f};
#pragma unroll
        for (int st = 0; st < 8; ++st) {
            LAS unsigned char* buf = lds + (st & 1) * ABUF2;
            { const unsigned ld_ = st < 4 ? ldstK : ldstV;
#pragma unroll
              for (int rr = 0; rr < 2; ++rr) { *(LAS u32x4*)(buf + rr * ABUF + ld_) = R[st & 3][rr * 2]; *(LAS u32x4*)(buf + rr * ABUF + AHEAD + ld_) = R[st & 3][rr * 2 + 1]; } }
            if (st + 3 < 8) ATT_LOAD((st + 3) & 3, kcur, st + 3); else ATT_LOAD((st + 3) & 3, knxt, st + 3 - 8);
            asm volatile("s_waitcnt lgkmcnt(0)" ::: "memory"); __builtin_amdgcn_s_barrier(); asm volatile("" ::: "memory");
            if (st == 0) { nitem = __builtin_amdgcn_readfirstlane((int)MISC[21]); const int ni_ = nitem >= 0 ? nitem : item; knxt = ATT_BASE(ni_); }
#pragma unroll
            for (int rr = 0; rr < 2; ++rr) {
                const LAS unsigned char* hb = buf + rr * ABUF + hsel * AHEAD;
                if (st < 4) {
                    const int kr = 2 * st + rr;
#pragma unroll
                    for (int t = 0; t < 2; ++t) {
                        const LAS unsigned char* kp = hb + (wb + 16 * t + ql) * KROW + g4 * 16;
                        const bf16x8 k0 = *(const LAS bf16x8*)kp, k1 = *(const LAS bf16x8*)(kp + 64);
                        f32x4 acc = (f32x4){0.f, 0.f, 0.f, 0.f};
                        acc = __builtin_amdgcn_mfma_f32_16x16x32_bf16(k0, Qf[0], acc, 0, 0, 0);
                        acc = __builtin_amdgcn_mfma_f32_16x16x32_bf16(k1, Qf[1], acc, 0, 0, 0);
#pragma unroll
                        for (int e = 0; e < 4; ++e) { const int ck = wb + 16 * t + 4 * g4 + e;
                            const float bias = bl[kr * 31 + 16 * t + e];
                            acc[e] = (ck >= cs && ck < cs + 16) ? acc[e] + bias : -1e30f; }
                        S[kr][t] = acc; }
                } else {
                    const int kr = 2 * (st - 4) + rr;
                    const LAS unsigned char* rp = hb + (wb + 4 * g4 + ((lane & 15) >> 2)) * AROW + (lane & 3) * 8;
#pragma unroll
                    for (int dt = 0; dt < 4; ++dt) {
                        const s16x4 lo = __builtin_amdgcn_ds_read_tr16_b64_v4i16((LAS s16x4*)(rp + dt * 32));
                        const s16x4 hi = __builtin_amdgcn_ds_read_tr16_b64_v4i16((LAS s16x4*)(rp + 16 * AROW + dt * 32));
                        const bf16x8 av = (bf16x8){lo[0], lo[1], lo[2], lo[3], hi[0], hi[1], hi[2], hi[3]};
                        O[dt] = __builtin_amdgcn_mfma_f32_16x16x32_bf16(av, Pf[kr], O[dt], 0, 0, 0); }
                }
            }
            if (st == 3) {
#pragma unroll
                for (int k2 = 0; k2 < 8; ++k2) { f32x4 p0, p1;
#pragma unroll
                    for (int e = 0; e < 4; ++e) { p0[e] = fast_exp2(S[k2][0][e]); p1[e] = fast_exp2(S[k2][1][e]); sum += p0[e] + p1[e]; }
                    Pf[k2] = __builtin_bit_cast(bf16x8, pg8::pack8(p0, p1)); }
                sum += __shfl_xor(sum, 16); sum += __shfl_xor(sum, 32);
            }
        }
        const float inv = fast_rcp(sum); float ssq_acc = 0.f;
        bf16_t* op = YAYS + tq * DM + 64 * h + 4 * g4;
#pragma unroll
        for (int dt = 0; dt < 4; ++dt) { const f32x4 o = O[dt] * inv; ssq_acc += (o[0] * o[0] + o[1] * o[1]) + (o[2] * o[2] + o[3] * o[3]);
            u32x2 w; w.x = cvt_pk_bf16(o[0], o[1]); w.y = cvt_pk_bf16(o[2], o[3]); *(u32x2*)(op + 16 * dt) = w; }
        ssq_acc += __shfl_xor(ssq_acc, 16); ssq_acc += __shfl_xor(ssq_acc, 32);
        if (g4 == 0) ssqa16[tq * 16 + h] = ssq_acc;
        item = nitem;
    }
#undef ATT_FETCH
#undef ATT_BASE
#undef ATT_SRC2
#undef ATT_LOAD
#undef ATT_UN
#undef ATT_HP
}

__device__ __forceinline__ void scan_chain(const Args& a, int g, int pm, int tid) {
    asm volatile("" : "+v"(tid));
    if (tid >= 256) return;
    const float* E = (const float*)(a.ws + WS_E); bf16_t* A5 = (bf16_t*)(a.ws + WS_A5); const f32x2* LAML = (const f32x2*)(a.ws + WS_LAML);
    const int p = tid & 63, d = (tid >> 6) & 1, b = 2 * pm + (tid >> 7);
    const f32x2 lam = LAML[(g * 2 + d) * SP + p];
    float xr = 0.f, xi = 0.f;
    const size_t R0 = (size_t)g * RCH + b * NCH;
#pragma unroll 1
    for (int rd = 0; rd < NCH / 32; ++rd) { float er[32], ei[32];
#pragma unroll
        for (int j = 0; j < 32; ++j) { const int kk = rd * 32 + j, k = d == 0 ? kk : NCH - 1 - kk; const float* ep = E + (R0 + k) * 256 + d * 128 + p; er[j] = ep[0]; ei[j] = ep[64]; }
#pragma unroll
        for (int j = 0; j < 32; ++j) { const int kk = rd * 32 + j, k = d == 0 ? kk : NCH - 1 - kk;
            bf16_t* ap = A5 + (R0 + k) * KS5 + 512 + d * 128 + p; ap[0] = (bf16_t)(cvt_pk_bf16(xr, 0.f) & 0xffffu); ap[64] = (bf16_t)(cvt_pk_bf16(xi, 0.f) & 0xffffu);
            const float nr = lam.x * xr - lam.y * xi + er[j], ni = lam.x * xi + lam.y * xr + ei[j]; xr = nr; xi = ni; } }
}

__global__ void __launch_bounds__(512, 2) hymba_fwd(Args args) {
    extern __shared__ __attribute__((aligned(16))) unsigned char lds_raw[];
    LAS unsigned char* lds = (LAS unsigned char*)lds_raw;
    volatile LAS unsigned* MISC = (volatile LAS unsigned*)(lds + MISC_OFF);
    const int tid = threadIdx.x;
    const int G = gridDim.x; const int bx = blockIdx.x; const int vcu = (G % 8 == 0) ? (bx % 8) * (G / 8) + bx / 8 : bx;
    unsigned char* ws = args.ws;
    unsigned* ctl = (unsigned*)(ws + WS_CTL);
    for (int u = tid; u < (LDS_BYTES - MISC_OFF) / 4; u += 512) MISC[u] = 0u;
    __syncthreads();
    XcdBarrier bar; bar.bar = ctl + CW_BAR; bar.x = 0; bar.st = nullptr; bar.nwg = (unsigned)G;
    XcdBarrier gbar = bar;
    const bool grp_ok = (G == 256);
    if (MK_N_LAUNCHES == 1) { bar = xcd_barrier_post(ctl + CW_BAR, MISC + 8, (unsigned)G); if (grp_ok) gbar = xcd_barrier_post(ctl + CW_GBAR + (bx & 7) * XCD_BAR_WORDS, MISC + 10, (unsigned)(G / 8)); else gbar = bar; }
    const int lo = args.ph_lo, hi = args.ph_hi;
#define IN(k) (lo <= (k) && (k) < hi)
#define SEAM(k) do { if (IN(k) && IN((k) + 1)) xcd_barrier(bar); } while (0)
#define SEAM_G(k) do { if (IN(k) && IN((k) + 1)) xcd_barrier(gbar); } while (0)
    bf16_t* WIN = (bf16_t*)(ws + WS_WIN); bf16_t* WGLU = (bf16_t*)(ws + WS_WGLU); bf16_t* WOUT = (bf16_t*)(ws + WS_WOUT); bf16_t* WGU = (bf16_t*)(ws + WS_WGU); bf16_t* WD = (bf16_t*)(ws + WS_WD);
    bf16_t* WST = (bf16_t*)(ws + WS_WST); bf16_t* KBT = (bf16_t*)(ws + WS_KB); bf16_t* WOT = (bf16_t*)(ws + WS_WO);
    bf16_t* XN = (bf16_t*)(ws + WS_XN); bf16_t* YG = (bf16_t*)(ws + WS_YG); bf16_t* XB = (bf16_t*)(ws + WS_XN);
    bf16_t* QKV = (bf16_t*)(ws + WS_BIG); bf16_t* A5 = (bf16_t*)(ws + WS_A5); float* E = (float*)(ws + WS_E); bf16_t* HB = (bf16_t*)(ws + WS_BIG);
    bf16_t* YAYS = (bf16_t*)(ws + WS_YAYS);
    float* ssqa16 = (float*)(ws + WS_SSQA16); float* ssqs4 = (float*)(ws + WS_SSQS4); float* ssqx8 = (float*)(ws + WS_SSQX8);
    LAS float* XL = (LAS float*)(lds + RING_BYTES);

#define REP(k) _Pragma("unroll") for (int rep_ = (DUP_PHASE == (k)) ? 0 : 1; rep_ < 2; ++rep_)
#define ALPHA ((rep_ == 0 && args.dup >= 0) ? 0.0f : 1.0f)
    if (IN(0)) { REP(0) { p0_prologue(args, lds, vcu, G, tid); __syncthreads(); } SEAM(0); }
    if (IN(1)) {
        pg8::Gemm g{XN, WIN, DM, DM, DM, 0, 0, nullptr}; pg8::StaticOrder S; S.init(M, INW, G, bx);
        pg8::EpiZ Ep{QKV, A5, args.in[I_QG], args.in[I_KG], XL, (const float*)(ws + WS_SSQ0)};
        REP(1) pg8::gemm_phase(lds, g, S, Ep);
        SEAM(1);
    }
    if (IN(2)) {
        for (int cidx = bx; cidx < 2 * SG; cidx += G) { const int g_ = cidx >> 1, pm_ = cidx & 1;
            { pg8::Gemm g{A5, WST, KS5, 512, 512, (size_t)RCH * KS5, (size_t)256 * 512, nullptr}; pg8::ListOrder S; S.n = 1; S.u0.pm = pm_; S.u0.pn = 0; S.u0.g = g_; S.u0.kh = 0; S.u1 = S.u0;
              pg8::EpiE Ep{E};
              pg8::gemm_phase(lds, g, S, Ep); }
            asm volatile("s_waitcnt vmcnt(0)" ::: "memory"); __syncthreads();
            scan_chain(args, g_, pm_, tid);
            asm volatile("s_waitcnt vmcnt(0)" ::: "memory"); __syncthreads();
            { pg8::Gemm g{A5, KBT, KS5, KS5, KS5, (size_t)RCH * KS5, 0, WOT}; pg8::ListOrder S; S.n = 2; S.u0.pm = pm_; S.u0.pn = 0; S.u0.g = g_; S.u0.kh = 0; S.u1 = S.u0; S.u1.pn = 1;
              pg8::EpiS5Out Ep{YG};
              pg8::gemm_phase(lds, g, S, Ep); }
        }
        __syncthreads();
        attn_phase(args, lds, MISC, vcu, G, bx < 2 * SG ? 1 : 0, tid);
        SEAM(2);
    }
    if (IN(3)) {
        pg8::Gemm g{YG, WGLU, SW, SW, SW, 0, 0, nullptr}; pg8::StaticOrder S; S.init(M, SW, G, bx);
        REP(3) { pg8::EpiGlu Ep{YG, args.in[I_BGLU], YAYS, ssqs4, XL}; pg8::gemm_phase(lds, g, S, Ep); }
        SEAM_G(3);
    }
    if (IN(4)) {
        pg8::Gemm g{YAYS, WOUT, DM, DM, AW, 0, 0, nullptr}; pg8::SplitKOrder S; S.so.init(M, DM, G, bx);
        REP(4) { pg8::EpiRes1 Ep{XN, XB, ssqa16, ssqs4, ssqx8, XL}; pg8::gemm_phase(lds, g, S, Ep); }
        SEAM_G(4);
    }
    if (IN(5)) {
        pg8::Gemm g{XB, WGU, DM, DM, DM, 0, 0, nullptr}; pg8::StaticOrder S; S.init(M, 2 * DFF, G, bx);
        pg8::EpiSwiGLU Ep{HB, ssqx8, {{0.f, 0.f, 0.f, 0.f}, {0.f, 0.f, 0.f, 0.f}}, -1};
        REP(5) pg8::gemm_phase(lds, g, S, Ep);
        SEAM_G(5);
    }
    if (IN(6)) {
        pg8::Gemm g{HB, WD, DFF, DFF, DFF, 0, 0, nullptr}; pg8::StaticOrder S; S.init(M, DM, G, bx);
        REP(6) { pg8::EpiRes2 Ep{args.out, XB}; pg8::gemm_phase(lds, g, S, Ep); }
    }
#undef IN
#undef SEAM
}

extern "C" void kernel_launch(void* const* d_in, const int* in_sizes, int n_in, void* d_out, int out_size, void* d_ws, size_t ws_size, hipStream_t stream) {
    static int grid = 0;
    if (grid == 0) {
        if (n_in != 23 || in_sizes[0] != M * DM || out_size != M * DM || ws_size < WS_END) { fprintf(stderr, "kernel_launch: unexpected shapes (n_in %d, in0 %d, out %d, ws %zu < %zu)\n", n_in, n_in > 0 ? in_sizes[0] : -1, out_size, ws_size, (size_t)WS_END); grid = -1; return; }
        int dev = 0, cus = 0, per_cu = 0;
        if (hipGetDevice(&dev) != hipSuccess || hipDeviceGetAttribute(&cus, hipDeviceAttributeMultiprocessorCount, dev) != hipSuccess) { grid = -1; return; }
        if (hipFuncSetAttribute((const void*)hymba_fwd, hipFuncAttributeMaxDynamicSharedMemorySize, LDS_BYTES) != hipSuccess) { fprintf(stderr, "kernel_launch: hipFuncSetAttribute failed\n"); grid = -1; return; }
        if (hipOccupancyMaxActiveBlocksPerMultiprocessor(&per_cu, (const void*)hymba_fwd, 512, LDS_BYTES) != hipSuccess || per_cu < 1) { fprintf(stderr, "kernel_launch: occupancy query says %d blocks per CU\n", per_cu); (void)hipGetLastError(); per_cu = 1; }
        grid = cus;
    }
    if (grid < 0) return;
    (void)hipMemsetAsync((char*)d_ws + WS_CTL, 0, CTL_ZERO_BYTES, stream);
    Args a{}; a.dup = DUP_PHASE;
    for (int i = 0; i < 23; ++i) a.in[i] = (const float*)d_in[i];
    a.out = (float*)d_out; a.ws = (unsigned char*)d_ws;
    if (MK_N_LAUNCHES == 1) {
        a.ph_lo = 0; a.ph_hi = NPHASE; a.li = 0;
        hipLaunchKernelGGL(hymba_fwd, dim3(grid), dim3(512), LDS_BYTES, stream, a);
    } else {
        for (int li = 0; li < NPHASE; ++li) { a.ph_lo = li; a.ph_hi = li + 1; a.li = li; hipLaunchKernelGGL(hymba_fwd, dim3(grid), dim3(512), LDS_BYTES, stream, a); }
    }
}
```

```cpp
#include <hip/hip_runtime.h>
#include <cstdio>
#include <cstdint>

#define DUP_PHASE (-1)
#ifndef MK_N_LAUNCHES
#define MK_N_LAUNCHES 1
#endif

#define GAS __attribute__((address_space(1)))
#define LAS __attribute__((address_space(3)))
typedef unsigned short bf16_t;
typedef short bf16x8 __attribute__((ext_vector_type(8)));
typedef short s16x4 __attribute__((ext_vector_type(4)));
typedef float f32x4 __attribute__((ext_vector_type(4)));
typedef float f32x2 __attribute__((ext_vector_type(2)));
typedef unsigned u32x4 __attribute__((ext_vector_type(4)));
typedef unsigned u32x2 __attribute__((ext_vector_type(2)));

constexpr int BATCH = 4, SEQ = 4096, DM = 2048, M = BATCH * SEQ;
constexpr int AW = 1024, SW = 1024, NH = 16, HD = 64, NQKV = 3 * AW, INW = 4096, DFF = 5632;
constexpr int GRIDW = 64, NROWS = SEQ / GRIDW;
constexpr int SG = 64, SC = 16, SP = 64;
constexpr int CL = 32, NCH = SEQ / CL, RCH = M / CL;
constexpr int KS5 = CL * SC + 256;
constexpr float RMS_EPS = 1e-6f;
constexpr int NPHASE = 7;

constexpr size_t MiB = 1u << 20;
constexpr size_t WS_CTL = 0, CTL_ZERO_BYTES = 65536;
constexpr size_t WS_WIN = 1 * MiB, WS_WGLU = 17 * MiB, WS_WOUT = 19 * MiB, WS_WGU = 27 * MiB, WS_WD = 71 * MiB;
constexpr size_t WS_WST = 93 * MiB, WS_KB = 109 * MiB, WS_WO = 111 * MiB, WS_LAML = 157 * MiB;
constexpr size_t WS_XN = 158 * MiB;
constexpr size_t WS_BIG = 222 * MiB;
constexpr size_t WS_A5 = WS_BIG + 96 * MiB, WS_E = WS_BIG + 144 * MiB;
constexpr size_t WS_YAYS = 398 * MiB, WS_SSQ = 462 * MiB, WS_YG = 464 * MiB, WS_END = 496 * MiB;
constexpr size_t WS_SSQA16 = WS_SSQ, WS_SSQA = WS_SSQ + 1 * MiB, WS_SSQS4 = WS_SSQA + 65536, WS_SSQX8 = WS_SSQS4 + 4 * 65536, WS_SSQ0 = WS_SSQX8 + 8 * 65536;
static_assert(WS_SSQ0 + 65536 <= WS_END, "ssq");
constexpr int CW_BAR = 4096;
static_assert((size_t)(CW_BAR + 3456) * 4 <= CTL_ZERO_BYTES, "ctl");

constexpr int RING_BYTES = 131072;
constexpr int MISC_OFF = 143360;
constexpr int LDS_BYTES = 147456;

__device__ __forceinline__ unsigned cvt_pk_bf16(float lo, float hi) { unsigned r; asm volatile("v_cvt_pk_bf16_f32 %0, %1, %2" : "=v"(r) : "v"(lo), "v"(hi)); return r; }
__device__ __forceinline__ float bf_lo(unsigned w) { return __uint_as_float(w << 16); }
__device__ __forceinline__ float bf_hi(unsigned w) { return __uint_as_float(w & 0xffff0000u); }
__device__ __forceinline__ float fast_rcp(float x) { return __builtin_amdgcn_rcpf(x); }
__device__ __forceinline__ float fast_exp2(float x) { return __builtin_amdgcn_exp2f(x); }
__device__ __forceinline__ float sigmoidf_(float x) { return fast_rcp(1.0f + fast_exp2(-1.44269504089f * x)); }
__device__ __forceinline__ float gelu_tanh(float x) { const float t = x * (1.0f + 0.044715f * x * x); return x * fast_rcp(1.0f + fast_exp2(-2.30220818f * t)); }
__device__ __forceinline__ float wave_sum(float v) {
#pragma unroll
    for (int o = 1; o < 64; o <<= 1) v += __shfl_xor(v, o);
    return v;
}

namespace pg8 {
constexpr int BM = 256, BK = 64, HALF = 128, HTB = HALF * BK * 2, NXCD = 8, WGM = 8;
__host__ __device__ __forceinline__ int lds_byte(int r, int c) { const int st = (r >> 4) * 2 + (c >> 5), rr = r & 15, cc = c & 31, ob = rr * 64 + cc * 2; return st * 1024 + (ob ^ (((ob >> 9) & 1) << 5)); }
__host__ __device__ __forceinline__ void stage_rc(int b, int& R, int& C) { const int st = b / 1024, sb = b % 1024, swz = sb ^ (((sb >> 9) & 1) << 5); R = (st >> 1) * 16 + swz / 64; C = (st & 1) * 32 + (swz % 64) / 2; }
__host__ __device__ __forceinline__ int perm32(int rho) { const int n = rho >> 4, i = rho & 15; return 8 * (i >> 2) + 4 * n + (i & 3); }

struct Unit { int pm, pn, g, kh; };
struct Gemm { const bf16_t* A; const bf16_t* Bt; int lda, ldb, K; size_t sA, sB; const bf16_t* Bt2; };

struct StaticOrder {
    int nM, nN, nwg, G, c;
    __device__ void init(int M_, int N_, int G_, int c_) { nM = M_ / BM; nN = N_ / BM; nwg = nM * nN; G = G_; c = c_; }
    __device__ bool next(int i, Unit& u) const {
        const long L = (long)i * G + c; if (L >= nwg) return false;
        int wgid = (int)L; { const int q = nwg / NXCD, r = nwg % NXCD, xcd = wgid % NXCD, off = wgid / NXCD; wgid = (xcd < r ? xcd * (q + 1) : r * (q + 1) + (xcd - r) * q) + off; }
        const int nig = WGM * nN, gid = wgid / nig, fm = gid * WGM, gsz = (nM - fm) < WGM ? (nM - fm) : WGM;
        u.pm = fm + ((wgid % nig) % gsz); u.pn = (wgid % nig) / gsz; u.g = 0; u.kh = 0; return true;
    }
};
struct SplitKOrder {
    StaticOrder so;
    __device__ bool next(int i, Unit& u) const { if (!so.next(i >> 1, u)) return false; u.kh = i & 1; return true; }
};
struct ListOrder {
    int n; Unit u0, u1;
    __device__ bool next(int i, Unit& u) const { if (i >= n) return false; u = i == 0 ? u0 : u1; return true; }
};
struct BatchOrder {
    int nM, nN, nwg, G, c;
    __device__ void init(int nM_, int nN_, int nb, int G_, int c_) { nM = nM_; nN = nN_; nwg = nM * nN * nb; G = G_; c = c_; }
    __device__ bool next(int i, Unit& u) const {
        const long L = (long)i * G + c; if (L >= nwg) return false;
        const int l = (int)L; u.pn = l % nN; u.pm = (l / nN) % nM; u.g = (l / (nN * nM)) % SG; u.kh = 0; return true;
    }
};

template <class Epi, class Sched>
__device__ __forceinline__ void gemm_phase(LAS unsigned char* lds, const Gemm g, const Sched& S, const Epi& E) {
    int tid = threadIdx.x; asm volatile("" : "+v"(tid));
    const int wid = __builtin_amdgcn_readfirstlane(tid >> 6), lane = tid & 63, wr = wid >> 2, wc = wid & 3, fr = lane & 15, fq = lane >> 4;
    const int K = g.K, nt = K / BK;
    unsigned voffA[2], voffB[2], voffT[2], voffS[2];
#pragma unroll
    for (int i = 0; i < 2; ++i) { int R, C; stage_rc(tid * 16 + i * 8192, R, C); const int Rb = Epi::PERM ? ((R & ~31) + perm32(R & 31)) : R;
        voffA[i] = (unsigned)(R * g.lda + C) * 2u; voffB[i] = (unsigned)(Rb * g.ldb + C) * 2u;
        voffT[i] = (unsigned)((((Rb >> 4) - (C >> 4) + 3) * 256 + (Rb & 15) * 16 + (C & 15)) * 2); voffS[i] = (unsigned)(Rb * 256 + C) * 2u; }
    const size_t kstep = (size_t)(BK * 2);
    const size_t hstepA = (size_t)HALF * g.lda * 2, hstepB = (size_t)HALF * g.ldb * 2;
    const unsigned ldsw = (unsigned)wid * 1024u;
    const int aoff = lds_byte(wr * 64 + fr, fq * 8), boff = lds_byte(wc * 32 + fr, fq * 8);
#define PG8_SA(b, h) (((b) * 2 + (h)) * HTB)
#define PG8_SB(b, h) ((4 + (b) * 2 + (h)) * HTB)
#define PG8_STAGE(bufoff, gbase, voff) do { _Pragma("unroll") for (int _i = 0; _i < 2; ++_i) \
        __builtin_amdgcn_global_load_lds((const unsigned*)((const char*)(gbase) + (voff)[_i]), (LAS unsigned*)(lds + (bufoff) + ldsw + _i * 8192), 16, 0, 0); } while (0)
#define PG8_LDA(dst, b, h) do { _Pragma("unroll") for (int m = 0; m < 4; ++m) _Pragma("unroll") for (int k = 0; k < 2; ++k) dst[m][k] = *(const LAS bf16x8*)(lds + PG8_SA(b, h) + aoff + m * 2048 + k * 1024); } while (0)
#define PG8_LDB(dst, b, h) do { _Pragma("unroll") for (int n = 0; n < 2; ++n) _Pragma("unroll") for (int k = 0; k < 2; ++k) dst[n][k] = *(const LAS bf16x8*)(lds + PG8_SB(b, h) + boff + n * 2048 + k * 1024); } while (0)
#define PG8_MMA(ai, bj, At, Bt) do { __builtin_amdgcn_s_setprio(1); _Pragma("unroll") for (int m = 0; m < 4; ++m) _Pragma("unroll") for (int n = 0; n < 2; ++n) _Pragma("unroll") for (int k = 0; k < 2; ++k) \
        acc[ai][bj][m][n] = __builtin_amdgcn_mfma_f32_16x16x32_bf16(Bt[n][k], At[m][k], acc[ai][bj][m][n], 0, 0, 0); __builtin_amdgcn_s_setprio(0); } while (0)
#define PG8_WAIT_V(n) asm volatile("s_waitcnt vmcnt(" #n ")" ::: "memory")
#define PG8_WAIT_L(n) asm volatile("s_waitcnt lgkmcnt(" #n ")" ::: "memory")
#define PG8_BAR __builtin_amdgcn_s_barrier()
#define PG8_SCHED __builtin_amdgcn_sched_barrier(0)
    Unit cur, nxt; int ui = 0;
    if (!S.next(0, cur)) return;
    f32x4 acc[2][2][4][2];
#pragma unroll
    for (int a = 0; a < 2; ++a)
#pragma unroll
        for (int b = 0; b < 2; ++b)
#pragma unroll
            for (int m = 0; m < 4; ++m)
#pragma unroll
                for (int n = 0; n < 2; ++n) acc[a][b][m][n] = (f32x4){0.f, 0.f, 0.f, 0.f};
    bf16x8 At[4][2], B0[2][2], B1[2][2];
    const char* cA = (const char*)g.A + ((size_t)cur.g * g.sA + (size_t)cur.pm * BM * g.lda + (size_t)cur.kh * K) * 2;
    const char* cB = (const char*)g.Bt + ((size_t)cur.g * g.sB + (size_t)cur.pn * BM * g.ldb + (size_t)cur.kh * K) * 2;
#define PG8_TBASE(u_) ((const char*)g.Bt + ((size_t)(u_).g * 64 * 256 + (size_t)(28 + 16 * (u_).pn) * 256) * 2)
#define PG8_SBASE(u_) ((const char*)g.Bt2 + ((size_t)(u_).g * 512 * 256 + (size_t)(u_).pn * BM * 256) * 2)
    const char* cT = PG8_TBASE(cur); const char* cS = PG8_SBASE(cur);
#define PG8_STAGE_B(bufoff, ub_, ut_, us_, tile_, half_) do { \
        if constexpr (Epi::TOEP) { const int tl_ = (tile_); const bool tz_ = tl_ < 8; \
            const char* bp_ = tz_ ? (ut_) - (size_t)tl_ * 2048 + (size_t)(half_) * 4096 : (us_) + (size_t)(tl_ - 8) * 128 + (size_t)(half_) * (HALF * 256 * 2); \
            unsigned vo_[2]; vo_[0] = tz_ ? voffT[0] : voffS[0]; vo_[1] = tz_ ? voffT[1] : voffS[1]; PG8_STAGE(bufoff, bp_, vo_); } \
        else PG8_STAGE(bufoff, (ub_) + (size_t)(tile_) * kstep + (size_t)(half_) * hstepB, voffB); } while (0)
    PG8_STAGE_B(PG8_SB(0, 0), cB, cT, cS, 0, 0); PG8_STAGE_B(PG8_SB(0, 1), cB, cT, cS, 0, 1); PG8_STAGE(PG8_SA(0, 0), cA, voffA); PG8_STAGE(PG8_SA(0, 1), cA + hstepA, voffA);
    if (wr == 1) PG8_BAR;
    PG8_WAIT_V(2); PG8_BAR;
    PG8_STAGE_B(PG8_SB(1, 0), cB, cT, cS, 1, 0); PG8_STAGE(PG8_SA(1, 0), cA + kstep, voffA); PG8_STAGE_B(PG8_SB(1, 1), cB, cT, cS, 1, 1);
    PG8_WAIT_V(6); PG8_BAR;
    for (;;) {
        const bool has_next = S.next(ui + 1, nxt);
        const char* nA = has_next ? (const char*)g.A + ((size_t)nxt.g * g.sA + (size_t)nxt.pm * BM * g.lda + (size_t)nxt.kh * K) * 2 : cA;
        const char* nB = has_next ? (const char*)g.Bt + ((size_t)nxt.g * g.sB + (size_t)nxt.pn * BM * g.ldb + (size_t)nxt.kh * K) * 2 : cB;
        const char* nT = has_next ? PG8_TBASE(nxt) : cT; const char* nS = has_next ? PG8_SBASE(nxt) : cS;
        for (int t = 0; t < nt; t += 2) {
            const bool last = (t == nt - 2);
            const char* a1 = cA + (size_t)(t + 1) * kstep;
            const char* a2 = last ? nA : cA + (size_t)(t + 2) * kstep; const char* a3 = a2 + kstep;
            const char* ub2 = last ? nB : cB; const char* ut2 = last ? nT : cT; const char* us2 = last ? nS : cS; const int ti2 = last ? 0 : t + 2;
            PG8_LDB(B0, 0, 0); PG8_LDB(B1, 0, 1); PG8_SCHED; PG8_LDA(At, 0, 0); PG8_STAGE(PG8_SA(1, 1), a1 + hstepA, voffA);
            PG8_WAIT_V(8); PG8_WAIT_L(0); PG8_BAR; PG8_MMA(0, 0, At, B0); PG8_MMA(0, 1, At, B1); PG8_BAR; PG8_SCHED;
            PG8_LDA(At, 0, 1); PG8_STAGE_B(PG8_SB(0, 0), ub2, ut2, us2, ti2, 0); PG8_STAGE_B(PG8_SB(0, 1), ub2, ut2, us2, ti2, 1); PG8_STAGE(PG8_SA(0, 0), a2, voffA);
            PG8_WAIT_V(8); PG8_WAIT_L(0); PG8_BAR; PG8_MMA(1, 0, At, B0); PG8_MMA(1, 1, At, B1); PG8_BAR; PG8_SCHED;
            PG8_LDB(B0, 1, 0); PG8_LDB(B1, 1, 1); PG8_SCHED; PG8_LDA(At, 1, 0); PG8_STAGE(PG8_SA(0, 1), a2 + hstepA, voffA);
            PG8_WAIT_V(8); PG8_WAIT_L(0); PG8_BAR; PG8_MMA(0, 0, At, B0); PG8_MMA(0, 1, At, B1); PG8_BAR; PG8_SCHED;
            PG8_LDA(At, 1, 1); PG8_STAGE_B(PG8_SB(1, 0), ub2, ut2, us2, ti2 + 1, 0); PG8_STAGE_B(PG8_SB(1, 1), ub2, ut2, us2, ti2 + 1, 1); PG8_STAGE(PG8_SA(1, 0), a3, voffA);
            PG8_WAIT_V(8); PG8_WAIT_L(0); PG8_BAR; PG8_MMA(1, 0, At, B0); PG8_MMA(1, 1, At, B1); PG8_BAR; PG8_SCHED;
        }
        if (wr == 0) PG8_BAR;
        E(acc, cur, wr, wc, fr, fq);
        if (!has_next) break;
        if (!(Epi::KSPLIT && cur.kh == 0)) {
#pragma unroll
        for (int a = 0; a < 2; ++a)
#pragma unroll
            for (int b = 0; b < 2; ++b)
#pragma unroll
                for (int m = 0; m < 4; ++m)
#pragma unroll
                    for (int n = 0; n < 2; ++n) acc[a][b][m][n] = (f32x4){0.f, 0.f, 0.f, 0.f};
        }
        cur = nxt; cA = nA; cB = nB; cT = nT; cS = nS; ++ui;
        if (wr == 1) PG8_BAR;
    }
    PG8_WAIT_V(0);
    PG8_BAR;
#undef PG8_SA
#undef PG8_SB
#undef PG8_STAGE
#undef PG8_STAGE_B
#undef PG8_TBASE
#undef PG8_SBASE
#undef PG8_LDA
#undef PG8_LDB
#undef PG8_MMA
#undef PG8_WAIT_V
#undef PG8_WAIT_L
#undef PG8_BAR
#undef PG8_SCHED
}

__device__ __forceinline__ u32x4 pack8(const f32x4 a, const f32x4 b) { u32x4 w; w.x = cvt_pk_bf16(a[0], a[1]); w.y = cvt_pk_bf16(a[2], a[3]); w.z = cvt_pk_bf16(b[0], b[1]); w.w = cvt_pk_bf16(b[2], b[3]); return w; }

struct EpiZ {
    static constexpr bool PERM = true, KSPLIT = false, TOEP = false;
    bf16_t* QKV; bf16_t* A5; const float* qg; const float* kg; LAS float* X; const float* ssq0;
    __device__ __forceinline__ void operator()(f32x4 (&acc)[2][2][4][2], const Unit& u, int wr, int wc, int fr, int fq) const {
        float rs0[2][4];
#pragma unroll
        for (int ai = 0; ai < 2; ++ai)
#pragma unroll
            for (int m = 0; m < 4; ++m) rs0[ai][m] = __builtin_amdgcn_rsqf(ssq0[u.pm * BM + ai * HALF + wr * 64 + m * 16 + fr] * (1.0f / DM) + RMS_EPS);
        if (u.pn < 8) {
#pragma unroll
            for (int ai = 0; ai < 2; ++ai)
#pragma unroll
                for (int m = 0; m < 4; ++m)
#pragma unroll
                    for (int bj = 0; bj < 2; ++bj) { const f32x4 a0 = acc[ai][bj][m][0], a1 = acc[ai][bj][m][1];
                        float ss = (a0[0] * a0[0] + a0[1] * a0[1]) + (a0[2] * a0[2] + a0[3] * a0[3]) + (a1[0] * a1[0] + a1[1] * a1[1]) + (a1[2] * a1[2] + a1[3] * a1[3]);
                        ss += __shfl_xor(ss, 16); ss += __shfl_xor(ss, 32);
                        if (fq == 0) X[(ai * HALF + wr * 64 + m * 16 + fr) * 8 + bj * 4 + wc] = ss; }
            asm volatile("s_waitcnt lgkmcnt(0)" ::: "memory"); __builtin_amdgcn_s_barrier(); asm volatile("" ::: "memory");
            const float* gp = (u.pn < 4 ? qg : kg) + ((wc & 1) * 32 + 8 * fq); const float gs = u.pn < 4 ? 0.125f * 1.44269504089f : 1.0f;
            const f32x4 g0 = *(const f32x4*)gp * gs, g1 = *(const f32x4*)(gp + 4) * gs;
#pragma unroll
            for (int ai = 0; ai < 2; ++ai)
#pragma unroll
                for (int m = 0; m < 4; ++m) { const int rl = ai * HALF + wr * 64 + m * 16 + fr, row = u.pm * BM + rl;
#pragma unroll
                    for (int bj = 0; bj < 2; ++bj) { const f32x2 pr = *(const LAS f32x2*)(X + rl * 8 + bj * 4 + (wc & 2)); const float r0 = rs0[ai][m], rn = r0 * __builtin_amdgcn_rsqf((pr.x + pr.y) * (r0 * r0) * (1.0f / HD) + RMS_EPS);
                        const int c8 = u.pn * BM + bj * HALF + wc * 32 + 8 * fq;
                        *(u32x4*)(QKV + (size_t)row * NQKV + c8) = pack8(acc[ai][bj][m][0] * g0 * rn, acc[ai][bj][m][1] * g1 * rn); } }
            return;
        }
#pragma unroll
        for (int ai = 0; ai < 2; ++ai)
#pragma unroll
            for (int m = 0; m < 4; ++m) { const int row = u.pm * BM + ai * HALF + wr * 64 + m * 16 + fr;
#pragma unroll
                for (int bj = 0; bj < 2; ++bj) { const int c8 = u.pn * BM + bj * HALF + wc * 32 + 8 * fq; const u32x4 w = pack8(acc[ai][bj][m][0] * rs0[ai][m], acc[ai][bj][m][1] * rs0[ai][m]);
                    if (u.pn < 12) *(u32x4*)(QKV + (size_t)row * NQKV + c8) = w;
                    else { const int ch = c8 - NQKV, gg = ch >> 4, c0 = ch & 15, R = row >> 5, s = row & 31; *(u32x4*)(A5 + ((size_t)gg * RCH + R) * KS5 + s * SC + c0) = w; } } }
    }
};
struct EpiE {
    static constexpr bool PERM = false, KSPLIT = false, TOEP = false;
    float* E;
    __device__ __forceinline__ void operator()(f32x4 (&acc)[2][2][4][2], const Unit& u, int wr, int wc, int fr, int fq) const {
#pragma unroll
        for (int ai = 0; ai < 2; ++ai)
#pragma unroll
            for (int m = 0; m < 4; ++m) { const int R = u.pm * BM + ai * HALF + wr * 64 + m * 16 + fr; float* rowp = E + ((size_t)u.g * RCH + R) * 256 + wc * 32 + 4 * fq;
#pragma unroll
                for (int bj = 0; bj < 2; ++bj)
#pragma unroll
                    for (int n = 0; n < 2; ++n) *(f32x4*)(rowp + bj * HALF + n * 16) = acc[ai][bj][m][n]; }
    }
};
struct EpiS5Out {
    static constexpr bool PERM = true, KSPLIT = false, TOEP = true;
    bf16_t* Yg;
    __device__ __forceinline__ void operator()(f32x4 (&acc)[2][2][4][2], const Unit& u, int wr, int wc, int fr, int fq) const {
#pragma unroll
        for (int ai = 0; ai < 2; ++ai)
#pragma unroll
            for (int m = 0; m < 4; ++m) { const int R = u.pm * BM + ai * HALF + wr * 64 + m * 16 + fr;
#pragma unroll
                for (int bj = 0; bj < 2; ++bj) { const int n8 = u.pn * BM + bj * HALF + wc * 32 + 8 * fq, s = n8 >> 4, c0 = n8 & 15;
                    f32x4 vv[2];
#pragma unroll
                    for (int n = 0; n < 2; ++n)
#pragma unroll
                        for (int hf = 0; hf < 2; ++hf) { const f32x2 xv = (f32x2){acc[ai][bj][m][n][2 * hf], acc[ai][bj][m][n][2 * hf + 1]};
                            const f32x2 t = (xv * -2.30220818f) * ((xv * xv) * 0.044715f + 1.0f); f32x2 ev; ev.x = fast_exp2(t.x); ev.y = fast_exp2(t.y);
                            const f32x2 dv = ev + 1.0f; f32x2 rv; rv.x = fast_rcp(dv.x); rv.y = fast_rcp(dv.y);
                            const f32x2 yv = xv * rv; vv[n][2 * hf] = yv.x; vv[n][2 * hf + 1] = yv.y; }
                    *(u32x4*)(Yg + (size_t)(R * CL + s) * SW + u.g * SC + c0) = pack8(vv[0], vv[1]); } }
    }
};
struct EpiGlu {
    static constexpr bool PERM = true, KSPLIT = false, TOEP = false;
    const bf16_t* Yg; const float* bias; bf16_t* YAYS; float* ssq4; LAS float* X;
    __device__ __forceinline__ void operator()(f32x4 (&acc)[2][2][4][2], const Unit& u, int wr, int wc, int fr, int fq) const {
        const int c8b = u.pn * BM + wc * 32 + 8 * fq;
        f32x4 bv[2][2];
#pragma unroll
        for (int bj = 0; bj < 2; ++bj)
#pragma unroll
            for (int n = 0; n < 2; ++n) bv[bj][n] = *(const f32x4*)(bias + c8b + bj * HALF + 4 * n);
#pragma unroll
        for (int ai = 0; ai < 2; ++ai) {
            u32x4 yv[4][2];
#pragma unroll
            for (int m = 0; m < 4; ++m)
#pragma unroll
                for (int bj = 0; bj < 2; ++bj) yv[m][bj] = *(const u32x4*)(Yg + (size_t)(u.pm * BM + ai * HALF + wr * 64 + m * 16 + fr) * SW + c8b + bj * HALF);
#pragma unroll
            for (int m = 0; m < 4; ++m) { const int row = u.pm * BM + ai * HALF + wr * 64 + m * 16 + fr; float ss = 0.f;
#pragma unroll
                for (int bj = 0; bj < 2; ++bj) { const int c8 = c8b + bj * HALF; const u32x4 y = yv[m][bj];
                    const f32x4 a0 = acc[ai][bj][m][0] + bv[bj][0], a1 = acc[ai][bj][m][1] + bv[bj][1];
                    f32x4 v0, v1;
                    { const unsigned yw[4] = {y.x, y.y, y.z, y.w};
#pragma unroll
                      for (int hf = 0; hf < 4; ++hf) { const f32x2 av = hf < 2 ? (f32x2){a0[2 * hf], a0[2 * hf + 1]} : (f32x2){a1[2 * hf - 4], a1[2 * hf - 3]};
                          const f32x2 t = av * -1.44269504089f; f32x2 ev; ev.x = fast_exp2(t.x); ev.y = fast_exp2(t.y);
                          const f32x2 dv = ev + 1.0f; f32x2 rv; rv.x = fast_rcp(dv.x); rv.y = fast_rcp(dv.y);
                          const f32x2 yv = (f32x2){bf_lo(yw[hf]), bf_hi(yw[hf])} * rv;
                          if (hf < 2) { v0[2 * hf] = yv.x; v0[2 * hf + 1] = yv.y; } else { v1[2 * hf - 4] = yv.x; v1[2 * hf - 3] = yv.y; } } }
#pragma unroll
                    for (int e = 0; e < 4; ++e) ss += v0[e] * v0[e] + v1[e] * v1[e];
                    *(u32x4*)(YAYS + (size_t)row * DM + AW + c8) = pack8(v0, v1); }
                ss += __shfl_xor(ss, 16); ss += __shfl_xor(ss, 32);
                if (fq == 0) X[(ai * HALF + wr * 64 + m * 16 + fr) * 4 + wc] = ss; }
            asm volatile("" ::: "memory"); }
        asm volatile("s_waitcnt lgkmcnt(0)" ::: "memory"); __builtin_amdgcn_s_barrier(); asm volatile("" ::: "memory");
        if (wc == 0 && fq == 0) {
#pragma unroll
            for (int ai = 0; ai < 2; ++ai)
#pragma unroll
                for (int m = 0; m < 4; ++m) { const int rl = ai * HALF + wr * 64 + m * 16 + fr; const f32x4 p = *(const LAS f32x4*)(X + rl * 4);
                    ssq4[(size_t)u.pn * M + u.pm * BM + rl] = (p[0] + p[1]) + (p[2] + p[3]); } }
    }
};
struct EpiRes1 {
    static constexpr bool PERM = true, KSPLIT = true, TOEP = false;
    const bf16_t* xb; bf16_t* XB; const float* ssqa; const float* ssqs4; float* ssqx8; LAS float* X;
    __device__ __forceinline__ void operator()(f32x4 (&acc)[2][2][4][2], const Unit& u, int wr, int wc, int fr, int fq) const {
        if (u.kh == 0) {
#pragma unroll
        for (int ai = 0; ai < 2; ++ai)
#pragma unroll
            for (int m = 0; m < 4; ++m) { const int row = u.pm * BM + ai * HALF + wr * 64 + m * 16 + fr;
                const float sq = (ssqs4[row] + ssqs4[M + row]) + (ssqs4[2 * M + row] + ssqs4[3 * M + row]);
                const float ra = __builtin_amdgcn_rsqf(ssqa[row] * (1.0f / AW) + RMS_EPS), rs = __builtin_amdgcn_rsqf(sq * (1.0f / SW) + RMS_EPS), f = ra * fast_rcp(rs);
#pragma unroll
                for (int bj = 0; bj < 2; ++bj)
#pragma unroll
                    for (int n = 0; n < 2; ++n) acc[ai][bj][m][n] *= f; }
        return; }
        float rsv[2][4];
#pragma unroll
        for (int ai = 0; ai < 2; ++ai)
#pragma unroll
            for (int m = 0; m < 4; ++m) { const int row = u.pm * BM + ai * HALF + wr * 64 + m * 16 + fr;
                const float sq = (ssqs4[row] + ssqs4[M + row]) + (ssqs4[2 * M + row] + ssqs4[3 * M + row]); rsv[ai][m] = __builtin_amdgcn_rsqf(sq * (1.0f / SW) + RMS_EPS); }
#pragma unroll
        for (int am = 0; am < 4; ++am) { const int ai = am >> 1, mb = (am & 1) * 2;
            u32x4 xv[2][2];
#pragma unroll
            for (int mm = 0; mm < 2; ++mm)
#pragma unroll
                for (int bj = 0; bj < 2; ++bj) xv[mm][bj] = *(const u32x4*)(xb + (size_t)(u.pm * BM + ai * HALF + wr * 64 + (mb + mm) * 16 + fr) * DM + u.pn * BM + bj * HALF + wc * 32 + 8 * fq);
#pragma unroll
            for (int mm = 0; mm < 2; ++mm) { const int m = mb + mm; const int row = u.pm * BM + ai * HALF + wr * 64 + m * 16 + fr; float ss = 0.f; const float rs = rsv[ai][m];
#pragma unroll
                for (int bj = 0; bj < 2; ++bj) { const size_t off = (size_t)row * DM + u.pn * BM + bj * HALF + wc * 32 + 8 * fq;
                    const u32x4 x4 = xv[mm][bj]; f32x4 x0, x1; x0[0] = bf_lo(x4.x); x0[1] = bf_hi(x4.x); x0[2] = bf_lo(x4.y); x0[3] = bf_hi(x4.y); x1[0] = bf_lo(x4.z); x1[1] = bf_hi(x4.z); x1[2] = bf_lo(x4.w); x1[3] = bf_hi(x4.w);
                    const f32x4 v0 = x0 + acc[ai][bj][m][0] * rs, v1 = x1 + acc[ai][bj][m][1] * rs;
#pragma unroll
                    for (int e = 0; e < 4; ++e) ss += v0[e] * v0[e] + v1[e] * v1[e];
                    *(u32x4*)(XB + off) = pack8(v0, v1); }
                ss += __shfl_xor(ss, 16); ss += __shfl_xor(ss, 32);
                if (fq == 0) X[(ai * HALF + wr * 64 + m * 16 + fr) * 4 + wc] = ss; }
            asm volatile("" ::: "memory"); }
        asm volatile("s_waitcnt lgkmcnt(0)" ::: "memory"); __builtin_amdgcn_s_barrier(); asm volatile("" ::: "memory");
        if (wc == 0 && fq == 0) {
#pragma unroll
            for (int ai = 0; ai < 2; ++ai)
#pragma unroll
                for (int m = 0; m < 4; ++m) { const int rl = ai * HALF + wr * 64 + m * 16 + fr; const f32x4 p = *(const LAS f32x4*)(X + rl * 4);
                    ssqx8[(size_t)u.pn * M + u.pm * BM + rl] = (p[0] + p[1]) + (p[2] + p[3]); } }
    }
};
struct EpiSwiGLU {
    static constexpr bool PERM = true, KSPLIT = false, TOEP = false;
    bf16_t* H; const float* ssqx8; mutable float rsv[2][4]; mutable int cpm;
    __device__ __forceinline__ void operator()(f32x4 (&acc)[2][2][4][2], const Unit& u, int wr, int wc, int fr, int fq) const {
        if (u.pm != cpm) { cpm = u.pm;
#pragma unroll
        for (int ai = 0; ai < 2; ++ai)
#pragma unroll
            for (int m = 0; m < 4; ++m) { const int row = u.pm * BM + ai * HALF + wr * 64 + m * 16 + fr; float sq = 0.f;
#pragma unroll
                for (int t = 0; t < 8; ++t) sq += ssqx8[(size_t)t * M + row];
                rsv[ai][m] = __builtin_amdgcn_rsqf(sq * (1.0f / DM) + RMS_EPS); } }
#pragma unroll
        for (int ai = 0; ai < 2; ++ai)
#pragma unroll
            for (int m = 0; m < 4; ++m) { const int row = u.pm * BM + ai * HALF + wr * 64 + m * 16 + fr; const float rs = rsv[ai][m];
                const float nrs = rs * -1.44269504089f, rs2 = rs * rs; f32x4 hv[2];
#pragma unroll
                for (int n = 0; n < 2; ++n)
#pragma unroll
                    for (int hf = 0; hf < 2; ++hf) { const f32x2 ga = (f32x2){acc[ai][0][m][n][2 * hf], acc[ai][0][m][n][2 * hf + 1]}, ua = (f32x2){acc[ai][1][m][n][2 * hf], acc[ai][1][m][n][2 * hf + 1]};
                        const f32x2 t = ga * nrs; f32x2 ev; ev.x = fast_exp2(t.x); ev.y = fast_exp2(t.y);
                        const f32x2 dv = ev + 1.0f; f32x2 rv; rv.x = fast_rcp(dv.x); rv.y = fast_rcp(dv.y);
                        const f32x2 hh = ((ga * ua) * rs2) * rv; hv[n][2 * hf] = hh.x; hv[n][2 * hf + 1] = hh.y; }
                *(u32x4*)(H + (size_t)row * DFF + u.pn * HALF + wc * 32 + 8 * fq) = pack8(hv[0], hv[1]); }
    }
};
struct EpiRes2 {
    static constexpr bool PERM = true, KSPLIT = false, TOEP = false;
    float* out; const bf16_t* XB;
    __device__ __forceinline__ void operator()(f32x4 (&acc)[2][2][4][2], const Unit& u, int wr, int wc, int fr, int fq) const {
#pragma unroll
        for (int ai = 0; ai < 2; ++ai) {
            u32x4 xb[4][2];
#pragma unroll
            for (int m = 0; m < 4; ++m)
#pragma unroll
                for (int bj = 0; bj < 2; ++bj) xb[m][bj] = *(const u32x4*)(XB + (size_t)(u.pm * BM + ai * HALF + wr * 64 + m * 16 + fr) * DM + u.pn * BM + wc * 32 + 8 * fq + bj * HALF);
#pragma unroll
            for (int m = 0; m < 4; ++m) { const size_t roff = (size_t)(u.pm * BM + ai * HALF + wr * 64 + m * 16 + fr) * DM + u.pn * BM + wc * 32 + 8 * fq;
#pragma unroll
                for (int bj = 0; bj < 2; ++bj) { const size_t off = roff + bj * HALF; const u32x4 x4 = xb[m][bj];
                    f32x4 v0, v1; v0[0] = bf_lo(x4.x); v0[1] = bf_hi(x4.x); v0[2] = bf_lo(x4.y); v0[3] = bf_hi(x4.y); v1[0] = bf_lo(x4.z); v1[1] = bf_hi(x4.z); v1[2] = bf_lo(x4.w); v1[3] = bf_hi(x4.w);
                    *(f32x4*)(out + off) = v0 + acc[ai][bj][m][0]; *(f32x4*)(out + off + 4) = v1 + acc[ai][bj][m][1]; } }
            asm volatile("" ::: "memory"); }
    }
};
}

#define RLX_AGENT __ATOMIC_RELAXED, __HIP_MEMORY_SCOPE_AGENT
#define XB_TMO      128
#define XB_XCNT(j)  (256  + 64 * (j))
#define XB_XSUB(j)  (1280 + 64 * (j))
#define XB_XGEN(j)  (2304 + 64 * (j))
#define XB_TOP      3328
#define XB_TOPGEN   3392
#define XCD_BAR_WORDS 3456
#define XB_SPIN_CAP (1u << 24)
__device__ __forceinline__ unsigned xb_ld(unsigned* p)              { return __hip_atomic_load(p, __ATOMIC_RELAXED, __HIP_MEMORY_SCOPE_AGENT); }
__device__ __forceinline__ unsigned xb_add(unsigned* p, unsigned v) { return __hip_atomic_fetch_add(p, v, __ATOMIC_RELAXED, __HIP_MEMORY_SCOPE_AGENT); }
__device__ __forceinline__ unsigned xb_xcc_id() { return (unsigned)__builtin_amdgcn_s_getreg((3 << 11) | 20) & 0xFu; }
#define XB_SPIN(cond, bar) do { unsigned _sp = 0; while (cond) { __builtin_amdgcn_s_sleep(1); \
    if ((++_sp & 255u) == 0u) { if (xb_ld(&(bar)[XB_TMO])) break; if (_sp > XB_SPIN_CAP) { atomicAdd(&(bar)[XB_TMO], 1u); break; } } } } while (0)
struct XcdBarrier { unsigned* bar; unsigned x; volatile LAS unsigned* st; };
__device__ __forceinline__ XcdBarrier xcd_barrier_post(unsigned* bar, volatile LAS unsigned* st) {
    XcdBarrier b; b.bar = bar; b.x = xb_xcc_id(); b.st = st;
    if (threadIdx.x == 0) (void)xb_add(&bar[XB_XCNT(b.x)], 1u);
    return b;
}
__device__ __forceinline__ void xcd_barrier_complete(unsigned* bar, unsigned x, unsigned& nloc, unsigned& nx) {
    const unsigned G = gridDim.x * gridDim.y * gridDim.z;
    unsigned sum, cnt, mine, sp = 0u;
    for (;;) {
        sum = 0u; cnt = 0u; mine = 0u;
#pragma unroll
        for (unsigned j = 0; j < 16; ++j) { const unsigned c = xb_ld(&bar[XB_XCNT(j)]); sum += c; cnt += (c > 0u) ? 1u : 0u; mine = (j == x) ? c : mine; }
        if (sum == G) break;
        __builtin_amdgcn_s_sleep(1);
        if ((++sp & 255u) == 0u) { if (xb_ld(&bar[XB_TMO])) break; if (sp > XB_SPIN_CAP) { atomicAdd(&bar[XB_TMO], 1u); break; } }
    }
    nloc = mine > 0u ? mine : 1u; nx = cnt > 0u ? cnt : 1u;
}
__device__ __forceinline__ void xcd_barrier(const XcdBarrier& b) {
    asm volatile("s_waitcnt vmcnt(0)" ::: "memory");
    __syncthreads();
    if (threadIdx.x == 0) {
        unsigned* bar = b.bar;
        __builtin_amdgcn_s_waitcnt(0);
        unsigned nloc = b.st[0], nx = b.st[1];
        if (nloc == 0u) { xcd_barrier_complete(bar, b.x, nloc, nx); b.st[0] = nloc; b.st[1] = nx; }
        const unsigned old = xb_add(&bar[XB_XSUB(b.x)], 1u);
        const unsigned gen = old / nloc;
        if (old + 1u == (gen + 1u) * nloc) {
            __builtin_amdgcn_fence(__ATOMIC_RELEASE, "agent");
            asm volatile("s_waitcnt vmcnt(0)" ::: "memory");
            const unsigned og = xb_add(&bar[XB_TOP], 1u);
            const unsigned tg = og / nx;
            if (og + 1u == (tg + 1u) * nx) xb_add(&bar[XB_TOPGEN], 1u);
            else XB_SPIN(xb_ld(&bar[XB_TOPGEN]) == tg, bar);
            __builtin_amdgcn_fence(__ATOMIC_ACQUIRE, "agent");
            xb_add(&bar[XB_XGEN(b.x)], 1u);
            asm volatile("s_waitcnt vmcnt(0)" ::: "memory");
        } else {
            XB_SPIN(xb_ld(&bar[XB_XGEN(b.x)]) == gen, bar);
            __builtin_amdgcn_fence(__ATOMIC_ACQUIRE, "agent");
            asm volatile("s_waitcnt vmcnt(0)" ::: "memory");
        }
    }
    __syncthreads();
}

struct Args { const float* in[23]; float* out; unsigned char* ws; int ph_lo, ph_hi, li, dup; };
enum { I_X = 0, I_GMIX, I_WIN, I_QG, I_KG, I_RPB, I_ARE, I_AIM, I_BRE, I_BIM, I_CRE, I_CIM, I_LS, I_D, I_WGLU, I_BGLU, I_GOA, I_GOS, I_WOUT, I_GFFN, I_WG, I_WU, I_WD };

#define LDS_WAIT() asm volatile("s_waitcnt lgkmcnt(0)" ::: "memory")

__device__ __forceinline__ void p0_transpose_item(const float* W, int N, const float* kscale, bf16_t* WT, int ldd, int drow0, int k0, int n0, int lane) {
    const int c = lane >> 3, n4 = (lane & 7) * 4;
    const float* src = W + (size_t)(k0 + 8 * c) * N + n0 + n4;
    f32x4 v[2][8];
#pragma unroll
    for (int h = 0; h < 2; ++h)
#pragma unroll
        for (int i = 0; i < 8; ++i) v[h][i] = __builtin_nontemporal_load((const f32x4*)(src + (size_t)i * N + 32 * h));
    if (kscale) { const f32x4 s0 = *(const f32x4*)(kscale + k0 + 8 * c), s1 = *(const f32x4*)(kscale + k0 + 8 * c + 4);
#pragma unroll
        for (int h = 0; h < 2; ++h)
#pragma unroll
            for (int i = 0; i < 8; ++i) v[h][i] *= (i < 4 ? s0[i & 3] : s1[i & 3]); }
#pragma unroll
    for (int h = 0; h < 2; ++h)
#pragma unroll
        for (int e = 0; e < 4; ++e) { u32x4 o; o.x = cvt_pk_bf16(v[h][0][e], v[h][1][e]); o.y = cvt_pk_bf16(v[h][2][e], v[h][3][e]); o.z = cvt_pk_bf16(v[h][4][e], v[h][5][e]); o.w = cvt_pk_bf16(v[h][6][e], v[h][7][e]);
            *(u32x4*)(WT + (size_t)(drow0 + 32 * h + n4 + e) * ldd + k0 + 8 * c) = o; }
}

__device__ __forceinline__ void dsincos(double a, double& s, double& c) {
    const double k = __builtin_rint(a * 0.63661977236758134308);
    double r = __builtin_fma(-k, 1.57079632679489655800e+00, a);
    r = __builtin_fma(-k, 6.12323399573676603587e-17, r);
    const double r2 = r * r;
    double sp = -7.6471637318198164759e-13; sp = sp * r2 + 1.6059043836821614599e-10; sp = sp * r2 - 2.5052108385441718775e-08; sp = sp * r2 + 2.7557319223985890653e-06;
    sp = sp * r2 - 1.9841269841269841270e-04; sp = sp * r2 + 8.3333333333333333333e-03; sp = sp * r2 - 1.6666666666666666667e-01; sp = sp * r2 * r + r;
    double cp = 4.7794773323873852974e-14; cp = cp * r2 - 1.1470745597729724714e-11; cp = cp * r2 + 2.0876756987868098979e-09; cp = cp * r2 - 2.7557319223985890653e-07;
    cp = cp * r2 + 2.4801587301587301587e-05; cp = cp * r2 - 1.3888888888888888889e-03; cp = cp * r2 + 4.1666666666666666667e-02; cp = cp * r2 - 0.5; cp = cp * r2 + 1.0;
    const int q = (int)((long long)k) & 3;
    s = (q == 0) ? sp : (q == 1) ? cp : (q == 2) ? -sp : -cp;
    c = (q == 0) ? cp : (q == 1) ? -sp : (q == 2) ? -cp : sp;
}

struct S5Params { f32x4 br4, bi4, cr4, ci4; float are, aim, ls; };
__device__ __forceinline__ void p0_s5_params(const Args& a, int g, int tid, S5Params& P) {
    const float* a_re = a.in[I_ARE]; const float* a_im = a.in[I_AIM]; const float* b_re = a.in[I_BRE]; const float* b_im = a.in[I_BIM];
    const float* c_re = a.in[I_CRE]; const float* c_im = a.in[I_CIM]; const float* lstep = a.in[I_LS];
#pragma unroll
    for (int j = 0; j < 4; ++j) { const int i = tid + 512 * j, c = i & 15, p = (i >> 4) & 63, d = i >> 10;
        const size_t bi = (((size_t)d * SG + g) * SP + p) * SC + c, ci = (((size_t)d * SG + g) * SC + c) * SP + p;
        P.br4[j] = b_re[bi]; P.bi4[j] = b_im[bi]; P.cr4[j] = c_re[ci]; P.ci4[j] = c_im[ci]; }
    { const int p = tid & 63, d = (tid >> 6) & 1; P.are = a_re[(d * SG + g) * SP + p]; P.aim = a_im[(d * SG + g) * SP + p]; P.ls = lstep[d * SG + g]; }
}
__device__ __forceinline__ void p0_s5_tables(const Args& a, LAS unsigned char* lds, int g, int q, int tid, const S5Params& P) {
    LAS f32x2* LP = (LAS f32x2*)lds;
    LAS float* Bb = (LAS float*)(lds + 33792);
    LAS f32x2* Cm = (LAS f32x2*)(lds + 50176);
    LAS float* Kt = (LAS float*)(lds + 66560);
    const float* dsk = a.in[I_D];
    unsigned char* ws = a.ws;
    __syncthreads();
    LAS f32x2* Fp = (LAS f32x2*)(Kt);
    if (tid < 128) { const int p = tid & 63, d = tid >> 6;
        const double lre = (double)fminf(P.are, -1e-4f), lim = (double)P.aim, dt = exp((double)P.ls);
        const double mag = exp(lre * dt); double sn, cs; dsincos(lim * dt, sn, cs);
        const double lr = mag * cs, li = mag * sn;
        const double nr = lr - 1.0, ni = li, den = 1.0 / (lre * lre + lim * lim);
        Fp[d * 64 + p] = (f32x2){(float)((nr * lre + ni * lim) * den), (float)((ni * lre - nr * lim) * den)};
        double wr_ = 1.0, wi_ = 0.0;
        for (int tau = 0; tau <= CL; ++tau) { LP[(d * 64 + p) * 33 + tau] = (f32x2){(float)wr_, (float)wi_}; const double t_ = wr_ * lr - wi_ * li; wi_ = wr_ * li + wi_ * lr; wr_ = t_; } }
    __syncthreads();
#pragma unroll
    for (int j = 0; j < 4; ++j) { const int i = tid + 512 * j, c = i & 15, p = (i >> 4) & 63, d = i >> 10; const f32x2 f = Fp[d * 64 + p];
        Bb[(d * 64 + p) * 32 + c] = f.x * P.br4[j] - f.y * P.bi4[j]; Bb[(d * 64 + p) * 32 + 16 + c] = f.x * P.bi4[j] + f.y * P.br4[j];
        Cm[i] = (f32x2){P.cr4[j], P.ci4[j]}; }
    __syncthreads();
    if (q == 0 && tid < 128) { const int p = tid & 63, d = tid >> 6; ((f32x2*)(ws + WS_LAML))[(g * 2 + d) * SP + p] = LP[(d * 64 + p) * 33 + CL]; }
    { const int wv = __builtin_amdgcn_readfirstlane(tid >> 6), l = tid & 63, c16 = l & 15, g4 = l >> 4;
#pragma unroll 1
      for (int d = 0; d < 2; ++d) {
        bf16x8 Bf[4];
#pragma unroll
        for (int ks = 0; ks < 4; ++ks) { float v[8];
#pragma unroll
            for (int j = 0; j < 8; ++j) v[j] = Bb[(d * 64 + 32 * (ks & 1) + 8 * g4 + j) * 32 + (ks >> 1) * 16 + c16];
            u32x4 w; w.x = cvt_pk_bf16(v[0], v[1]); w.y = cvt_pk_bf16(v[2], v[3]); w.z = cvt_pk_bf16(v[4], v[5]); w.w = cvt_pk_bf16(v[6], v[7]); Bf[ks] = __builtin_bit_cast(bf16x8, w); }
#pragma unroll 1
        for (int tt = 0; tt < 4; ++tt) { const int tau = wv + 8 * tt;
            f32x4 acc = (f32x4){0.f, 0.f, 0.f, 0.f};
#pragma unroll
            for (int ks = 0; ks < 2; ++ks) { float gr[8], gi[8];
#pragma unroll
                for (int j = 0; j < 8; ++j) { const int p = 32 * ks + 8 * g4 + j; const f32x2 cm = Cm[(d * 64 + p) * 16 + c16], lp = LP[(d * 64 + p) * 33 + tau];
                    gr[j] = cm.x * lp.x - cm.y * lp.y; gi[j] = -(cm.x * lp.y + cm.y * lp.x); }
                u32x4 wr_, wi_; wr_.x = cvt_pk_bf16(gr[0], gr[1]); wr_.y = cvt_pk_bf16(gr[2], gr[3]); wr_.z = cvt_pk_bf16(gr[4], gr[5]); wr_.w = cvt_pk_bf16(gr[6], gr[7]);
                wi_.x = cvt_pk_bf16(gi[0], gi[1]); wi_.y = cvt_pk_bf16(gi[2], gi[3]); wi_.z = cvt_pk_bf16(gi[4], gi[5]); wi_.w = cvt_pk_bf16(gi[6], gi[7]);
                acc = __builtin_amdgcn_mfma_f32_16x16x32_bf16(__builtin_bit_cast(bf16x8, wr_), Bf[ks], acc, 0, 0, 0);
                acc = __builtin_amdgcn_mfma_f32_16x16x32_bf16(__builtin_bit_cast(bf16x8, wi_), Bf[2 + ks], acc, 0, 0, 0); }
#pragma unroll
            for (int e = 0; e < 4; ++e) Kt[((d * 32 + tau) * 16 + 4 * g4 + e) * 16 + c16] = acc[e]; } } }
    __syncthreads();
    { const int d = q >> 1, ri = q & 1, p = tid >> 3, s0 = (tid & 7) * 4;
      bf16_t* dst = (bf16_t*)(ws + WS_WST) + ((size_t)g * 256 + q * 64 + p) * 512 + s0 * 16;
      float bx_[16], by_[16];
#pragma unroll
      for (int e = 0; e < 16; ++e) { bx_[e] = Bb[(d * 64 + p) * 32 + e]; by_[e] = Bb[(d * 64 + p) * 32 + 16 + e]; }
#pragma unroll
      for (int sp = 0; sp < 4; ++sp) { const int pw = d == 0 ? (CL - 1 - (s0 + sp)) : (s0 + sp); const f32x2 lp = LP[(d * 64 + p) * 33 + pw]; float v[16];
#pragma unroll
          for (int e = 0; e < 16; ++e) v[e] = ri == 0 ? (lp.x * bx_[e] - lp.y * by_[e]) : (lp.x * by_[e] + lp.y * bx_[e]);
          u32x4 w0, w1; w0.x = cvt_pk_bf16(v[0], v[1]); w0.y = cvt_pk_bf16(v[2], v[3]); w0.z = cvt_pk_bf16(v[4], v[5]); w0.w = cvt_pk_bf16(v[6], v[7]);
          w1.x = cvt_pk_bf16(v[8], v[9]); w1.y = cvt_pk_bf16(v[10], v[11]); w1.z = cvt_pk_bf16(v[12], v[13]); w1.w = cvt_pk_bf16(v[14], v[15]);
          *(u32x4*)(dst + sp * 16) = w0; *(u32x4*)(dst + sp * 16 + 8) = w1; } }
    { const int L = 16 * q + (tid >> 5), c = (tid >> 1) & 15, c0 = (tid & 1) * 8;
      if (L < 63) { const float dsv = dsk[g * SC + c]; float v[8];
          const LAS float* k0 = Kt + ((L >= 31 ? (L - 31) : (32 + 31 - L)) * 16 + c) * 16 + c0;
#pragma unroll
          for (int e = 0; e < 8; ++e) v[e] = k0[e];
          if (L == 31) { const LAS float* k1 = Kt + (32 * 16 + c) * 16 + c0;
#pragma unroll
              for (int e = 0; e < 8; ++e) v[e] += k1[e] + ((c == c0 + e) ? dsv : 0.f); }
          u32x4 w; w.x = cvt_pk_bf16(v[0], v[1]); w.y = cvt_pk_bf16(v[2], v[3]); w.z = cvt_pk_bf16(v[4], v[5]); w.w = cvt_pk_bf16(v[6], v[7]);
          *(u32x4*)((bf16_t*)(ws + WS_KB) + (((size_t)g * 64 + L) * 16 + c) * 16 + c0) = w; } }
    { const int c = tid & 15, s = 8 * q + ((tid >> 4) & 7), hi2 = tid >> 7;
      bf16_t* dst = (bf16_t*)(ws + WS_WO) + ((size_t)g * 512 + s * 16 + c) * 256;
      { const int d = hi2 >> 1, ri = hi2 & 1, pw = d == 0 ? (s + 1) : (CL - s);
#pragma unroll 1
        for (int pb = 0; pb < 8; ++pb) { float v[8];
#pragma unroll
            for (int e = 0; e < 8; ++e) { const int p = 8 * pb + e; const f32x2 cm = Cm[(d * 64 + p) * 16 + c], lp = LP[(d * 64 + p) * 33 + pw];
                v[e] = ri == 0 ? (cm.x * lp.x - cm.y * lp.y) : -(cm.x * lp.y + cm.y * lp.x); }
            u32x4 w; w.x = cvt_pk_bf16(v[0], v[1]); w.y = cvt_pk_bf16(v[2], v[3]); w.z = cvt_pk_bf16(v[4], v[5]); w.w = cvt_pk_bf16(v[6], v[7]);
            *(u32x4*)(dst + hi2 * 64 + 8 * pb) = w; } } }
    __syncthreads();
}

__device__ __forceinline__ void p0_prologue(const Args& a, LAS unsigned char* lds, int vcu, int G, int tid) {
    asm volatile("" : "+v"(tid));
    const int wave = __builtin_amdgcn_readfirstlane(tid >> 6), lane = tid & 63;
    unsigned char* ws = a.ws;
    S5Params P5; p0_s5_params(a, (vcu < SG * 4 ? vcu : SG * 4 - 1) >> 2, tid, P5);
    const int gw = vcu * 8 + wave, NGW = G * 8;
    constexpr int I_IN = (DM / 64) * (INW / 64), I_GL = (SW / 64) * (SW / 64), I_OUT = (DM / 64) * (DM / 64), I_GU = (DM / 64) * (DFF / 64), I_DN = (DFF / 64) * (DM / 64);
    constexpr int NITEMS = I_IN + I_GL + I_OUT + 2 * I_GU + I_DN;
    const float* x = a.in[I_X]; bf16_t* XN = (bf16_t*)(ws + WS_XN); float* ssq0 = (float*)(ws + WS_SSQ0);
    const int n_tr = (NITEMS + NGW - 1) / NGW, n_xn = (M + 2 * NGW - 1) / (2 * NGW), n_steps = n_tr + n_xn, tstep = vcu % n_steps;
    for (int st = 0; st < n_steps; ++st) {
        if (st == tstep) { for (int it = vcu; it < SG * 4; it += G) { if (it != vcu) p0_s5_params(a, it >> 2, tid, P5); p0_s5_tables(a, lds, it >> 2, it & 3, tid, P5); } }
        if (st < n_tr) {
            int r = gw + st * NGW; if (r >= NITEMS) continue;
            if (r < I_IN) { const int nb = INW / 64, kb = r / nb, n0 = (r % nb) * 64; p0_transpose_item(a.in[I_WIN], INW, a.in[I_GMIX], (bf16_t*)(ws + WS_WIN), DM, n0, kb * 64, n0, lane); continue; } r -= I_IN;
            if (r < I_GL) { const int nb = SW / 64, kb = r / nb, n0 = (r % nb) * 64; p0_transpose_item(a.in[I_WGLU], SW, nullptr, (bf16_t*)(ws + WS_WGLU), SW, n0, kb * 64, n0, lane); continue; } r -= I_GL;
            if (r < I_OUT) { const int nb = DM / 64, kb = r / nb, n0 = (r % nb) * 64, k0 = kb * 64;
                p0_transpose_item(a.in[I_WOUT], DM, k0 < AW ? a.in[I_GOA] : a.in[I_GOS] - AW, (bf16_t*)(ws + WS_WOUT), DM, n0, k0, n0, lane); continue; } r -= I_OUT;
            if (r < 2 * I_GU) { const int up = r >= I_GU; if (up) r -= I_GU; const int nb = DFF / 64, kb = r / nb, n0 = (r % nb) * 64;
                p0_transpose_item(up ? a.in[I_WU] : a.in[I_WG], DFF, a.in[I_GFFN], (bf16_t*)(ws + WS_WGU), DM, 256 * (n0 >> 7) + (n0 & 127) + (up ? 128 : 0), kb * 64, n0, lane); continue; } r -= 2 * I_GU;
            { const int nb = DM / 64, kb = r / nb, n0 = (r % nb) * 64; p0_transpose_item(a.in[I_WD], DM, nullptr, (bf16_t*)(ws + WS_WD), DFF, n0, kb * 64, n0, lane); }
            continue; }
        { const int m = gw + (st - n_tr) * 2 * NGW; if (m >= M) continue; const int m1 = m + NGW < M ? m + NGW : m;
        const f32x4* xr0 = (const f32x4*)(x + (size_t)m * DM) + lane; const f32x4* xr1 = (const f32x4*)(x + (size_t)m1 * DM) + lane; f32x4 v0[8], v1[8]; float s0 = 0.f, s1 = 0.f;
#pragma unroll
        for (int j = 0; j < 8; ++j) { v0[j] = __builtin_nontemporal_load(xr0 + 64 * j); v1[j] = __builtin_nontemporal_load(xr1 + 64 * j); }
        u32x2* o0 = (u32x2*)(XN + (size_t)m * DM) + lane; u32x2* o1 = (u32x2*)(XN + (size_t)m1 * DM) + lane;
#pragma unroll
        for (int j = 0; j < 8; ++j) { s0 += (v0[j][0] * v0[j][0] + v0[j][1] * v0[j][1]) + (v0[j][2] * v0[j][2] + v0[j][3] * v0[j][3]); s1 += (v1[j][0] * v1[j][0] + v1[j][1] * v1[j][1]) + (v1[j][2] * v1[j][2] + v1[j][3] * v1[j][3]);
            u32x2 w; w.x = cvt_pk_bf16(v0[j][0], v0[j][1]); w.y = cvt_pk_bf16(v0[j][2], v0[j][3]); o0[64 * j] = w;
            u32x2 w2; w2.x = cvt_pk_bf16(v1[j][0], v1[j][1]); w2.y = cvt_pk_bf16(v1[j][2], v1[j][3]); o1[64 * j] = w2; }
        s0 = wave_sum(s0); s1 = wave_sum(s1);
        if (lane == 0) { ssq0[m] = s0; ssq0[m1] = s1; } }
    }
}

constexpr int ATT_PF = 6;
constexpr int KROW = 144, AROW = 160;
constexpr int AHEAD = 64 * AROW;
constexpr int ABUF = 2 * AHEAD;
constexpr int ABUF2 = 2 * ABUF;
constexpr int ATT_RPB_OFF = 2 * ABUF2;
static_assert(ATT_RPB_OFF + 16 * 465 * 4 <= MISC_OFF, "attention LDS");

__device__ __forceinline__ void attn_phase(const Args& a, LAS unsigned char* lds, volatile LAS unsigned* MISC, int vcu, int G, int has_g2, int tid) {
    asm volatile("" : "+v"(tid));
    const int wave = __builtin_amdgcn_readfirstlane(tid >> 6), lane = tid & 63, ql = lane & 15, g4 = lane >> 4;
    const bf16_t* QKV = (const bf16_t*)(a.ws + WS_BIG); bf16_t* YAYS = (bf16_t*)(a.ws + WS_YAYS); float* ssqa16 = (float*)(a.ws + WS_SSQA16);
    LAS float* rpbL = (LAS float*)(lds + ATT_RPB_OFF);
    for (int i = tid; i < 16 * 465; i += 512) rpbL[i] = a.in[I_RPB][i] * 1.44269504089f;
    const int j = wave & 3, hsel = wave >> 2;
    const int cq = 16 * j + ql, cs = min(max(cq - 8, 0), GRIDW - 16), wb = (j == 0) ? 0 : (j == 1) ? 8 : (j == 2) ? 24 : 32;
    int it_lo, it_hi, it_step;
    if (G == 256) { const int x_ = vcu >> 5, k_ = vcu & 15; it_step = 16; if (has_g2) { it_lo = x_ * 256 + 208 + k_; it_hi = x_ * 256 + 256; } else { it_lo = x_ * 256 + k_; it_hi = x_ * 256 + 208; } }
    else { it_lo = vcu; it_hi = BATCH * NROWS * 8; it_step = G; }
#define ATT_FETCH(dst) do { if (tid == 0) { const int nx_ = ((dst) == 20) ? it_lo : item + it_step; MISC[dst] = (unsigned)(nx_ < it_hi ? nx_ : -1); } } while (0)
    int item = 0;
    ATT_FETCH(20);
    __syncthreads();
    item = __builtin_amdgcn_readfirstlane((int)MISC[20]);
    const int skey = tid >> 3, sch = tid & 7;
    const unsigned ldstK = (unsigned)(skey * KROW + sch * 16), ldstV = (unsigned)(skey * AROW + sch * 16);
    u32x4 R[4][4];
#define ATT_UN(it_) ((((it_) >> 8) << 5) | ((it_) & 31))
#define ATT_HP(it_) (((it_) >> 5) & 7)
#define ATT_BASE(it_) (QKV + ((size_t)(ATT_UN(it_) >> 6) * SEQ + 64 * min(max((ATT_UN(it_) & 63) - 4, 0), NROWS - 8) + skey) * NQKV + AW + 128 * ATT_HP(it_) + 8 * sch)
#define ATT_SRC2(base_, s_, rr_, i_) ((base_) + (size_t)((((s_) & 3) * 2) + (rr_)) * 64 * NQKV + ((s_) < 4 ? 0 : AW) + 64 * (i_))
#define ATT_LOAD(slot_, base_, s_) do { _Pragma("unroll") for (int rr_ = 0; rr_ < 2; ++rr_) _Pragma("unroll") for (int i_ = 0; i_ < 2; ++i_) R[slot_][rr_ * 2 + i_] = *(const u32x4*)ATT_SRC2(base_, s_, rr_, i_); } while (0)
    if (item >= 0) { const bf16_t* kb0 = ATT_BASE(item);
#pragma unroll
        for (int p = 0; p < 3; ++p) ATT_LOAD(p, kb0, p);
    }
    while (item >= 0) {
        const int un_ = ATT_UN(item), b = un_ >> 6, r = un_ & 63, hp = ATT_HP(item), h = 2 * hp + hsel, row_start = min(max(r - 4, 0), NROWS - 8);
        ATT_FETCH(21);
        const size_t tq = (size_t)b * SEQ + 64 * r + cq;
        bf16x8 Qf[2];
        { const u32x4* qp = (const u32x4*)(QKV + tq * NQKV + 64 * h + 8 * g4); Qf[0] = __builtin_bit_cast(bf16x8, qp[0]); Qf[1] = __builtin_bit_cast(bf16x8, qp[4]); }
        const LAS float* bl = rpbL + h * 465 + (row_start - r + 7) * 31 + (wb + 4 * g4 - cq + 15);
        f32x4 S[8][2]; bf16x8 Pf[8]; f32x4 O[4]; float sum = 0.f; int nitem = -1;
        const bf16_t* kcur = ATT_BASE(item); const bf16_t* knxt = kcur;
#pragma unroll
        for (int dt = 0; dt < 4; ++dt) O[dt] = (f32x4){0.f, 0.f, 0.f, 0.f};
#pragma unroll
        for (int st = 0; st < 8; ++st) {
            LAS unsigned char* buf = lds + (st & 1) * ABUF2;
            { const unsigned ld_ = st < 4 ? ldstK : ldstV;
#pragma unroll
              for (int rr = 0; rr < 2; ++rr) { *(LAS u32x4*)(buf + rr * ABUF + ld_) = R[st & 3][rr * 2]; *(LAS u32x4*)(buf + rr * ABUF + AHEAD + ld_) = R[st & 3][rr * 2 + 1]; } }
            if (st + 3 < 8) ATT_LOAD((st + 3) & 3, kcur, st + 3); else ATT_LOAD((st + 3) & 3, knxt, st + 3 - 8);
            asm volatile("s_waitcnt lgkmcnt(0)" ::: "memory"); __builtin_amdgcn_s_barrier(); asm volatile("" ::: "memory");
            if (st == 0) { nitem = __builtin_amdgcn_readfirstlane((int)MISC[21]); const int ni_ = nitem >= 0 ? nitem : item; knxt = ATT_BASE(ni_); }
#pragma unroll
            for (int rr = 0; rr < 2; ++rr) {
                const LAS unsigned char* hb = buf + rr * ABUF + hsel * AHEAD;
                if (st < 4) {
                    const int kr = 2 * st + rr;
#pragma unroll
                    for (int t = 0; t < 2; ++t) {
                        const LAS unsigned char* kp = hb + (wb + 16 * t + ql) * KROW + g4 * 16;
                        const bf16x8 k0 = *(const LAS bf16x8*)kp, k1 = *(const LAS bf16x8*)(kp + 64);
                        f32x4 acc = (f32x4){0.f, 0.f, 0.f, 0.f};
                        acc = __builtin_amdgcn_mfma_f32_16x16x32_bf16(k0, Qf[0], acc, 0, 0, 0);
                        acc = __builtin_amdgcn_mfma_f32_16x16x32_bf16(k1, Qf[1], acc, 0, 0, 0);
#pragma unroll
                        for (int e = 0; e < 4; ++e) { const int ck = wb + 16 * t + 4 * g4 + e;
                            const float bias = bl[kr * 31 + 16 * t + e];
                            acc[e] = (ck >= cs && ck < cs + 16) ? acc[e] + bias : -1e30f; }
                        S[kr][t] = acc; }
                } else {
                    const int kr = 2 * (st - 4) + rr;
                    const LAS unsigned char* rp = hb + (wb + 4 * g4 + ((lane & 15) >> 2)) * AROW + (lane & 3) * 8;
#pragma unroll
                    for (int dt = 0; dt < 4; ++dt) {
                        const s16x4 lo = __builtin_amdgcn_ds_read_tr16_b64_v4i16((LAS s16x4*)(rp + dt * 32));
                        const s16x4 hi = __builtin_amdgcn_ds_read_tr16_b64_v4i16((LAS s16x4*)(rp + 16 * AROW + dt * 32));
                        const bf16x8 av = (bf16x8){lo[0], lo[1], lo[2], lo[3], hi[0], hi[1], hi[2], hi[3]};
                        O[dt] = __builtin_amdgcn_mfma_f32_16x16x32_bf16(av, Pf[kr], O[dt], 0, 0, 0); }
                }
            }
            if (st == 3) {
#pragma unroll
                for (int k2 = 0; k2 < 8; ++k2) { f32x4 p0, p1;
#pragma unroll
                    for (int e = 0; e < 4; ++e) { p0[e] = fast_exp2(S[k2][0][e]); p1[e] = fast_exp2(S[k2][1][e]); sum += p0[e] + p1[e]; }
                    Pf[k2] = __builtin_bit_cast(bf16x8, pg8::pack8(p0, p1)); }
                sum += __shfl_xor(sum, 16); sum += __shfl_xor(sum, 32);
            }
        }
        const float inv = fast_rcp(sum); float ssq_acc = 0.f;
        bf16_t* op = YAYS + tq * DM + 64 * h + 4 * g4;
#pragma unroll
        for (int dt = 0; dt < 4; ++dt) { const f32x4 o = O[dt] * inv; ssq_acc += (o[0] * o[0] + o[1] * o[1]) + (o[2] * o[2] + o[3] * o[3]);
            u32x2 w; w.x = cvt_pk_bf16(o[0], o[1]); w.y = cvt_pk_bf16(o[2], o[3]); *(u32x2*)(op + 16 * dt) = w; }
        ssq_acc += __shfl_xor(ssq_acc, 16); ssq_acc += __shfl_xor(ssq_acc, 32);
        if (g4 == 0) ssqa16[tq * 16 + h] = ssq_acc;
        item = nitem;
    }
#undef ATT_FETCH
#undef ATT_BASE
#undef ATT_SRC2
#undef ATT_LOAD
#undef ATT_UN
#undef ATT_HP
}

__device__ __forceinline__ void scan_chain(const Args& a, int g, int pm, int tid) {
    asm volatile("" : "+v"(tid));
    if (tid >= 256) return;
    const float* E = (const float*)(a.ws + WS_E); bf16_t* A5 = (bf16_t*)(a.ws + WS_A5); const f32x2* LAML = (const f32x2*)(a.ws + WS_LAML);
    const int p = tid & 63, d = (tid >> 6) & 1, b = 2 * pm + (tid >> 7);
    const f32x2 lam = LAML[(g * 2 + d) * SP + p];
    float xr = 0.f, xi = 0.f;
    const size_t R0 = (size_t)g * RCH + b * NCH;
#pragma unroll 1
    for (int rd = 0; rd < NCH / 32; ++rd) { float er[32], ei[32];
#pragma unroll
        for (int j = 0; j < 32; ++j) { const int kk = rd * 32 + j, k = d == 0 ? kk : NCH - 1 - kk; const float* ep = E + (R0 + k) * 256 + d * 128 + p; er[j] = ep[0]; ei[j] = ep[64]; }
#pragma unroll
        for (int j = 0; j < 32; ++j) { const int kk = rd * 32 + j, k = d == 0 ? kk : NCH - 1 - kk;
            bf16_t* ap = A5 + (R0 + k) * KS5 + 512 + d * 128 + p; ap[0] = (bf16_t)(cvt_pk_bf16(xr, 0.f) & 0xffffu); ap[64] = (bf16_t)(cvt_pk_bf16(xi, 0.f) & 0xffffu);
            const float nr = lam.x * xr - lam.y * xi + er[j], ni = lam.x * xi + lam.y * xr + ei[j]; xr = nr; xi = ni; } }
}

__global__ void __launch_bounds__(512, 2) hymba_fwd(Args args) {
    extern __shared__ __attribute__((aligned(16))) unsigned char lds_raw[];
    LAS unsigned char* lds = (LAS unsigned char*)lds_raw;
    volatile LAS unsigned* MISC = (volatile LAS unsigned*)(lds + MISC_OFF);
    const int tid = threadIdx.x;
    const int G = gridDim.x; const int bx = blockIdx.x; const int vcu = (G % 8 == 0) ? (bx % 8) * (G / 8) + bx / 8 : bx;
    unsigned char* ws = args.ws;
    unsigned* ctl = (unsigned*)(ws + WS_CTL);
    for (int u = tid; u < (LDS_BYTES - MISC_OFF) / 4; u += 512) MISC[u] = 0u;
    __syncthreads();
    XcdBarrier bar; bar.bar = ctl + CW_BAR; bar.x = 0; bar.st = nullptr;
    if (MK_N_LAUNCHES == 1) bar = xcd_barrier_post(ctl + CW_BAR, MISC + 8);
    const int lo = args.ph_lo, hi = args.ph_hi;
#define IN(k) (lo <= (k) && (k) < hi)
#define SEAM(k) do { if (IN(k) && IN((k) + 1)) xcd_barrier(bar); } while (0)
    bf16_t* WIN = (bf16_t*)(ws + WS_WIN); bf16_t* WGLU = (bf16_t*)(ws + WS_WGLU); bf16_t* WOUT = (bf16_t*)(ws + WS_WOUT); bf16_t* WGU = (bf16_t*)(ws + WS_WGU); bf16_t* WD = (bf16_t*)(ws + WS_WD);
    bf16_t* WST = (bf16_t*)(ws + WS_WST); bf16_t* KBT = (bf16_t*)(ws + WS_KB); bf16_t* WOT = (bf16_t*)(ws + WS_WO);
    bf16_t* XN = (bf16_t*)(ws + WS_XN); bf16_t* YG = (bf16_t*)(ws + WS_YG); bf16_t* XB = (bf16_t*)(ws + WS_XN);
    bf16_t* QKV = (bf16_t*)(ws + WS_BIG); bf16_t* A5 = (bf16_t*)(ws + WS_A5); float* E = (float*)(ws + WS_E); bf16_t* HB = (bf16_t*)(ws + WS_BIG);
    bf16_t* YAYS = (bf16_t*)(ws + WS_YAYS);
    float* ssqa16 = (float*)(ws + WS_SSQA16); float* ssqa = (float*)(ws + WS_SSQA); float* ssqs4 = (float*)(ws + WS_SSQS4); float* ssqx8 = (float*)(ws + WS_SSQX8);
    LAS float* XL = (LAS float*)(lds + RING_BYTES);

#define REP(k) _Pragma("unroll") for (int rep_ = (DUP_PHASE == (k)) ? 0 : 1; rep_ < 2; ++rep_)
#define ALPHA ((rep_ == 0 && args.dup >= 0) ? 0.0f : 1.0f)
    if (IN(0)) { REP(0) { p0_prologue(args, lds, vcu, G, tid); __syncthreads(); } SEAM(0); }
    if (IN(1)) {
        pg8::Gemm g{XN, WIN, DM, DM, DM, 0, 0, nullptr}; pg8::StaticOrder S; S.init(M, INW, G, bx);
        pg8::EpiZ Ep{QKV, A5, args.in[I_QG], args.in[I_KG], XL, (const float*)(ws + WS_SSQ0)};
        REP(1) pg8::gemm_phase(lds, g, S, Ep);
        SEAM(1);
    }
    if (IN(2)) {
        for (int cidx = bx; cidx < 2 * SG; cidx += G) { const int g_ = cidx >> 1, pm_ = cidx & 1;
            { pg8::Gemm g{A5, WST, KS5, 512, 512, (size_t)RCH * KS5, (size_t)256 * 512, nullptr}; pg8::ListOrder S; S.n = 1; S.u0.pm = pm_; S.u0.pn = 0; S.u0.g = g_; S.u0.kh = 0; S.u1 = S.u0;
              pg8::EpiE Ep{E};
              pg8::gemm_phase(lds, g, S, Ep); }
            asm volatile("s_waitcnt vmcnt(0)" ::: "memory"); __syncthreads();
            scan_chain(args, g_, pm_, tid);
            asm volatile("s_waitcnt vmcnt(0)" ::: "memory"); __syncthreads();
            { pg8::Gemm g{A5, KBT, KS5, KS5, KS5, (size_t)RCH * KS5, 0, WOT}; pg8::ListOrder S; S.n = 2; S.u0.pm = pm_; S.u0.pn = 0; S.u0.g = g_; S.u0.kh = 0; S.u1 = S.u0; S.u1.pn = 1;
              pg8::EpiS5Out Ep{YG};
              pg8::gemm_phase(lds, g, S, Ep); }
        }
        __syncthreads();
        attn_phase(args, lds, MISC, vcu, G, bx < 2 * SG ? 1 : 0, tid);
        SEAM(2);
    }
    if (IN(3)) {
        pg8::Gemm g{YG, WGLU, SW, SW, SW, 0, 0, nullptr}; pg8::StaticOrder S; S.init(M, SW, G, bx);
        for (int t = vcu * 512 + tid; t < M; t += G * 512) { const f32x4* p = (const f32x4*)(ssqa16 + (size_t)t * 16); const f32x4 s0 = p[0], s1 = p[1], s2 = p[2], s3 = p[3];
            const f32x4 sv = (s0 + s1) + (s2 + s3); ssqa[t] = (sv[0] + sv[1]) + (sv[2] + sv[3]); }
        REP(3) { pg8::EpiGlu Ep{YG, args.in[I_BGLU], YAYS, ssqs4, XL}; pg8::gemm_phase(lds, g, S, Ep); }
        SEAM(3);
    }
    if (IN(4)) {
        pg8::Gemm g{YAYS, WOUT, DM, DM, AW, 0, 0, nullptr}; pg8::SplitKOrder S; S.so.init(M, DM, G, bx);
        REP(4) { pg8::EpiRes1 Ep{XN, XB, ssqa, ssqs4, ssqx8, XL}; pg8::gemm_phase(lds, g, S, Ep); }
        SEAM(4);
    }
    if (IN(5)) {
        pg8::Gemm g{XB, WGU, DM, DM, DM, 0, 0, nullptr}; pg8::StaticOrder S; S.init(M, 2 * DFF, G, bx);
        pg8::EpiSwiGLU Ep{HB, ssqx8, {{0.f, 0.f, 0.f, 0.f}, {0.f, 0.f, 0.f, 0.f}}, -1};
        REP(5) pg8::gemm_phase(lds, g, S, Ep);
        SEAM(5);
    }
    if (IN(6)) {
        pg8::Gemm g{HB, WD, DFF, DFF, DFF, 0, 0, nullptr}; pg8::StaticOrder S; S.init(M, DM, G, bx);
        REP(6) { pg8::EpiRes2 Ep{args.out, XB}; pg8::gemm_phase(lds, g, S, Ep); }
    }
#undef IN
#undef SEAM
}

extern "C" void kernel_launch(void* const* d_in, const int* in_sizes, int n_in, void* d_out, int out_size, void* d_ws, size_t ws_size, hipStream_t stream) {
    static int grid = 0;
    if (grid == 0) {
        if (n_in != 23 || in_sizes[0] != M * DM || out_size != M * DM || ws_size < WS_END) { fprintf(stderr, "kernel_launch: unexpected shapes (n_in %d, in0 %d, out %d, ws %zu < %zu)\n", n_in, n_in > 0 ? in_sizes[0] : -1, out_size, ws_size, (size_t)WS_END); grid = -1; return; }
        int dev = 0, cus = 0, per_cu = 0;
        if (hipGetDevice(&dev) != hipSuccess || hipDeviceGetAttribute(&cus, hipDeviceAttributeMultiprocessorCount, dev) != hipSuccess) { grid = -1; return; }
        if (hipFuncSetAttribute((const void*)hymba_fwd, hipFuncAttributeMaxDynamicSharedMemorySize, LDS_BYTES) != hipSuccess) { fprintf(stderr, "kernel_launch: hipFuncSetAttribute failed\n"); grid = -1; return; }
        if (hipOccupancyMaxActiveBlocksPerMultiprocessor(&per_cu, (const void*)hymba_fwd, 512, LDS_BYTES) != hipSuccess || per_cu < 1) { fprintf(stderr, "kernel_launch: occupancy query says %d blocks per CU\n", per_cu); (void)hipGetLastError(); per_cu = 1; }
        grid = cus;
    }
    if (grid < 0) return;
    (void)hipMemsetAsync((char*)d_ws + WS_CTL, 0, CTL_ZERO_BYTES, stream);
    Args a{}; a.dup = DUP_PHASE;
    for (int i = 0; i < 23; ++i) a.in[i] = (const float*)d_in[i];
    a.out = (float*)d_out; a.ws = (unsigned char*)d_ws;
    if (MK_N_LAUNCHES == 1) {
        a.ph_lo = 0; a.ph_hi = NPHASE; a.li = 0;
        void* kargs[] = {&a};
        const hipError_t le = hipLaunchCooperativeKernel((const void*)hymba_fwd, dim3(grid), dim3(512), kargs, LDS_BYTES, stream);
        if (le != hipSuccess) fprintf(stderr, "kernel_launch: cooperative launch failed: %s (grid %d)\n", hipGetErrorString(le), grid);
    } else {
        for (int li = 0; li < NPHASE; ++li) { a.ph_lo = li; a.ph_hi = li + 1; a.li = li; hipLaunchKernelGGL(hymba_fwd, dim3(grid), dim3(512), LDS_BYTES, stream, a); }
    }
}
```

```cpp
#include <hip/hip_runtime.h>
#include <cstdio>
#include <cstdint>

#define DUP_PHASE (-1)
#ifndef MK_N_LAUNCHES
#define MK_N_LAUNCHES 1
#endif

#define GAS __attribute__((address_space(1)))
#define LAS __attribute__((address_space(3)))
typedef unsigned short bf16_t;
typedef short bf16x8 __attribute__((ext_vector_type(8)));
typedef short s16x4 __attribute__((ext_vector_type(4)));
typedef float f32x4 __attribute__((ext_vector_type(4)));
typedef float f32x2 __attribute__((ext_vector_type(2)));
typedef unsigned u32x4 __attribute__((ext_vector_type(4)));
typedef unsigned u32x2 __attribute__((ext_vector_type(2)));
typedef int i32x4 __attribute__((ext_vector_type(4)));

constexpr int BATCH = 4, SEQ = 4096, DM = 2048, M = BATCH * SEQ;
constexpr int AW = 1024, SW = 1024, NH = 16, HD = 64, NQKV = 3 * AW, INW = 4096, DFF = 5632;
constexpr int GRIDW = 64, NROWS = SEQ / GRIDW;
constexpr int SG = 64, SC = 16, SP = 64;
constexpr int CL = 32, NCH = SEQ / CL, RCH = M / CL;
constexpr int KS5 = CL * SC + 256;
constexpr float RMS_EPS = 1e-6f;
constexpr int NPHASE = 7;

constexpr size_t MiB = 1u << 20;
constexpr size_t WS_CTL = 0, CTL_ZERO_BYTES = 65536;
constexpr size_t WS_WIN = 1 * MiB, WS_WGLU = 17 * MiB, WS_WOUT = 19 * MiB, WS_WGU = 27 * MiB, WS_WD = 71 * MiB;
constexpr size_t WS_WST = 93 * MiB, WS_KB = 109 * MiB, WS_WO = 111 * MiB, WS_LAML = 157 * MiB;
constexpr size_t WS_XN = 158 * MiB;
constexpr size_t WS_BIG = 222 * MiB;
constexpr size_t WS_A5 = WS_BIG + 96 * MiB, WS_E = WS_BIG + 144 * MiB;
constexpr size_t WS_YAYS = 398 * MiB, WS_SSQ = 462 * MiB, WS_YG = 464 * MiB, WS_WQ = WS_YG, WS_END = 496 * MiB;
constexpr size_t WS_SSQA16 = WS_SSQ, WS_SSQA = WS_SSQ + 1 * MiB, WS_SSQS4 = WS_SSQA + 65536, WS_SSQX8 = WS_SSQS4 + 4 * 65536, WS_SSQ0 = WS_SSQX8 + 8 * 65536, WS_SB = WS_SSQ0 + 65536;
static_assert(WS_SB + 2 * DFF * 4 <= WS_YG, "ssq");
constexpr int CW_BAR = 4096;
static_assert((size_t)(CW_BAR + 3456) * 4 <= CTL_ZERO_BYTES, "ctl");

constexpr int RING_BYTES = 131072;
constexpr int MISC_OFF = 143360;
constexpr int LDS_BYTES = 147456;

__device__ __forceinline__ unsigned cvt_pk_bf16(float lo, float hi) { unsigned r; asm volatile("v_cvt_pk_bf16_f32 %0, %1, %2" : "=v"(r) : "v"(lo), "v"(hi)); return r; }
__device__ __forceinline__ float bf_lo(unsigned w) { return __uint_as_float(w << 16); }
__device__ __forceinline__ float bf_hi(unsigned w) { return __uint_as_float(w & 0xffff0000u); }
__device__ __forceinline__ float fast_rcp(float x) { return __builtin_amdgcn_rcpf(x); }
__device__ __forceinline__ float fast_exp2(float x) { return __builtin_amdgcn_exp2f(x); }
__device__ __forceinline__ float sigmoidf_(float x) { return fast_rcp(1.0f + fast_exp2(-1.44269504089f * x)); }
__device__ __forceinline__ float gelu_tanh(float x) { const float t = x * (1.0f + 0.044715f * x * x); return x * fast_rcp(1.0f + fast_exp2(-2.30220818f * t)); }
__device__ __forceinline__ float wave_sum(float v) {
#pragma unroll
    for (int o = 1; o < 64; o <<= 1) v += __shfl_xor(v, o);
    return v;
}

namespace pg8 {
constexpr int BM = 256, BK = 64, HALF = 128, HTB = HALF * BK * 2, NXCD = 8, WGM = 8;
__host__ __device__ __forceinline__ int lds_byte(int r, int c) { const int st = (r >> 4) * 2 + (c >> 5), rr = r & 15, cc = c & 31, ob = rr * 64 + cc * 2; return st * 1024 + (ob ^ (((ob >> 9) & 1) << 5)); }
__host__ __device__ __forceinline__ void stage_rc(int b, int& R, int& C) { const int st = b / 1024, sb = b % 1024, swz = sb ^ (((sb >> 9) & 1) << 5); R = (st >> 1) * 16 + swz / 64; C = (st & 1) * 32 + (swz % 64) / 2; }
__host__ __device__ __forceinline__ int perm32(int rho) { const int n = rho >> 4, i = rho & 15; return 8 * (i >> 2) + 4 * n + (i & 3); }

struct Unit { int pm, pn, g, kh; };
struct Gemm { const bf16_t* A; const bf16_t* Bt; int lda, ldb, K; size_t sA, sB; const bf16_t* Bt2; };

struct StaticOrder {
    int nM, nN, nwg, G, c;
    __device__ void init(int M_, int N_, int G_, int c_) { nM = M_ / BM; nN = N_ / BM; nwg = nM * nN; G = G_; c = c_; }
    __device__ bool next(int i, Unit& u) const {
        const long L = (long)i * G + c; if (L >= nwg) return false;
        int wgid = (int)L; { const int q = nwg / NXCD, r = nwg % NXCD, xcd = wgid % NXCD, off = wgid / NXCD; wgid = (xcd < r ? xcd * (q + 1) : r * (q + 1) + (xcd - r) * q) + off; }
        const int nig = WGM * nN, gid = wgid / nig, fm = gid * WGM, gsz = (nM - fm) < WGM ? (nM - fm) : WGM;
        u.pm = fm + ((wgid % nig) % gsz); u.pn = (wgid % nig) / gsz; u.g = 0; u.kh = 0; return true;
    }
};
struct SplitKOrder {
    StaticOrder so;
    __device__ bool next(int i, Unit& u) const { if (!so.next(i >> 1, u)) return false; u.kh = i & 1; return true; }
};
struct ListOrder {
    int n; Unit u0, u1;
    __device__ bool next(int i, Unit& u) const { if (i >= n) return false; u = i == 0 ? u0 : u1; return true; }
};
struct BatchOrder {
    int nM, nN, nwg, G, c;
    __device__ void init(int nM_, int nN_, int nb, int G_, int c_) { nM = nM_; nN = nN_; nwg = nM * nN * nb; G = G_; c = c_; }
    __device__ bool next(int i, Unit& u) const {
        const long L = (long)i * G + c; if (L >= nwg) return false;
        const int l = (int)L; u.pn = l % nN; u.pm = (l / nN) % nM; u.g = (l / (nN * nM)) % SG; u.kh = 0; return true;
    }
};

__device__ __forceinline__ f32x4 mma16(bf16x8 a, bf16x8 b, f32x4 c) { return __builtin_amdgcn_mfma_f32_16x16x32_bf16(a, b, c, 0, 0, 0); }
__device__ __forceinline__ i32x4 mma16(bf16x8 a, bf16x8 b, i32x4 c) { return __builtin_amdgcn_mfma_i32_16x16x64_i8(__builtin_bit_cast(i32x4, a), __builtin_bit_cast(i32x4, b), c, 0, 0, 0); }
template <class Epi, class Sched>
__device__ __forceinline__ void gemm_phase(LAS unsigned char* lds, const Gemm g, const Sched& S, const Epi& E) {
    int tid = threadIdx.x; asm volatile("" : "+v"(tid));
    const int wid = __builtin_amdgcn_readfirstlane(tid >> 6), lane = tid & 63, wr = wid >> 2, wc = wid & 3, fr = lane & 15, fq = lane >> 4;
    const int K = g.K, nt = K / BK;
    unsigned voffA[2], voffB[2], voffT[2], voffS[2];
#pragma unroll
    for (int i = 0; i < 2; ++i) { int R, C; stage_rc(tid * 16 + i * 8192, R, C); const int Rb = Epi::PERM ? ((R & ~31) + perm32(R & 31)) : R;
        voffA[i] = (unsigned)(R * g.lda + C) * 2u; voffB[i] = (unsigned)(Rb * g.ldb + C) * 2u;
        voffT[i] = (unsigned)((((Rb >> 4) - (C >> 4) + 3) * 256 + (Rb & 15) * 16 + (C & 15)) * 2); voffS[i] = (unsigned)(Rb * 256 + C) * 2u; }
    const size_t kstep = (size_t)(BK * 2);
    const size_t hstepA = (size_t)HALF * g.lda * 2, hstepB = (size_t)HALF * g.ldb * 2;
    const unsigned ldsw = (unsigned)wid * 1024u;
    const int aoff = lds_byte(wr * 64 + fr, fq * 8), boff = lds_byte(wc * 32 + fr, fq * 8);
#define PG8_SA(b, h) (((b) * 2 + (h)) * HTB)
#define PG8_SB(b, h) ((4 + (b) * 2 + (h)) * HTB)
#define PG8_STAGE(bufoff, gbase, voff) do { _Pragma("unroll") for (int _i = 0; _i < 2; ++_i) \
        __builtin_amdgcn_global_load_lds((const unsigned*)((const char*)(gbase) + (voff)[_i]), (LAS unsigned*)(lds + (bufoff) + ldsw + _i * 8192), 16, 0, 0); } while (0)
#define PG8_LDA(dst, b, h) do { _Pragma("unroll") for (int m = 0; m < 4; ++m) _Pragma("unroll") for (int k = 0; k < 2; ++k) dst[m][k] = *(const LAS bf16x8*)(lds + PG8_SA(b, h) + aoff + m * 2048 + k * 1024); } while (0)
#define PG8_LDB(dst, b, h) do { _Pragma("unroll") for (int n = 0; n < 2; ++n) _Pragma("unroll") for (int k = 0; k < 2; ++k) dst[n][k] = *(const LAS bf16x8*)(lds + PG8_SB(b, h) + boff + n * 2048 + k * 1024); } while (0)
#define PG8_MMA(ai, bj, At, Bt) do { __builtin_amdgcn_s_setprio(1); _Pragma("unroll") for (int m = 0; m < 4; ++m) _Pragma("unroll") for (int n = 0; n < 2; ++n) _Pragma("unroll") for (int k = 0; k < 2; ++k) \
        acc[ai][bj][m][n] = mma16(Bt[n][k], At[m][k], acc[ai][bj][m][n]); __builtin_amdgcn_s_setprio(0); } while (0)
#define PG8_WAIT_V(n) asm volatile("s_waitcnt vmcnt(" #n ")" ::: "memory")
#define PG8_WAIT_L(n) asm volatile("s_waitcnt lgkmcnt(" #n ")" ::: "memory")
#define PG8_BAR __builtin_amdgcn_s_barrier()
#define PG8_SCHED __builtin_amdgcn_sched_barrier(0)
    Unit cur, nxt; int ui = 0;
    if (!S.next(0, cur)) return;
    typename Epi::acc_t acc[2][2][4][2];
#pragma unroll
    for (int a = 0; a < 2; ++a)
#pragma unroll
        for (int b = 0; b < 2; ++b)
#pragma unroll
            for (int m = 0; m < 4; ++m)
#pragma unroll
                for (int n = 0; n < 2; ++n) acc[a][b][m][n] = (typename Epi::acc_t){0, 0, 0, 0};
    bf16x8 At[4][2], B0[2][2], B1[2][2];
    const char* cA = (const char*)g.A + ((size_t)cur.g * g.sA + (size_t)cur.pm * BM * g.lda + (size_t)cur.kh * K) * 2;
    const char* cB = (const char*)g.Bt + ((size_t)cur.g * g.sB + (size_t)cur.pn * BM * g.ldb + (size_t)cur.kh * K) * 2;
#define PG8_TBASE(u_) ((const char*)g.Bt + ((size_t)(u_).g * 64 * 256 + (size_t)(28 + 16 * (u_).pn) * 256) * 2)
#define PG8_SBASE(u_) ((const char*)g.Bt2 + ((size_t)(u_).g * 512 * 256 + (size_t)(u_).pn * BM * 256) * 2)
    const char* cT = PG8_TBASE(cur); const char* cS = PG8_SBASE(cur);
#define PG8_STAGE_B(bufoff, ub_, ut_, us_, tile_, half_) do { \
        if constexpr (Epi::TOEP) { const int tl_ = (tile_); const bool tz_ = tl_ < 8; \
            const char* bp_ = tz_ ? (ut_) - (size_t)tl_ * 2048 + (size_t)(half_) * 4096 : (us_) + (size_t)(tl_ - 8) * 128 + (size_t)(half_) * (HALF * 256 * 2); \
            unsigned vo_[2]; vo_[0] = tz_ ? voffT[0] : voffS[0]; vo_[1] = tz_ ? voffT[1] : voffS[1]; PG8_STAGE(bufoff, bp_, vo_); } \
        else PG8_STAGE(bufoff, (ub_) + (size_t)(tile_) * kstep + (size_t)(half_) * hstepB, voffB); } while (0)
    PG8_STAGE_B(PG8_SB(0, 0), cB, cT, cS, 0, 0); PG8_STAGE_B(PG8_SB(0, 1), cB, cT, cS, 0, 1); PG8_STAGE(PG8_SA(0, 0), cA, voffA); PG8_STAGE(PG8_SA(0, 1), cA + hstepA, voffA);
    if (wr == 1) PG8_BAR;
    PG8_WAIT_V(2); PG8_BAR;
    PG8_STAGE_B(PG8_SB(1, 0), cB, cT, cS, 1, 0); PG8_STAGE(PG8_SA(1, 0), cA + kstep, voffA); PG8_STAGE_B(PG8_SB(1, 1), cB, cT, cS, 1, 1);
    PG8_WAIT_V(6); PG8_BAR;
    for (;;) {
        const bool has_next = S.next(ui + 1, nxt);
        const char* nA = has_next ? (const char*)g.A + ((size_t)nxt.g * g.sA + (size_t)nxt.pm * BM * g.lda + (size_t)nxt.kh * K) * 2 : cA;
        const char* nB = has_next ? (const char*)g.Bt + ((size_t)nxt.g * g.sB + (size_t)nxt.pn * BM * g.ldb + (size_t)nxt.kh * K) * 2 : cB;
        const char* nT = has_next ? PG8_TBASE(nxt) : cT; const char* nS = has_next ? PG8_SBASE(nxt) : cS;
        for (int t = 0; t < nt; t += 2) {
            const bool last = (t == nt - 2);
            const char* a1 = cA + (size_t)(t + 1) * kstep;
            const char* a2 = last ? nA : cA + (size_t)(t + 2) * kstep; const char* a3 = a2 + kstep;
            const char* ub2 = last ? nB : cB; const char* ut2 = last ? nT : cT; const char* us2 = last ? nS : cS; const int ti2 = last ? 0 : t + 2;
            PG8_LDB(B0, 0, 0); PG8_LDB(B1, 0, 1); PG8_SCHED; PG8_LDA(At, 0, 0); PG8_STAGE(PG8_SA(1, 1), a1 + hstepA, voffA);
            PG8_WAIT_V(8); PG8_WAIT_L(0); PG8_BAR; PG8_MMA(0, 0, At, B0); PG8_MMA(0, 1, At, B1); PG8_BAR; PG8_SCHED;
            PG8_LDA(At, 0, 1); PG8_STAGE_B(PG8_SB(0, 0), ub2, ut2, us2, ti2, 0); PG8_STAGE_B(PG8_SB(0, 1), ub2, ut2, us2, ti2, 1); PG8_STAGE(PG8_SA(0, 0), a2, voffA);
            PG8_WAIT_V(8); PG8_WAIT_L(0); PG8_BAR; PG8_MMA(1, 0, At, B0); PG8_MMA(1, 1, At, B1); PG8_BAR; PG8_SCHED;
            PG8_LDB(B0, 1, 0); PG8_LDB(B1, 1, 1); PG8_SCHED; PG8_LDA(At, 1, 0); PG8_STAGE(PG8_SA(0, 1), a2 + hstepA, voffA);
            PG8_WAIT_V(8); PG8_WAIT_L(0); PG8_BAR; PG8_MMA(0, 0, At, B0); PG8_MMA(0, 1, At, B1); PG8_BAR; PG8_SCHED;
            PG8_LDA(At, 1, 1); PG8_STAGE_B(PG8_SB(1, 0), ub2, ut2, us2, ti2 + 1, 0); PG8_STAGE_B(PG8_SB(1, 1), ub2, ut2, us2, ti2 + 1, 1); PG8_STAGE(PG8_SA(1, 0), a3, voffA);
            PG8_WAIT_V(8); PG8_WAIT_L(0); PG8_BAR; PG8_MMA(1, 0, At, B0); PG8_MMA(1, 1, At, B1); PG8_BAR; PG8_SCHED;
        }
        if (wr == 0) PG8_BAR;
        E(acc, cur, wr, wc, fr, fq);
        if (!has_next) break;
        if (!(Epi::KSPLIT && cur.kh == 0)) {
#pragma unroll
        for (int a = 0; a < 2; ++a)
#pragma unroll
            for (int b = 0; b < 2; ++b)
#pragma unroll
                for (int m = 0; m < 4; ++m)
#pragma unroll
                    for (int n = 0; n < 2; ++n) acc[a][b][m][n] = (typename Epi::acc_t){0, 0, 0, 0};
        }
        cur = nxt; cA = nA; cB = nB; cT = nT; cS = nS; ++ui;
        if (wr == 1) PG8_BAR;
    }
    PG8_WAIT_V(0);
    PG8_BAR;
#undef PG8_SA
#undef PG8_SB
#undef PG8_STAGE
#undef PG8_STAGE_B
#undef PG8_TBASE
#undef PG8_SBASE
#undef PG8_LDA
#undef PG8_LDB
#undef PG8_MMA
#undef PG8_WAIT_V
#undef PG8_WAIT_L
#undef PG8_BAR
#undef PG8_SCHED
}

__device__ __forceinline__ u32x4 pack8(const f32x4 a, const f32x4 b) { u32x4 w; w.x = cvt_pk_bf16(a[0], a[1]); w.y = cvt_pk_bf16(a[2], a[3]); w.z = cvt_pk_bf16(b[0], b[1]); w.w = cvt_pk_bf16(b[2], b[3]); return w; }

struct EpiZ {
    static constexpr bool PERM = true, KSPLIT = false, TOEP = false; typedef f32x4 acc_t;
    bf16_t* QKV; bf16_t* A5; const float* qg; const float* kg; LAS float* X; const float* ssq0;
    __device__ __forceinline__ void operator()(f32x4 (&acc)[2][2][4][2], const Unit& u, int wr, int wc, int fr, int fq) const {
        float rs0[2][4];
#pragma unroll
        for (int ai = 0; ai < 2; ++ai)
#pragma unroll
            for (int m = 0; m < 4; ++m) rs0[ai][m] = __builtin_amdgcn_rsqf(ssq0[u.pm * BM + ai * HALF + wr * 64 + m * 16 + fr] * (1.0f / DM) + RMS_EPS);
        if (u.pn < 8) {
#pragma unroll
            for (int ai = 0; ai < 2; ++ai)
#pragma unroll
                for (int m = 0; m < 4; ++m)
#pragma unroll
                    for (int bj = 0; bj < 2; ++bj) { const f32x4 a0 = acc[ai][bj][m][0], a1 = acc[ai][bj][m][1];
                        float ss = (a0[0] * a0[0] + a0[1] * a0[1]) + (a0[2] * a0[2] + a0[3] * a0[3]) + (a1[0] * a1[0] + a1[1] * a1[1]) + (a1[2] * a1[2] + a1[3] * a1[3]);
                        ss += __shfl_xor(ss, 16); ss += __shfl_xor(ss, 32);
                        if (fq == 0) X[(ai * HALF + wr * 64 + m * 16 + fr) * 8 + bj * 4 + wc] = ss; }
            asm volatile("s_waitcnt lgkmcnt(0)" ::: "memory"); __builtin_amdgcn_s_barrier(); asm volatile("" ::: "memory");
            const float* gp = (u.pn < 4 ? qg : kg) + ((wc & 1) * 32 + 8 * fq); const float gs = u.pn < 4 ? 0.125f * 1.44269504089f : 1.0f;
            const f32x4 g0 = *(const f32x4*)gp * gs, g1 = *(const f32x4*)(gp + 4) * gs;
#pragma unroll
            for (int ai = 0; ai < 2; ++ai)
#pragma unroll
                for (int m = 0; m < 4; ++m) { const int rl = ai * HALF + wr * 64 + m * 16 + fr, row = u.pm * BM + rl;
#pragma unroll
                    for (int bj = 0; bj < 2; ++bj) { const f32x2 pr = *(const LAS f32x2*)(X + rl * 8 + bj * 4 + (wc & 2)); const float r0 = rs0[ai][m], rn = r0 * __builtin_amdgcn_rsqf((pr.x + pr.y) * (r0 * r0) * (1.0f / HD) + RMS_EPS);
                        const int c8 = u.pn * BM + bj * HALF + wc * 32 + 8 * fq;
                        *(u32x4*)(QKV + (size_t)row * NQKV + c8) = pack8(acc[ai][bj][m][0] * g0 * rn, acc[ai][bj][m][1] * g1 * rn); } }
            return;
        }
#pragma unroll
        for (int ai = 0; ai < 2; ++ai)
#pragma unroll
            for (int m = 0; m < 4; ++m) { const int row = u.pm * BM + ai * HALF + wr * 64 + m * 16 + fr;
#pragma unroll
                for (int bj = 0; bj < 2; ++bj) { const int c8 = u.pn * BM + bj * HALF + wc * 32 + 8 * fq; const u32x4 w = pack8(acc[ai][bj][m][0] * rs0[ai][m], acc[ai][bj][m][1] * rs0[ai][m]);
                    if (u.pn < 12) *(u32x4*)(QKV + (size_t)row * NQKV + c8) = w;
                    else { const int ch = c8 - NQKV, gg = ch >> 4, c0 = ch & 15, R = row >> 5, s = row & 31; *(u32x4*)(A5 + ((size_t)gg * RCH + R) * KS5 + s * SC + c0) = w; } } }
    }
};
struct EpiE {
    static constexpr bool PERM = false, KSPLIT = false, TOEP = false; typedef f32x4 acc_t;
    float* E;
    __device__ __forceinline__ void operator()(f32x4 (&acc)[2][2][4][2], const Unit& u, int wr, int wc, int fr, int fq) const {
#pragma unroll
        for (int ai = 0; ai < 2; ++ai)
#pragma unroll
            for (int m = 0; m < 4; ++m) { const int R = u.pm * BM + ai * HALF + wr * 64 + m * 16 + fr; float* rowp = E + ((size_t)u.g * RCH + R) * 256 + wc * 32 + 4 * fq;
#pragma unroll
                for (int bj = 0; bj < 2; ++bj)
#pragma unroll
                    for (int n = 0; n < 2; ++n) *(f32x4*)(rowp + bj * HALF + n * 16) = acc[ai][bj][m][n]; }
    }
};
struct EpiS5Out {
    static constexpr bool PERM = true, KSPLIT = false, TOEP = true; typedef f32x4 acc_t;
    bf16_t* Yg;
    __device__ __forceinline__ void operator()(f32x4 (&acc)[2][2][4][2], const Unit& u, int wr, int wc, int fr, int fq) const {
#pragma unroll
        for (int ai = 0; ai < 2; ++ai)
#pragma unroll
            for (int m = 0; m < 4; ++m) { const int R = u.pm * BM + ai * HALF + wr * 64 + m * 16 + fr;
#pragma unroll
                for (int bj = 0; bj < 2; ++bj) { const int n8 = u.pn * BM + bj * HALF + wc * 32 + 8 * fq, s = n8 >> 4, c0 = n8 & 15;
                    f32x4 vv[2];
#pragma unroll
                    for (int n = 0; n < 2; ++n)
#pragma unroll
                        for (int hf = 0; hf < 2; ++hf) { const f32x2 xv = (f32x2){acc[ai][bj][m][n][2 * hf], acc[ai][bj][m][n][2 * hf + 1]};
                            const f32x2 t = (xv * -2.30220818f) * ((xv * xv) * 0.044715f + 1.0f); f32x2 ev; ev.x = fast_exp2(t.x); ev.y = fast_exp2(t.y);
                            const f32x2 dv = ev + 1.0f; f32x2 rv; rv.x = fast_rcp(dv.x); rv.y = fast_rcp(dv.y);
                            const f32x2 yv = xv * rv; vv[n][2 * hf] = yv.x; vv[n][2 * hf + 1] = yv.y; }
                    *(u32x4*)(Yg + (size_t)(R * CL + s) * SW + u.g * SC + c0) = pack8(vv[0], vv[1]); } }
    }
};
struct EpiGlu {
    static constexpr bool PERM = true, KSPLIT = false, TOEP = false; typedef f32x4 acc_t;
    const bf16_t* Yg; const float* bias; bf16_t* YAYS; float* ssq4; LAS float* X;
    __device__ __forceinline__ void operator()(f32x4 (&acc)[2][2][4][2], const Unit& u, int wr, int wc, int fr, int fq) const {
        const int c8b = u.pn * BM + wc * 32 + 8 * fq;
        f32x4 bv[2][2];
#pragma unroll
        for (int bj = 0; bj < 2; ++bj)
#pragma unroll
            for (int n = 0; n < 2; ++n) bv[bj][n] = *(const f32x4*)(bias + c8b + bj * HALF + 4 * n);
#pragma unroll
        for (int ai = 0; ai < 2; ++ai) {
            u32x4 yv[4][2];
#pragma unroll
            for (int m = 0; m < 4; ++m)
#pragma unroll
                for (int bj = 0; bj < 2; ++bj) yv[m][bj] = *(const u32x4*)(Yg + (size_t)(u.pm * BM + ai * HALF + wr * 64 + m * 16 + fr) * SW + c8b + bj * HALF);
#pragma unroll
            for (int m = 0; m < 4; ++m) { const int row = u.pm * BM + ai * HALF + wr * 64 + m * 16 + fr; float ss = 0.f;
#pragma unroll
                for (int bj = 0; bj < 2; ++bj) { const int c8 = c8b + bj * HALF; const u32x4 y = yv[m][bj];
                    const f32x4 a0 = acc[ai][bj][m][0] + bv[bj][0], a1 = acc[ai][bj][m][1] + bv[bj][1];
                    f32x4 v0, v1;
                    { const unsigned yw[4] = {y.x, y.y, y.z, y.w};
#pragma unroll
                      for (int hf = 0; hf < 4; ++hf) { const f32x2 av = hf < 2 ? (f32x2){a0[2 * hf], a0[2 * hf + 1]} : (f32x2){a1[2 * hf - 4], a1[2 * hf - 3]};
                          const f32x2 t = av * -1.44269504089f; f32x2 ev; ev.x = fast_exp2(t.x); ev.y = fast_exp2(t.y);
                          const f32x2 dv = ev + 1.0f; f32x2 rv; rv.x = fast_rcp(dv.x); rv.y = fast_rcp(dv.y);
                          const f32x2 yv = (f32x2){bf_lo(yw[hf]), bf_hi(yw[hf])} * rv;
                          if (hf < 2) { v0[2 * hf] = yv.x; v0[2 * hf + 1] = yv.y; } else { v1[2 * hf - 4] = yv.x; v1[2 * hf - 3] = yv.y; } } }
#pragma unroll
                    for (int e = 0; e < 4; ++e) ss += v0[e] * v0[e] + v1[e] * v1[e];
                    *(u32x4*)(YAYS + (size_t)row * DM + AW + c8) = pack8(v0, v1); }
                ss += __shfl_xor(ss, 16); ss += __shfl_xor(ss, 32);
                if (fq == 0) X[(ai * HALF + wr * 64 + m * 16 + fr) * 4 + wc] = ss; }
            asm volatile("" ::: "memory"); }
        asm volatile("s_waitcnt lgkmcnt(0)" ::: "memory"); __builtin_amdgcn_s_barrier(); asm volatile("" ::: "memory");
        if (wc == 0 && fq == 0) {
#pragma unroll
            for (int ai = 0; ai < 2; ++ai)
#pragma unroll
                for (int m = 0; m < 4; ++m) { const int rl = ai * HALF + wr * 64 + m * 16 + fr; const f32x4 p = *(const LAS f32x4*)(X + rl * 4);
                    ssq4[(size_t)u.pn * M + u.pm * BM + rl] = (p[0] + p[1]) + (p[2] + p[3]); } }
    }
};
struct EpiRes1 {
    static constexpr bool PERM = true, KSPLIT = true, TOEP = false; typedef f32x4 acc_t;
    const bf16_t* xb; bf16_t* XB; const float* ssqa; const float* ssqs4; float* ssqx8; LAS float* X;
    __device__ __forceinline__ void operator()(f32x4 (&acc)[2][2][4][2], const Unit& u, int wr, int wc, int fr, int fq) const {
        if (u.kh == 0) {
#pragma unroll
        for (int ai = 0; ai < 2; ++ai)
#pragma unroll
            for (int m = 0; m < 4; ++m) { const int row = u.pm * BM + ai * HALF + wr * 64 + m * 16 + fr;
                const float sq = (ssqs4[row] + ssqs4[M + row]) + (ssqs4[2 * M + row] + ssqs4[3 * M + row]);
                const float ra = __builtin_amdgcn_rsqf(ssqa[row] * (1.0f / AW) + RMS_EPS), rs = __builtin_amdgcn_rsqf(sq * (1.0f / SW) + RMS_EPS), f = ra * fast_rcp(rs);
#pragma unroll
                for (int bj = 0; bj < 2; ++bj)
#pragma unroll
                    for (int n = 0; n < 2; ++n) acc[ai][bj][m][n] *= f; }
        return; }
        float rsv[2][4];
#pragma unroll
        for (int ai = 0; ai < 2; ++ai)
#pragma unroll
            for (int m = 0; m < 4; ++m) { const int row = u.pm * BM + ai * HALF + wr * 64 + m * 16 + fr;
                const float sq = (ssqs4[row] + ssqs4[M + row]) + (ssqs4[2 * M + row] + ssqs4[3 * M + row]); rsv[ai][m] = __builtin_amdgcn_rsqf(sq * (1.0f / SW) + RMS_EPS); }
#pragma unroll
        for (int am = 0; am < 4; ++am) { const int ai = am >> 1, mb = (am & 1) * 2;
            u32x4 xv[2][2];
#pragma unroll
            for (int mm = 0; mm < 2; ++mm)
#pragma unroll
                for (int bj = 0; bj < 2; ++bj) xv[mm][bj] = *(const u32x4*)(xb + (size_t)(u.pm * BM + ai * HALF + wr * 64 + (mb + mm) * 16 + fr) * DM + u.pn * BM + bj * HALF + wc * 32 + 8 * fq);
#pragma unroll
            for (int mm = 0; mm < 2; ++mm) { const int m = mb + mm; const int row = u.pm * BM + ai * HALF + wr * 64 + m * 16 + fr; float ss = 0.f; const float rs = rsv[ai][m];
#pragma unroll
                for (int bj = 0; bj < 2; ++bj) { const size_t off = (size_t)row * DM + u.pn * BM + bj * HALF + wc * 32 + 8 * fq;
                    const u32x4 x4 = xv[mm][bj]; f32x4 x0, x1; x0[0] = bf_lo(x4.x); x0[1] = bf_hi(x4.x); x0[2] = bf_lo(x4.y); x0[3] = bf_hi(x4.y); x1[0] = bf_lo(x4.z); x1[1] = bf_hi(x4.z); x1[2] = bf_lo(x4.w); x1[3] = bf_hi(x4.w);
                    const f32x4 v0 = x0 + acc[ai][bj][m][0] * rs, v1 = x1 + acc[ai][bj][m][1] * rs;
#pragma unroll
                    for (int e = 0; e < 4; ++e) ss += v0[e] * v0[e] + v1[e] * v1[e];
                    *(u32x4*)(XB + off) = pack8(v0, v1); }
                ss += __shfl_xor(ss, 16); ss += __shfl_xor(ss, 32);
                if (fq == 0) X[(ai * HALF + wr * 64 + m * 16 + fr) * 4 + wc] = ss; }
            asm volatile("" ::: "memory"); }
        asm volatile("s_waitcnt lgkmcnt(0)" ::: "memory"); __builtin_amdgcn_s_barrier(); asm volatile("" ::: "memory");
        if (wc == 0 && fq == 0) {
#pragma unroll
            for (int ai = 0; ai < 2; ++ai)
#pragma unroll
                for (int m = 0; m < 4; ++m) { const int rl = ai * HALF + wr * 64 + m * 16 + fr; const f32x4 p = *(const LAS f32x4*)(X + rl * 4);
                    ssqx8[(size_t)u.pn * M + u.pm * BM + rl] = (p[0] + p[1]) + (p[2] + p[3]); } }
    }
};
struct EpiSwiGLU {
    static constexpr bool PERM = true, KSPLIT = false, TOEP = false; typedef i32x4 acc_t;
    bf16_t* H; const LAS float* FA; const float* sb; mutable float rsv[2][4]; mutable int cpm;
    __device__ __forceinline__ void operator()(i32x4 (&acc)[2][2][4][2], const Unit& u, int wr, int wc, int fr, int fq) const {
        if (u.pm != cpm) { cpm = u.pm;
#pragma unroll
        for (int ai = 0; ai < 2; ++ai)
#pragma unroll
            for (int m = 0; m < 4; ++m) rsv[ai][m] = FA[ai * HALF + wr * 64 + m * 16 + fr]; }
        const float* sp = sb + u.pn * BM + wc * 32 + 8 * fq;
        const f32x4 sg0 = *(const f32x4*)sp, sg1 = *(const f32x4*)(sp + 4), su0 = *(const f32x4*)(sp + HALF), su1 = *(const f32x4*)(sp + HALF + 4);
#pragma unroll
        for (int ai = 0; ai < 2; ++ai)
#pragma unroll
            for (int m = 0; m < 4; ++m) { const int row = u.pm * BM + ai * HALF + wr * 64 + m * 16 + fr; const float rs = rsv[ai][m];
                f32x4 hv[2];
#pragma unroll
                for (int n = 0; n < 2; ++n) { const f32x4 sg = (n == 0 ? sg0 : sg1) * rs, su = (n == 0 ? su0 : su1) * rs;
#pragma unroll
                    for (int hf = 0; hf < 2; ++hf) { const f32x2 ga = (f32x2){(float)acc[ai][0][m][n][2 * hf] * sg[2 * hf], (float)acc[ai][0][m][n][2 * hf + 1] * sg[2 * hf + 1]};
                        const f32x2 ua = (f32x2){(float)acc[ai][1][m][n][2 * hf] * su[2 * hf], (float)acc[ai][1][m][n][2 * hf + 1] * su[2 * hf + 1]};
                        const f32x2 t = ga * -1.44269504089f; f32x2 ev; ev.x = fast_exp2(t.x); ev.y = fast_exp2(t.y);
                        const f32x2 dv = ev + 1.0f; f32x2 rv; rv.x = fast_rcp(dv.x); rv.y = fast_rcp(dv.y);
                        const f32x2 hh = (ga * ua) * rv; hv[n][2 * hf] = hh.x; hv[n][2 * hf + 1] = hh.y; } }
                *(u32x4*)(H + (size_t)row * DFF + u.pn * HALF + wc * 32 + 8 * fq) = pack8(hv[0], hv[1]); }
    }
};
struct EpiRes2 {
    static constexpr bool PERM = true, KSPLIT = false, TOEP = false; typedef f32x4 acc_t;
    float* out; const bf16_t* XB;
    __device__ __forceinline__ void operator()(f32x4 (&acc)[2][2][4][2], const Unit& u, int wr, int wc, int fr, int fq) const {
#pragma unroll
        for (int ai = 0; ai < 2; ++ai) {
            u32x4 xb[4][2];
#pragma unroll
            for (int m = 0; m < 4; ++m)
#pragma unroll
                for (int bj = 0; bj < 2; ++bj) xb[m][bj] = *(const u32x4*)(XB + (size_t)(u.pm * BM + ai * HALF + wr * 64 + m * 16 + fr) * DM + u.pn * BM + wc * 32 + 8 * fq + bj * HALF);
#pragma unroll
            for (int m = 0; m < 4; ++m) { const size_t roff = (size_t)(u.pm * BM + ai * HALF + wr * 64 + m * 16 + fr) * DM + u.pn * BM + wc * 32 + 8 * fq;
#pragma unroll
                for (int bj = 0; bj < 2; ++bj) { const size_t off = roff + bj * HALF; const u32x4 x4 = xb[m][bj];
                    f32x4 v0, v1; v0[0] = bf_lo(x4.x); v0[1] = bf_hi(x4.x); v0[2] = bf_lo(x4.y); v0[3] = bf_hi(x4.y); v1[0] = bf_lo(x4.z); v1[1] = bf_hi(x4.z); v1[2] = bf_lo(x4.w); v1[3] = bf_hi(x4.w);
                    *(f32x4*)(out + off) = v0 + acc[ai][bj][m][0]; *(f32x4*)(out + off + 4) = v1 + acc[ai][bj][m][1]; } }
            asm volatile("" ::: "memory"); }
    }
};
}

#define RLX_AGENT __ATOMIC_RELAXED, __HIP_MEMORY_SCOPE_AGENT
#define XB_TMO      128
#define XB_XCNT(j)  (256  + 64 * (j))
#define XB_XSUB(j)  (1280 + 64 * (j))
#define XB_XGEN(j)  (2304 + 64 * (j))
#define XB_TOP      3328
#define XB_TOPGEN   3392
#define XCD_BAR_WORDS 3456
#define XB_SPIN_CAP (1u << 24)
__device__ __forceinline__ unsigned xb_ld(unsigned* p)              { return __hip_atomic_load(p, __ATOMIC_RELAXED, __HIP_MEMORY_SCOPE_AGENT); }
__device__ __forceinline__ unsigned xb_add(unsigned* p, unsigned v) { return __hip_atomic_fetch_add(p, v, __ATOMIC_RELAXED, __HIP_MEMORY_SCOPE_AGENT); }
__device__ __forceinline__ unsigned xb_xcc_id() { return (unsigned)__builtin_amdgcn_s_getreg((3 << 11) | 20) & 0xFu; }
#define XB_SPIN(cond, bar) do { unsigned _sp = 0; while (cond) { __builtin_amdgcn_s_sleep(1); \
    if ((++_sp & 255u) == 0u) { if (xb_ld(&(bar)[XB_TMO])) break; if (_sp > XB_SPIN_CAP) { atomicAdd(&(bar)[XB_TMO], 1u); break; } } } } while (0)
struct XcdBarrier { unsigned* bar; unsigned x; volatile LAS unsigned* st; };
__device__ __forceinline__ XcdBarrier xcd_barrier_post(unsigned* bar, volatile LAS unsigned* st) {
    XcdBarrier b; b.bar = bar; b.x = xb_xcc_id(); b.st = st;
    if (threadIdx.x == 0) (void)xb_add(&bar[XB_XCNT(b.x)], 1u);
    return b;
}
__device__ __forceinline__ void xcd_barrier_complete(unsigned* bar, unsigned x, unsigned& nloc, unsigned& nx) {
    const unsigned G = gridDim.x * gridDim.y * gridDim.z;
    unsigned sum, cnt, mine, sp = 0u;
    for (;;) {
        sum = 0u; cnt = 0u; mine = 0u;
#pragma unroll
        for (unsigned j = 0; j < 16; ++j) { const unsigned c = xb_ld(&bar[XB_XCNT(j)]); sum += c; cnt += (c > 0u) ? 1u : 0u; mine = (j == x) ? c : mine; }
        if (sum == G) break;
        __builtin_amdgcn_s_sleep(1);
        if ((++sp & 255u) == 0u) { if (xb_ld(&bar[XB_TMO])) break; if (sp > XB_SPIN_CAP) { atomicAdd(&bar[XB_TMO], 1u); break; } }
    }
    nloc = mine > 0u ? mine : 1u; nx = cnt > 0u ? cnt : 1u;
}
__device__ __forceinline__ void xcd_barrier(const XcdBarrier& b) {
    asm volatile("s_waitcnt vmcnt(0)" ::: "memory");
    __syncthreads();
    if (threadIdx.x == 0) {
        unsigned* bar = b.bar;
        __builtin_amdgcn_s_waitcnt(0);
        unsigned nloc = b.st[0], nx = b.st[1];
        if (nloc == 0u) { xcd_barrier_complete(bar, b.x, nloc, nx); b.st[0] = nloc; b.st[1] = nx; }
        const unsigned old = xb_add(&bar[XB_XSUB(b.x)], 1u);
        const unsigned gen = old / nloc;
        if (old + 1u == (gen + 1u) * nloc) {
            __builtin_amdgcn_fence(__ATOMIC_RELEASE, "agent");
            asm volatile("s_waitcnt vmcnt(0)" ::: "memory");
            const unsigned og = xb_add(&bar[XB_TOP], 1u);
            const unsigned tg = og / nx;
            if (og + 1u == (tg + 1u) * nx) xb_add(&bar[XB_TOPGEN], 1u);
            else XB_SPIN(xb_ld(&bar[XB_TOPGEN]) == tg, bar);
            __builtin_amdgcn_fence(__ATOMIC_ACQUIRE, "agent");
            xb_add(&bar[XB_XGEN(b.x)], 1u);
            asm volatile("s_waitcnt vmcnt(0)" ::: "memory");
        } else {
            XB_SPIN(xb_ld(&bar[XB_XGEN(b.x)]) == gen, bar);
            __builtin_amdgcn_fence(__ATOMIC_ACQUIRE, "agent");
            asm volatile("s_waitcnt vmcnt(0)" ::: "memory");
        }
    }
    __syncthreads();
}

struct Args { const float* in[23]; float* out; unsigned char* ws; int ph_lo, ph_hi, li, dup; };
enum { I_X = 0, I_GMIX, I_WIN, I_QG, I_KG, I_RPB, I_ARE, I_AIM, I_BRE, I_BIM, I_CRE, I_CIM, I_LS, I_D, I_WGLU, I_BGLU, I_GOA, I_GOS, I_WOUT, I_GFFN, I_WG, I_WU, I_WD };

#define LDS_WAIT() asm volatile("s_waitcnt lgkmcnt(0)" ::: "memory")

__device__ __forceinline__ void p0_transpose_item(const float* W, int N, const float* kscale, bf16_t* WT, int ldd, int drow0, int k0, int n0, int lane) {
    const int c = lane >> 3, n4 = (lane & 7) * 4;
    const float* src = W + (size_t)(k0 + 8 * c) * N + n0 + n4;
    f32x4 v[2][8];
#pragma unroll
    for (int h = 0; h < 2; ++h)
#pragma unroll
        for (int i = 0; i < 8; ++i) v[h][i] = __builtin_nontemporal_load((const f32x4*)(src + (size_t)i * N + 32 * h));
    if (kscale) { const f32x4 s0 = *(const f32x4*)(kscale + k0 + 8 * c), s1 = *(const f32x4*)(kscale + k0 + 8 * c + 4);
#pragma unroll
        for (int h = 0; h < 2; ++h)
#pragma unroll
            for (int i = 0; i < 8; ++i) v[h][i] *= (i < 4 ? s0[i & 3] : s1[i & 3]); }
#pragma unroll
    for (int h = 0; h < 2; ++h)
#pragma unroll
        for (int e = 0; e < 4; ++e) { u32x4 o; o.x = cvt_pk_bf16(v[h][0][e], v[h][1][e]); o.y = cvt_pk_bf16(v[h][2][e], v[h][3][e]); o.z = cvt_pk_bf16(v[h][4][e], v[h][5][e]); o.w = cvt_pk_bf16(v[h][6][e], v[h][7][e]);
            *(u32x4*)(WT + (size_t)(drow0 + 32 * h + n4 + e) * ldd + k0 + 8 * c) = o; }
}

__device__ __forceinline__ void dsincos(double a, double& s, double& c) {
    const double k = __builtin_rint(a * 0.63661977236758134308);
    double r = __builtin_fma(-k, 1.57079632679489655800e+00, a);
    r = __builtin_fma(-k, 6.12323399573676603587e-17, r);
    const double r2 = r * r;
    double sp = -7.6471637318198164759e-13; sp = sp * r2 + 1.6059043836821614599e-10; sp = sp * r2 - 2.5052108385441718775e-08; sp = sp * r2 + 2.7557319223985890653e-06;
    sp = sp * r2 - 1.9841269841269841270e-04; sp = sp * r2 + 8.3333333333333333333e-03; sp = sp * r2 - 1.6666666666666666667e-01; sp = sp * r2 * r + r;
    double cp = 4.7794773323873852974e-14; cp = cp * r2 - 1.1470745597729724714e-11; cp = cp * r2 + 2.0876756987868098979e-09; cp = cp * r2 - 2.7557319223985890653e-07;
    cp = cp * r2 + 2.4801587301587301587e-05; cp = cp * r2 - 1.3888888888888888889e-03; cp = cp * r2 + 4.1666666666666666667e-02; cp = cp * r2 - 0.5; cp = cp * r2 + 1.0;
    const int q = (int)((long long)k) & 3;
    s = (q == 0) ? sp : (q == 1) ? cp : (q == 2) ? -sp : -cp;
    c = (q == 0) ? cp : (q == 1) ? -sp : (q == 2) ? -cp : sp;
}

struct S5Params { f32x4 br4, bi4, cr4, ci4; float are, aim, ls; };
__device__ __forceinline__ void p0_s5_params(const Args& a, int g, int tid, S5Params& P) {
    const float* a_re = a.in[I_ARE]; const float* a_im = a.in[I_AIM]; const float* b_re = a.in[I_BRE]; const float* b_im = a.in[I_BIM];
    const float* c_re = a.in[I_CRE]; const float* c_im = a.in[I_CIM]; const float* lstep = a.in[I_LS];
#pragma unroll
    for (int j = 0; j < 4; ++j) { const int i = tid + 512 * j, c = i & 15, p = (i >> 4) & 63, d = i >> 10;
        const size_t bi = (((size_t)d * SG + g) * SP + p) * SC + c, ci = (((size_t)d * SG + g) * SC + c) * SP + p;
        P.br4[j] = b_re[bi]; P.bi4[j] = b_im[bi]; P.cr4[j] = c_re[ci]; P.ci4[j] = c_im[ci]; }
    { const int p = tid & 63, d = (tid >> 6) & 1; P.are = a_re[(d * SG + g) * SP + p]; P.aim = a_im[(d * SG + g) * SP + p]; P.ls = lstep[d * SG + g]; }
}
__device__ __forceinline__ void p0_s5_tables(const Args& a, LAS unsigned char* lds, int g, int q, int tid, const S5Params& P) {
    LAS f32x2* LP = (LAS f32x2*)lds;
    LAS float* Bb = (LAS float*)(lds + 33792);
    LAS f32x2* Cm = (LAS f32x2*)(lds + 50176);
    LAS float* Kt = (LAS float*)(lds + 66560);
    const float* dsk = a.in[I_D];
    unsigned char* ws = a.ws;
    __syncthreads();
    LAS f32x2* Fp = (LAS f32x2*)(Kt);
    if (tid < 128) { const int p = tid & 63, d = tid >> 6;
        const double lre = (double)fminf(P.are, -1e-4f), lim = (double)P.aim, dt = exp((double)P.ls);
        const double mag = exp(lre * dt); double sn, cs; dsincos(lim * dt, sn, cs);
        const double lr = mag * cs, li = mag * sn;
        const double nr = lr - 1.0, ni = li, den = 1.0 / (lre * lre + lim * lim);
        Fp[d * 64 + p] = (f32x2){(float)((nr * lre + ni * lim) * den), (float)((ni * lre - nr * lim) * den)};
        double wr_ = 1.0, wi_ = 0.0;
        for (int tau = 0; tau <= CL; ++tau) { LP[(d * 64 + p) * 33 + tau] = (f32x2){(float)wr_, (float)wi_}; const double t_ = wr_ * lr - wi_ * li; wi_ = wr_ * li + wi_ * lr; wr_ = t_; } }
    __syncthreads();
#pragma unroll
    for (int j = 0; j < 4; ++j) { const int i = tid + 512 * j, c = i & 15, p = (i >> 4) & 63, d = i >> 10; const f32x2 f = Fp[d * 64 + p];
        Bb[(d * 64 + p) * 32 + c] = f.x * P.br4[j] - f.y * P.bi4[j]; Bb[(d * 64 + p) * 32 + 16 + c] = f.x * P.bi4[j] + f.y * P.br4[j];
        Cm[i] = (f32x2){P.cr4[j], P.ci4[j]}; }
    __syncthreads();
    if (q == 0 && tid < 128) { const int p = tid & 63, d = tid >> 6; ((f32x2*)(ws + WS_LAML))[(g * 2 + d) * SP + p] = LP[(d * 64 + p) * 33 + CL]; }
    { const int wv = __builtin_amdgcn_readfirstlane(tid >> 6), l = tid & 63, c16 = l & 15, g4 = l >> 4;
#pragma unroll 1
      for (int d = 0; d < 2; ++d) {
        bf16x8 Bf[4];
#pragma unroll
        for (int ks = 0; ks < 4; ++ks) { float v[8];
#pragma unroll
            for (int j = 0; j < 8; ++j) v[j] = Bb[(d * 64 + 32 * (ks & 1) + 8 * g4 + j) * 32 + (ks >> 1) * 16 + c16];
            u32x4 w; w.x = cvt_pk_bf16(v[0], v[1]); w.y = cvt_pk_bf16(v[2], v[3]); w.z = cvt_pk_bf16(v[4], v[5]); w.w = cvt_pk_bf16(v[6], v[7]); Bf[ks] = __builtin_bit_cast(bf16x8, w); }
#pragma unroll 1
        for (int tt = 0; tt < 4; ++tt) { const int tau = wv + 8 * tt;
            f32x4 acc = (f32x4){0.f, 0.f, 0.f, 0.f};
#pragma unroll
            for (int ks = 0; ks < 2; ++ks) { float gr[8], gi[8];
#pragma unroll
                for (int j = 0; j < 8; ++j) { const int p = 32 * ks + 8 * g4 + j; const f32x2 cm = Cm[(d * 64 + p) * 16 + c16], lp = LP[(d * 64 + p) * 33 + tau];
                    gr[j] = cm.x * lp.x - cm.y * lp.y; gi[j] = -(cm.x * lp.y + cm.y * lp.x); }
                u32x4 wr_, wi_; wr_.x = cvt_pk_bf16(gr[0], gr[1]); wr_.y = cvt_pk_bf16(gr[2], gr[3]); wr_.z = cvt_pk_bf16(gr[4], gr[5]); wr_.w = cvt_pk_bf16(gr[6], gr[7]);
                wi_.x = cvt_pk_bf16(gi[0], gi[1]); wi_.y = cvt_pk_bf16(gi[2], gi[3]); wi_.z = cvt_pk_bf16(gi[4], gi[5]); wi_.w = cvt_pk_bf16(gi[6], gi[7]);
                acc = __builtin_amdgcn_mfma_f32_16x16x32_bf16(__builtin_bit_cast(bf16x8, wr_), Bf[ks], acc, 0, 0, 0);
                acc = __builtin_amdgcn_mfma_f32_16x16x32_bf16(__builtin_bit_cast(bf16x8, wi_), Bf[2 + ks], acc, 0, 0, 0); }
#pragma unroll
            for (int e = 0; e < 4; ++e) Kt[((d * 32 + tau) * 16 + 4 * g4 + e) * 16 + c16] = acc[e]; } } }
    __syncthreads();
    { const int d = q >> 1, ri = q & 1, p = tid >> 3, s0 = (tid & 7) * 4;
      bf16_t* dst = (bf16_t*)(ws + WS_WST) + ((size_t)g * 256 + q * 64 + p) * 512 + s0 * 16;
      float bx_[16], by_[16];
#pragma unroll
      for (int e = 0; e < 16; ++e) { bx_[e] = Bb[(d * 64 + p) * 32 + e]; by_[e] = Bb[(d * 64 + p) * 32 + 16 + e]; }
#pragma unroll
      for (int sp = 0; sp < 4; ++sp) { const int pw = d == 0 ? (CL - 1 - (s0 + sp)) : (s0 + sp); const f32x2 lp = LP[(d * 64 + p) * 33 + pw]; float v[16];
#pragma unroll
          for (int e = 0; e < 16; ++e) v[e] = ri == 0 ? (lp.x * bx_[e] - lp.y * by_[e]) : (lp.x * by_[e] + lp.y * bx_[e]);
          u32x4 w0, w1; w0.x = cvt_pk_bf16(v[0], v[1]); w0.y = cvt_pk_bf16(v[2], v[3]); w0.z = cvt_pk_bf16(v[4], v[5]); w0.w = cvt_pk_bf16(v[6], v[7]);
          w1.x = cvt_pk_bf16(v[8], v[9]); w1.y = cvt_pk_bf16(v[10], v[11]); w1.z = cvt_pk_bf16(v[12], v[13]); w1.w = cvt_pk_bf16(v[14], v[15]);
          *(u32x4*)(dst + sp * 16) = w0; *(u32x4*)(dst + sp * 16 + 8) = w1; } }
    { const int L = 16 * q + (tid >> 5), c = (tid >> 1) & 15, c0 = (tid & 1) * 8;
      if (L < 63) { const float dsv = dsk[g * SC + c]; float v[8];
          const LAS float* k0 = Kt + ((L >= 31 ? (L - 31) : (32 + 31 - L)) * 16 + c) * 16 + c0;
#pragma unroll
          for (int e = 0; e < 8; ++e) v[e] = k0[e];
          if (L == 31) { const LAS float* k1 = Kt + (32 * 16 + c) * 16 + c0;
#pragma unroll
              for (int e = 0; e < 8; ++e) v[e] += k1[e] + ((c == c0 + e) ? dsv : 0.f); }
          u32x4 w; w.x = cvt_pk_bf16(v[0], v[1]); w.y = cvt_pk_bf16(v[2], v[3]); w.z = cvt_pk_bf16(v[4], v[5]); w.w = cvt_pk_bf16(v[6], v[7]);
          *(u32x4*)((bf16_t*)(ws + WS_KB) + (((size_t)g * 64 + L) * 16 + c) * 16 + c0) = w; } }
    { const int c = tid & 15, s = 8 * q + ((tid >> 4) & 7), hi2 = tid >> 7;
      bf16_t* dst = (bf16_t*)(ws + WS_WO) + ((size_t)g * 512 + s * 16 + c) * 256;
      { const int d = hi2 >> 1, ri = hi2 & 1, pw = d == 0 ? (s + 1) : (CL - s);
#pragma unroll 1
        for (int pb = 0; pb < 8; ++pb) { float v[8];
#pragma unroll
            for (int e = 0; e < 8; ++e) { const int p = 8 * pb + e; const f32x2 cm = Cm[(d * 64 + p) * 16 + c], lp = LP[(d * 64 + p) * 33 + pw];
                v[e] = ri == 0 ? (cm.x * lp.x - cm.y * lp.y) : -(cm.x * lp.y + cm.y * lp.x); }
            u32x4 w; w.x = cvt_pk_bf16(v[0], v[1]); w.y = cvt_pk_bf16(v[2], v[3]); w.z = cvt_pk_bf16(v[4], v[5]); w.w = cvt_pk_bf16(v[6], v[7]);
            *(u32x4*)(dst + hi2 * 64 + 8 * pb) = w; } } }
    __syncthreads();
}

__device__ __forceinline__ void p0_prologue(const Args& a, LAS unsigned char* lds, int vcu, int G, int tid) {
    asm volatile("" : "+v"(tid));
    const int wave = __builtin_amdgcn_readfirstlane(tid >> 6), lane = tid & 63;
    unsigned char* ws = a.ws;
    S5Params P5; p0_s5_params(a, (vcu < SG * 4 ? vcu : SG * 4 - 1) >> 2, tid, P5);
    const int gw = vcu * 8 + wave, NGW = G * 8;
    constexpr int I_IN = (DM / 64) * (INW / 64), I_GL = (SW / 64) * (SW / 64), I_OUT = (DM / 64) * (DM / 64), I_GU = (DM / 64) * (DFF / 64), I_DN = (DFF / 64) * (DM / 64);
    constexpr int NITEMS = I_IN + I_GL + I_OUT + 2 * I_GU + I_DN;
    const float* x = a.in[I_X]; bf16_t* XN = (bf16_t*)(ws + WS_XN); float* ssq0 = (float*)(ws + WS_SSQ0);
    const int n_tr = (NITEMS + NGW - 1) / NGW, n_xn = (M + 2 * NGW - 1) / (2 * NGW), n_steps = n_tr + n_xn, tstep = vcu % n_steps;
    for (int st = 0; st < n_steps; ++st) {
        if (st == tstep) { for (int it = vcu; it < SG * 4; it += G) { if (it != vcu) p0_s5_params(a, it >> 2, tid, P5); p0_s5_tables(a, lds, it >> 2, it & 3, tid, P5); } }
        if (st < n_tr) {
            int r = gw + st * NGW; if (r >= NITEMS) continue;
            if (r < I_IN) { const int nb = INW / 64, kb = r / nb, n0 = (r % nb) * 64; p0_transpose_item(a.in[I_WIN], INW, a.in[I_GMIX], (bf16_t*)(ws + WS_WIN), DM, n0, kb * 64, n0, lane); continue; } r -= I_IN;
            if (r < I_GL) { const int nb = SW / 64, kb = r / nb, n0 = (r % nb) * 64; p0_transpose_item(a.in[I_WGLU], SW, nullptr, (bf16_t*)(ws + WS_WGLU), SW, n0, kb * 64, n0, lane); continue; } r -= I_GL;
            if (r < I_OUT) { const int nb = DM / 64, kb = r / nb, n0 = (r % nb) * 64, k0 = kb * 64;
                p0_transpose_item(a.in[I_WOUT], DM, k0 < AW ? a.in[I_GOA] : a.in[I_GOS] - AW, (bf16_t*)(ws + WS_WOUT), DM, n0, k0, n0, lane); continue; } r -= I_OUT;
            if (r < 2 * I_GU) { const int up = r >= I_GU; if (up) r -= I_GU; const int nb = DFF / 64, kb = r / nb, n0 = (r % nb) * 64;
                p0_transpose_item(up ? a.in[I_WU] : a.in[I_WG], DFF, a.in[I_GFFN], (bf16_t*)(ws + WS_WGU), DM, 256 * (n0 >> 7) + (n0 & 127) + (up ? 128 : 0), kb * 64, n0, lane); continue; } r -= 2 * I_GU;
            { const int nb = DM / 64, kb = r / nb, n0 = (r % nb) * 64; p0_transpose_item(a.in[I_WD], DM, nullptr, (bf16_t*)(ws + WS_WD), DFF, n0, kb * 64, n0, lane); }
            continue; }
        { const int m = gw + (st - n_tr) * 2 * NGW; if (m >= M) continue; const int m1 = m + NGW < M ? m + NGW : m;
        const f32x4* xr0 = (const f32x4*)(x + (size_t)m * DM) + lane; const f32x4* xr1 = (const f32x4*)(x + (size_t)m1 * DM) + lane; f32x4 v0[8], v1[8]; float s0 = 0.f, s1 = 0.f;
#pragma unroll
        for (int j = 0; j < 8; ++j) { v0[j] = __builtin_nontemporal_load(xr0 + 64 * j); v1[j] = __builtin_nontemporal_load(xr1 + 64 * j); }
        u32x2* o0 = (u32x2*)(XN + (size_t)m * DM) + lane; u32x2* o1 = (u32x2*)(XN + (size_t)m1 * DM) + lane;
#pragma unroll
        for (int j = 0; j < 8; ++j) { s0 += (v0[j][0] * v0[j][0] + v0[j][1] * v0[j][1]) + (v0[j][2] * v0[j][2] + v0[j][3] * v0[j][3]); s1 += (v1[j][0] * v1[j][0] + v1[j][1] * v1[j][1]) + (v1[j][2] * v1[j][2] + v1[j][3] * v1[j][3]);
            u32x2 w; w.x = cvt_pk_bf16(v0[j][0], v0[j][1]); w.y = cvt_pk_bf16(v0[j][2], v0[j][3]); o0[64 * j] = w;
            u32x2 w2; w2.x = cvt_pk_bf16(v1[j][0], v1[j][1]); w2.y = cvt_pk_bf16(v1[j][2], v1[j][3]); o1[64 * j] = w2; }
        s0 = wave_sum(s0); s1 = wave_sum(s1);
        if (lane == 0) { ssq0[m] = s0; ssq0[m1] = s1; } }
    }
}

constexpr int ATT_PF = 6;
constexpr int KROW = 144, AROW = 160;
constexpr int AHEAD = 64 * AROW;
constexpr int ABUF = 2 * AHEAD;
constexpr int ABUF2 = 2 * ABUF;
constexpr int ATT_RPB_OFF = 2 * ABUF2;
static_assert(ATT_RPB_OFF + 16 * 465 * 4 <= MISC_OFF, "attention LDS");

__device__ __forceinline__ void attn_phase(const Args& a, LAS unsigned char* lds, volatile LAS unsigned* MISC, int vcu, int G, int has_g2, int tid) {
    asm volatile("" : "+v"(tid));
    const int wave = __builtin_amdgcn_readfirstlane(tid >> 6), lane = tid & 63, ql = lane & 15, g4 = lane >> 4;
    const bf16_t* QKV = (const bf16_t*)(a.ws + WS_BIG); bf16_t* YAYS = (bf16_t*)(a.ws + WS_YAYS); float* ssqa16 = (float*)(a.ws + WS_SSQA16);
    LAS float* rpbL = (LAS float*)(lds + ATT_RPB_OFF);
    for (int i = tid; i < 16 * 465; i += 512) rpbL[i] = a.in[I_RPB][i] * 1.44269504089f;
    const int j = wave & 3, hsel = wave >> 2;
    const int cq = 16 * j + ql, cs = min(max(cq - 8, 0), GRIDW - 16), wb = (j == 0) ? 0 : (j == 1) ? 8 : (j == 2) ? 24 : 32;
    int it_lo, it_hi, it_step;
    if (G == 256) { const int x_ = vcu >> 5, k_ = vcu & 15; it_step = 16; if (has_g2) { it_lo = x_ * 256 + 208 + k_; it_hi = x_ * 256 + 256; } else { it_lo = x_ * 256 + k_; it_hi = x_ * 256 + 208; } }
    else { it_lo = vcu; it_hi = BATCH * NROWS * 8; it_step = G; }
#define ATT_FETCH(dst) do { if (tid == 0) { const int nx_ = ((dst) == 20) ? it_lo : item + it_step; MISC[dst] = (unsigned)(nx_ < it_hi ? nx_ : -1); } } while (0)
    int item = 0;
    ATT_FETCH(20);
    __syncthreads();
    item = __builtin_amdgcn_readfirstlane((int)MISC[20]);
    const int skey = tid >> 3, sch = tid & 7;
    const unsigned ldstK = (unsigned)(skey * KROW + sch * 16), ldstV = (unsigned)(skey * AROW + sch * 16);
    u32x4 R[4][4];
#define ATT_UN(it_) ((((it_) >> 8) << 5) | ((it_) & 31))
#define ATT_HP(it_) (((it_) >> 5) & 7)
#define ATT_BASE(it_) (QKV + ((size_t)(ATT_UN(it_) >> 6) * SEQ + 64 * min(max((ATT_UN(it_) & 63) - 4, 0), NROWS - 8) + skey) * NQKV + AW + 128 * ATT_HP(it_) + 8 * sch)
#define ATT_SRC2(base_, s_, rr_, i_) ((base_) + (size_t)((((s_) & 3) * 2) + (rr_)) * 64 * NQKV + ((s_) < 4 ? 0 : AW) + 64 * (i_))
#define ATT_LOAD(slot_, base_, s_) do { _Pragma("unroll") for (int rr_ = 0; rr_ < 2; ++rr_) _Pragma("unroll") for (int i_ = 0; i_ < 2; ++i_) R[slot_][rr_ * 2 + i_] = *(const u32x4*)ATT_SRC2(base_, s_, rr_, i_); } while (0)
    if (item >= 0) { const bf16_t* kb0 = ATT_BASE(item);
#pragma unroll
        for (int p = 0; p < 3; ++p) ATT_LOAD(p, kb0, p);
    }
    while (item >= 0) {
        const int un_ = ATT_UN(item), b = un_ >> 6, r = un_ & 63, hp = ATT_HP(item), h = 2 * hp + hsel, row_start = min(max(r - 4, 0), NROWS - 8);
        ATT_FETCH(21);
        const size_t tq = (size_t)b * SEQ + 64 * r + cq;
        bf16x8 Qf[2];
        { const u32x4* qp = (const u32x4*)(QKV + tq * NQKV + 64 * h + 8 * g4); Qf[0] = __builtin_bit_cast(bf16x8, qp[0]); Qf[1] = __builtin_bit_cast(bf16x8, qp[4]); }
        const LAS float* bl = rpbL + h * 465 + (row_start - r + 7) * 31 + (wb + 4 * g4 - cq + 15);
        f32x4 S[8][2]; bf16x8 Pf[8]; f32x4 O[4]; float sum = 0.f; int nitem = -1;
        const bf16_t* kcur = ATT_BASE(item); const bf16_t* knxt = kcur;
#pragma unroll
        for (int dt = 0; dt < 4; ++dt) O[dt] = (f32x4){0.f, 0.f, 0.f, 0.f};
#pragma unroll
        for (int st = 0; st < 8; ++st) {
            LAS unsigned char* buf = lds + (st & 1) * ABUF2;
            { const unsigned ld_ = st < 4 ? ldstK : ldstV;
#pragma unroll
              for (int rr = 0; rr < 2; ++rr) { *(LAS u32x4*)(buf + rr * ABUF + ld_) = R[st & 3][rr * 2]; *(LAS u32x4*)(buf + rr * ABUF + AHEAD + ld_) = R[st & 3][rr * 2 + 1]; } }
            if (st + 3 < 8) ATT_LOAD((st + 3) & 3, kcur, st + 3); else ATT_LOAD((st + 3) & 3, knxt, st + 3 - 8);
            asm volatile("s_waitcnt lgkmcnt(0)" ::: "memory"); __builtin_amdgcn_s_barrier(); asm volatile("" ::: "memory");
            if (st == 0) { nitem = __builtin_amdgcn_readfirstlane((int)MISC[21]); const int ni_ = nitem >= 0 ? nitem : item; knxt = ATT_BASE(ni_); }
#pragma unroll
            for (int rr = 0; rr < 2; ++rr) {
                const LAS unsigned char* hb = buf + rr * ABUF + hsel * AHEAD;
                if (st < 4) {
                    const int kr = 2 * st + rr;
#pragma unroll
                    for (int t = 0; t < 2; ++t) {
                        const LAS unsigned char* kp = hb + (wb + 16 * t + ql) * KROW + g4 * 16;
                        const bf16x8 k0 = *(const LAS bf16x8*)kp, k1 = *(const LAS bf16x8*)(kp + 64);
                        f32x4 acc = (f32x4){0.f, 0.f, 0.f, 0.f};
                        acc = __builtin_amdgcn_mfma_f32_16x16x32_bf16(k0, Qf[0], acc, 0, 0, 0);
                        acc = __builtin_amdgcn_mfma_f32_16x16x32_bf16(k1, Qf[1], acc, 0, 0, 0);
#pragma unroll
                        for (int e = 0; e < 4; ++e) { const int ck = wb + 16 * t + 4 * g4 + e;
                            const float bias = bl[kr * 31 + 16 * t + e];
                            acc[e] = (ck >= cs && ck < cs + 16) ? acc[e] + bias : -1e30f; }
                        S[kr][t] = acc; }
                } else {
                    const int kr = 2 * (st - 4) + rr;
                    const LAS unsigned char* rp = hb + (wb + 4 * g4 + ((lane & 15) >> 2)) * AROW + (lane & 3) * 8;
#pragma unroll
                    for (int dt = 0; dt < 4; ++dt) {
                        const s16x4 lo = __builtin_amdgcn_ds_read_tr16_b64_v4i16((LAS s16x4*)(rp + dt * 32));
                        const s16x4 hi = __builtin_amdgcn_ds_read_tr16_b64_v4i16((LAS s16x4*)(rp + 16 * AROW + dt * 32));
                        const bf16x8 av = (bf16x8){lo[0], lo[1], lo[2], lo[3], hi[0], hi[1], hi[2], hi[3]};
                        O[dt] = __builtin_amdgcn_mfma_f32_16x16x32_bf16(av, Pf[kr], O[dt], 0, 0, 0); }
                }
            }
            if (st == 3) {
#pragma unroll
                for (int k2 = 0; k2 < 8; ++k2) { f32x4 p0, p1;
#pragma unroll
                    for (int e = 0; e < 4; ++e) { p0[e] = fast_exp2(S[k2][0][e]); p1[e] = fast_exp2(S[k2][1][e]); sum += p0[e] + p1[e]; }
                    Pf[k2] = __builtin_bit_cast(bf16x8, pg8::pack8(p0, p1)); }
                sum += __shfl_xor(sum, 16); sum += __shfl_xor(sum, 32);
            }
        }
        const float inv = fast_rcp(sum); float ssq_acc = 0.f;
        bf16_t* op = YAYS + tq * DM + 64 * h + 4 * g4;
#pragma unroll
        for (int dt = 0; dt < 4; ++dt) { const f32x4 o = O[dt] * inv; ssq_acc += (o[0] * o[0] + o[1] * o[1]) + (o[2] * o[2] + o[3] * o[3]);
            u32x2 w; w.x = cvt_pk_bf16(o[0], o[1]); w.y = cvt_pk_bf16(o[2], o[3]); *(u32x2*)(op + 16 * dt) = w; }
        ssq_acc += __shfl_xor(ssq_acc, 16); ssq_acc += __shfl_xor(ssq_acc, 32);
        if (g4 == 0) ssqa16[tq * 16 + h] = ssq_acc;
        item = nitem;
    }
#undef ATT_FETCH
#undef ATT_BASE
#undef ATT_SRC2
#undef ATT_LOAD
#undef ATT_UN
#undef ATT_HP
}

__device__ __forceinline__ void scan_chain(const Args& a, int g, int pm, int tid) {
    asm volatile("" : "+v"(tid));
    if (tid >= 256) return;
    const float* E = (const float*)(a.ws + WS_E); bf16_t* A5 = (bf16_t*)(a.ws + WS_A5); const f32x2* LAML = (const f32x2*)(a.ws + WS_LAML);
    const int p = tid & 63, d = (tid >> 6) & 1, b = 2 * pm + (tid >> 7);
    const f32x2 lam = LAML[(g * 2 + d) * SP + p];
    float xr = 0.f, xi = 0.f;
    const size_t R0 = (size_t)g * RCH + b * NCH;
#pragma unroll 1
    for (int rd = 0; rd < NCH / 32; ++rd) { float er[32], ei[32];
#pragma unroll
        for (int j = 0; j < 32; ++j) { const int kk = rd * 32 + j, k = d == 0 ? kk : NCH - 1 - kk; const float* ep = E + (R0 + k) * 256 + d * 128 + p; er[j] = ep[0]; ei[j] = ep[64]; }
#pragma unroll
        for (int j = 0; j < 32; ++j) { const int kk = rd * 32 + j, k = d == 0 ? kk : NCH - 1 - kk;
            bf16_t* ap = A5 + (R0 + k) * KS5 + 512 + d * 128 + p; ap[0] = (bf16_t)(cvt_pk_bf16(xr, 0.f) & 0xffffu); ap[64] = (bf16_t)(cvt_pk_bf16(xi, 0.f) & 0xffffu);
            const float nr = lam.x * xr - lam.y * xi + er[j], ni = lam.x * xi + lam.y * xr + ei[j]; xr = nr; xi = ni; } }
}

__device__ __forceinline__ unsigned pack_i8x4(float a, float b, float c, float d) {
    const int ia = (int)__builtin_rintf(a), ib = (int)__builtin_rintf(b), ic = (int)__builtin_rintf(c), id = (int)__builtin_rintf(d);
    return (unsigned)(ia & 255) | ((unsigned)(ib & 255) << 8) | ((unsigned)(ic & 255) << 16) | ((unsigned)id << 24);
}
__device__ __forceinline__ float quant_row_2048(const bf16_t* src, unsigned char* dst, int lane) {
    const u32x4* sp = (const u32x4*)(src + 32 * lane); u32x4 w[4];
#pragma unroll
    for (int j = 0; j < 4; ++j) w[j] = sp[j];
    float v[32]; float mx = 0.f;
#pragma unroll
    for (int j = 0; j < 4; ++j) { v[8 * j + 0] = bf_lo(w[j].x); v[8 * j + 1] = bf_hi(w[j].x); v[8 * j + 2] = bf_lo(w[j].y); v[8 * j + 3] = bf_hi(w[j].y);
        v[8 * j + 4] = bf_lo(w[j].z); v[8 * j + 5] = bf_hi(w[j].z); v[8 * j + 6] = bf_lo(w[j].w); v[8 * j + 7] = bf_hi(w[j].w); }
#pragma unroll
    for (int e = 0; e < 32; ++e) mx = fmaxf(mx, fabsf(v[e]));
#pragma unroll
    for (int o = 1; o < 64; o <<= 1) mx = fmaxf(mx, __shfl_xor(mx, o));
    mx = fmaxf(mx, 1e-20f);
    const float inv = 127.0f / mx;
    u32x4 q0, q1;
    q0.x = pack_i8x4(v[0] * inv, v[1] * inv, v[2] * inv, v[3] * inv); q0.y = pack_i8x4(v[4] * inv, v[5] * inv, v[6] * inv, v[7] * inv);
    q0.z = pack_i8x4(v[8] * inv, v[9] * inv, v[10] * inv, v[11] * inv); q0.w = pack_i8x4(v[12] * inv, v[13] * inv, v[14] * inv, v[15] * inv);
    q1.x = pack_i8x4(v[16] * inv, v[17] * inv, v[18] * inv, v[19] * inv); q1.y = pack_i8x4(v[20] * inv, v[21] * inv, v[22] * inv, v[23] * inv);
    q1.z = pack_i8x4(v[24] * inv, v[25] * inv, v[26] * inv, v[27] * inv); q1.w = pack_i8x4(v[28] * inv, v[29] * inv, v[30] * inv, v[31] * inv);
    u32x4* dp = (u32x4*)(dst + 32 * lane); dp[0] = q0; dp[1] = q1;
    return mx * (1.0f / 127.0f);
}

__global__ void __launch_bounds__(512, 2) hymba_fwd(Args args) {
    extern __shared__ __attribute__((aligned(16))) unsigned char lds_raw[];
    LAS unsigned char* lds = (LAS unsigned char*)lds_raw;
    volatile LAS unsigned* MISC = (volatile LAS unsigned*)(lds + MISC_OFF);
    const int tid = threadIdx.x;
    const int G = gridDim.x; const int bx = blockIdx.x; const int vcu = (G % 8 == 0) ? (bx % 8) * (G / 8) + bx / 8 : bx;
    unsigned char* ws = args.ws;
    unsigned* ctl = (unsigned*)(ws + WS_CTL);
    for (int u = tid; u < (LDS_BYTES - MISC_OFF) / 4; u += 512) MISC[u] = 0u;
    __syncthreads();
    XcdBarrier bar; bar.bar = ctl + CW_BAR; bar.x = 0; bar.st = nullptr;
    if (MK_N_LAUNCHES == 1) bar = xcd_barrier_post(ctl + CW_BAR, MISC + 8);
    const int lo = args.ph_lo, hi = args.ph_hi;
#define IN(k) (lo <= (k) && (k) < hi)
#define SEAM(k) do { if (IN(k) && IN((k) + 1)) xcd_barrier(bar); } while (0)
    bf16_t* WIN = (bf16_t*)(ws + WS_WIN); bf16_t* WGLU = (bf16_t*)(ws + WS_WGLU); bf16_t* WOUT = (bf16_t*)(ws + WS_WOUT); bf16_t* WGU = (bf16_t*)(ws + WS_WGU); bf16_t* WD = (bf16_t*)(ws + WS_WD);
    bf16_t* WST = (bf16_t*)(ws + WS_WST); bf16_t* KBT = (bf16_t*)(ws + WS_KB); bf16_t* WOT = (bf16_t*)(ws + WS_WO);
    bf16_t* XN = (bf16_t*)(ws + WS_XN); bf16_t* YG = (bf16_t*)(ws + WS_YG); bf16_t* XB = (bf16_t*)(ws + WS_XN);
    bf16_t* QKV = (bf16_t*)(ws + WS_BIG); bf16_t* A5 = (bf16_t*)(ws + WS_A5); float* E = (float*)(ws + WS_E); bf16_t* HB = (bf16_t*)(ws + WS_BIG);
    bf16_t* YAYS = (bf16_t*)(ws + WS_YAYS);
    float* ssqa16 = (float*)(ws + WS_SSQA16); float* ssqa = (float*)(ws + WS_SSQA); float* ssqs4 = (float*)(ws + WS_SSQS4); float* ssqx8 = (float*)(ws + WS_SSQX8);
    LAS float* XL = (LAS float*)(lds + RING_BYTES);

#define REP(k) _Pragma("unroll") for (int rep_ = (DUP_PHASE == (k)) ? 0 : 1; rep_ < 2; ++rep_)
#define ALPHA ((rep_ == 0 && args.dup >= 0) ? 0.0f : 1.0f)
    if (IN(0)) { REP(0) { p0_prologue(args, lds, vcu, G, tid); __syncthreads(); } SEAM(0); }
    if (IN(1)) {
        pg8::Gemm g{XN, WIN, DM, DM, DM, 0, 0, nullptr}; pg8::StaticOrder S; S.init(M, INW, G, bx);
        pg8::EpiZ Ep{QKV, A5, args.in[I_QG], args.in[I_KG], XL, (const float*)(ws + WS_SSQ0)};
        REP(1) pg8::gemm_phase(lds, g, S, Ep);
        SEAM(1);
    }
    if (IN(2)) {
        for (int cidx = bx; cidx < 2 * SG; cidx += G) { const int g_ = cidx >> 1, pm_ = cidx & 1;
            { pg8::Gemm g{A5, WST, KS5, 512, 512, (size_t)RCH * KS5, (size_t)256 * 512, nullptr}; pg8::ListOrder S; S.n = 1; S.u0.pm = pm_; S.u0.pn = 0; S.u0.g = g_; S.u0.kh = 0; S.u1 = S.u0;
              pg8::EpiE Ep{E};
              pg8::gemm_phase(lds, g, S, Ep); }
            asm volatile("s_waitcnt vmcnt(0)" ::: "memory"); __syncthreads();
            scan_chain(args, g_, pm_, tid);
            asm volatile("s_waitcnt vmcnt(0)" ::: "memory"); __syncthreads();
            { pg8::Gemm g{A5, KBT, KS5, KS5, KS5, (size_t)RCH * KS5, 0, WOT}; pg8::ListOrder S; S.n = 2; S.u0.pm = pm_; S.u0.pn = 0; S.u0.g = g_; S.u0.kh = 0; S.u1 = S.u0; S.u1.pn = 1;
              pg8::EpiS5Out Ep{YG};
              pg8::gemm_phase(lds, g, S, Ep); }
        }
        __syncthreads();
        attn_phase(args, lds, MISC, vcu, G, bx < 2 * SG ? 1 : 0, tid);
        SEAM(2);
    }
    if (IN(3)) {
        pg8::Gemm g{YG, WGLU, SW, SW, SW, 0, 0, nullptr}; pg8::StaticOrder S; S.init(M, SW, G, bx);
        for (int t = vcu * 512 + tid; t < M; t += G * 512) { const f32x4* p = (const f32x4*)(ssqa16 + (size_t)t * 16); const f32x4 s0 = p[0], s1 = p[1], s2 = p[2], s3 = p[3];
            const f32x4 sv = (s0 + s1) + (s2 + s3); ssqa[t] = (sv[0] + sv[1]) + (sv[2] + sv[3]); }
        REP(3) { pg8::EpiGlu Ep{YG, args.in[I_BGLU], YAYS, ssqs4, XL}; pg8::gemm_phase(lds, g, S, Ep); }
        SEAM(3);
    }
    if (IN(4)) {
        { const int wave_ = __builtin_amdgcn_readfirstlane(tid >> 6), lane_ = tid & 63; float* sbp = (float*)(ws + WS_SB);
          for (int row = vcu * 8 + wave_; row < 2 * DFF; row += G * 8) { const float sc = quant_row_2048(WGU + (size_t)row * DM, ws + WS_WQ + (size_t)row * DM, lane_); if (lane_ == 0) sbp[row] = sc; } }
        pg8::Gemm g{YAYS, WOUT, DM, DM, AW, 0, 0, nullptr}; pg8::SplitKOrder S; S.so.init(M, DM, G, bx);
        REP(4) { pg8::EpiRes1 Ep{XN, XB, ssqa, ssqs4, ssqx8, XL}; pg8::gemm_phase(lds, g, S, Ep); }
        SEAM(4);
    }
    if (IN(5)) {
        pg8::Gemm g{(const bf16_t*)(ws + WS_YAYS), (const bf16_t*)(ws + WS_WQ), DM / 2, DM / 2, DM / 2, 0, 0, nullptr}; pg8::StaticOrder S; S.init(M, 2 * DFF, G, bx);
        { pg8::Unit u0; LAS float* FA = XL + 2048;
          if (S.next(0, u0)) { const int wave_ = __builtin_amdgcn_readfirstlane(tid >> 6), lane_ = tid & 63;
            for (int rl = wave_; rl < 256; rl += 8) { const int row = u0.pm * 256 + rl;
                const float sc = quant_row_2048(XB + (size_t)row * DM, ws + WS_YAYS + (size_t)row * DM, lane_);
                float sq = 0.f;
#pragma unroll
                for (int t = 0; t < 8; ++t) sq += ssqx8[(size_t)t * M + row];
                if (lane_ == 0) FA[rl] = sc * __builtin_amdgcn_rsqf(sq * (1.0f / DM) + RMS_EPS); } }
          asm volatile("s_waitcnt vmcnt(0) lgkmcnt(0)" ::: "memory"); __syncthreads();
          pg8::EpiSwiGLU Ep{HB, FA, (const float*)(ws + WS_SB), {{0.f, 0.f, 0.f, 0.f}, {0.f, 0.f, 0.f, 0.f}}, -1};
          pg8::gemm_phase(lds, g, S, Ep); }
        SEAM(5);
    }
    if (IN(6)) {
        pg8::Gemm g{HB, WD, DFF, DFF, DFF, 0, 0, nullptr}; pg8::StaticOrder S; S.init(M, DM, G, bx);
        REP(6) { pg8::EpiRes2 Ep{args.out, XB}; pg8::gemm_phase(lds, g, S, Ep); }
    }
#undef IN
#undef SEAM
}

extern "C" void kernel_launch(void* const* d_in, const int* in_sizes, int n_in, void* d_out, int out_size, void* d_ws, size_t ws_size, hipStream_t stream) {
    static int grid = 0;
    if (grid == 0) {
        if (n_in != 23 || in_sizes[0] != M * DM || out_size != M * DM || ws_size < WS_END) { fprintf(stderr, "kernel_launch: unexpected shapes (n_in %d, in0 %d, out %d, ws %zu < %zu)\n", n_in, n_in > 0 ? in_sizes[0] : -1, out_size, ws_size, (size_t)WS_END); grid = -1; return; }
        int dev = 0, cus = 0, per_cu = 0;
        if (hipGetDevice(&dev) != hipSuccess || hipDeviceGetAttribute(&cus, hipDeviceAttributeMultiprocessorCount, dev) != hipSuccess) { grid = -1; return; }
        if (hipFuncSetAttribute((const void*)hymba_fwd, hipFuncAttributeMaxDynamicSharedMemorySize, LDS_BYTES) != hipSuccess) { fprintf(stderr, "kernel_launch: hipFuncSetAttribute failed\n"); grid = -1; return; }
        if (hipOccupancyMaxActiveBlocksPerMultiprocessor(&per_cu, (const void*)hymba_fwd, 512, LDS_BYTES) != hipSuccess || per_cu < 1) { fprintf(stderr, "kernel_launch: occupancy query says %d blocks per CU\n", per_cu); (void)hipGetLastError(); per_cu = 1; }
        grid = cus;
    }
    if (grid < 0) return;
    (void)hipMemsetAsync((char*)d_ws + WS_CTL, 0, CTL_ZERO_BYTES, stream);
    Args a{}; a.dup = DUP_PHASE;
    for (int i = 0; i < 23; ++i) a.in[i] = (const float*)d_in[i];
    a.out = (float*)d_out; a.ws = (unsigned char*)d_ws;
    if (MK_N_LAUNCHES == 1) {
        a.ph_lo = 0; a.ph_hi = NPHASE; a.li = 0;
        void* kargs[] = {&a};
        const hipError_t le = hipLaunchCooperativeKernel((const void*)hymba_fwd, dim3(grid), dim3(512), kargs, LDS_BYTES, stream);
        if (le != hipSuccess) fprintf(stderr, "kernel_launch: cooperative launch failed: %s (grid %d)\n", hipGetErrorString(le), grid);
    } else {
        for (int li = 0; li < NPHASE; ++li) { a.ph_lo = li; a.ph_hi = li + 1; a.li = li; hipLaunchKernelGGL(hymba_fwd, dim3(grid), dim3(512), LDS_BYTES, stream, a); }
    }
}
```

```cpp
#include <hip/hip_runtime.h>
#include <cstdio>
#include <cstdint>

#define DUP_PHASE (-1)
#ifndef MK_N_LAUNCHES
#define MK_N_LAUNCHES 1
#endif

#define GAS __attribute__((address_space(1)))
#define LAS __attribute__((address_space(3)))
typedef unsigned short bf16_t;
typedef short bf16x8 __attribute__((ext_vector_type(8)));
typedef short s16x4 __attribute__((ext_vector_type(4)));
typedef float f32x4 __attribute__((ext_vector_type(4)));
typedef float f32x2 __attribute__((ext_vector_type(2)));
typedef unsigned u32x4 __attribute__((ext_vector_type(4)));
typedef unsigned u32x2 __attribute__((ext_vector_type(2)));
typedef int i32x4 __attribute__((ext_vector_type(4)));

constexpr int BATCH = 4, SEQ = 4096, DM = 2048, M = BATCH * SEQ;
constexpr int AW = 1024, SW = 1024, NH = 16, HD = 64, NQKV = 3 * AW, INW = 4096, DFF = 5632;
constexpr int GRIDW = 64, NROWS = SEQ / GRIDW;
constexpr int SG = 64, SC = 16, SP = 64;
constexpr int CL = 32, NCH = SEQ / CL, RCH = M / CL;
constexpr int KS5 = CL * SC + 256;
constexpr float RMS_EPS = 1e-6f;
constexpr int NPHASE = 7;

constexpr size_t MiB = 1u << 20;
constexpr size_t WS_CTL = 0, CTL_ZERO_BYTES = 65536;
constexpr size_t WS_WIN = 1 * MiB, WS_WGLU = 17 * MiB, WS_WOUT = 19 * MiB, WS_WGU = 27 * MiB, WS_WD = 71 * MiB;
constexpr size_t WS_WST = 93 * MiB, WS_KB = 109 * MiB, WS_WO = 111 * MiB, WS_LAML = 157 * MiB;
constexpr size_t WS_XN = 158 * MiB;
constexpr size_t WS_BIG = 222 * MiB;
constexpr size_t WS_A5 = WS_BIG + 96 * MiB, WS_E = WS_BIG + 144 * MiB;
constexpr size_t WS_YAYS = 398 * MiB, WS_SSQ = 462 * MiB, WS_YG = 464 * MiB, WS_WQ = WS_YG, WS_END = 496 * MiB;
constexpr size_t WS_SSQA16 = WS_SSQ, WS_SSQA = WS_SSQ + 1 * MiB, WS_SSQS4 = WS_SSQA + 65536, WS_SSQX8 = WS_SSQS4 + 4 * 65536, WS_SSQ0 = WS_SSQX8 + 8 * 65536, WS_SB = WS_SSQ0 + 65536, WS_FAX = WS_SB + 65536;
static_assert(2 * DFF * 4 <= 65536 && WS_FAX + 65536 <= WS_YG, "ssq");
constexpr int CW_BAR = 4096;
static_assert((size_t)(CW_BAR + 3456) * 4 <= CTL_ZERO_BYTES, "ctl");

constexpr int RING_BYTES = 131072;
constexpr int MISC_OFF = 143360;
constexpr int LDS_BYTES = 147456;

__device__ __forceinline__ unsigned cvt_pk_bf16(float lo, float hi) { unsigned r; asm volatile("v_cvt_pk_bf16_f32 %0, %1, %2" : "=v"(r) : "v"(lo), "v"(hi)); return r; }
__device__ __forceinline__ float bf_lo(unsigned w) { return __uint_as_float(w << 16); }
__device__ __forceinline__ float bf_hi(unsigned w) { return __uint_as_float(w & 0xffff0000u); }
__device__ __forceinline__ float fast_rcp(float x) { return __builtin_amdgcn_rcpf(x); }
__device__ __forceinline__ float fast_exp2(float x) { return __builtin_amdgcn_exp2f(x); }
__device__ __forceinline__ float sigmoidf_(float x) { return fast_rcp(1.0f + fast_exp2(-1.44269504089f * x)); }
__device__ __forceinline__ float gelu_tanh(float x) { const float t = x * (1.0f + 0.044715f * x * x); return x * fast_rcp(1.0f + fast_exp2(-2.30220818f * t)); }
__device__ __forceinline__ float wave_sum(float v) {
#pragma unroll
    for (int o = 1; o < 64; o <<= 1) v += __shfl_xor(v, o);
    return v;
}

namespace pg8 {
constexpr int BM = 256, BK = 64, HALF = 128, HTB = HALF * BK * 2, NXCD = 8, WGM = 8;
__host__ __device__ __forceinline__ int lds_byte(int r, int c) { const int st = (r >> 4) * 2 + (c >> 5), rr = r & 15, cc = c & 31, ob = rr * 64 + cc * 2; return st * 1024 + (ob ^ (((ob >> 9) & 1) << 5)); }
__host__ __device__ __forceinline__ void stage_rc(int b, int& R, int& C) { const int st = b / 1024, sb = b % 1024, swz = sb ^ (((sb >> 9) & 1) << 5); R = (st >> 1) * 16 + swz / 64; C = (st & 1) * 32 + (swz % 64) / 2; }
__host__ __device__ __forceinline__ int perm32(int rho) { const int n = rho >> 4, i = rho & 15; return 8 * (i >> 2) + 4 * n + (i & 3); }

struct Unit { int pm, pn, g, kh; };
struct Gemm { const bf16_t* A; const bf16_t* Bt; int lda, ldb, K; size_t sA, sB; const bf16_t* Bt2; };

struct StaticOrder {
    int nM, nN, nwg, G, c;
    __device__ void init(int M_, int N_, int G_, int c_) { nM = M_ / BM; nN = N_ / BM; nwg = nM * nN; G = G_; c = c_; }
    __device__ bool next(int i, Unit& u) const {
        const long L = (long)i * G + c; if (L >= nwg) return false;
        int wgid = (int)L; { const int q = nwg / NXCD, r = nwg % NXCD, xcd = wgid % NXCD, off = wgid / NXCD; wgid = (xcd < r ? xcd * (q + 1) : r * (q + 1) + (xcd - r) * q) + off; }
        const int nig = WGM * nN, gid = wgid / nig, fm = gid * WGM, gsz = (nM - fm) < WGM ? (nM - fm) : WGM;
        u.pm = fm + ((wgid % nig) % gsz); u.pn = (wgid % nig) / gsz; u.g = 0; u.kh = 0; return true;
    }
};
struct SplitKOrder {
    StaticOrder so;
    __device__ bool next(int i, Unit& u) const { if (!so.next(i >> 1, u)) return false; u.kh = i & 1; return true; }
};
struct ListOrder {
    int n; Unit u0, u1;
    __device__ bool next(int i, Unit& u) const { if (i >= n) return false; u = i == 0 ? u0 : u1; return true; }
};
struct BatchOrder {
    int nM, nN, nwg, G, c;
    __device__ void init(int nM_, int nN_, int nb, int G_, int c_) { nM = nM_; nN = nN_; nwg = nM * nN * nb; G = G_; c = c_; }
    __device__ bool next(int i, Unit& u) const {
        const long L = (long)i * G + c; if (L >= nwg) return false;
        const int l = (int)L; u.pn = l % nN; u.pm = (l / nN) % nM; u.g = (l / (nN * nM)) % SG; u.kh = 0; return true;
    }
};

__device__ __forceinline__ f32x4 mma16(bf16x8 a, bf16x8 b, f32x4 c) { return __builtin_amdgcn_mfma_f32_16x16x32_bf16(a, b, c, 0, 0, 0); }
__device__ __forceinline__ i32x4 mma16(bf16x8 a, bf16x8 b, i32x4 c) { return __builtin_amdgcn_mfma_i32_16x16x64_i8(__builtin_bit_cast(i32x4, a), __builtin_bit_cast(i32x4, b), c, 0, 0, 0); }
template <class Epi, class Sched>
__device__ __forceinline__ void gemm_phase(LAS unsigned char* lds, const Gemm g, const Sched& S, const Epi& E) {
    int tid = threadIdx.x; asm volatile("" : "+v"(tid));
    const int wid = __builtin_amdgcn_readfirstlane(tid >> 6), lane = tid & 63, wr = wid >> 2, wc = wid & 3, fr = lane & 15, fq = lane >> 4;
    const int K = g.K, nt = K / BK;
    unsigned voffA[2], voffB[2], voffT[2], voffS[2];
#pragma unroll
    for (int i = 0; i < 2; ++i) { int R, C; stage_rc(tid * 16 + i * 8192, R, C); const int Rb = Epi::PERM ? ((R & ~31) + perm32(R & 31)) : R;
        voffA[i] = (unsigned)(R * g.lda + C) * 2u; voffB[i] = (unsigned)(Rb * g.ldb + C) * 2u;
        voffT[i] = (unsigned)((((Rb >> 4) - (C >> 4) + 3) * 256 + (Rb & 15) * 16 + (C & 15)) * 2); voffS[i] = (unsigned)(Rb * 256 + C) * 2u; }
    const size_t kstep = (size_t)(BK * 2);
    const size_t hstepA = (size_t)HALF * g.lda * 2, hstepB = (size_t)HALF * g.ldb * 2;
    const unsigned ldsw = (unsigned)wid * 1024u;
    const int aoff = lds_byte(wr * 64 + fr, fq * 8), boff = lds_byte(wc * 32 + fr, fq * 8);
#define PG8_SA(b, h) (((b) * 2 + (h)) * HTB)
#define PG8_SB(b, h) ((4 + (b) * 2 + (h)) * HTB)
#define PG8_STAGE(bufoff, gbase, voff) do { _Pragma("unroll") for (int _i = 0; _i < 2; ++_i) \
        __builtin_amdgcn_global_load_lds((const unsigned*)((const char*)(gbase) + (voff)[_i]), (LAS unsigned*)(lds + (bufoff) + ldsw + _i * 8192), 16, 0, 0); } while (0)
#define PG8_LDA(dst, b, h) do { _Pragma("unroll") for (int m = 0; m < 4; ++m) _Pragma("unroll") for (int k = 0; k < 2; ++k) dst[m][k] = *(const LAS bf16x8*)(lds + PG8_SA(b, h) + aoff + m * 2048 + k * 1024); } while (0)
#define PG8_LDB(dst, b, h) do { _Pragma("unroll") for (int n = 0; n < 2; ++n) _Pragma("unroll") for (int k = 0; k < 2; ++k) dst[n][k] = *(const LAS bf16x8*)(lds + PG8_SB(b, h) + boff + n * 2048 + k * 1024); } while (0)
#define PG8_MMA(ai, bj, At, Bt) do { __builtin_amdgcn_s_setprio(1); _Pragma("unroll") for (int m = 0; m < 4; ++m) _Pragma("unroll") for (int n = 0; n < 2; ++n) _Pragma("unroll") for (int k = 0; k < 2; ++k) \
        acc[ai][bj][m][n] = mma16(Bt[n][k], At[m][k], acc[ai][bj][m][n]); __builtin_amdgcn_s_setprio(0); } while (0)
#define PG8_WAIT_V(n) asm volatile("s_waitcnt vmcnt(" #n ")" ::: "memory")
#define PG8_WAIT_L(n) asm volatile("s_waitcnt lgkmcnt(" #n ")" ::: "memory")
#define PG8_BAR __builtin_amdgcn_s_barrier()
#define PG8_SCHED __builtin_amdgcn_sched_barrier(0)
    Unit cur, nxt; int ui = 0;
    if (!S.next(0, cur)) return;
    typename Epi::acc_t acc[2][2][4][2];
#pragma unroll
    for (int a = 0; a < 2; ++a)
#pragma unroll
        for (int b = 0; b < 2; ++b)
#pragma unroll
            for (int m = 0; m < 4; ++m)
#pragma unroll
                for (int n = 0; n < 2; ++n) acc[a][b][m][n] = (typename Epi::acc_t){0, 0, 0, 0};
    bf16x8 At[4][2], B0[2][2], B1[2][2];
    const char* cA = (const char*)g.A + ((size_t)cur.g * g.sA + (size_t)cur.pm * BM * g.lda + (size_t)cur.kh * K) * 2;
    const char* cB = (const char*)g.Bt + ((size_t)cur.g * g.sB + (size_t)cur.pn * BM * g.ldb + (size_t)cur.kh * K) * 2;
#define PG8_TBASE(u_) ((const char*)g.Bt + ((size_t)(u_).g * 64 * 256 + (size_t)(28 + 16 * (u_).pn) * 256) * 2)
#define PG8_SBASE(u_) ((const char*)g.Bt2 + ((size_t)(u_).g * 512 * 256 + (size_t)(u_).pn * BM * 256) * 2)
    const char* cT = PG8_TBASE(cur); const char* cS = PG8_SBASE(cur);
#define PG8_STAGE_B(bufoff, ub_, ut_, us_, tile_, half_) do { \
        if constexpr (Epi::TOEP) { const int tl_ = (tile_); const bool tz_ = tl_ < 8; \
            const char* bp_ = tz_ ? (ut_) - (size_t)tl_ * 2048 + (size_t)(half_) * 4096 : (us_) + (size_t)(tl_ - 8) * 128 + (size_t)(half_) * (HALF * 256 * 2); \
            unsigned vo_[2]; vo_[0] = tz_ ? voffT[0] : voffS[0]; vo_[1] = tz_ ? voffT[1] : voffS[1]; PG8_STAGE(bufoff, bp_, vo_); } \
        else PG8_STAGE(bufoff, (ub_) + (size_t)(tile_) * kstep + (size_t)(half_) * hstepB, voffB); } while (0)
    PG8_STAGE_B(PG8_SB(0, 0), cB, cT, cS, 0, 0); PG8_STAGE_B(PG8_SB(0, 1), cB, cT, cS, 0, 1); PG8_STAGE(PG8_SA(0, 0), cA, voffA); PG8_STAGE(PG8_SA(0, 1), cA + hstepA, voffA);
    if (wr == 1) PG8_BAR;
    PG8_WAIT_V(2); PG8_BAR;
    PG8_STAGE_B(PG8_SB(1, 0), cB, cT, cS, 1, 0); PG8_STAGE(PG8_SA(1, 0), cA + kstep, voffA); PG8_STAGE_B(PG8_SB(1, 1), cB, cT, cS, 1, 1);
    PG8_WAIT_V(6); PG8_BAR;
    for (;;) {
        const bool has_next = S.next(ui + 1, nxt);
        const char* nA = has_next ? (const char*)g.A + ((size_t)nxt.g * g.sA + (size_t)nxt.pm * BM * g.lda + (size_t)nxt.kh * K) * 2 : cA;
        const char* nB = has_next ? (const char*)g.Bt + ((size_t)nxt.g * g.sB + (size_t)nxt.pn * BM * g.ldb + (size_t)nxt.kh * K) * 2 : cB;
        const char* nT = has_next ? PG8_TBASE(nxt) : cT; const char* nS = has_next ? PG8_SBASE(nxt) : cS;
        for (int t = 0; t < nt; t += 2) {
            const bool last = (t == nt - 2);
            const char* a1 = cA + (size_t)(t + 1) * kstep;
            const char* a2 = last ? nA : cA + (size_t)(t + 2) * kstep; const char* a3 = a2 + kstep;
            const char* ub2 = last ? nB : cB; const char* ut2 = last ? nT : cT; const char* us2 = last ? nS : cS; const int ti2 = last ? 0 : t + 2;
            PG8_LDB(B0, 0, 0); PG8_LDB(B1, 0, 1); PG8_SCHED; PG8_LDA(At, 0, 0); PG8_STAGE(PG8_SA(1, 1), a1 + hstepA, voffA);
            PG8_WAIT_V(8); PG8_WAIT_L(0); PG8_BAR; PG8_MMA(0, 0, At, B0); PG8_MMA(0, 1, At, B1); PG8_BAR; PG8_SCHED;
            PG8_LDA(At, 0, 1); PG8_STAGE_B(PG8_SB(0, 0), ub2, ut2, us2, ti2, 0); PG8_STAGE_B(PG8_SB(0, 1), ub2, ut2, us2, ti2, 1); PG8_STAGE(PG8_SA(0, 0), a2, voffA);
            PG8_WAIT_V(8); PG8_WAIT_L(0); PG8_BAR; PG8_MMA(1, 0, At, B0); PG8_MMA(1, 1, At, B1); PG8_BAR; PG8_SCHED;
            PG8_LDB(B0, 1, 0); PG8_LDB(B1, 1, 1); PG8_SCHED; PG8_LDA(At, 1, 0); PG8_STAGE(PG8_SA(0, 1), a2 + hstepA, voffA);
            PG8_WAIT_V(8); PG8_WAIT_L(0); PG8_BAR; PG8_MMA(0, 0, At, B0); PG8_MMA(0, 1, At, B1); PG8_BAR; PG8_SCHED;
            PG8_LDA(At, 1, 1); PG8_STAGE_B(PG8_SB(1, 0), ub2, ut2, us2, ti2 + 1, 0); PG8_STAGE_B(PG8_SB(1, 1), ub2, ut2, us2, ti2 + 1, 1); PG8_STAGE(PG8_SA(1, 0), a3, voffA);
            PG8_WAIT_V(8); PG8_WAIT_L(0); PG8_BAR; PG8_MMA(1, 0, At, B0); PG8_MMA(1, 1, At, B1); PG8_BAR; PG8_SCHED;
        }
        if (wr == 0) PG8_BAR;
        E(acc, cur, wr, wc, fr, fq);
        if (!has_next) break;
        if (!(Epi::KSPLIT && cur.kh == 0)) {
#pragma unroll
        for (int a = 0; a < 2; ++a)
#pragma unroll
            for (int b = 0; b < 2; ++b)
#pragma unroll
                for (int m = 0; m < 4; ++m)
#pragma unroll
                    for (int n = 0; n < 2; ++n) acc[a][b][m][n] = (typename Epi::acc_t){0, 0, 0, 0};
        }
        cur = nxt; cA = nA; cB = nB; cT = nT; cS = nS; ++ui;
        if (wr == 1) PG8_BAR;
    }
    PG8_WAIT_V(0);
    PG8_BAR;
#undef PG8_SA
#undef PG8_SB
#undef PG8_STAGE
#undef PG8_STAGE_B
#undef PG8_TBASE
#undef PG8_SBASE
#undef PG8_LDA
#undef PG8_LDB
#undef PG8_MMA
#undef PG8_WAIT_V
#undef PG8_WAIT_L
#undef PG8_BAR
#undef PG8_SCHED
}

__device__ __forceinline__ u32x4 pack8(const f32x4 a, const f32x4 b) { u32x4 w; w.x = cvt_pk_bf16(a[0], a[1]); w.y = cvt_pk_bf16(a[2], a[3]); w.z = cvt_pk_bf16(b[0], b[1]); w.w = cvt_pk_bf16(b[2], b[3]); return w; }

struct EpiZ {
    static constexpr bool PERM = true, KSPLIT = false, TOEP = false; typedef f32x4 acc_t;
    bf16_t* QKV; bf16_t* A5; const float* qg; const float* kg; LAS float* X; const float* ssq0;
    __device__ __forceinline__ void operator()(f32x4 (&acc)[2][2][4][2], const Unit& u, int wr, int wc, int fr, int fq) const {
        float rs0[2][4];
#pragma unroll
        for (int ai = 0; ai < 2; ++ai)
#pragma unroll
            for (int m = 0; m < 4; ++m) rs0[ai][m] = __builtin_amdgcn_rsqf(ssq0[u.pm * BM + ai * HALF + wr * 64 + m * 16 + fr] * (1.0f / DM) + RMS_EPS);
        if (u.pn < 8) {
#pragma unroll
            for (int ai = 0; ai < 2; ++ai)
#pragma unroll
                for (int m = 0; m < 4; ++m)
#pragma unroll
                    for (int bj = 0; bj < 2; ++bj) { const f32x4 a0 = acc[ai][bj][m][0], a1 = acc[ai][bj][m][1];
                        float ss = (a0[0] * a0[0] + a0[1] * a0[1]) + (a0[2] * a0[2] + a0[3] * a0[3]) + (a1[0] * a1[0] + a1[1] * a1[1]) + (a1[2] * a1[2] + a1[3] * a1[3]);
                        ss += __shfl_xor(ss, 16); ss += __shfl_xor(ss, 32);
                        if (fq == 0) X[(ai * HALF + wr * 64 + m * 16 + fr) * 8 + bj * 4 + wc] = ss; }
            asm volatile("s_waitcnt lgkmcnt(0)" ::: "memory"); __builtin_amdgcn_s_barrier(); asm volatile("" ::: "memory");
            const float* gp = (u.pn < 4 ? qg : kg) + ((wc & 1) * 32 + 8 * fq); const float gs = u.pn < 4 ? 0.125f * 1.44269504089f : 1.0f;
            const f32x4 g0 = *(const f32x4*)gp * gs, g1 = *(const f32x4*)(gp + 4) * gs;
#pragma unroll
            for (int ai = 0; ai < 2; ++ai)
#pragma unroll
                for (int m = 0; m < 4; ++m) { const int rl = ai * HALF + wr * 64 + m * 16 + fr, row = u.pm * BM + rl;
#pragma unroll
                    for (int bj = 0; bj < 2; ++bj) { const f32x2 pr = *(const LAS f32x2*)(X + rl * 8 + bj * 4 + (wc & 2)); const float r0 = rs0[ai][m], rn = r0 * __builtin_amdgcn_rsqf((pr.x + pr.y) * (r0 * r0) * (1.0f / HD) + RMS_EPS);
                        const int c8 = u.pn * BM + bj * HALF + wc * 32 + 8 * fq;
                        *(u32x4*)(QKV + (size_t)row * NQKV + c8) = pack8(acc[ai][bj][m][0] * g0 * rn, acc[ai][bj][m][1] * g1 * rn); } }
            return;
        }
#pragma unroll
        for (int ai = 0; ai < 2; ++ai)
#pragma unroll
            for (int m = 0; m < 4; ++m) { const int row = u.pm * BM + ai * HALF + wr * 64 + m * 16 + fr;
#pragma unroll
                for (int bj = 0; bj < 2; ++bj) { const int c8 = u.pn * BM + bj * HALF + wc * 32 + 8 * fq; const u32x4 w = pack8(acc[ai][bj][m][0] * rs0[ai][m], acc[ai][bj][m][1] * rs0[ai][m]);
                    if (u.pn < 12) *(u32x4*)(QKV + (size_t)row * NQKV + c8) = w;
                    else { const int ch = c8 - NQKV, gg = ch >> 4, c0 = ch & 15, R = row >> 5, s = row & 31; *(u32x4*)(A5 + ((size_t)gg * RCH + R) * KS5 + s * SC + c0) = w; } } }
    }
};
struct EpiE {
    static constexpr bool PERM = false, KSPLIT = false, TOEP = false; typedef f32x4 acc_t;
    float* E;
    __device__ __forceinline__ void operator()(f32x4 (&acc)[2][2][4][2], const Unit& u, int wr, int wc, int fr, int fq) const {
#pragma unroll
        for (int ai = 0; ai < 2; ++ai)
#pragma unroll
            for (int m = 0; m < 4; ++m) { const int R = u.pm * BM + ai * HALF + wr * 64 + m * 16 + fr; float* rowp = E + ((size_t)u.g * RCH + R) * 256 + wc * 32 + 4 * fq;
#pragma unroll
                for (int bj = 0; bj < 2; ++bj)
#pragma unroll
                    for (int n = 0; n < 2; ++n) *(f32x4*)(rowp + bj * HALF + n * 16) = acc[ai][bj][m][n]; }
    }
};
struct EpiS5Out {
    static constexpr bool PERM = true, KSPLIT = false, TOEP = true; typedef f32x4 acc_t;
    bf16_t* Yg;
    __device__ __forceinline__ void operator()(f32x4 (&acc)[2][2][4][2], const Unit& u, int wr, int wc, int fr, int fq) const {
#pragma unroll
        for (int ai = 0; ai < 2; ++ai)
#pragma unroll
            for (int m = 0; m < 4; ++m) { const int R = u.pm * BM + ai * HALF + wr * 64 + m * 16 + fr;
#pragma unroll
                for (int bj = 0; bj < 2; ++bj) { const int n8 = u.pn * BM + bj * HALF + wc * 32 + 8 * fq, s = n8 >> 4, c0 = n8 & 15;
                    f32x4 vv[2];
#pragma unroll
                    for (int n = 0; n < 2; ++n)
#pragma unroll
                        for (int hf = 0; hf < 2; ++hf) { const f32x2 xv = (f32x2){acc[ai][bj][m][n][2 * hf], acc[ai][bj][m][n][2 * hf + 1]};
                            const f32x2 t = (xv * -2.30220818f) * ((xv * xv) * 0.044715f + 1.0f); f32x2 ev; ev.x = fast_exp2(t.x); ev.y = fast_exp2(t.y);
                            const f32x2 dv = ev + 1.0f; f32x2 rv; rv.x = fast_rcp(dv.x); rv.y = fast_rcp(dv.y);
                            const f32x2 yv = xv * rv; vv[n][2 * hf] = yv.x; vv[n][2 * hf + 1] = yv.y; }
                    *(u32x4*)(Yg + (size_t)(R * CL + s) * SW + u.g * SC + c0) = pack8(vv[0], vv[1]); } }
    }
};
struct EpiGlu {
    static constexpr bool PERM = true, KSPLIT = false, TOEP = false; typedef f32x4 acc_t;
    const bf16_t* Yg; const float* bias; bf16_t* YAYS; float* ssq4; LAS float* X;
    __device__ __forceinline__ void operator()(f32x4 (&acc)[2][2][4][2], const Unit& u, int wr, int wc, int fr, int fq) const {
        const int c8b = u.pn * BM + wc * 32 + 8 * fq;
        f32x4 bv[2][2];
#pragma unroll
        for (int bj = 0; bj < 2; ++bj)
#pragma unroll
            for (int n = 0; n < 2; ++n) bv[bj][n] = *(const f32x4*)(bias + c8b + bj * HALF + 4 * n);
#pragma unroll
        for (int ai = 0; ai < 2; ++ai) {
            u32x4 yv[4][2];
#pragma unroll
            for (int m = 0; m < 4; ++m)
#pragma unroll
                for (int bj = 0; bj < 2; ++bj) yv[m][bj] = *(const u32x4*)(Yg + (size_t)(u.pm * BM + ai * HALF + wr * 64 + m * 16 + fr) * SW + c8b + bj * HALF);
#pragma unroll
            for (int m = 0; m < 4; ++m) { const int row = u.pm * BM + ai * HALF + wr * 64 + m * 16 + fr; float ss = 0.f;
#pragma unroll
                for (int bj = 0; bj < 2; ++bj) { const int c8 = c8b + bj * HALF; const u32x4 y = yv[m][bj];
                    const f32x4 a0 = acc[ai][bj][m][0] + bv[bj][0], a1 = acc[ai][bj][m][1] + bv[bj][1];
                    f32x4 v0, v1;
                    { const unsigned yw[4] = {y.x, y.y, y.z, y.w};
#pragma unroll
                      for (int hf = 0; hf < 4; ++hf) { const f32x2 av = hf < 2 ? (f32x2){a0[2 * hf], a0[2 * hf + 1]} : (f32x2){a1[2 * hf - 4], a1[2 * hf - 3]};
                          const f32x2 t = av * -1.44269504089f; f32x2 ev; ev.x = fast_exp2(t.x); ev.y = fast_exp2(t.y);
                          const f32x2 dv = ev + 1.0f; f32x2 rv; rv.x = fast_rcp(dv.x); rv.y = fast_rcp(dv.y);
                          const f32x2 yv = (f32x2){bf_lo(yw[hf]), bf_hi(yw[hf])} * rv;
                          if (hf < 2) { v0[2 * hf] = yv.x; v0[2 * hf + 1] = yv.y; } else { v1[2 * hf - 4] = yv.x; v1[2 * hf - 3] = yv.y; } } }
#pragma unroll
                    for (int e = 0; e < 4; ++e) ss += v0[e] * v0[e] + v1[e] * v1[e];
                    *(u32x4*)(YAYS + (size_t)row * DM + AW + c8) = pack8(v0, v1); }
                ss += __shfl_xor(ss, 16); ss += __shfl_xor(ss, 32);
                if (fq == 0) X[(ai * HALF + wr * 64 + m * 16 + fr) * 4 + wc] = ss; }
            asm volatile("" ::: "memory"); }
        asm volatile("s_waitcnt lgkmcnt(0)" ::: "memory"); __builtin_amdgcn_s_barrier(); asm volatile("" ::: "memory");
        if (wc == 0 && fq == 0) {
#pragma unroll
            for (int ai = 0; ai < 2; ++ai)
#pragma unroll
                for (int m = 0; m < 4; ++m) { const int rl = ai * HALF + wr * 64 + m * 16 + fr; const f32x4 p = *(const LAS f32x4*)(X + rl * 4);
                    ssq4[(size_t)u.pn * M + u.pm * BM + rl] = (p[0] + p[1]) + (p[2] + p[3]); } }
    }
};
struct EpiRes1 {
    static constexpr bool PERM = true, KSPLIT = true, TOEP = false; typedef f32x4 acc_t;
    const bf16_t* xb; bf16_t* XB; const float* ssqa; const float* ssqs4; float* ssqx8; LAS float* X;
    __device__ __forceinline__ void operator()(f32x4 (&acc)[2][2][4][2], const Unit& u, int wr, int wc, int fr, int fq) const {
        if (u.kh == 0) {
#pragma unroll
        for (int ai = 0; ai < 2; ++ai)
#pragma unroll
            for (int m = 0; m < 4; ++m) { const int row = u.pm * BM + ai * HALF + wr * 64 + m * 16 + fr;
                const float sq = (ssqs4[row] + ssqs4[M + row]) + (ssqs4[2 * M + row] + ssqs4[3 * M + row]);
                const float ra = __builtin_amdgcn_rsqf(ssqa[row] * (1.0f / AW) + RMS_EPS), rs = __builtin_amdgcn_rsqf(sq * (1.0f / SW) + RMS_EPS), f = ra * fast_rcp(rs);
#pragma unroll
                for (int bj = 0; bj < 2; ++bj)
#pragma unroll
                    for (int n = 0; n < 2; ++n) acc[ai][bj][m][n] *= f; }
        return; }
        float rsv[2][4];
#pragma unroll
        for (int ai = 0; ai < 2; ++ai)
#pragma unroll
            for (int m = 0; m < 4; ++m) { const int row = u.pm * BM + ai * HALF + wr * 64 + m * 16 + fr;
                const float sq = (ssqs4[row] + ssqs4[M + row]) + (ssqs4[2 * M + row] + ssqs4[3 * M + row]); rsv[ai][m] = __builtin_amdgcn_rsqf(sq * (1.0f / SW) + RMS_EPS); }
#pragma unroll
        for (int am = 0; am < 4; ++am) { const int ai = am >> 1, mb = (am & 1) * 2;
            u32x4 xv[2][2];
#pragma unroll
            for (int mm = 0; mm < 2; ++mm)
#pragma unroll
                for (int bj = 0; bj < 2; ++bj) xv[mm][bj] = *(const u32x4*)(xb + (size_t)(u.pm * BM + ai * HALF + wr * 64 + (mb + mm) * 16 + fr) * DM + u.pn * BM + bj * HALF + wc * 32 + 8 * fq);
#pragma unroll
            for (int mm = 0; mm < 2; ++mm) { const int m = mb + mm; const int row = u.pm * BM + ai * HALF + wr * 64 + m * 16 + fr; float ss = 0.f; const float rs = rsv[ai][m];
#pragma unroll
                for (int bj = 0; bj < 2; ++bj) { const size_t off = (size_t)row * DM + u.pn * BM + bj * HALF + wc * 32 + 8 * fq;
                    const u32x4 x4 = xv[mm][bj]; f32x4 x0, x1; x0[0] = bf_lo(x4.x); x0[1] = bf_hi(x4.x); x0[2] = bf_lo(x4.y); x0[3] = bf_hi(x4.y); x1[0] = bf_lo(x4.z); x1[1] = bf_hi(x4.z); x1[2] = bf_lo(x4.w); x1[3] = bf_hi(x4.w);
                    const f32x4 v0 = x0 + acc[ai][bj][m][0] * rs, v1 = x1 + acc[ai][bj][m][1] * rs;
#pragma unroll
                    for (int e = 0; e < 4; ++e) ss += v0[e] * v0[e] + v1[e] * v1[e];
                    *(u32x4*)(XB + off) = pack8(v0, v1); }
                ss += __shfl_xor(ss, 16); ss += __shfl_xor(ss, 32);
                if (fq == 0) X[(ai * HALF + wr * 64 + m * 16 + fr) * 4 + wc] = ss; }
            asm volatile("" ::: "memory"); }
        asm volatile("s_waitcnt lgkmcnt(0)" ::: "memory"); __builtin_amdgcn_s_barrier(); asm volatile("" ::: "memory");
        if (wc == 0 && fq == 0) {
#pragma unroll
            for (int ai = 0; ai < 2; ++ai)
#pragma unroll
                for (int m = 0; m < 4; ++m) { const int rl = ai * HALF + wr * 64 + m * 16 + fr; const f32x4 p = *(const LAS f32x4*)(X + rl * 4);
                    ssqx8[(size_t)u.pn * M + u.pm * BM + rl] = (p[0] + p[1]) + (p[2] + p[3]); } }
    }
};
struct EpiSwiGLU {
    static constexpr bool PERM = true, KSPLIT = false, TOEP = false; typedef i32x4 acc_t;
    bf16_t* H; const float* FA; const float* sb; mutable float rsv[2][4]; mutable int cpm;
    __device__ __forceinline__ void operator()(i32x4 (&acc)[2][2][4][2], const Unit& u, int wr, int wc, int fr, int fq) const {
        if (u.pm != cpm) { cpm = u.pm;
#pragma unroll
        for (int ai = 0; ai < 2; ++ai)
#pragma unroll
            for (int m = 0; m < 4; ++m) rsv[ai][m] = FA[u.pm * BM + ai * HALF + wr * 64 + m * 16 + fr]; }
        const float* sp = sb + u.pn * BM + wc * 32 + 8 * fq;
        const f32x4 sg0 = *(const f32x4*)sp, sg1 = *(const f32x4*)(sp + 4), su0 = *(const f32x4*)(sp + HALF), su1 = *(const f32x4*)(sp + HALF + 4);
#pragma unroll
        for (int ai = 0; ai < 2; ++ai)
#pragma unroll
            for (int m = 0; m < 4; ++m) { const int row = u.pm * BM + ai * HALF + wr * 64 + m * 16 + fr; const float rs = rsv[ai][m];
                f32x4 hv[2];
#pragma unroll
                for (int n = 0; n < 2; ++n) { const f32x4 sg = (n == 0 ? sg0 : sg1) * rs, su = (n == 0 ? su0 : su1) * rs;
#pragma unroll
                    for (int hf = 0; hf < 2; ++hf) { const f32x2 ga = (f32x2){(float)acc[ai][0][m][n][2 * hf] * sg[2 * hf], (float)acc[ai][0][m][n][2 * hf + 1] * sg[2 * hf + 1]};
                        const f32x2 ua = (f32x2){(float)acc[ai][1][m][n][2 * hf] * su[2 * hf], (float)acc[ai][1][m][n][2 * hf + 1] * su[2 * hf + 1]};
                        const f32x2 t = ga * -1.44269504089f; f32x2 ev; ev.x = fast_exp2(t.x); ev.y = fast_exp2(t.y);
                        const f32x2 dv = ev + 1.0f; f32x2 rv; rv.x = fast_rcp(dv.x); rv.y = fast_rcp(dv.y);
                        const f32x2 hh = (ga * ua) * rv; hv[n][2 * hf] = hh.x; hv[n][2 * hf + 1] = hh.y; } }
                *(u32x4*)(H + (size_t)row * DFF + u.pn * HALF + wc * 32 + 8 * fq) = pack8(hv[0], hv[1]); }
    }
};
struct EpiRes2 {
    static constexpr bool PERM = true, KSPLIT = false, TOEP = false; typedef f32x4 acc_t;
    float* out; const bf16_t* XB;
    __device__ __forceinline__ void operator()(f32x4 (&acc)[2][2][4][2], const Unit& u, int wr, int wc, int fr, int fq) const {
#pragma unroll
        for (int ai = 0; ai < 2; ++ai) {
            u32x4 xb[4][2];
#pragma unroll
            for (int m = 0; m < 4; ++m)
#pragma unroll
                for (int bj = 0; bj < 2; ++bj) xb[m][bj] = *(const u32x4*)(XB + (size_t)(u.pm * BM + ai * HALF + wr * 64 + m * 16 + fr) * DM + u.pn * BM + wc * 32 + 8 * fq + bj * HALF);
#pragma unroll
            for (int m = 0; m < 4; ++m) { const size_t roff = (size_t)(u.pm * BM + ai * HALF + wr * 64 + m * 16 + fr) * DM + u.pn * BM + wc * 32 + 8 * fq;
#pragma unroll
                for (int bj = 0; bj < 2; ++bj) { const size_t off = roff + bj * HALF; const u32x4 x4 = xb[m][bj];
                    f32x4 v0, v1; v0[0] = bf_lo(x4.x); v0[1] = bf_hi(x4.x); v0[2] = bf_lo(x4.y); v0[3] = bf_hi(x4.y); v1[0] = bf_lo(x4.z); v1[1] = bf_hi(x4.z); v1[2] = bf_lo(x4.w); v1[3] = bf_hi(x4.w);
                    *(f32x4*)(out + off) = v0 + acc[ai][bj][m][0]; *(f32x4*)(out + off + 4) = v1 + acc[ai][bj][m][1]; } }
            asm volatile("" ::: "memory"); }
    }
};
}

#define RLX_AGENT __ATOMIC_RELAXED, __HIP_MEMORY_SCOPE_AGENT
#define XB_TMO      128
#define XB_XCNT(j)  (256  + 64 * (j))
#define XB_XSUB(j)  (1280 + 64 * (j))
#define XB_XGEN(j)  (2304 + 64 * (j))
#define XB_TOP      3328
#define XB_TOPGEN   3392
#define XCD_BAR_WORDS 3456
#define XB_SPIN_CAP (1u << 24)
__device__ __forceinline__ unsigned xb_ld(unsigned* p)              { return __hip_atomic_load(p, __ATOMIC_RELAXED, __HIP_MEMORY_SCOPE_AGENT); }
__device__ __forceinline__ unsigned xb_add(unsigned* p, unsigned v) { return __hip_atomic_fetch_add(p, v, __ATOMIC_RELAXED, __HIP_MEMORY_SCOPE_AGENT); }
__device__ __forceinline__ unsigned xb_xcc_id() { return (unsigned)__builtin_amdgcn_s_getreg((3 << 11) | 20) & 0xFu; }
#define XB_SPIN(cond, bar) do { unsigned _sp = 0; while (cond) { __builtin_amdgcn_s_sleep(1); \
    if ((++_sp & 255u) == 0u) { if (xb_ld(&(bar)[XB_TMO])) break; if (_sp > XB_SPIN_CAP) { atomicAdd(&(bar)[XB_TMO], 1u); break; } } } } while (0)
struct XcdBarrier { unsigned* bar; unsigned x; volatile LAS unsigned* st; };
__device__ __forceinline__ XcdBarrier xcd_barrier_post(unsigned* bar, volatile LAS unsigned* st) {
    XcdBarrier b; b.bar = bar; b.x = xb_xcc_id(); b.st = st;
    if (threadIdx.x == 0) (void)xb_add(&bar[XB_XCNT(b.x)], 1u);
    return b;
}
__device__ __forceinline__ void xcd_barrier_complete(unsigned* bar, unsigned x, unsigned& nloc, unsigned& nx) {
    const unsigned G = gridDim.x * gridDim.y * gridDim.z;
    unsigned sum, cnt, mine, sp = 0u;
    for (;;) {
        sum = 0u; cnt = 0u; mine = 0u;
#pragma unroll
        for (unsigned j = 0; j < 16; ++j) { const unsigned c = xb_ld(&bar[XB_XCNT(j)]); sum += c; cnt += (c > 0u) ? 1u : 0u; mine = (j == x) ? c : mine; }
        if (sum == G) break;
        __builtin_amdgcn_s_sleep(1);
        if ((++sp & 255u) == 0u) { if (xb_ld(&bar[XB_TMO])) break; if (sp > XB_SPIN_CAP) { atomicAdd(&bar[XB_TMO], 1u); break; } }
    }
    nloc = mine > 0u ? mine : 1u; nx = cnt > 0u ? cnt : 1u;
}
__device__ __forceinline__ void xcd_barrier(const XcdBarrier& b) {
    asm volatile("s_waitcnt vmcnt(0)" ::: "memory");
    __syncthreads();
    if (threadIdx.x == 0) {
        unsigned* bar = b.bar;
        __builtin_amdgcn_s_waitcnt(0);
        unsigned nloc = b.st[0], nx = b.st[1];
        if (nloc == 0u) { xcd_barrier_complete(bar, b.x, nloc, nx); b.st[0] = nloc; b.st[1] = nx; }
        const unsigned old = xb_add(&bar[XB_XSUB(b.x)], 1u);
        const unsigned gen = old / nloc;
        if (old + 1u == (gen + 1u) * nloc) {
            __builtin_amdgcn_fence(__ATOMIC_RELEASE, "agent");
            asm volatile("s_waitcnt vmcnt(0)" ::: "memory");
            const unsigned og = xb_add(&bar[XB_TOP], 1u);
            const unsigned tg = og / nx;
            if (og + 1u == (tg + 1u) * nx) xb_add(&bar[XB_TOPGEN], 1u);
            else XB_SPIN(xb_ld(&bar[XB_TOPGEN]) == tg, bar);
            __builtin_amdgcn_fence(__ATOMIC_ACQUIRE, "agent");
            xb_add(&bar[XB_XGEN(b.x)], 1u);
            asm volatile("s_waitcnt vmcnt(0)" ::: "memory");
        } else {
            XB_SPIN(xb_ld(&bar[XB_XGEN(b.x)]) == gen, bar);
            __builtin_amdgcn_fence(__ATOMIC_ACQUIRE, "agent");
            asm volatile("s_waitcnt vmcnt(0)" ::: "memory");
        }
    }
    __syncthreads();
}

struct Args { const float* in[23]; float* out; unsigned char* ws; int ph_lo, ph_hi, li, dup; };
enum { I_X = 0, I_GMIX, I_WIN, I_QG, I_KG, I_RPB, I_ARE, I_AIM, I_BRE, I_BIM, I_CRE, I_CIM, I_LS, I_D, I_WGLU, I_BGLU, I_GOA, I_GOS, I_WOUT, I_GFFN, I_WG, I_WU, I_WD };

#define LDS_WAIT() asm volatile("s_waitcnt lgkmcnt(0)" ::: "memory")

__device__ __forceinline__ void p0_transpose_item(const float* W, int N, const float* kscale, bf16_t* WT, int ldd, int drow0, int k0, int n0, int lane) {
    const int c = lane >> 3, n4 = (lane & 7) * 4;
    const float* src = W + (size_t)(k0 + 8 * c) * N + n0 + n4;
    f32x4 v[2][8];
#pragma unroll
    for (int h = 0; h < 2; ++h)
#pragma unroll
        for (int i = 0; i < 8; ++i) v[h][i] = __builtin_nontemporal_load((const f32x4*)(src + (size_t)i * N + 32 * h));
    if (kscale) { const f32x4 s0 = *(const f32x4*)(kscale + k0 + 8 * c), s1 = *(const f32x4*)(kscale + k0 + 8 * c + 4);
#pragma unroll
        for (int h = 0; h < 2; ++h)
#pragma unroll
            for (int i = 0; i < 8; ++i) v[h][i] *= (i < 4 ? s0[i & 3] : s1[i & 3]); }
#pragma unroll
    for (int h = 0; h < 2; ++h)
#pragma unroll
        for (int e = 0; e < 4; ++e) { u32x4 o; o.x = cvt_pk_bf16(v[h][0][e], v[h][1][e]); o.y = cvt_pk_bf16(v[h][2][e], v[h][3][e]); o.z = cvt_pk_bf16(v[h][4][e], v[h][5][e]); o.w = cvt_pk_bf16(v[h][6][e], v[h][7][e]);
            *(u32x4*)(WT + (size_t)(drow0 + 32 * h + n4 + e) * ldd + k0 + 8 * c) = o; }
}

__device__ __forceinline__ void dsincos(double a, double& s, double& c) {
    const double k = __builtin_rint(a * 0.63661977236758134308);
    double r = __builtin_fma(-k, 1.57079632679489655800e+00, a);
    r = __builtin_fma(-k, 6.12323399573676603587e-17, r);
    const double r2 = r * r;
    double sp = -7.6471637318198164759e-13; sp = sp * r2 + 1.6059043836821614599e-10; sp = sp * r2 - 2.5052108385441718775e-08; sp = sp * r2 + 2.7557319223985890653e-06;
    sp = sp * r2 - 1.9841269841269841270e-04; sp = sp * r2 + 8.3333333333333333333e-03; sp = sp * r2 - 1.6666666666666666667e-01; sp = sp * r2 * r + r;
    double cp = 4.7794773323873852974e-14; cp = cp * r2 - 1.1470745597729724714e-11; cp = cp * r2 + 2.0876756987868098979e-09; cp = cp * r2 - 2.7557319223985890653e-07;
    cp = cp * r2 + 2.4801587301587301587e-05; cp = cp * r2 - 1.3888888888888888889e-03; cp = cp * r2 + 4.1666666666666666667e-02; cp = cp * r2 - 0.5; cp = cp * r2 + 1.0;
    const int q = (int)((long long)k) & 3;
    s = (q == 0) ? sp : (q == 1) ? cp : (q == 2) ? -sp : -cp;
    c = (q == 0) ? cp : (q == 1) ? -sp : (q == 2) ? -cp : sp;
}

struct S5Params { f32x4 br4, bi4, cr4, ci4; float are, aim, ls; };
__device__ __forceinline__ void p0_s5_params(const Args& a, int g, int tid, S5Params& P) {
    const float* a_re = a.in[I_ARE]; const float* a_im = a.in[I_AIM]; const float* b_re = a.in[I_BRE]; const float* b_im = a.in[I_BIM];
    const float* c_re = a.in[I_CRE]; const float* c_im = a.in[I_CIM]; const float* lstep = a.in[I_LS];
#pragma unroll
    for (int j = 0; j < 4; ++j) { const int i = tid + 512 * j, c = i & 15, p = (i >> 4) & 63, d = i >> 10;
        const size_t bi = (((size_t)d * SG + g) * SP + p) * SC + c, ci = (((size_t)d * SG + g) * SC + c) * SP + p;
        P.br4[j] = b_re[bi]; P.bi4[j] = b_im[bi]; P.cr4[j] = c_re[ci]; P.ci4[j] = c_im[ci]; }
    { const int p = tid & 63, d = (tid >> 6) & 1; P.are = a_re[(d * SG + g) * SP + p]; P.aim = a_im[(d * SG + g) * SP + p]; P.ls = lstep[d * SG + g]; }
}
__device__ __forceinline__ void p0_s5_tables(const Args& a, LAS unsigned char* lds, int g, int q, int tid, const S5Params& P) {
    LAS f32x2* LP = (LAS f32x2*)lds;
    LAS float* Bb = (LAS float*)(lds + 33792);
    LAS f32x2* Cm = (LAS f32x2*)(lds + 50176);
    LAS float* Kt = (LAS float*)(lds + 66560);
    const float* dsk = a.in[I_D];
    unsigned char* ws = a.ws;
    __syncthreads();
    LAS f32x2* Fp = (LAS f32x2*)(Kt);
    if (tid < 128) { const int p = tid & 63, d = tid >> 6;
        const double lre = (double)fminf(P.are, -1e-4f), lim = (double)P.aim, dt = exp((double)P.ls);
        const double mag = exp(lre * dt); double sn, cs; dsincos(lim * dt, sn, cs);
        const double lr = mag * cs, li = mag * sn;
        const double nr = lr - 1.0, ni = li, den = 1.0 / (lre * lre + lim * lim);
        Fp[d * 64 + p] = (f32x2){(float)((nr * lre + ni * lim) * den), (float)((ni * lre - nr * lim) * den)};
        double wr_ = 1.0, wi_ = 0.0;
        for (int tau = 0; tau <= CL; ++tau) { LP[(d * 64 + p) * 33 + tau] = (f32x2){(float)wr_, (float)wi_}; const double t_ = wr_ * lr - wi_ * li; wi_ = wr_ * li + wi_ * lr; wr_ = t_; } }
    __syncthreads();
#pragma unroll
    for (int j = 0; j < 4; ++j) { const int i = tid + 512 * j, c = i & 15, p = (i >> 4) & 63, d = i >> 10; const f32x2 f = Fp[d * 64 + p];
        Bb[(d * 64 + p) * 32 + c] = f.x * P.br4[j] - f.y * P.bi4[j]; Bb[(d * 64 + p) * 32 + 16 + c] = f.x * P.bi4[j] + f.y * P.br4[j];
        Cm[i] = (f32x2){P.cr4[j], P.ci4[j]}; }
    __syncthreads();
    if (q == 0 && tid < 128) { const int p = tid & 63, d = tid >> 6; ((f32x2*)(ws + WS_LAML))[(g * 2 + d) * SP + p] = LP[(d * 64 + p) * 33 + CL]; }
    { const int wv = __builtin_amdgcn_readfirstlane(tid >> 6), l = tid & 63, c16 = l & 15, g4 = l >> 4;
#pragma unroll 1
      for (int d = 0; d < 2; ++d) {
        bf16x8 Bf[4];
#pragma unroll
        for (int ks = 0; ks < 4; ++ks) { float v[8];
#pragma unroll
            for (int j = 0; j < 8; ++j) v[j] = Bb[(d * 64 + 32 * (ks & 1) + 8 * g4 + j) * 32 + (ks >> 1) * 16 + c16];
            u32x4 w; w.x = cvt_pk_bf16(v[0], v[1]); w.y = cvt_pk_bf16(v[2], v[3]); w.z = cvt_pk_bf16(v[4], v[5]); w.w = cvt_pk_bf16(v[6], v[7]); Bf[ks] = __builtin_bit_cast(bf16x8, w); }
#pragma unroll 1
        for (int tt = 0; tt < 4; ++tt) { const int tau = wv + 8 * tt;
            f32x4 acc = (f32x4){0.f, 0.f, 0.f, 0.f};
#pragma unroll
            for (int ks = 0; ks < 2; ++ks) { float gr[8], gi[8];
#pragma unroll
                for (int j = 0; j < 8; ++j) { const int p = 32 * ks + 8 * g4 + j; const f32x2 cm = Cm[(d * 64 + p) * 16 + c16], lp = LP[(d * 64 + p) * 33 + tau];
                    gr[j] = cm.x * lp.x - cm.y * lp.y; gi[j] = -(cm.x * lp.y + cm.y * lp.x); }
                u32x4 wr_, wi_; wr_.x = cvt_pk_bf16(gr[0], gr[1]); wr_.y = cvt_pk_bf16(gr[2], gr[3]); wr_.z = cvt_pk_bf16(gr[4], gr[5]); wr_.w = cvt_pk_bf16(gr[6], gr[7]);
                wi_.x = cvt_pk_bf16(gi[0], gi[1]); wi_.y = cvt_pk_bf16(gi[2], gi[3]); wi_.z = cvt_pk_bf16(gi[4], gi[5]); wi_.w = cvt_pk_bf16(gi[6], gi[7]);
                acc = __builtin_amdgcn_mfma_f32_16x16x32_bf16(__builtin_bit_cast(bf16x8, wr_), Bf[ks], acc, 0, 0, 0);
                acc = __builtin_amdgcn_mfma_f32_16x16x32_bf16(__builtin_bit_cast(bf16x8, wi_), Bf[2 + ks], acc, 0, 0, 0); }
#pragma unroll
            for (int e = 0; e < 4; ++e) Kt[((d * 32 + tau) * 16 + 4 * g4 + e) * 16 + c16] = acc[e]; } } }
    __syncthreads();
    { const int d = q >> 1, ri = q & 1, p = tid >> 3, s0 = (tid & 7) * 4;
      bf16_t* dst = (bf16_t*)(ws + WS_WST) + ((size_t)g * 256 + q * 64 + p) * 512 + s0 * 16;
      float bx_[16], by_[16];
#pragma unroll
      for (int e = 0; e < 16; ++e) { bx_[e] = Bb[(d * 64 + p) * 32 + e]; by_[e] = Bb[(d * 64 + p) * 32 + 16 + e]; }
#pragma unroll
      for (int sp = 0; sp < 4; ++sp) { const int pw = d == 0 ? (CL - 1 - (s0 + sp)) : (s0 + sp); const f32x2 lp = LP[(d * 64 + p) * 33 + pw]; float v[16];
#pragma unroll
          for (int e = 0; e < 16; ++e) v[e] = ri == 0 ? (lp.x * bx_[e] - lp.y * by_[e]) : (lp.x * by_[e] + lp.y * bx_[e]);
          u32x4 w0, w1; w0.x = cvt_pk_bf16(v[0], v[1]); w0.y = cvt_pk_bf16(v[2], v[3]); w0.z = cvt_pk_bf16(v[4], v[5]); w0.w = cvt_pk_bf16(v[6], v[7]);
          w1.x = cvt_pk_bf16(v[8], v[9]); w1.y = cvt_pk_bf16(v[10], v[11]); w1.z = cvt_pk_bf16(v[12], v[13]); w1.w = cvt_pk_bf16(v[14], v[15]);
          *(u32x4*)(dst + sp * 16) = w0; *(u32x4*)(dst + sp * 16 + 8) = w1; } }
    { const int L = 16 * q + (tid >> 5), c = (tid >> 1) & 15, c0 = (tid & 1) * 8;
      if (L < 63) { const float dsv = dsk[g * SC + c]; float v[8];
          const LAS float* k0 = Kt + ((L >= 31 ? (L - 31) : (32 + 31 - L)) * 16 + c) * 16 + c0;
#pragma unroll
          for (int e = 0; e < 8; ++e) v[e] = k0[e];
          if (L == 31) { const LAS float* k1 = Kt + (32 * 16 + c) * 16 + c0;
#pragma unroll
              for (int e = 0; e < 8; ++e) v[e] += k1[e] + ((c == c0 + e) ? dsv : 0.f); }
          u32x4 w; w.x = cvt_pk_bf16(v[0], v[1]); w.y = cvt_pk_bf16(v[2], v[3]); w.z = cvt_pk_bf16(v[4], v[5]); w.w = cvt_pk_bf16(v[6], v[7]);
          *(u32x4*)((bf16_t*)(ws + WS_KB) + (((size_t)g * 64 + L) * 16 + c) * 16 + c0) = w; } }
    { const int c = tid & 15, s = 8 * q + ((tid >> 4) & 7), hi2 = tid >> 7;
      bf16_t* dst = (bf16_t*)(ws + WS_WO) + ((size_t)g * 512 + s * 16 + c) * 256;
      { const int d = hi2 >> 1, ri = hi2 & 1, pw = d == 0 ? (s + 1) : (CL - s);
#pragma unroll 1
        for (int pb = 0; pb < 8; ++pb) { float v[8];
#pragma unroll
            for (int e = 0; e < 8; ++e) { const int p = 8 * pb + e; const f32x2 cm = Cm[(d * 64 + p) * 16 + c], lp = LP[(d * 64 + p) * 33 + pw];
                v[e] = ri == 0 ? (cm.x * lp.x - cm.y * lp.y) : -(cm.x * lp.y + cm.y * lp.x); }
            u32x4 w; w.x = cvt_pk_bf16(v[0], v[1]); w.y = cvt_pk_bf16(v[2], v[3]); w.z = cvt_pk_bf16(v[4], v[5]); w.w = cvt_pk_bf16(v[6], v[7]);
            *(u32x4*)(dst + hi2 * 64 + 8 * pb) = w; } } }
    __syncthreads();
}

__device__ __forceinline__ void p0_prologue(const Args& a, LAS unsigned char* lds, int vcu, int G, int tid) {
    asm volatile("" : "+v"(tid));
    const int wave = __builtin_amdgcn_readfirstlane(tid >> 6), lane = tid & 63;
    unsigned char* ws = a.ws;
    S5Params P5; p0_s5_params(a, (vcu < SG * 4 ? vcu : SG * 4 - 1) >> 2, tid, P5);
    const int gw = vcu * 8 + wave, NGW = G * 8;
    constexpr int I_IN = (DM / 64) * (INW / 64), I_GL = (SW / 64) * (SW / 64), I_OUT = (DM / 64) * (DM / 64), I_GU = (DM / 64) * (DFF / 64), I_DN = (DFF / 64) * (DM / 64);
    constexpr int NITEMS = I_IN + I_GL + I_OUT + 2 * I_GU + I_DN;
    const float* x = a.in[I_X]; bf16_t* XN = (bf16_t*)(ws + WS_XN); float* ssq0 = (float*)(ws + WS_SSQ0);
    const int n_tr = (NITEMS + NGW - 1) / NGW, n_xn = (M + 2 * NGW - 1) / (2 * NGW), n_steps = n_tr + n_xn, tstep = vcu % n_steps;
    for (int st = 0; st < n_steps; ++st) {
        if (st == tstep) { for (int it = vcu; it < SG * 4; it += G) { if (it != vcu) p0_s5_params(a, it >> 2, tid, P5); p0_s5_tables(a, lds, it >> 2, it & 3, tid, P5); } }
        if (st < n_tr) {
            int r = gw + st * NGW; if (r >= NITEMS) continue;
            if (r < I_IN) { const int nb = INW / 64, kb = r / nb, n0 = (r % nb) * 64; p0_transpose_item(a.in[I_WIN], INW, a.in[I_GMIX], (bf16_t*)(ws + WS_WIN), DM, n0, kb * 64, n0, lane); continue; } r -= I_IN;
            if (r < I_GL) { const int nb = SW / 64, kb = r / nb, n0 = (r % nb) * 64; p0_transpose_item(a.in[I_WGLU], SW, nullptr, (bf16_t*)(ws + WS_WGLU), SW, n0, kb * 64, n0, lane); continue; } r -= I_GL;
            if (r < I_OUT) { const int nb = DM / 64, kb = r / nb, n0 = (r % nb) * 64, k0 = kb * 64;
                p0_transpose_item(a.in[I_WOUT], DM, k0 < AW ? a.in[I_GOA] : a.in[I_GOS] - AW, (bf16_t*)(ws + WS_WOUT), DM, n0, k0, n0, lane); continue; } r -= I_OUT;
            if (r < 2 * I_GU) { const int up = r >= I_GU; if (up) r -= I_GU; const int nb = DFF / 64, kb = r / nb, n0 = (r % nb) * 64;
                p0_transpose_item(up ? a.in[I_WU] : a.in[I_WG], DFF, a.in[I_GFFN], (bf16_t*)(ws + WS_WGU), DM, 256 * (n0 >> 7) + (n0 & 127) + (up ? 128 : 0), kb * 64, n0, lane); continue; } r -= 2 * I_GU;
            { const int nb = DM / 64, kb = r / nb, n0 = (r % nb) * 64; p0_transpose_item(a.in[I_WD], DM, nullptr, (bf16_t*)(ws + WS_WD), DFF, n0, kb * 64, n0, lane); }
            continue; }
        { const int m = gw + (st - n_tr) * 2 * NGW; if (m >= M) continue; const int m1 = m + NGW < M ? m + NGW : m;
        const f32x4* xr0 = (const f32x4*)(x + (size_t)m * DM) + lane; const f32x4* xr1 = (const f32x4*)(x + (size_t)m1 * DM) + lane; f32x4 v0[8], v1[8]; float s0 = 0.f, s1 = 0.f;
#pragma unroll
        for (int j = 0; j < 8; ++j) { v0[j] = __builtin_nontemporal_load(xr0 + 64 * j); v1[j] = __builtin_nontemporal_load(xr1 + 64 * j); }
        u32x2* o0 = (u32x2*)(XN + (size_t)m * DM) + lane; u32x2* o1 = (u32x2*)(XN + (size_t)m1 * DM) + lane;
#pragma unroll
        for (int j = 0; j < 8; ++j) { s0 += (v0[j][0] * v0[j][0] + v0[j][1] * v0[j][1]) + (v0[j][2] * v0[j][2] + v0[j][3] * v0[j][3]); s1 += (v1[j][0] * v1[j][0] + v1[j][1] * v1[j][1]) + (v1[j][2] * v1[j][2] + v1[j][3] * v1[j][3]);
            u32x2 w; w.x = cvt_pk_bf16(v0[j][0], v0[j][1]); w.y = cvt_pk_bf16(v0[j][2], v0[j][3]); o0[64 * j] = w;
            u32x2 w2; w2.x = cvt_pk_bf16(v1[j][0], v1[j][1]); w2.y = cvt_pk_bf16(v1[j][2], v1[j][3]); o1[64 * j] = w2; }
        s0 = wave_sum(s0); s1 = wave_sum(s1);
        if (lane == 0) { ssq0[m] = s0; ssq0[m1] = s1; } }
    }
}

constexpr int ATT_PF = 6;
constexpr int KROW = 144, AROW = 160;
constexpr int AHEAD = 64 * AROW;
constexpr int ABUF = 2 * AHEAD;
constexpr int ABUF2 = 2 * ABUF;
constexpr int ATT_RPB_OFF = 2 * ABUF2;
static_assert(ATT_RPB_OFF + 16 * 465 * 4 <= MISC_OFF, "attention LDS");

__device__ __forceinline__ void attn_phase(const Args& a, LAS unsigned char* lds, volatile LAS unsigned* MISC, int vcu, int G, int has_g2, int tid) {
    asm volatile("" : "+v"(tid));
    const int wave = __builtin_amdgcn_readfirstlane(tid >> 6), lane = tid & 63, ql = lane & 15, g4 = lane >> 4;
    const bf16_t* QKV = (const bf16_t*)(a.ws + WS_BIG); bf16_t* YAYS = (bf16_t*)(a.ws + WS_YAYS); float* ssqa16 = (float*)(a.ws + WS_SSQA16);
    LAS float* rpbL = (LAS float*)(lds + ATT_RPB_OFF);
    for (int i = tid; i < 16 * 465; i += 512) rpbL[i] = a.in[I_RPB][i] * 1.44269504089f;
    const int j = wave & 3, hsel = wave >> 2;
    const int cq = 16 * j + ql, cs = min(max(cq - 8, 0), GRIDW - 16), wb = (j == 0) ? 0 : (j == 1) ? 8 : (j == 2) ? 24 : 32;
    int it_lo, it_hi, it_step;
    if (G == 256) { const int x_ = vcu >> 5, k_ = vcu & 15; it_step = 16; if (has_g2) { it_lo = x_ * 256 + 208 + k_; it_hi = x_ * 256 + 256; } else { it_lo = x_ * 256 + k_; it_hi = x_ * 256 + 208; } }
    else { it_lo = vcu; it_hi = BATCH * NROWS * 8; it_step = G; }
#define ATT_FETCH(dst) do { if (tid == 0) { const int nx_ = ((dst) == 20) ? it_lo : item + it_step; MISC[dst] = (unsigned)(nx_ < it_hi ? nx_ : -1); } } while (0)
    int item = 0;
    ATT_FETCH(20);
    __syncthreads();
    item = __builtin_amdgcn_readfirstlane((int)MISC[20]);
    const int skey = tid >> 3, sch = tid & 7;
    const unsigned ldstK = (unsigned)(skey * KROW + sch * 16), ldstV = (unsigned)(skey * AROW + sch * 16);
    u32x4 R[4][4];
#define ATT_UN(it_) ((((it_) >> 8) << 5) | ((it_) & 31))
#define ATT_HP(it_) (((it_) >> 5) & 7)
#define ATT_BASE(it_) (QKV + ((size_t)(ATT_UN(it_) >> 6) * SEQ + 64 * min(max((ATT_UN(it_) & 63) - 4, 0), NROWS - 8) + skey) * NQKV + AW + 128 * ATT_HP(it_) + 8 * sch)
#define ATT_SRC2(base_, s_, rr_, i_) ((base_) + (size_t)((((s_) & 3) * 2) + (rr_)) * 64 * NQKV + ((s_) < 4 ? 0 : AW) + 64 * (i_))
#define ATT_LOAD(slot_, base_, s_) do { _Pragma("unroll") for (int rr_ = 0; rr_ < 2; ++rr_) _Pragma("unroll") for (int i_ = 0; i_ < 2; ++i_) R[slot_][rr_ * 2 + i_] = *(const u32x4*)ATT_SRC2(base_, s_, rr_, i_); } while (0)
    if (item >= 0) { const bf16_t* kb0 = ATT_BASE(item);
#pragma unroll
        for (int p = 0; p < 3; ++p) ATT_LOAD(p, kb0, p);
    }
    while (item >= 0) {
        const int un_ = ATT_UN(item), b = un_ >> 6, r = un_ & 63, hp = ATT_HP(item), h = 2 * hp + hsel, row_start = min(max(r - 4, 0), NROWS - 8);
        ATT_FETCH(21);
        const size_t tq = (size_t)b * SEQ + 64 * r + cq;
        bf16x8 Qf[2];
        { const u32x4* qp = (const u32x4*)(QKV + tq * NQKV + 64 * h + 8 * g4); Qf[0] = __builtin_bit_cast(bf16x8, qp[0]); Qf[1] = __builtin_bit_cast(bf16x8, qp[4]); }
        const LAS float* bl = rpbL + h * 465 + (row_start - r + 7) * 31 + (wb + 4 * g4 - cq + 15);
        f32x4 S[8][2]; bf16x8 Pf[8]; f32x4 O[4]; float sum = 0.f; int nitem = -1;
        const bf16_t* kcur = ATT_BASE(item); const bf16_t* knxt = kcur;
#pragma unroll
        for (int dt = 0; dt < 4; ++dt) O[dt] = (f32x4){0.f, 0.f, 0.f, 0.f};
#pragma unroll
        for (int st = 0; st < 8; ++st) {
            LAS unsigned char* buf = lds + (st & 1) * ABUF2;
            { const unsigned ld_ = st < 4 ? ldstK : ldstV;
#pragma unroll
              for (int rr = 0; rr < 2; ++rr) { *(LAS u32x4*)(buf + rr * ABUF + ld_) = R[st & 3][rr * 2]; *(LAS u32x4*)(buf + rr * ABUF + AHEAD + ld_) = R[st & 3][rr * 2 + 1]; } }
            if (st + 3 < 8) ATT_LOAD((st + 3) & 3, kcur, st + 3); else ATT_LOAD((st + 3) & 3, knxt, st + 3 - 8);
            asm volatile("s_waitcnt lgkmcnt(0)" ::: "memory"); __builtin_amdgcn_s_barrier(); asm volatile("" ::: "memory");
            if (st == 0) { nitem = __builtin_amdgcn_readfirstlane((int)MISC[21]); const int ni_ = nitem >= 0 ? nitem : item; knxt = ATT_BASE(ni_); }
#pragma unroll
            for (int rr = 0; rr < 2; ++rr) {
                const LAS unsigned char* hb = buf + rr * ABUF + hsel * AHEAD;
                if (st < 4) {
                    const int kr = 2 * st + rr;
#pragma unroll
                    for (int t = 0; t < 2; ++t) {
                        const LAS unsigned char* kp = hb + (wb + 16 * t + ql) * KROW + g4 * 16;
                        const bf16x8 k0 = *(const LAS bf16x8*)kp, k1 = *(const LAS bf16x8*)(kp + 64);
                        f32x4 acc = (f32x4){0.f, 0.f, 0.f, 0.f};
                        acc = __builtin_amdgcn_mfma_f32_16x16x32_bf16(k0, Qf[0], acc, 0, 0, 0);
                        acc = __builtin_amdgcn_mfma_f32_16x16x32_bf16(k1, Qf[1], acc, 0, 0, 0);
#pragma unroll
                        for (int e = 0; e < 4; ++e) { const int ck = wb + 16 * t + 4 * g4 + e;
                            const float bias = bl[kr * 31 + 16 * t + e];
                            acc[e] = (ck >= cs && ck < cs + 16) ? acc[e] + bias : -1e30f; }
                        S[kr][t] = acc; }
                } else {
                    const int kr = 2 * (st - 4) + rr;
                    const LAS unsigned char* rp = hb + (wb + 4 * g4 + ((lane & 15) >> 2)) * AROW + (lane & 3) * 8;
#pragma unroll
                    for (int dt = 0; dt < 4; ++dt) {
                        const s16x4 lo = __builtin_amdgcn_ds_read_tr16_b64_v4i16((LAS s16x4*)(rp + dt * 32));
                        const s16x4 hi = __builtin_amdgcn_ds_read_tr16_b64_v4i16((LAS s16x4*)(rp + 16 * AROW + dt * 32));
                        const bf16x8 av = (bf16x8){lo[0], lo[1], lo[2], lo[3], hi[0], hi[1], hi[2], hi[3]};
                        O[dt] = __builtin_amdgcn_mfma_f32_16x16x32_bf16(av, Pf[kr], O[dt], 0, 0, 0); }
                }
            }
            if (st == 3) {
#pragma unroll
                for (int k2 = 0; k2 < 8; ++k2) { f32x4 p0, p1;
#pragma unroll
                    for (int e = 0; e < 4; ++e) { p0[e] = fast_exp2(S[k2][0][e]); p1[e] = fast_exp2(S[k2][1][e]); sum += p0[e] + p1[e]; }
                    Pf[k2] = __builtin_bit_cast(bf16x8, pg8::pack8(p0, p1)); }
                sum += __shfl_xor(sum, 16); sum += __shfl_xor(sum, 32);
            }
        }
        const float inv = fast_rcp(sum); float ssq_acc = 0.f;
        bf16_t* op = YAYS + tq * DM + 64 * h + 4 * g4;
#pragma unroll
        for (int dt = 0; dt < 4; ++dt) { const f32x4 o = O[dt] * inv; ssq_acc += (o[0] * o[0] + o[1] * o[1]) + (o[2] * o[2] + o[3] * o[3]);
            u32x2 w; w.x = cvt_pk_bf16(o[0], o[1]); w.y = cvt_pk_bf16(o[2], o[3]); *(u32x2*)(op + 16 * dt) = w; }
        ssq_acc += __shfl_xor(ssq_acc, 16); ssq_acc += __shfl_xor(ssq_acc, 32);
        if (g4 == 0) ssqa16[tq * 16 + h] = ssq_acc;
        item = nitem;
    }
#undef ATT_FETCH
#undef ATT_BASE
#undef ATT_SRC2
#undef ATT_LOAD
#undef ATT_UN
#undef ATT_HP
}

__device__ __forceinline__ void scan_chain(const Args& a, int g, int pm, int tid) {
    asm volatile("" : "+v"(tid));
    if (tid >= 256) return;
    const float* E = (const float*)(a.ws + WS_E); bf16_t* A5 = (bf16_t*)(a.ws + WS_A5); const f32x2* LAML = (const f32x2*)(a.ws + WS_LAML);
    const int p = tid & 63, d = (tid >> 6) & 1, b = 2 * pm + (tid >> 7);
    const f32x2 lam = LAML[(g * 2 + d) * SP + p];
    float xr = 0.f, xi = 0.f;
    const size_t R0 = (size_t)g * RCH + b * NCH;
#pragma unroll 1
    for (int rd = 0; rd < NCH / 32; ++rd) { float er[32], ei[32];
#pragma unroll
        for (int j = 0; j < 32; ++j) { const int kk = rd * 32 + j, k = d == 0 ? kk : NCH - 1 - kk; const float* ep = E + (R0 + k) * 256 + d * 128 + p; er[j] = ep[0]; ei[j] = ep[64]; }
#pragma unroll
        for (int j = 0; j < 32; ++j) { const int kk = rd * 32 + j, k = d == 0 ? kk : NCH - 1 - kk;
            bf16_t* ap = A5 + (R0 + k) * KS5 + 512 + d * 128 + p; ap[0] = (bf16_t)(cvt_pk_bf16(xr, 0.f) & 0xffffu); ap[64] = (bf16_t)(cvt_pk_bf16(xi, 0.f) & 0xffffu);
            const float nr = lam.x * xr - lam.y * xi + er[j], ni = lam.x * xi + lam.y * xr + ei[j]; xr = nr; xi = ni; } }
}

__device__ __forceinline__ unsigned pack_i8x4(float a, float b, float c, float d) {
    const int ia = (int)__builtin_rintf(a), ib = (int)__builtin_rintf(b), ic = (int)__builtin_rintf(c), id = (int)__builtin_rintf(d);
    return (unsigned)(ia & 255) | ((unsigned)(ib & 255) << 8) | ((unsigned)(ic & 255) << 16) | ((unsigned)id << 24);
}
struct QRow { u32x4 w[4]; };
__device__ __forceinline__ void quant_row_load(QRow& r, const bf16_t* src, int lane) {
    const u32x4* sp = (const u32x4*)(src + 32 * lane);
#pragma unroll
    for (int j = 0; j < 4; ++j) r.w[j] = sp[j];
}
__device__ __forceinline__ float quant_row_finish(const QRow& r, unsigned char* dst, int lane) {
    float mx = 0.f;
#pragma unroll
    for (int j = 0; j < 4; ++j) { const u32x4 w = r.w[j];
        mx = fmaxf(fmaxf(fmaxf(mx, fmaxf(fabsf(bf_lo(w.x)), fabsf(bf_hi(w.x)))), fmaxf(fabsf(bf_lo(w.y)), fabsf(bf_hi(w.y)))), fmaxf(fmaxf(fabsf(bf_lo(w.z)), fabsf(bf_hi(w.z))), fmaxf(fabsf(bf_lo(w.w)), fabsf(bf_hi(w.w))))); }
#pragma unroll
    for (int o = 1; o < 64; o <<= 1) mx = fmaxf(mx, __shfl_xor(mx, o));
    mx = fmaxf(mx, 1e-20f);
    const float inv = 127.0f / mx;
    unsigned q[8];
#pragma unroll
    for (int j = 0; j < 4; ++j) { const u32x4 w = r.w[j];
        q[2 * j] = pack_i8x4(bf_lo(w.x) * inv, bf_hi(w.x) * inv, bf_lo(w.y) * inv, bf_hi(w.y) * inv); q[2 * j + 1] = pack_i8x4(bf_lo(w.z) * inv, bf_hi(w.z) * inv, bf_lo(w.w) * inv, bf_hi(w.w) * inv); }
    u32x4* dp = (u32x4*)(dst + 32 * lane); dp[0] = (u32x4){q[0], q[1], q[2], q[3]}; dp[1] = (u32x4){q[4], q[5], q[6], q[7]};
    return mx * (1.0f / 127.0f);
}

__global__ void __launch_bounds__(512, 2) hymba_fwd(Args args) {
    extern __shared__ __attribute__((aligned(16))) unsigned char lds_raw[];
    LAS unsigned char* lds = (LAS unsigned char*)lds_raw;
    volatile LAS unsigned* MISC = (volatile LAS unsigned*)(lds + MISC_OFF);
    const int tid = threadIdx.x;
    const int G = gridDim.x; const int bx = blockIdx.x; const int vcu = (G % 8 == 0) ? (bx % 8) * (G / 8) + bx / 8 : bx;
    unsigned char* ws = args.ws;
    unsigned* ctl = (unsigned*)(ws + WS_CTL);
    for (int u = tid; u < (LDS_BYTES - MISC_OFF) / 4; u += 512) MISC[u] = 0u;
    __syncthreads();
    XcdBarrier bar; bar.bar = ctl + CW_BAR; bar.x = 0; bar.st = nullptr;
    if (MK_N_LAUNCHES == 1) bar = xcd_barrier_post(ctl + CW_BAR, MISC + 8);
    const int lo = args.ph_lo, hi = args.ph_hi;
#define IN(k) (lo <= (k) && (k) < hi)
#define SEAM(k) do { if (IN(k) && IN((k) + 1)) xcd_barrier(bar); } while (0)
    bf16_t* WIN = (bf16_t*)(ws + WS_WIN); bf16_t* WGLU = (bf16_t*)(ws + WS_WGLU); bf16_t* WOUT = (bf16_t*)(ws + WS_WOUT); bf16_t* WGU = (bf16_t*)(ws + WS_WGU); bf16_t* WD = (bf16_t*)(ws + WS_WD);
    bf16_t* WST = (bf16_t*)(ws + WS_WST); bf16_t* KBT = (bf16_t*)(ws + WS_KB); bf16_t* WOT = (bf16_t*)(ws + WS_WO);
    bf16_t* XN = (bf16_t*)(ws + WS_XN); bf16_t* YG = (bf16_t*)(ws + WS_YG); bf16_t* XB = (bf16_t*)(ws + WS_XN);
    bf16_t* QKV = (bf16_t*)(ws + WS_BIG); bf16_t* A5 = (bf16_t*)(ws + WS_A5); float* E = (float*)(ws + WS_E); bf16_t* HB = (bf16_t*)(ws + WS_BIG);
    bf16_t* YAYS = (bf16_t*)(ws + WS_YAYS);
    float* ssqa16 = (float*)(ws + WS_SSQA16); float* ssqa = (float*)(ws + WS_SSQA); float* ssqs4 = (float*)(ws + WS_SSQS4); float* ssqx8 = (float*)(ws + WS_SSQX8);
    LAS float* XL = (LAS float*)(lds + RING_BYTES);

#define REP(k) _Pragma("unroll") for (int rep_ = (DUP_PHASE == (k)) ? 0 : 1; rep_ < 2; ++rep_)
#define ALPHA ((rep_ == 0 && args.dup >= 0) ? 0.0f : 1.0f)
    if (IN(0)) { REP(0) { p0_prologue(args, lds, vcu, G, tid); __syncthreads(); } SEAM(0); }
    if (IN(1)) {
        pg8::Gemm g{XN, WIN, DM, DM, DM, 0, 0, nullptr}; pg8::StaticOrder S; S.init(M, INW, G, bx);
        pg8::EpiZ Ep{QKV, A5, args.in[I_QG], args.in[I_KG], XL, (const float*)(ws + WS_SSQ0)};
        REP(1) pg8::gemm_phase(lds, g, S, Ep);
        SEAM(1);
    }
    if (IN(2)) {
        for (int cidx = bx; cidx < 2 * SG; cidx += G) { const int g_ = cidx >> 1, pm_ = cidx & 1;
            { pg8::Gemm g{A5, WST, KS5, 512, 512, (size_t)RCH * KS5, (size_t)256 * 512, nullptr}; pg8::ListOrder S; S.n = 1; S.u0.pm = pm_; S.u0.pn = 0; S.u0.g = g_; S.u0.kh = 0; S.u1 = S.u0;
              pg8::EpiE Ep{E};
              pg8::gemm_phase(lds, g, S, Ep); }
            asm volatile("s_waitcnt vmcnt(0)" ::: "memory"); __syncthreads();
            scan_chain(args, g_, pm_, tid);
            asm volatile("s_waitcnt vmcnt(0)" ::: "memory"); __syncthreads();
            { pg8::Gemm g{A5, KBT, KS5, KS5, KS5, (size_t)RCH * KS5, 0, WOT}; pg8::ListOrder S; S.n = 2; S.u0.pm = pm_; S.u0.pn = 0; S.u0.g = g_; S.u0.kh = 0; S.u1 = S.u0; S.u1.pn = 1;
              pg8::EpiS5Out Ep{YG};
              pg8::gemm_phase(lds, g, S, Ep); }
        }
        __syncthreads();
        attn_phase(args, lds, MISC, vcu, G, bx < 2 * SG ? 1 : 0, tid);
        SEAM(2);
    }
    if (IN(3)) {
        pg8::Gemm g{YG, WGLU, SW, SW, SW, 0, 0, nullptr}; pg8::StaticOrder S; S.init(M, SW, G, bx);
        for (int t = vcu * 512 + tid; t < M; t += G * 512) { const f32x4* p = (const f32x4*)(ssqa16 + (size_t)t * 16); const f32x4 s0 = p[0], s1 = p[1], s2 = p[2], s3 = p[3];
            const f32x4 sv = (s0 + s1) + (s2 + s3); ssqa[t] = (sv[0] + sv[1]) + (sv[2] + sv[3]); }
        REP(3) { pg8::EpiGlu Ep{YG, args.in[I_BGLU], YAYS, ssqs4, XL}; pg8::gemm_phase(lds, g, S, Ep); }
        SEAM(3);
    }
    if (IN(4)) {
        { const int wave_ = __builtin_amdgcn_readfirstlane(tid >> 6), lane_ = tid & 63; float* sbp = (float*)(ws + WS_SB);
          const int gw_ = vcu * 8 + wave_, ngw_ = G * 8;
          for (int r0 = gw_; r0 < 2 * DFF; r0 += 3 * ngw_) { QRow qr[3];
#pragma unroll
            for (int i = 0; i < 3; ++i) { const int row = r0 + i * ngw_; if (row < 2 * DFF) quant_row_load(qr[i], WGU + (size_t)row * DM, lane_); }
#pragma unroll
            for (int i = 0; i < 3; ++i) { const int row = r0 + i * ngw_; if (row < 2 * DFF) { const float sc = quant_row_finish(qr[i], ws + WS_WQ + (size_t)row * DM, lane_); if (lane_ == 0) sbp[row] = sc; } } } }
        pg8::Gemm g{YAYS, WOUT, DM, DM, AW, 0, 0, nullptr}; pg8::SplitKOrder S; S.so.init(M, DM, G, bx);
        REP(4) { pg8::EpiRes1 Ep{XN, XB, ssqa, ssqs4, ssqx8, XL}; pg8::gemm_phase(lds, g, S, Ep); }
        SEAM(4);
    }
    if (IN(5)) {
        pg8::Gemm g{(const bf16_t*)(ws + WS_YAYS), (const bf16_t*)(ws + WS_WQ), DM / 2, DM / 2, DM / 2, 0, 0, nullptr}; pg8::StaticOrder S; S.init(M, 2 * DFF, G, bx);
        { const int wave_ = __builtin_amdgcn_readfirstlane(tid >> 6), lane_ = tid & 63; float* fax = (float*)(ws + WS_FAX);
          for (int rb = vcu * 64 + wave_ * 8; rb < M; rb += G * 64) {
#pragma unroll 1
            for (int h = 0; h < 2; ++h) { QRow qr[4];
#pragma unroll
                for (int i = 0; i < 4; ++i) quant_row_load(qr[i], XB + (size_t)(rb + 4 * h + i) * DM, lane_);
#pragma unroll
                for (int i = 0; i < 4; ++i) { const int row = rb + 4 * h + i; const float sc = quant_row_finish(qr[i], ws + WS_YAYS + (size_t)row * DM, lane_);
                    float sq = 0.f;
#pragma unroll
                    for (int t = 0; t < 8; ++t) sq += ssqx8[(size_t)t * M + row];
                    if (lane_ == 0) fax[row] = sc * __builtin_amdgcn_rsqf(sq * (1.0f / DM) + RMS_EPS); } } } }
        if (MK_N_LAUNCHES == 1) xcd_barrier(bar);
        { pg8::EpiSwiGLU Ep{HB, (const float*)(ws + WS_FAX), (const float*)(ws + WS_SB), {{0.f, 0.f, 0.f, 0.f}, {0.f, 0.f, 0.f, 0.f}}, -1};
          pg8::gemm_phase(lds, g, S, Ep); }
        SEAM(5);
    }
    if (IN(6)) {
        pg8::Gemm g{HB, WD, DFF, DFF, DFF, 0, 0, nullptr}; pg8::StaticOrder S; S.init(M, DM, G, bx);
        REP(6) { pg8::EpiRes2 Ep{args.out, XB}; pg8::gemm_phase(lds, g, S, Ep); }
    }
#undef IN
#undef SEAM
}

extern "C" void kernel_launch(void* const* d_in, const int* in_sizes, int n_in, void* d_out, int out_size, void* d_ws, size_t ws_size, hipStream_t stream) {
    static int grid = 0;
    if (grid == 0) {
        if (n_in != 23 || in_sizes[0] != M * DM || out_size != M * DM || ws_size < WS_END) { fprintf(stderr, "kernel_launch: unexpected shapes (n_in %d, in0 %d, out %d, ws %zu < %zu)\n", n_in, n_in > 0 ? in_sizes[0] : -1, out_size, ws_size, (size_t)WS_END); grid = -1; return; }
        int dev = 0, cus = 0, per_cu = 0;
        if (hipGetDevice(&dev) != hipSuccess || hipDeviceGetAttribute(&cus, hipDeviceAttributeMultiprocessorCount, dev) != hipSuccess) { grid = -1; return; }
        if (hipFuncSetAttribute((const void*)hymba_fwd, hipFuncAttributeMaxDynamicSharedMemorySize, LDS_BYTES) != hipSuccess) { fprintf(stderr, "kernel_launch: hipFuncSetAttribute failed\n"); grid = -1; return; }
        if (hipOccupancyMaxActiveBlocksPerMultiprocessor(&per_cu, (const void*)hymba_fwd, 512, LDS_BYTES) != hipSuccess || per_cu < 1) { fprintf(stderr, "kernel_launch: occupancy query says %d blocks per CU\n", per_cu); (void)hipGetLastError(); per_cu = 1; }
        grid = cus;
    }
    if (grid < 0) return;
    (void)hipMemsetAsync((char*)d_ws + WS_CTL, 0, CTL_ZERO_BYTES, stream);
    Args a{}; a.dup = DUP_PHASE;
    for (int i = 0; i < 23; ++i) a.in[i] = (const float*)d_in[i];
    a.out = (float*)d_out; a.ws = (unsigned char*)d_ws;
    if (MK_N_LAUNCHES == 1) {
        a.ph_lo = 0; a.ph_hi = NPHASE; a.li = 0;
        void* kargs[] = {&a};
        const hipError_t le = hipLaunchCooperativeKernel((const void*)hymba_fwd, dim3(grid), dim3(512), kargs, LDS_BYTES, stream);
        if (le != hipSuccess) fprintf(stderr, "kernel_launch: cooperative launch failed: %s (grid %d)\n", hipGetErrorString(le), grid);
    } else {
        for (int li = 0; li < NPHASE; ++li) { a.ph_lo = li; a.ph_hi = li + 1; a.li = li; hipLaunchKernelGGL(hymba_fwd, dim3(grid), dim3(512), LDS_BYTES, stream, a); }
    }
}
```

```cpp
#include <hip/hip_runtime.h>
#include <cstdio>
#include <cstdint>

#define DUP_PHASE (-1)
#ifndef MK_N_LAUNCHES
#define MK_N_LAUNCHES 1
#endif

#define GAS __attribute__((address_space(1)))
#define LAS __attribute__((address_space(3)))
typedef unsigned short bf16_t;
typedef short bf16x8 __attribute__((ext_vector_type(8)));
typedef short s16x4 __attribute__((ext_vector_type(4)));
typedef float f32x4 __attribute__((ext_vector_type(4)));
typedef float f32x2 __attribute__((ext_vector_type(2)));
typedef unsigned u32x4 __attribute__((ext_vector_type(4)));
typedef unsigned u32x2 __attribute__((ext_vector_type(2)));
typedef int i32x4 __attribute__((ext_vector_type(4)));

constexpr int BATCH = 4, SEQ = 4096, DM = 2048, M = BATCH * SEQ;
constexpr int AW = 1024, SW = 1024, NH = 16, HD = 64, NQKV = 3 * AW, INW = 4096, DFF = 5632;
constexpr int GRIDW = 64, NROWS = SEQ / GRIDW;
constexpr int SG = 64, SC = 16, SP = 64;
constexpr int CL = 32, NCH = SEQ / CL, RCH = M / CL;
constexpr int KS5 = CL * SC + 256;
constexpr float RMS_EPS = 1e-6f;
constexpr int NPHASE = 7;

constexpr size_t MiB = 1u << 20;
constexpr size_t WS_CTL = 0, CTL_ZERO_BYTES = 65536;
constexpr size_t WS_WIN = 1 * MiB, WS_WGLU = 17 * MiB, WS_WOUT = 19 * MiB, WS_WGU = 27 * MiB, WS_WD = 71 * MiB;
constexpr size_t WS_WST = 93 * MiB, WS_KB = 109 * MiB, WS_WO = 111 * MiB, WS_LAML = 157 * MiB;
constexpr size_t WS_XN = 158 * MiB;
constexpr size_t WS_BIG = 222 * MiB;
constexpr size_t WS_A5 = WS_BIG + 96 * MiB, WS_E = WS_BIG + 144 * MiB;
constexpr size_t WS_YAYS = 398 * MiB, WS_SSQ = 462 * MiB, WS_YG = 464 * MiB, WS_WQ = WS_YG, WS_END = 496 * MiB;
constexpr size_t WS_SSQA16 = WS_SSQ, WS_SSQA = WS_SSQ + 1 * MiB, WS_SSQS4 = WS_SSQA + 65536, WS_SSQX8 = WS_SSQS4 + 4 * 65536, WS_SSQ0 = WS_SSQX8 + 8 * 65536, WS_SB = WS_SSQ0 + 65536, WS_FAX = WS_SB + 65536;
static_assert(2 * DFF * 4 <= 65536 && WS_FAX + 65536 <= WS_YG, "ssq");
constexpr int CW_BAR = 4096;
static_assert((size_t)(CW_BAR + 3456) * 4 <= CTL_ZERO_BYTES, "ctl");

constexpr int RING_BYTES = 131072;
constexpr int MISC_OFF = 143360;
constexpr int LDS_BYTES = 147456;

__device__ __forceinline__ unsigned cvt_pk_bf16(float lo, float hi) { unsigned r; asm volatile("v_cvt_pk_bf16_f32 %0, %1, %2" : "=v"(r) : "v"(lo), "v"(hi)); return r; }
__device__ __forceinline__ unsigned cvt_pk_bf16_t(float lo, float hi) { unsigned r; asm volatile("s_nop 0\n\tv_cvt_pk_bf16_f32 %0, %1, %2" : "=v"(r) : "v"(lo), "v"(hi)); return r; }
__device__ __forceinline__ unsigned cvt_pk_bf16_tm(float lo, float hi) { unsigned r; asm volatile("s_nop 0\n\tv_cvt_pk_bf16_f32 %0, %1, %2\n\ts_nop 1" : "=v"(r) : "v"(lo), "v"(hi)); return r; }
__device__ __forceinline__ float bf_lo(unsigned w) { return __uint_as_float(w << 16); }
__device__ __forceinline__ float bf_hi(unsigned w) { return __uint_as_float(w & 0xffff0000u); }
__device__ __forceinline__ float fast_rcp(float x) { return __builtin_amdgcn_rcpf(x); }
__device__ __forceinline__ float fast_exp2(float x) { return __builtin_amdgcn_exp2f(x); }
__device__ __forceinline__ float sigmoidf_(float x) { return fast_rcp(1.0f + fast_exp2(-1.44269504089f * x)); }
__device__ __forceinline__ float gelu_tanh(float x) { const float t = x * (1.0f + 0.044715f * x * x); return x * fast_rcp(1.0f + fast_exp2(-2.30220818f * t)); }
__device__ __forceinline__ float wave_sum(float v) {
#pragma unroll
    for (int o = 1; o < 64; o <<= 1) v += __shfl_xor(v, o);
    return v;
}

namespace pg8 {
constexpr int BM = 256, BK = 64, HALF = 128, HTB = HALF * BK * 2, NXCD = 8, WGM = 8;
__host__ __device__ __forceinline__ int lds_byte(int r, int c) { const int st = (r >> 4) * 2 + (c >> 5), rr = r & 15, cc = c & 31, ob = rr * 64 + cc * 2; return st * 1024 + (ob ^ (((ob >> 9) & 1) << 5)); }
__host__ __device__ __forceinline__ void stage_rc(int b, int& R, int& C) { const int st = b / 1024, sb = b % 1024, swz = sb ^ (((sb >> 9) & 1) << 5); R = (st >> 1) * 16 + swz / 64; C = (st & 1) * 32 + (swz % 64) / 2; }
__host__ __device__ __forceinline__ int perm32(int rho) { const int n = rho >> 4, i = rho & 15; return 8 * (i >> 2) + 4 * n + (i & 3); }

struct Unit { int pm, pn, g, kh; };
struct Gemm { const bf16_t* A; const bf16_t* Bt; int lda, ldb, K; size_t sA, sB; const bf16_t* Bt2; };

struct StaticOrder {
    int nM, nN, nwg, G, c;
    __device__ void init(int M_, int N_, int G_, int c_) { nM = M_ / BM; nN = N_ / BM; nwg = nM * nN; G = G_; c = c_; }
    __device__ bool next(int i, Unit& u) const {
        const long L = (long)i * G + c; if (L >= nwg) return false;
        int wgid = (int)L; { const int q = nwg / NXCD, r = nwg % NXCD, xcd = wgid % NXCD, off = wgid / NXCD; wgid = (xcd < r ? xcd * (q + 1) : r * (q + 1) + (xcd - r) * q) + off; }
        const int nig = WGM * nN, gid = wgid / nig, fm = gid * WGM, gsz = (nM - fm) < WGM ? (nM - fm) : WGM;
        u.pm = fm + ((wgid % nig) % gsz); u.pn = (wgid % nig) / gsz; u.g = 0; u.kh = 0; return true;
    }
};
struct SplitKOrder {
    StaticOrder so;
    __device__ bool next(int i, Unit& u) const { if (!so.next(i >> 1, u)) return false; u.kh = i & 1; return true; }
};
struct ListOrder {
    int n; Unit u0, u1;
    __device__ bool next(int i, Unit& u) const { if (i >= n) return false; u = i == 0 ? u0 : u1; return true; }
};
struct BatchOrder {
    int nM, nN, nwg, G, c;
    __device__ void init(int nM_, int nN_, int nb, int G_, int c_) { nM = nM_; nN = nN_; nwg = nM * nN * nb; G = G_; c = c_; }
    __device__ bool next(int i, Unit& u) const {
        const long L = (long)i * G + c; if (L >= nwg) return false;
        const int l = (int)L; u.pn = l % nN; u.pm = (l / nN) % nM; u.g = (l / (nN * nM)) % SG; u.kh = 0; return true;
    }
};

__device__ __forceinline__ f32x4 mma16(bf16x8 a, bf16x8 b, f32x4 c) { return __builtin_amdgcn_mfma_f32_16x16x32_bf16(a, b, c, 0, 0, 0); }
__device__ __forceinline__ i32x4 mma16(bf16x8 a, bf16x8 b, i32x4 c) { return __builtin_amdgcn_mfma_i32_16x16x64_i8(__builtin_bit_cast(i32x4, a), __builtin_bit_cast(i32x4, b), c, 0, 0, 0); }
template <class Epi, class Sched>
__device__ __forceinline__ void gemm_phase(LAS unsigned char* lds, const Gemm g, const Sched& S, const Epi& E) {
    int tid = threadIdx.x; asm volatile("" : "+v"(tid));
    const int wid = __builtin_amdgcn_readfirstlane(tid >> 6), lane = tid & 63, wr = wid >> 2, wc = wid & 3, fr = lane & 15, fq = lane >> 4;
    const int K = g.K, nt = K / BK;
    unsigned voffA[2], voffB[2], voffT[2], voffS[2];
#pragma unroll
    for (int i = 0; i < 2; ++i) { int R, C; stage_rc(tid * 16 + i * 8192, R, C); const int Rb = Epi::PERM ? ((R & ~31) + perm32(R & 31)) : R;
        voffA[i] = (unsigned)(R * g.lda + C) * 2u; voffB[i] = (unsigned)(Rb * g.ldb + C) * 2u;
        voffT[i] = (unsigned)((((Rb >> 4) - (C >> 4) + 3) * 256 + (Rb & 15) * 16 + (C & 15)) * 2); voffS[i] = (unsigned)(Rb * 256 + C) * 2u; }
    const size_t kstep = (size_t)(BK * 2);
    const size_t hstepA = (size_t)HALF * g.lda * 2, hstepB = (size_t)HALF * g.ldb * 2;
    const unsigned ldsw = (unsigned)wid * 1024u;
    const int aoff = lds_byte(wr * 64 + fr, fq * 8), boff = lds_byte(wc * 32 + fr, fq * 8);
#define PG8_SA(b, h) (((b) * 2 + (h)) * HTB)
#define PG8_SB(b, h) ((4 + (b) * 2 + (h)) * HTB)
#define PG8_STAGE(bufoff, gbase, voff) do { _Pragma("unroll") for (int _i = 0; _i < 2; ++_i) \
        __builtin_amdgcn_global_load_lds((const unsigned*)((const char*)(gbase) + (voff)[_i]), (LAS unsigned*)(lds + (bufoff) + ldsw + _i * 8192), 16, 0, 0); } while (0)
#define PG8_LDA(dst, b, h) do { _Pragma("unroll") for (int m = 0; m < 4; ++m) _Pragma("unroll") for (int k = 0; k < 2; ++k) dst[m][k] = *(const LAS bf16x8*)(lds + PG8_SA(b, h) + aoff + m * 2048 + k * 1024); } while (0)
#define PG8_LDB(dst, b, h) do { _Pragma("unroll") for (int n = 0; n < 2; ++n) _Pragma("unroll") for (int k = 0; k < 2; ++k) dst[n][k] = *(const LAS bf16x8*)(lds + PG8_SB(b, h) + boff + n * 2048 + k * 1024); } while (0)
#define PG8_MMA(ai, bj, At, Bt) do { __builtin_amdgcn_s_setprio(1); _Pragma("unroll") for (int m = 0; m < 4; ++m) _Pragma("unroll") for (int n = 0; n < 2; ++n) _Pragma("unroll") for (int k = 0; k < 2; ++k) \
        acc[ai][bj][m][n] = mma16(Bt[n][k], At[m][k], acc[ai][bj][m][n]); __builtin_amdgcn_s_setprio(0); } while (0)
#define PG8_WAIT_V(n) asm volatile("s_waitcnt vmcnt(" #n ")" ::: "memory")
#define PG8_WAIT_L(n) asm volatile("s_waitcnt lgkmcnt(" #n ")" ::: "memory")
#define PG8_BAR __builtin_amdgcn_s_barrier()
#define PG8_SCHED __builtin_amdgcn_sched_barrier(0)
    Unit cur, nxt; int ui = 0;
    if (!S.next(0, cur)) return;
    typename Epi::acc_t acc[2][2][4][2];
#pragma unroll
    for (int a = 0; a < 2; ++a)
#pragma unroll
        for (int b = 0; b < 2; ++b)
#pragma unroll
            for (int m = 0; m < 4; ++m)
#pragma unroll
                for (int n = 0; n < 2; ++n) acc[a][b][m][n] = (typename Epi::acc_t){0, 0, 0, 0};
    bf16x8 At[4][2], B0[2][2], B1[2][2];
    const char* cA = (const char*)g.A + ((size_t)cur.g * g.sA + (size_t)cur.pm * BM * g.lda + (size_t)cur.kh * K) * 2;
    const char* cB = (const char*)g.Bt + ((size_t)cur.g * g.sB + (size_t)cur.pn * BM * g.ldb + (size_t)cur.kh * K) * 2;
#define PG8_TBASE(u_) ((const char*)g.Bt + ((size_t)(u_).g * 64 * 256 + (size_t)(28 + 16 * (u_).pn) * 256) * 2)
#define PG8_SBASE(u_) ((const char*)g.Bt2 + ((size_t)(u_).g * 512 * 256 + (size_t)(u_).pn * BM * 256) * 2)
    const char* cT = PG8_TBASE(cur); const char* cS = PG8_SBASE(cur);
#define PG8_STAGE_B(bufoff, ub_, ut_, us_, tile_, half_) do { \
        if constexpr (Epi::TOEP) { const int tl_ = (tile_); const bool tz_ = tl_ < 8; \
            const char* bp_ = tz_ ? (ut_) - (size_t)tl_ * 2048 + (size_t)(half_) * 4096 : (us_) + (size_t)(tl_ - 8) * 128 + (size_t)(half_) * (HALF * 256 * 2); \
            unsigned vo_[2]; vo_[0] = tz_ ? voffT[0] : voffS[0]; vo_[1] = tz_ ? voffT[1] : voffS[1]; PG8_STAGE(bufoff, bp_, vo_); } \
        else PG8_STAGE(bufoff, (ub_) + (size_t)(tile_) * kstep + (size_t)(half_) * hstepB, voffB); } while (0)
    PG8_STAGE_B(PG8_SB(0, 0), cB, cT, cS, 0, 0); PG8_STAGE_B(PG8_SB(0, 1), cB, cT, cS, 0, 1); PG8_STAGE(PG8_SA(0, 0), cA, voffA); PG8_STAGE(PG8_SA(0, 1), cA + hstepA, voffA);
    if (wr == 1) PG8_BAR;
    PG8_WAIT_V(2); PG8_BAR;
    PG8_STAGE_B(PG8_SB(1, 0), cB, cT, cS, 1, 0); PG8_STAGE(PG8_SA(1, 0), cA + kstep, voffA); PG8_STAGE_B(PG8_SB(1, 1), cB, cT, cS, 1, 1);
    PG8_WAIT_V(6); PG8_BAR;
    for (;;) {
        const bool has_next = S.next(ui + 1, nxt);
        const char* nA = has_next ? (const char*)g.A + ((size_t)nxt.g * g.sA + (size_t)nxt.pm * BM * g.lda + (size_t)nxt.kh * K) * 2 : cA;
        const char* nB = has_next ? (const char*)g.Bt + ((size_t)nxt.g * g.sB + (size_t)nxt.pn * BM * g.ldb + (size_t)nxt.kh * K) * 2 : cB;
        const char* nT = has_next ? PG8_TBASE(nxt) : cT; const char* nS = has_next ? PG8_SBASE(nxt) : cS;
        for (int t = 0; t < nt; t += 2) {
            const bool last = (t == nt - 2);
            const char* a1 = cA + (size_t)(t + 1) * kstep;
            const char* a2 = last ? nA : cA + (size_t)(t + 2) * kstep; const char* a3 = a2 + kstep;
            const char* ub2 = last ? nB : cB; const char* ut2 = last ? nT : cT; const char* us2 = last ? nS : cS; const int ti2 = last ? 0 : t + 2;
            PG8_LDB(B0, 0, 0); PG8_LDB(B1, 0, 1); PG8_SCHED; PG8_LDA(At, 0, 0); PG8_STAGE(PG8_SA(1, 1), a1 + hstepA, voffA);
            PG8_WAIT_V(8); PG8_WAIT_L(0); PG8_BAR; PG8_MMA(0, 0, At, B0); PG8_MMA(0, 1, At, B1); PG8_BAR; PG8_SCHED;
            PG8_LDA(At, 0, 1); PG8_STAGE_B(PG8_SB(0, 0), ub2, ut2, us2, ti2, 0); PG8_STAGE_B(PG8_SB(0, 1), ub2, ut2, us2, ti2, 1); PG8_STAGE(PG8_SA(0, 0), a2, voffA);
            PG8_WAIT_V(8); PG8_WAIT_L(0); PG8_BAR; PG8_MMA(1, 0, At, B0); PG8_MMA(1, 1, At, B1); PG8_BAR; PG8_SCHED;
            PG8_LDB(B0, 1, 0); PG8_LDB(B1, 1, 1); PG8_SCHED; PG8_LDA(At, 1, 0); PG8_STAGE(PG8_SA(0, 1), a2 + hstepA, voffA);
            PG8_WAIT_V(8); PG8_WAIT_L(0); PG8_BAR; PG8_MMA(0, 0, At, B0); PG8_MMA(0, 1, At, B1); PG8_BAR; PG8_SCHED;
            PG8_LDA(At, 1, 1); PG8_STAGE_B(PG8_SB(1, 0), ub2, ut2, us2, ti2 + 1, 0); PG8_STAGE_B(PG8_SB(1, 1), ub2, ut2, us2, ti2 + 1, 1); PG8_STAGE(PG8_SA(1, 0), a3, voffA);
            PG8_WAIT_V(8); PG8_WAIT_L(0); PG8_BAR; PG8_MMA(1, 0, At, B0); PG8_MMA(1, 1, At, B1); PG8_BAR; PG8_SCHED;
        }
        if (wr == 0) PG8_BAR;
        E(acc, cur, wr, wc, fr, fq);
        if (!has_next) break;
        if (!(Epi::KSPLIT && cur.kh == 0)) {
#pragma unroll
        for (int a = 0; a < 2; ++a)
#pragma unroll
            for (int b = 0; b < 2; ++b)
#pragma unroll
                for (int m = 0; m < 4; ++m)
#pragma unroll
                    for (int n = 0; n < 2; ++n) acc[a][b][m][n] = (typename Epi::acc_t){0, 0, 0, 0};
        }
        cur = nxt; cA = nA; cB = nB; cT = nT; cS = nS; ++ui;
        if (wr == 1) PG8_BAR;
    }
    PG8_WAIT_V(0);
    PG8_BAR;
#undef PG8_SA
#undef PG8_SB
#undef PG8_STAGE
#undef PG8_STAGE_B
#undef PG8_TBASE
#undef PG8_SBASE
#undef PG8_LDA
#undef PG8_LDB
#undef PG8_MMA
#undef PG8_WAIT_V
#undef PG8_WAIT_L
#undef PG8_BAR
#undef PG8_SCHED
}

__device__ __forceinline__ u32x4 pack8(const f32x4 a, const f32x4 b) { u32x4 w; w.x = cvt_pk_bf16(a[0], a[1]); w.y = cvt_pk_bf16(a[2], a[3]); w.z = cvt_pk_bf16(b[0], b[1]); w.w = cvt_pk_bf16(b[2], b[3]); return w; }

struct EpiZ {
    static constexpr bool PERM = true, KSPLIT = false, TOEP = false; typedef f32x4 acc_t;
    bf16_t* QKV; bf16_t* A5; const float* qg; const float* kg; LAS float* X; const float* ssq0;
    __device__ __forceinline__ void operator()(f32x4 (&acc)[2][2][4][2], const Unit& u, int wr, int wc, int fr, int fq) const {
        float rs0[2][4];
#pragma unroll
        for (int ai = 0; ai < 2; ++ai)
#pragma unroll
            for (int m = 0; m < 4; ++m) rs0[ai][m] = __builtin_amdgcn_rsqf(ssq0[u.pm * BM + ai * HALF + wr * 64 + m * 16 + fr] * (1.0f / DM) + RMS_EPS);
        if (u.pn < 8) {
#pragma unroll
            for (int ai = 0; ai < 2; ++ai)
#pragma unroll
                for (int m = 0; m < 4; ++m)
#pragma unroll
                    for (int bj = 0; bj < 2; ++bj) { const f32x4 a0 = acc[ai][bj][m][0], a1 = acc[ai][bj][m][1];
                        float ss = (a0[0] * a0[0] + a0[1] * a0[1]) + (a0[2] * a0[2] + a0[3] * a0[3]) + (a1[0] * a1[0] + a1[1] * a1[1]) + (a1[2] * a1[2] + a1[3] * a1[3]);
                        ss += __shfl_xor(ss, 16); ss += __shfl_xor(ss, 32);
                        if (fq == 0) X[(ai * HALF + wr * 64 + m * 16 + fr) * 8 + bj * 4 + wc] = ss; }
            asm volatile("s_waitcnt lgkmcnt(0)" ::: "memory"); __builtin_amdgcn_s_barrier(); asm volatile("" ::: "memory");
            const float* gp = (u.pn < 4 ? qg : kg) + ((wc & 1) * 32 + 8 * fq); const float gs = u.pn < 4 ? 0.125f * 1.44269504089f : 1.0f;
            const f32x4 g0 = *(const f32x4*)gp * gs, g1 = *(const f32x4*)(gp + 4) * gs;
#pragma unroll
            for (int ai = 0; ai < 2; ++ai)
#pragma unroll
                for (int m = 0; m < 4; ++m) { const int rl = ai * HALF + wr * 64 + m * 16 + fr, row = u.pm * BM + rl;
#pragma unroll
                    for (int bj = 0; bj < 2; ++bj) { const f32x2 pr = *(const LAS f32x2*)(X + rl * 8 + bj * 4 + (wc & 2)); const float r0 = rs0[ai][m], rn = r0 * __builtin_amdgcn_rsqf((pr.x + pr.y) * (r0 * r0) * (1.0f / HD) + RMS_EPS);
                        const int c8 = u.pn * BM + bj * HALF + wc * 32 + 8 * fq;
                        *(u32x4*)(QKV + (size_t)row * NQKV + c8) = pack8(acc[ai][bj][m][0] * g0 * rn, acc[ai][bj][m][1] * g1 * rn); } }
            return;
        }
#pragma unroll
        for (int ai = 0; ai < 2; ++ai)
#pragma unroll
            for (int m = 0; m < 4; ++m) { const int row = u.pm * BM + ai * HALF + wr * 64 + m * 16 + fr;
#pragma unroll
                for (int bj = 0; bj < 2; ++bj) { const int c8 = u.pn * BM + bj * HALF + wc * 32 + 8 * fq; const u32x4 w = pack8(acc[ai][bj][m][0] * rs0[ai][m], acc[ai][bj][m][1] * rs0[ai][m]);
                    if (u.pn < 12) *(u32x4*)(QKV + (size_t)row * NQKV + c8) = w;
                    else { const int ch = c8 - NQKV, gg = ch >> 4, c0 = ch & 15, R = row >> 5, s = row & 31; *(u32x4*)(A5 + ((size_t)gg * RCH + R) * KS5 + s * SC + c0) = w; } } }
    }
};
struct EpiE {
    static constexpr bool PERM = false, KSPLIT = false, TOEP = false; typedef f32x4 acc_t;
    float* E;
    __device__ __forceinline__ void operator()(f32x4 (&acc)[2][2][4][2], const Unit& u, int wr, int wc, int fr, int fq) const {
#pragma unroll
        for (int ai = 0; ai < 2; ++ai)
#pragma unroll
            for (int m = 0; m < 4; ++m) { const int R = u.pm * BM + ai * HALF + wr * 64 + m * 16 + fr; float* rowp = E + ((size_t)u.g * RCH + R) * 256 + wc * 32 + 4 * fq;
#pragma unroll
                for (int bj = 0; bj < 2; ++bj)
#pragma unroll
                    for (int n = 0; n < 2; ++n) *(f32x4*)(rowp + bj * HALF + n * 16) = acc[ai][bj][m][n]; }
    }
};
struct EpiS5Out {
    static constexpr bool PERM = true, KSPLIT = false, TOEP = true; typedef f32x4 acc_t;
    bf16_t* Yg;
    __device__ __forceinline__ void operator()(f32x4 (&acc)[2][2][4][2], const Unit& u, int wr, int wc, int fr, int fq) const {
#pragma unroll
        for (int ai = 0; ai < 2; ++ai)
#pragma unroll
            for (int m = 0; m < 4; ++m) { const int R = u.pm * BM + ai * HALF + wr * 64 + m * 16 + fr;
#pragma unroll
                for (int bj = 0; bj < 2; ++bj) { const int n8 = u.pn * BM + bj * HALF + wc * 32 + 8 * fq, s = n8 >> 4, c0 = n8 & 15;
                    f32x4 vv[2];
#pragma unroll
                    for (int n = 0; n < 2; ++n)
#pragma unroll
                        for (int hf = 0; hf < 2; ++hf) { const f32x2 xv = (f32x2){acc[ai][bj][m][n][2 * hf], acc[ai][bj][m][n][2 * hf + 1]};
                            const f32x2 t = (xv * -2.30220818f) * ((xv * xv) * 0.044715f + 1.0f); f32x2 ev; ev.x = fast_exp2(t.x); ev.y = fast_exp2(t.y);
                            const f32x2 dv = ev + 1.0f; f32x2 rv; rv.x = fast_rcp(dv.x); rv.y = fast_rcp(dv.y);
                            const f32x2 yv = xv * rv; vv[n][2 * hf] = yv.x; vv[n][2 * hf + 1] = yv.y; }
                    *(u32x4*)(Yg + (size_t)(R * CL + s) * SW + u.g * SC + c0) = pack8(vv[0], vv[1]); } }
    }
};
struct EpiGlu {
    static constexpr bool PERM = true, KSPLIT = false, TOEP = false; typedef f32x4 acc_t;
    const bf16_t* Yg; const float* bias; bf16_t* YAYS; float* ssq4; LAS float* X;
    __device__ __forceinline__ void operator()(f32x4 (&acc)[2][2][4][2], const Unit& u, int wr, int wc, int fr, int fq) const {
        const int c8b = u.pn * BM + wc * 32 + 8 * fq;
        f32x4 bv[2][2];
#pragma unroll
        for (int bj = 0; bj < 2; ++bj)
#pragma unroll
            for (int n = 0; n < 2; ++n) bv[bj][n] = *(const f32x4*)(bias + c8b + bj * HALF + 4 * n);
#pragma unroll
        for (int ai = 0; ai < 2; ++ai) {
            u32x4 yv[4][2];
#pragma unroll
            for (int m = 0; m < 4; ++m)
#pragma unroll
                for (int bj = 0; bj < 2; ++bj) yv[m][bj] = *(const u32x4*)(Yg + (size_t)(u.pm * BM + ai * HALF + wr * 64 + m * 16 + fr) * SW + c8b + bj * HALF);
#pragma unroll
            for (int m = 0; m < 4; ++m) { const int row = u.pm * BM + ai * HALF + wr * 64 + m * 16 + fr; float ss = 0.f;
#pragma unroll
                for (int bj = 0; bj < 2; ++bj) { const int c8 = c8b + bj * HALF; const u32x4 y = yv[m][bj];
                    const f32x4 a0 = acc[ai][bj][m][0] + bv[bj][0], a1 = acc[ai][bj][m][1] + bv[bj][1];
                    f32x4 v0, v1;
                    { const unsigned yw[4] = {y.x, y.y, y.z, y.w};
#pragma unroll
                      for (int hf = 0; hf < 4; ++hf) { const f32x2 av = hf < 2 ? (f32x2){a0[2 * hf], a0[2 * hf + 1]} : (f32x2){a1[2 * hf - 4], a1[2 * hf - 3]};
                          const f32x2 t = av * -1.44269504089f; f32x2 ev; ev.x = fast_exp2(t.x); ev.y = fast_exp2(t.y);
                          const f32x2 dv = ev + 1.0f; f32x2 rv; rv.x = fast_rcp(dv.x); rv.y = fast_rcp(dv.y);
                          const f32x2 yv = (f32x2){bf_lo(yw[hf]), bf_hi(yw[hf])} * rv;
                          if (hf < 2) { v0[2 * hf] = yv.x; v0[2 * hf + 1] = yv.y; } else { v1[2 * hf - 4] = yv.x; v1[2 * hf - 3] = yv.y; } } }
#pragma unroll
                    for (int e = 0; e < 4; ++e) ss += v0[e] * v0[e] + v1[e] * v1[e];
                    *(u32x4*)(YAYS + (size_t)row * DM + AW + c8) = pack8(v0, v1); }
                ss += __shfl_xor(ss, 16); ss += __shfl_xor(ss, 32);
                if (fq == 0) X[(ai * HALF + wr * 64 + m * 16 + fr) * 4 + wc] = ss; }
            asm volatile("" ::: "memory"); }
        asm volatile("s_waitcnt lgkmcnt(0)" ::: "memory"); __builtin_amdgcn_s_barrier(); asm volatile("" ::: "memory");
        if (wc == 0 && fq == 0) {
#pragma unroll
            for (int ai = 0; ai < 2; ++ai)
#pragma unroll
                for (int m = 0; m < 4; ++m) { const int rl = ai * HALF + wr * 64 + m * 16 + fr; const f32x4 p = *(const LAS f32x4*)(X + rl * 4);
                    ssq4[(size_t)u.pn * M + u.pm * BM + rl] = (p[0] + p[1]) + (p[2] + p[3]); } }
    }
};
struct EpiRes1 {
    static constexpr bool PERM = true, KSPLIT = true, TOEP = false; typedef f32x4 acc_t;
    const bf16_t* xb; bf16_t* XB; const float* ssqa; const float* ssqs4; float* ssqx8; LAS float* X;
    __device__ __forceinline__ void operator()(f32x4 (&acc)[2][2][4][2], const Unit& u, int wr, int wc, int fr, int fq) const {
        if (u.kh == 0) {
#pragma unroll
        for (int ai = 0; ai < 2; ++ai)
#pragma unroll
            for (int m = 0; m < 4; ++m) { const int row = u.pm * BM + ai * HALF + wr * 64 + m * 16 + fr;
                const float sq = (ssqs4[row] + ssqs4[M + row]) + (ssqs4[2 * M + row] + ssqs4[3 * M + row]);
                const float ra = __builtin_amdgcn_rsqf(ssqa[row] * (1.0f / AW) + RMS_EPS), rs = __builtin_amdgcn_rsqf(sq * (1.0f / SW) + RMS_EPS), f = ra * fast_rcp(rs);
#pragma unroll
                for (int bj = 0; bj < 2; ++bj)
#pragma unroll
                    for (int n = 0; n < 2; ++n) acc[ai][bj][m][n] *= f; }
        return; }
        float rsv[2][4];
#pragma unroll
        for (int ai = 0; ai < 2; ++ai)
#pragma unroll
            for (int m = 0; m < 4; ++m) { const int row = u.pm * BM + ai * HALF + wr * 64 + m * 16 + fr;
                const float sq = (ssqs4[row] + ssqs4[M + row]) + (ssqs4[2 * M + row] + ssqs4[3 * M + row]); rsv[ai][m] = __builtin_amdgcn_rsqf(sq * (1.0f / SW) + RMS_EPS); }
#pragma unroll
        for (int am = 0; am < 4; ++am) { const int ai = am >> 1, mb = (am & 1) * 2;
            u32x4 xv[2][2];
#pragma unroll
            for (int mm = 0; mm < 2; ++mm)
#pragma unroll
                for (int bj = 0; bj < 2; ++bj) xv[mm][bj] = *(const u32x4*)(xb + (size_t)(u.pm * BM + ai * HALF + wr * 64 + (mb + mm) * 16 + fr) * DM + u.pn * BM + bj * HALF + wc * 32 + 8 * fq);
#pragma unroll
            for (int mm = 0; mm < 2; ++mm) { const int m = mb + mm; const int row = u.pm * BM + ai * HALF + wr * 64 + m * 16 + fr; float ss = 0.f; const float rs = rsv[ai][m];
#pragma unroll
                for (int bj = 0; bj < 2; ++bj) { const size_t off = (size_t)row * DM + u.pn * BM + bj * HALF + wc * 32 + 8 * fq;
                    const u32x4 x4 = xv[mm][bj]; f32x4 x0, x1; x0[0] = bf_lo(x4.x); x0[1] = bf_hi(x4.x); x0[2] = bf_lo(x4.y); x0[3] = bf_hi(x4.y); x1[0] = bf_lo(x4.z); x1[1] = bf_hi(x4.z); x1[2] = bf_lo(x4.w); x1[3] = bf_hi(x4.w);
                    const f32x4 v0 = x0 + acc[ai][bj][m][0] * rs, v1 = x1 + acc[ai][bj][m][1] * rs;
#pragma unroll
                    for (int e = 0; e < 4; ++e) ss += v0[e] * v0[e] + v1[e] * v1[e];
                    *(u32x4*)(XB + off) = pack8(v0, v1); }
                ss += __shfl_xor(ss, 16); ss += __shfl_xor(ss, 32);
                if (fq == 0) X[(ai * HALF + wr * 64 + m * 16 + fr) * 4 + wc] = ss; }
            asm volatile("" ::: "memory"); }
        asm volatile("s_waitcnt lgkmcnt(0)" ::: "memory"); __builtin_amdgcn_s_barrier(); asm volatile("" ::: "memory");
        if (wc == 0 && fq == 0) {
#pragma unroll
            for (int ai = 0; ai < 2; ++ai)
#pragma unroll
                for (int m = 0; m < 4; ++m) { const int rl = ai * HALF + wr * 64 + m * 16 + fr; const f32x4 p = *(const LAS f32x4*)(X + rl * 4);
                    ssqx8[(size_t)u.pn * M + u.pm * BM + rl] = (p[0] + p[1]) + (p[2] + p[3]); } }
    }
};
struct EpiSwiGLU {
    static constexpr bool PERM = true, KSPLIT = false, TOEP = false; typedef i32x4 acc_t;
    bf16_t* H; const float* FA; const float* sb; mutable float rsv[2][4]; mutable int cpm;
    __device__ __forceinline__ void operator()(i32x4 (&acc)[2][2][4][2], const Unit& u, int wr, int wc, int fr, int fq) const {
        if (u.pm != cpm) { cpm = u.pm;
#pragma unroll
        for (int ai = 0; ai < 2; ++ai)
#pragma unroll
            for (int m = 0; m < 4; ++m) rsv[ai][m] = FA[u.pm * BM + ai * HALF + wr * 64 + m * 16 + fr]; }
        const float* sp = sb + u.pn * BM + wc * 32 + 8 * fq;
        const f32x4 sg0 = *(const f32x4*)sp, sg1 = *(const f32x4*)(sp + 4), su0 = *(const f32x4*)(sp + HALF), su1 = *(const f32x4*)(sp + HALF + 4);
#pragma unroll
        for (int ai = 0; ai < 2; ++ai)
#pragma unroll
            for (int m = 0; m < 4; ++m) { const int row = u.pm * BM + ai * HALF + wr * 64 + m * 16 + fr; const float rs = rsv[ai][m];
                f32x4 hv[2];
#pragma unroll
                for (int n = 0; n < 2; ++n) { const f32x4 sg = (n == 0 ? sg0 : sg1) * rs, su = (n == 0 ? su0 : su1) * rs;
#pragma unroll
                    for (int hf = 0; hf < 2; ++hf) { const f32x2 ga = (f32x2){(float)acc[ai][0][m][n][2 * hf] * sg[2 * hf], (float)acc[ai][0][m][n][2 * hf + 1] * sg[2 * hf + 1]};
                        const f32x2 ua = (f32x2){(float)acc[ai][1][m][n][2 * hf] * su[2 * hf], (float)acc[ai][1][m][n][2 * hf + 1] * su[2 * hf + 1]};
                        const f32x2 t = ga * -1.44269504089f; f32x2 ev; ev.x = fast_exp2(t.x); ev.y = fast_exp2(t.y);
                        const f32x2 dv = ev + 1.0f; f32x2 rv; rv.x = fast_rcp(dv.x); rv.y = fast_rcp(dv.y);
                        const f32x2 hh = (ga * ua) * rv; hv[n][2 * hf] = hh.x; hv[n][2 * hf + 1] = hh.y; } }
                *(u32x4*)(H + (size_t)row * DFF + u.pn * HALF + wc * 32 + 8 * fq) = pack8(hv[0], hv[1]); }
    }
};
struct EpiRes2 {
    static constexpr bool PERM = true, KSPLIT = false, TOEP = false; typedef f32x4 acc_t;
    float* out; const bf16_t* XB;
    __device__ __forceinline__ void operator()(f32x4 (&acc)[2][2][4][2], const Unit& u, int wr, int wc, int fr, int fq) const {
#pragma unroll
        for (int ai = 0; ai < 2; ++ai) {
            u32x4 xb[4][2];
#pragma unroll
            for (int m = 0; m < 4; ++m)
#pragma unroll
                for (int bj = 0; bj < 2; ++bj) xb[m][bj] = *(const u32x4*)(XB + (size_t)(u.pm * BM + ai * HALF + wr * 64 + m * 16 + fr) * DM + u.pn * BM + wc * 32 + 8 * fq + bj * HALF);
#pragma unroll
            for (int m = 0; m < 4; ++m) { const size_t roff = (size_t)(u.pm * BM + ai * HALF + wr * 64 + m * 16 + fr) * DM + u.pn * BM + wc * 32 + 8 * fq;
#pragma unroll
                for (int bj = 0; bj < 2; ++bj) { const size_t off = roff + bj * HALF; const u32x4 x4 = xb[m][bj];
                    f32x4 v0, v1; v0[0] = bf_lo(x4.x); v0[1] = bf_hi(x4.x); v0[2] = bf_lo(x4.y); v0[3] = bf_hi(x4.y); v1[0] = bf_lo(x4.z); v1[1] = bf_hi(x4.z); v1[2] = bf_lo(x4.w); v1[3] = bf_hi(x4.w);
                    *(f32x4*)(out + off) = v0 + acc[ai][bj][m][0]; *(f32x4*)(out + off + 4) = v1 + acc[ai][bj][m][1]; } }
            asm volatile("" ::: "memory"); }
    }
};
}

#define RLX_AGENT __ATOMIC_RELAXED, __HIP_MEMORY_SCOPE_AGENT
#define XB_TMO      128
#define XB_XCNT(j)  (256  + 64 * (j))
#define XB_XSUB(j)  (1280 + 64 * (j))
#define XB_XGEN(j)  (2304 + 64 * (j))
#define XB_TOP      3328
#define XB_TOPGEN   3392
#define XCD_BAR_WORDS 3456
#define XB_SPIN_CAP (1u << 24)
__device__ __forceinline__ unsigned xb_ld(unsigned* p)              { return __hip_atomic_load(p, __ATOMIC_RELAXED, __HIP_MEMORY_SCOPE_AGENT); }
__device__ __forceinline__ unsigned xb_add(unsigned* p, unsigned v) { return __hip_atomic_fetch_add(p, v, __ATOMIC_RELAXED, __HIP_MEMORY_SCOPE_AGENT); }
__device__ __forceinline__ unsigned xb_xcc_id() { return (unsigned)__builtin_amdgcn_s_getreg((3 << 11) | 20) & 0xFu; }
#define XB_SPIN(cond, bar) do { unsigned _sp = 0; while (cond) { __builtin_amdgcn_s_sleep(1); \
    if ((++_sp & 255u) == 0u) { if (xb_ld(&(bar)[XB_TMO])) break; if (_sp > XB_SPIN_CAP) { atomicAdd(&(bar)[XB_TMO], 1u); break; } } } } while (0)
struct XcdBarrier { unsigned* bar; unsigned x; volatile LAS unsigned* st; };
__device__ __forceinline__ XcdBarrier xcd_barrier_post(unsigned* bar, volatile LAS unsigned* st) {
    XcdBarrier b; b.bar = bar; b.x = xb_xcc_id(); b.st = st;
    if (threadIdx.x == 0) (void)xb_add(&bar[XB_XCNT(b.x)], 1u);
    return b;
}
__device__ __forceinline__ void xcd_barrier_complete(unsigned* bar, unsigned x, unsigned& nloc, unsigned& nx) {
    const unsigned G = gridDim.x * gridDim.y * gridDim.z;
    unsigned sum, cnt, mine, sp = 0u;
    for (;;) {
        sum = 0u; cnt = 0u; mine = 0u;
#pragma unroll
        for (unsigned j = 0; j < 16; ++j) { const unsigned c = xb_ld(&bar[XB_XCNT(j)]); sum += c; cnt += (c > 0u) ? 1u : 0u; mine = (j == x) ? c : mine; }
        if (sum == G) break;
        __builtin_amdgcn_s_sleep(1);
        if ((++sp & 255u) == 0u) { if (xb_ld(&bar[XB_TMO])) break; if (sp > XB_SPIN_CAP) { atomicAdd(&bar[XB_TMO], 1u); break; } }
    }
    nloc = mine > 0u ? mine : 1u; nx = cnt > 0u ? cnt : 1u;
}
__device__ __forceinline__ void xcd_barrier(const XcdBarrier& b) {
    asm volatile("s_waitcnt vmcnt(0)" ::: "memory");
    __syncthreads();
    if (threadIdx.x == 0) {
        unsigned* bar = b.bar;
        __builtin_amdgcn_s_waitcnt(0);
        unsigned nloc = b.st[0], nx = b.st[1];
        if (nloc == 0u) { xcd_barrier_complete(bar, b.x, nloc, nx); b.st[0] = nloc; b.st[1] = nx; }
        const unsigned old = xb_add(&bar[XB_XSUB(b.x)], 1u);
        const unsigned gen = old / nloc;
        if (old + 1u == (gen + 1u) * nloc) {
            __builtin_amdgcn_fence(__ATOMIC_RELEASE, "agent");
            asm volatile("s_waitcnt vmcnt(0)" ::: "memory");
            const unsigned og = xb_add(&bar[XB_TOP], 1u);
            const unsigned tg = og / nx;
            if (og + 1u == (tg + 1u) * nx) xb_add(&bar[XB_TOPGEN], 1u);
            else XB_SPIN(xb_ld(&bar[XB_TOPGEN]) == tg, bar);
            __builtin_amdgcn_fence(__ATOMIC_ACQUIRE, "agent");
            xb_add(&bar[XB_XGEN(b.x)], 1u);
            asm volatile("s_waitcnt vmcnt(0)" ::: "memory");
        } else {
            XB_SPIN(xb_ld(&bar[XB_XGEN(b.x)]) == gen, bar);
            __builtin_amdgcn_fence(__ATOMIC_ACQUIRE, "agent");
            asm volatile("s_waitcnt vmcnt(0)" ::: "memory");
        }
    }
    __syncthreads();
}

struct Args { const float* in[23]; float* out; unsigned char* ws; int ph_lo, ph_hi, li, dup; };
enum { I_X = 0, I_GMIX, I_WIN, I_QG, I_KG, I_RPB, I_ARE, I_AIM, I_BRE, I_BIM, I_CRE, I_CIM, I_LS, I_D, I_WGLU, I_BGLU, I_GOA, I_GOS, I_WOUT, I_GFFN, I_WG, I_WU, I_WD };

#define LDS_WAIT() asm volatile("s_waitcnt lgkmcnt(0)" ::: "memory")

__device__ __forceinline__ void p0_transpose_item(const float* W, int N, const float* kscale, bf16_t* WT, int ldd, int drow0, int k0, int n0, int lane) {
    const int c = lane >> 3, n4 = (lane & 7) * 4;
    const float* src = W + (size_t)(k0 + 8 * c) * N + n0 + n4;
    f32x4 v[2][8];
#pragma unroll
    for (int h = 0; h < 2; ++h)
#pragma unroll
        for (int i = 0; i < 8; ++i) v[h][i] = __builtin_nontemporal_load((const f32x4*)(src + (size_t)i * N + 32 * h));
    if (kscale) { const f32x4 s0 = *(const f32x4*)(kscale + k0 + 8 * c), s1 = *(const f32x4*)(kscale + k0 + 8 * c + 4);
#pragma unroll
        for (int h = 0; h < 2; ++h)
#pragma unroll
            for (int i = 0; i < 8; ++i) v[h][i] *= (i < 4 ? s0[i & 3] : s1[i & 3]); }
#pragma unroll
    for (int h = 0; h < 2; ++h)
#pragma unroll
        for (int e = 0; e < 4; ++e) { u32x4 o; o.x = cvt_pk_bf16(v[h][0][e], v[h][1][e]); o.y = cvt_pk_bf16(v[h][2][e], v[h][3][e]); o.z = cvt_pk_bf16(v[h][4][e], v[h][5][e]); o.w = cvt_pk_bf16(v[h][6][e], v[h][7][e]);
            *(u32x4*)(WT + (size_t)(drow0 + 32 * h + n4 + e) * ldd + k0 + 8 * c) = o; }
}

__device__ __forceinline__ void dsincos(double a, double& s, double& c) {
    const double k = __builtin_rint(a * 0.63661977236758134308);
    double r = __builtin_fma(-k, 1.57079632679489655800e+00, a);
    r = __builtin_fma(-k, 6.12323399573676603587e-17, r);
    const double r2 = r * r;
    double sp = -7.6471637318198164759e-13; sp = sp * r2 + 1.6059043836821614599e-10; sp = sp * r2 - 2.5052108385441718775e-08; sp = sp * r2 + 2.7557319223985890653e-06;
    sp = sp * r2 - 1.9841269841269841270e-04; sp = sp * r2 + 8.3333333333333333333e-03; sp = sp * r2 - 1.6666666666666666667e-01; sp = sp * r2 * r + r;
    double cp = 4.7794773323873852974e-14; cp = cp * r2 - 1.1470745597729724714e-11; cp = cp * r2 + 2.0876756987868098979e-09; cp = cp * r2 - 2.7557319223985890653e-07;
    cp = cp * r2 + 2.4801587301587301587e-05; cp = cp * r2 - 1.3888888888888888889e-03; cp = cp * r2 + 4.1666666666666666667e-02; cp = cp * r2 - 0.5; cp = cp * r2 + 1.0;
    const int q = (int)((long long)k) & 3;
    s = (q == 0) ? sp : (q == 1) ? cp : (q == 2) ? -sp : -cp;
    c = (q == 0) ? cp : (q == 1) ? -sp : (q == 2) ? -cp : sp;
}

struct S5Params { f32x4 br4, bi4, cr4, ci4; float are, aim, ls; };
__device__ __forceinline__ void p0_s5_params(const Args& a, int g, int tid, S5Params& P) {
    const float* a_re = a.in[I_ARE]; const float* a_im = a.in[I_AIM]; const float* b_re = a.in[I_BRE]; const float* b_im = a.in[I_BIM];
    const float* c_re = a.in[I_CRE]; const float* c_im = a.in[I_CIM]; const float* lstep = a.in[I_LS];
#pragma unroll
    for (int j = 0; j < 4; ++j) { const int i = tid + 512 * j, c = i & 15, p = (i >> 4) & 63, d = i >> 10;
        const size_t bi = (((size_t)d * SG + g) * SP + p) * SC + c, ci = (((size_t)d * SG + g) * SC + c) * SP + p;
        P.br4[j] = b_re[bi]; P.bi4[j] = b_im[bi]; P.cr4[j] = c_re[ci]; P.ci4[j] = c_im[ci]; }
    { const int p = tid & 63, d = (tid >> 6) & 1; P.are = a_re[(d * SG + g) * SP + p]; P.aim = a_im[(d * SG + g) * SP + p]; P.ls = lstep[d * SG + g]; }
}
__device__ __forceinline__ void p0_s5_tables(const Args& a, LAS unsigned char* lds, int g, int q, int tid, const S5Params& P) {
    LAS f32x2* LP = (LAS f32x2*)lds;
    LAS float* Bb = (LAS float*)(lds + 33792);
    LAS f32x2* Cm = (LAS f32x2*)(lds + 50176);
    LAS float* Kt = (LAS float*)(lds + 66560);
    const float* dsk = a.in[I_D];
    unsigned char* ws = a.ws;
    __syncthreads();
    LAS f32x2* Fp = (LAS f32x2*)(Kt);
    if (tid < 128) { const int p = tid & 63, d = tid >> 6;
        const double lre = (double)fminf(P.are, -1e-4f), lim = (double)P.aim, dt = exp((double)P.ls);
        const double mag = exp(lre * dt); double sn, cs; dsincos(lim * dt, sn, cs);
        const double lr = mag * cs, li = mag * sn;
        const double nr = lr - 1.0, ni = li, den = 1.0 / (lre * lre + lim * lim);
        Fp[d * 64 + p] = (f32x2){(float)((nr * lre + ni * lim) * den), (float)((ni * lre - nr * lim) * den)};
        double wr_ = 1.0, wi_ = 0.0;
        for (int tau = 0; tau <= CL; ++tau) { LP[(d * 64 + p) * 33 + tau] = (f32x2){(float)wr_, (float)wi_}; const double t_ = wr_ * lr - wi_ * li; wi_ = wr_ * li + wi_ * lr; wr_ = t_; } }
    __syncthreads();
#pragma unroll
    for (int j = 0; j < 4; ++j) { const int i = tid + 512 * j, c = i & 15, p = (i >> 4) & 63, d = i >> 10; const f32x2 f = Fp[d * 64 + p];
        Bb[(d * 64 + p) * 32 + c] = f.x * P.br4[j] - f.y * P.bi4[j]; Bb[(d * 64 + p) * 32 + 16 + c] = f.x * P.bi4[j] + f.y * P.br4[j];
        Cm[i] = (f32x2){P.cr4[j], P.ci4[j]}; }
    __syncthreads();
    if (q == 0 && tid < 128) { const int p = tid & 63, d = tid >> 6; ((f32x2*)(ws + WS_LAML))[(g * 2 + d) * SP + p] = LP[(d * 64 + p) * 33 + CL]; }
    { const int wv = __builtin_amdgcn_readfirstlane(tid >> 6), l = tid & 63, c16 = l & 15, g4 = l >> 4;
#pragma unroll 1
      for (int d = 0; d < 2; ++d) {
        bf16x8 Bf[4];
#pragma unroll
        for (int ks = 0; ks < 4; ++ks) { float v[8];
#pragma unroll
            for (int j = 0; j < 8; ++j) v[j] = Bb[(d * 64 + 32 * (ks & 1) + 8 * g4 + j) * 32 + (ks >> 1) * 16 + c16];
            u32x4 w; w.x = cvt_pk_bf16(v[0], v[1]); w.y = cvt_pk_bf16(v[2], v[3]); w.z = cvt_pk_bf16(v[4], v[5]); w.w = cvt_pk_bf16(v[6], v[7]); Bf[ks] = __builtin_bit_cast(bf16x8, w); }
#pragma unroll 1
        for (int tt = 0; tt < 4; ++tt) { const int tau = wv + 8 * tt;
            f32x4 acc = (f32x4){0.f, 0.f, 0.f, 0.f};
#pragma unroll
            for (int ks = 0; ks < 2; ++ks) { float gr[8], gi[8];
#pragma unroll
                for (int j = 0; j < 8; ++j) { const int p = 32 * ks + 8 * g4 + j; const f32x2 cm = Cm[(d * 64 + p) * 16 + c16], lp = LP[(d * 64 + p) * 33 + tau];
                    gr[j] = cm.x * lp.x - cm.y * lp.y; gi[j] = -(cm.x * lp.y + cm.y * lp.x); }
                u32x4 wr_, wi_; wr_.x = cvt_pk_bf16(gr[0], gr[1]); wr_.y = cvt_pk_bf16(gr[2], gr[3]); wr_.z = cvt_pk_bf16(gr[4], gr[5]); wr_.w = cvt_pk_bf16(gr[6], gr[7]);
                wi_.x = cvt_pk_bf16(gi[0], gi[1]); wi_.y = cvt_pk_bf16(gi[2], gi[3]); wi_.z = cvt_pk_bf16(gi[4], gi[5]); wi_.w = cvt_pk_bf16(gi[6], gi[7]);
                acc = __builtin_amdgcn_mfma_f32_16x16x32_bf16(__builtin_bit_cast(bf16x8, wr_), Bf[ks], acc, 0, 0, 0);
                acc = __builtin_amdgcn_mfma_f32_16x16x32_bf16(__builtin_bit_cast(bf16x8, wi_), Bf[2 + ks], acc, 0, 0, 0); }
#pragma unroll
            for (int e = 0; e < 4; ++e) Kt[((d * 32 + tau) * 16 + 4 * g4 + e) * 16 + c16] = acc[e]; } } }
    __syncthreads();
    { const int d = q >> 1, ri = q & 1, p = tid >> 3, s0 = (tid & 7) * 4;
      bf16_t* dst = (bf16_t*)(ws + WS_WST) + ((size_t)g * 256 + q * 64 + p) * 512 + s0 * 16;
      float bx_[16], by_[16];
#pragma unroll
      for (int e = 0; e < 16; ++e) { bx_[e] = Bb[(d * 64 + p) * 32 + e]; by_[e] = Bb[(d * 64 + p) * 32 + 16 + e]; }
#pragma unroll
      for (int sp = 0; sp < 4; ++sp) { const int pw = d == 0 ? (CL - 1 - (s0 + sp)) : (s0 + sp); const f32x2 lp = LP[(d * 64 + p) * 33 + pw]; float v[16];
#pragma unroll
          for (int e = 0; e < 16; ++e) v[e] = ri == 0 ? (lp.x * bx_[e] - lp.y * by_[e]) : (lp.x * by_[e] + lp.y * bx_[e]);
          u32x4 w0, w1; w0.x = cvt_pk_bf16(v[0], v[1]); w0.y = cvt_pk_bf16(v[2], v[3]); w0.z = cvt_pk_bf16(v[4], v[5]); w0.w = cvt_pk_bf16(v[6], v[7]);
          w1.x = cvt_pk_bf16(v[8], v[9]); w1.y = cvt_pk_bf16(v[10], v[11]); w1.z = cvt_pk_bf16(v[12], v[13]); w1.w = cvt_pk_bf16(v[14], v[15]);
          *(u32x4*)(dst + sp * 16) = w0; *(u32x4*)(dst + sp * 16 + 8) = w1; } }
    { const int L = 16 * q + (tid >> 5), c = (tid >> 1) & 15, c0 = (tid & 1) * 8;
      if (L < 63) { const float dsv = dsk[g * SC + c]; float v[8];
          const LAS float* k0 = Kt + ((L >= 31 ? (L - 31) : (32 + 31 - L)) * 16 + c) * 16 + c0;
#pragma unroll
          for (int e = 0; e < 8; ++e) v[e] = k0[e];
          if (L == 31) { const LAS float* k1 = Kt + (32 * 16 + c) * 16 + c0;
#pragma unroll
              for (int e = 0; e < 8; ++e) v[e] += k1[e] + ((c == c0 + e) ? dsv : 0.f); }
          u32x4 w; w.x = cvt_pk_bf16(v[0], v[1]); w.y = cvt_pk_bf16(v[2], v[3]); w.z = cvt_pk_bf16(v[4], v[5]); w.w = cvt_pk_bf16(v[6], v[7]);
          *(u32x4*)((bf16_t*)(ws + WS_KB) + (((size_t)g * 64 + L) * 16 + c) * 16 + c0) = w; } }
    { const int c = tid & 15, s = 8 * q + ((tid >> 4) & 7), hi2 = tid >> 7;
      bf16_t* dst = (bf16_t*)(ws + WS_WO) + ((size_t)g * 512 + s * 16 + c) * 256;
      { const int d = hi2 >> 1, ri = hi2 & 1, pw = d == 0 ? (s + 1) : (CL - s);
#pragma unroll 1
        for (int pb = 0; pb < 8; ++pb) { float v[8];
#pragma unroll
            for (int e = 0; e < 8; ++e) { const int p = 8 * pb + e; const f32x2 cm = Cm[(d * 64 + p) * 16 + c], lp = LP[(d * 64 + p) * 33 + pw];
                v[e] = ri == 0 ? (cm.x * lp.x - cm.y * lp.y) : -(cm.x * lp.y + cm.y * lp.x); }
            u32x4 w; w.x = cvt_pk_bf16(v[0], v[1]); w.y = cvt_pk_bf16(v[2], v[3]); w.z = cvt_pk_bf16(v[4], v[5]); w.w = cvt_pk_bf16(v[6], v[7]);
            *(u32x4*)(dst + hi2 * 64 + 8 * pb) = w; } } }
    __syncthreads();
}

__device__ __forceinline__ void p0_prologue(const Args& a, LAS unsigned char* lds, int vcu, int G, int tid) {
    asm volatile("" : "+v"(tid));
    const int wave = __builtin_amdgcn_readfirstlane(tid >> 6), lane = tid & 63;
    unsigned char* ws = a.ws;
    S5Params P5; p0_s5_params(a, (vcu < SG * 4 ? vcu : SG * 4 - 1) >> 2, tid, P5);
    const int gw = vcu * 8 + wave, NGW = G * 8;
    constexpr int I_IN = (DM / 64) * (INW / 64), I_GL = (SW / 64) * (SW / 64), I_OUT = (DM / 64) * (DM / 64), I_GU = (DM / 64) * (DFF / 64), I_DN = (DFF / 64) * (DM / 64);
    constexpr int NITEMS = I_IN + I_GL + I_OUT + 2 * I_GU + I_DN;
    const float* x = a.in[I_X]; bf16_t* XN = (bf16_t*)(ws + WS_XN); float* ssq0 = (float*)(ws + WS_SSQ0);
    const int n_tr = (NITEMS + NGW - 1) / NGW, n_xn = (M + 2 * NGW - 1) / (2 * NGW), n_steps = n_tr + n_xn, tstep = vcu % n_steps;
    for (int st = 0; st < n_steps; ++st) {
        if (st == tstep) { for (int it = vcu; it < SG * 4; it += G) { if (it != vcu) p0_s5_params(a, it >> 2, tid, P5); p0_s5_tables(a, lds, it >> 2, it & 3, tid, P5); } }
        if (st < n_tr) {
            int r = gw + st * NGW; if (r >= NITEMS) continue;
            if (r < I_IN) { const int nb = INW / 64, kb = r / nb, n0 = (r % nb) * 64; p0_transpose_item(a.in[I_WIN], INW, a.in[I_GMIX], (bf16_t*)(ws + WS_WIN), DM, n0, kb * 64, n0, lane); continue; } r -= I_IN;
            if (r < I_GL) { const int nb = SW / 64, kb = r / nb, n0 = (r % nb) * 64; p0_transpose_item(a.in[I_WGLU], SW, nullptr, (bf16_t*)(ws + WS_WGLU), SW, n0, kb * 64, n0, lane); continue; } r -= I_GL;
            if (r < I_OUT) { const int nb = DM / 64, kb = r / nb, n0 = (r % nb) * 64, k0 = kb * 64;
                p0_transpose_item(a.in[I_WOUT], DM, k0 < AW ? a.in[I_GOA] : a.in[I_GOS] - AW, (bf16_t*)(ws + WS_WOUT), DM, n0, k0, n0, lane); continue; } r -= I_OUT;
            if (r < 2 * I_GU) { const int up = r >= I_GU; if (up) r -= I_GU; const int nb = DFF / 64, kb = r / nb, n0 = (r % nb) * 64;
                p0_transpose_item(up ? a.in[I_WU] : a.in[I_WG], DFF, a.in[I_GFFN], (bf16_t*)(ws + WS_WGU), DM, 256 * (n0 >> 7) + (n0 & 127) + (up ? 128 : 0), kb * 64, n0, lane); continue; } r -= 2 * I_GU;
            { const int nb = DM / 64, kb = r / nb, n0 = (r % nb) * 64; p0_transpose_item(a.in[I_WD], DM, nullptr, (bf16_t*)(ws + WS_WD), DFF, n0, kb * 64, n0, lane); }
            continue; }
        { const int m = gw + (st - n_tr) * 2 * NGW; if (m >= M) continue; const int m1 = m + NGW < M ? m + NGW : m;
        const f32x4* xr0 = (const f32x4*)(x + (size_t)m * DM) + lane; const f32x4* xr1 = (const f32x4*)(x + (size_t)m1 * DM) + lane; f32x4 v0[8], v1[8]; float s0 = 0.f, s1 = 0.f;
#pragma unroll
        for (int j = 0; j < 8; ++j) { v0[j] = __builtin_nontemporal_load(xr0 + 64 * j); v1[j] = __builtin_nontemporal_load(xr1 + 64 * j); }
        u32x2* o0 = (u32x2*)(XN + (size_t)m * DM) + lane; u32x2* o1 = (u32x2*)(XN + (size_t)m1 * DM) + lane;
#pragma unroll
        for (int j = 0; j < 8; ++j) { s0 += (v0[j][0] * v0[j][0] + v0[j][1] * v0[j][1]) + (v0[j][2] * v0[j][2] + v0[j][3] * v0[j][3]); s1 += (v1[j][0] * v1[j][0] + v1[j][1] * v1[j][1]) + (v1[j][2] * v1[j][2] + v1[j][3] * v1[j][3]);
            u32x2 w; w.x = cvt_pk_bf16(v0[j][0], v0[j][1]); w.y = cvt_pk_bf16(v0[j][2], v0[j][3]); o0[64 * j] = w;
            u32x2 w2; w2.x = cvt_pk_bf16(v1[j][0], v1[j][1]); w2.y = cvt_pk_bf16(v1[j][2], v1[j][3]); o1[64 * j] = w2; }
        s0 = wave_sum(s0); s1 = wave_sum(s1);
        if (lane == 0) { ssq0[m] = s0; ssq0[m1] = s1; } }
    }
}

constexpr int ATT_NS = 9;
constexpr int ATT_CHAIN_ITEMS = 0;
constexpr int KROW = 144, AROW = 160;
constexpr int AHEAD = 64 * AROW;
constexpr int ABUF = 2 * AHEAD;
constexpr int ABUF2 = 2 * ABUF;
constexpr int ATT_RPB_OFF = 2 * ABUF2;
static_assert(ATT_RPB_OFF + (16 * 465 + 16) * 4 <= MISC_OFF, "attention LDS");

__device__ __forceinline__ void attn_phase(const Args& a, LAS unsigned char* lds, volatile LAS unsigned* MISC, int vcu, int G, int has_g2, int tid) {
    asm volatile("" : "+v"(tid));
    const int wave = __builtin_amdgcn_readfirstlane(tid >> 6), lane = tid & 63, ql = lane & 15, g4 = lane >> 4;
    const bf16_t* QKV = (const bf16_t*)(a.ws + WS_BIG); bf16_t* YAYS = (bf16_t*)(a.ws + WS_YAYS); float* ssqa16 = (float*)(a.ws + WS_SSQA16);
    LAS float* rpbL = (LAS float*)(lds + ATT_RPB_OFF);
    for (int i = tid; i < 16 * 465; i += 512) rpbL[i] = a.in[I_RPB][i] * 1.44269504089f;
    const int j = wave & 3, hsel = wave >> 2;
    const int cq = 16 * j + ql, cs = min(max(cq - 8, 0), GRIDW - 16), wb = (j == 0) ? 0 : (j == 1) ? 8 : (j == 2) ? 24 : 32;
    int it_lo, it_hi, it_step;
    if (G == 256) { const int x_ = vcu >> 5, k_ = vcu & 15; it_step = 16;
        if (has_g2) { it_lo = x_ * 128 + 128 - 16 * ATT_CHAIN_ITEMS + k_; it_hi = x_ * 128 + 128; } else { it_lo = x_ * 128 + k_; it_hi = x_ * 128 + 128 - 16 * ATT_CHAIN_ITEMS; } }
    else { it_lo = vcu; it_hi = BATCH * (NROWS / 2) * 8; it_step = G; }
    int item = it_lo < it_hi ? it_lo : -1;
    const int skey = tid >> 3, sch = tid & 7;
    const unsigned ldstK = (unsigned)(skey * KROW + sch * 16), ldstV = (unsigned)(skey * AROW + sch * 16);
    u32x4 R[3][4];
#define ATT_UN(it_) ((((it_) >> 7) << 5) | (((it_) & 15) << 1))
#define ATT_HP(it_) (((it_) >> 4) & 7)
#define ATT_RS0(it_) min(max((ATT_UN(it_) & 63) - 4, 0), NROWS - 8)
#define ATT_BASE(it_) (QKV + ((size_t)(ATT_UN(it_) >> 6) * SEQ + 64 * ATT_RS0(it_) + skey) * NQKV + AW + 128 * ATT_HP(it_) + 8 * sch)
#define ATT_LOAD(slot_, base_, rs0_, s_) do { const bf16_t* p_ = (base_) + (size_t)min((s_), NROWS - 1 - (rs0_)) * (64 * NQKV); \
        R[slot_][0] = *(const u32x4*)p_; R[slot_][1] = *(const u32x4*)(p_ + 64); R[slot_][2] = *(const u32x4*)(p_ + AW); R[slot_][3] = *(const u32x4*)(p_ + AW + 64); } while (0)
    if (item >= 0) { const bf16_t* kb0 = ATT_BASE(item); const int rs_ = ATT_RS0(item);
#pragma unroll
        for (int p = 0; p < 3; ++p) ATT_LOAD(p, kb0, rs_, p);
    }
    f32x4 mka[2];
#pragma unroll
    for (int t = 0; t < 2; ++t)
#pragma unroll
        for (int e = 0; e < 4; ++e) { const int ck = wb + 16 * t + 4 * g4 + e; mka[t][e] = (ck >= cs && ck < cs + 16) ? 0.f : -1e30f; }
    if (tid < 16) { rpbL[-16 + tid] = 0.f; rpbL[16 * 465 + tid] = 0.f; }
    int par = 0;
    while (item >= 0) {
        const int un_ = ATT_UN(item), b = un_ >> 6, r0 = un_ & 63, hp = ATT_HP(item), h = 2 * hp + hsel;
        const int rs0 = min(max(r0 - 4, 0), NROWS - 8), rs1 = min(max(r0 - 3, 0), NROWS - 8), dd = rs1 - rs0;
        const int nitem = item + it_step < it_hi ? item + it_step : -1, ni_ = nitem >= 0 ? nitem : item;
        const bf16_t* kcur = ATT_BASE(item); const bf16_t* knxt = ATT_BASE(ni_); const int rs0n = ATT_RS0(ni_);
        const size_t tq0 = (size_t)b * SEQ + 64 * r0 + cq;
        bf16x8 Qf[2][2];
#pragma unroll
        for (int q = 0; q < 2; ++q) { const u32x4* qp = (const u32x4*)(QKV + (tq0 + 64 * q) * NQKV + 64 * h + 8 * g4); Qf[q][0] = __builtin_bit_cast(bf16x8, qp[0]); Qf[q][1] = __builtin_bit_cast(bf16x8, qp[4]); }
        const LAS float* bl0 = rpbL + h * 465 + (rs0 - r0 + 7) * 31 + (wb + 4 * g4 - cq + 15); const LAS float* bl1 = bl0 - 31;
        f32x4 O[2][4]; float sum[2] = {0.f, 0.f};
#pragma unroll
        for (int q = 0; q < 2; ++q)
#pragma unroll
            for (int dt = 0; dt < 4; ++dt) O[q][dt] = (f32x4){0.f, 0.f, 0.f, 0.f};
#pragma unroll
        for (int st = 0; st < ATT_NS; ++st) {
            LAS unsigned char* buf = lds + ((st ^ par) & 1) * ABUF2;
            *(LAS u32x4*)(buf + ldstK) = R[st % 3][0]; *(LAS u32x4*)(buf + AHEAD + ldstK) = R[st % 3][1];
            *(LAS u32x4*)(buf + ABUF + ldstV) = R[st % 3][2]; *(LAS u32x4*)(buf + ABUF + AHEAD + ldstV) = R[st % 3][3];
            if (st + 3 < ATT_NS) ATT_LOAD(st % 3, kcur, rs0, st + 3); else ATT_LOAD(st % 3, knxt, rs0n, st + 3 - ATT_NS);
            asm volatile("s_waitcnt lgkmcnt(0)" ::: "memory"); __builtin_amdgcn_s_barrier(); asm volatile("" ::: "memory");
            const bool act0 = st < 8, act1 = (st == 0) ? (dd == 0) : (st == 8) ? (dd == 1) : true;
            if (act0 || act1) {
                bf16x8 kf[2][2], av[4];
                { const LAS unsigned char* hb = buf + hsel * AHEAD;
#pragma unroll
                  for (int t = 0; t < 2; ++t) { const LAS unsigned char* kp = hb + (wb + 16 * t + ql) * KROW + g4 * 16; kf[t][0] = *(const LAS bf16x8*)kp; kf[t][1] = *(const LAS bf16x8*)(kp + 64); }
                  const LAS unsigned char* rp = hb + ABUF + (wb + 4 * g4 + ((lane & 15) >> 2)) * AROW + (lane & 3) * 8;
#pragma unroll
                  for (int dt = 0; dt < 4; ++dt) {
                      const s16x4 lo = __builtin_amdgcn_ds_read_tr16_b64_v4i16((LAS s16x4*)(rp + dt * 32));
                      const s16x4 hi = __builtin_amdgcn_ds_read_tr16_b64_v4i16((LAS s16x4*)(rp + 16 * AROW + dt * 32));
                      av[dt] = (bf16x8){lo[0], lo[1], lo[2], lo[3], hi[0], hi[1], hi[2], hi[3]}; } }
#pragma unroll
                for (int q = 0; q < 2; ++q) {
                    if (q == 0 ? !act0 : !act1) continue;
                    const LAS float* bl = (q == 0 ? bl0 : bl1) + st * 31;
                    f32x4 pv[2];
#pragma unroll
                    for (int t = 0; t < 2; ++t) { f32x4 acc = (f32x4){0.f, 0.f, 0.f, 0.f};
                        acc = __builtin_amdgcn_mfma_f32_16x16x32_bf16(kf[t][0], Qf[q][0], acc, 0, 0, 0);
                        acc = __builtin_amdgcn_mfma_f32_16x16x32_bf16(kf[t][1], Qf[q][1], acc, 0, 0, 0);
#pragma unroll
                        for (int e = 0; e < 4; ++e) { const float p = fast_exp2((acc[e] + bl[16 * t + e]) + mka[t][e]); pv[t][e] = p; sum[q] += p; } }
                    u32x4 pw; pw.x = cvt_pk_bf16_t(pv[0][0], pv[0][1]); pw.y = cvt_pk_bf16_t(pv[0][2], pv[0][3]); pw.z = cvt_pk_bf16_t(pv[1][0], pv[1][1]); pw.w = cvt_pk_bf16_tm(pv[1][2], pv[1][3]);
                    const bf16x8 Pf = __builtin_bit_cast(bf16x8, pw);
#pragma unroll
                    for (int dt = 0; dt < 4; ++dt) O[q][dt] = __builtin_amdgcn_mfma_f32_16x16x32_bf16(av[dt], Pf, O[q][dt], 0, 0, 0);
                }
            }
        }
        par ^= (ATT_NS & 1);
#pragma unroll
        for (int q = 0; q < 2; ++q) { float sm = sum[q]; sm += __shfl_xor(sm, 16); sm += __shfl_xor(sm, 32);
            const float inv = fast_rcp(sm); float ssq_acc = 0.f; const size_t tq = tq0 + 64 * q;
            bf16_t* op = YAYS + tq * DM + 64 * h + 4 * g4;
#pragma unroll
            for (int dt = 0; dt < 4; ++dt) { const f32x4 o = O[q][dt] * inv; ssq_acc += (o[0] * o[0] + o[1] * o[1]) + (o[2] * o[2] + o[3] * o[3]);
                u32x2 w; w.x = cvt_pk_bf16(o[0], o[1]); w.y = cvt_pk_bf16(o[2], o[3]); *(u32x2*)(op + 16 * dt) = w; }
            ssq_acc += __shfl_xor(ssq_acc, 16); ssq_acc += __shfl_xor(ssq_acc, 32);
            if (g4 == 0) ssqa16[tq * 16 + h] = ssq_acc; }
        item = nitem;
    }
#undef ATT_BASE
#undef ATT_RS0
#undef ATT_LOAD
#undef ATT_UN
#undef ATT_HP
}

__device__ __forceinline__ void scan_chain(const Args& a, int g, int pm, int tid) {
    asm volatile("" : "+v"(tid));
    if (tid >= 256) return;
    const float* E = (const float*)(a.ws + WS_E); bf16_t* A5 = (bf16_t*)(a.ws + WS_A5); const f32x2* LAML = (const f32x2*)(a.ws + WS_LAML);
    const int p = tid & 63, d = (tid >> 6) & 1, b = 2 * pm + (tid >> 7);
    const f32x2 lam = LAML[(g * 2 + d) * SP + p];
    float xr = 0.f, xi = 0.f;
    const size_t R0 = (size_t)g * RCH + b * NCH;
#pragma unroll 1
    for (int rd = 0; rd < NCH / 32; ++rd) { float er[32], ei[32];
#pragma unroll
        for (int j = 0; j < 32; ++j) { const int kk = rd * 32 + j, k = d == 0 ? kk : NCH - 1 - kk; const float* ep = E + (R0 + k) * 256 + d * 128 + p; er[j] = ep[0]; ei[j] = ep[64]; }
#pragma unroll
        for (int j = 0; j < 32; ++j) { const int kk = rd * 32 + j, k = d == 0 ? kk : NCH - 1 - kk;
            bf16_t* ap = A5 + (R0 + k) * KS5 + 512 + d * 128 + p; ap[0] = (bf16_t)(cvt_pk_bf16(xr, 0.f) & 0xffffu); ap[64] = (bf16_t)(cvt_pk_bf16(xi, 0.f) & 0xffffu);
            const float nr = lam.x * xr - lam.y * xi + er[j], ni = lam.x * xi + lam.y * xr + ei[j]; xr = nr; xi = ni; } }
}

__device__ __forceinline__ unsigned pack_i8x4(float a, float b, float c, float d) {
    const int ia = (int)__builtin_rintf(a), ib = (int)__builtin_rintf(b), ic = (int)__builtin_rintf(c), id = (int)__builtin_rintf(d);
    return (unsigned)(ia & 255) | ((unsigned)(ib & 255) << 8) | ((unsigned)(ic & 255) << 16) | ((unsigned)id << 24);
}
struct QRow { u32x4 w[4]; };
__device__ __forceinline__ void quant_row_load(QRow& r, const bf16_t* src, int lane) {
    const u32x4* sp = (const u32x4*)(src + 32 * lane);
#pragma unroll
    for (int j = 0; j < 4; ++j) r.w[j] = sp[j];
}
__device__ __forceinline__ float quant_row_finish(const QRow& r, unsigned char* dst, int lane) {
    float mx = 0.f;
#pragma unroll
    for (int j = 0; j < 4; ++j) { const u32x4 w = r.w[j];
        mx = fmaxf(fmaxf(fmaxf(mx, fmaxf(fabsf(bf_lo(w.x)), fabsf(bf_hi(w.x)))), fmaxf(fabsf(bf_lo(w.y)), fabsf(bf_hi(w.y)))), fmaxf(fmaxf(fabsf(bf_lo(w.z)), fabsf(bf_hi(w.z))), fmaxf(fabsf(bf_lo(w.w)), fabsf(bf_hi(w.w))))); }
#pragma unroll
    for (int o = 1; o < 64; o <<= 1) mx = fmaxf(mx, __shfl_xor(mx, o));
    mx = fmaxf(mx, 1e-20f);
    const float inv = 127.0f / mx;
    unsigned q[8];
#pragma unroll
    for (int j = 0; j < 4; ++j) { const u32x4 w = r.w[j];
        q[2 * j] = pack_i8x4(bf_lo(w.x) * inv, bf_hi(w.x) * inv, bf_lo(w.y) * inv, bf_hi(w.y) * inv); q[2 * j + 1] = pack_i8x4(bf_lo(w.z) * inv, bf_hi(w.z) * inv, bf_lo(w.w) * inv, bf_hi(w.w) * inv); }
    u32x4* dp = (u32x4*)(dst + 32 * lane); dp[0] = (u32x4){q[0], q[1], q[2], q[3]}; dp[1] = (u32x4){q[4], q[5], q[6], q[7]};
    return mx * (1.0f / 127.0f);
}

__global__ void __launch_bounds__(512, 2) hymba_fwd(Args args) {
    extern __shared__ __attribute__((aligned(16))) unsigned char lds_raw[];
    LAS unsigned char* lds = (LAS unsigned char*)lds_raw;
    volatile LAS unsigned* MISC = (volatile LAS unsigned*)(lds + MISC_OFF);
    const int tid = threadIdx.x;
    const int G = gridDim.x; const int bx = blockIdx.x; const int vcu = (G % 8 == 0) ? (bx % 8) * (G / 8) + bx / 8 : bx;
    unsigned char* ws = args.ws;
    unsigned* ctl = (unsigned*)(ws + WS_CTL);
    for (int u = tid; u < (LDS_BYTES - MISC_OFF) / 4; u += 512) MISC[u] = 0u;
    __syncthreads();
    XcdBarrier bar; bar.bar = ctl + CW_BAR; bar.x = 0; bar.st = nullptr;
    if (MK_N_LAUNCHES == 1) bar = xcd_barrier_post(ctl + CW_BAR, MISC + 8);
    const int lo = args.ph_lo, hi = args.ph_hi;
#define IN(k) (lo <= (k) && (k) < hi)
#define SEAM(k) do { if (IN(k) && IN((k) + 1)) xcd_barrier(bar); } while (0)
    bf16_t* WIN = (bf16_t*)(ws + WS_WIN); bf16_t* WGLU = (bf16_t*)(ws + WS_WGLU); bf16_t* WOUT = (bf16_t*)(ws + WS_WOUT); bf16_t* WGU = (bf16_t*)(ws + WS_WGU); bf16_t* WD = (bf16_t*)(ws + WS_WD);
    bf16_t* WST = (bf16_t*)(ws + WS_WST); bf16_t* KBT = (bf16_t*)(ws + WS_KB); bf16_t* WOT = (bf16_t*)(ws + WS_WO);
    bf16_t* XN = (bf16_t*)(ws + WS_XN); bf16_t* YG = (bf16_t*)(ws + WS_YG); bf16_t* XB = (bf16_t*)(ws + WS_XN);
    bf16_t* QKV = (bf16_t*)(ws + WS_BIG); bf16_t* A5 = (bf16_t*)(ws + WS_A5); float* E = (float*)(ws + WS_E); bf16_t* HB = (bf16_t*)(ws + WS_BIG);
    bf16_t* YAYS = (bf16_t*)(ws + WS_YAYS);
    float* ssqa16 = (float*)(ws + WS_SSQA16); float* ssqa = (float*)(ws + WS_SSQA); float* ssqs4 = (float*)(ws + WS_SSQS4); float* ssqx8 = (float*)(ws + WS_SSQX8);
    LAS float* XL = (LAS float*)(lds + RING_BYTES);

#define REP(k) _Pragma("unroll") for (int rep_ = (DUP_PHASE == (k)) ? 0 : 1; rep_ < 2; ++rep_)
#define ALPHA ((rep_ == 0 && args.dup >= 0) ? 0.0f : 1.0f)
    if (IN(0)) { REP(0) { p0_prologue(args, lds, vcu, G, tid); __syncthreads(); } SEAM(0); }
    if (IN(1)) {
        pg8::Gemm g{XN, WIN, DM, DM, DM, 0, 0, nullptr}; pg8::StaticOrder S; S.init(M, INW, G, bx);
        pg8::EpiZ Ep{QKV, A5, args.in[I_QG], args.in[I_KG], XL, (const float*)(ws + WS_SSQ0)};
        REP(1) pg8::gemm_phase(lds, g, S, Ep);
        SEAM(1);
    }
    if (IN(2)) {
        for (int cidx = bx; cidx < 2 * SG; cidx += G) { const int g_ = cidx >> 1, pm_ = cidx & 1;
            { pg8::Gemm g{A5, WST, KS5, 512, 512, (size_t)RCH * KS5, (size_t)256 * 512, nullptr}; pg8::ListOrder S; S.n = 1; S.u0.pm = pm_; S.u0.pn = 0; S.u0.g = g_; S.u0.kh = 0; S.u1 = S.u0;
              pg8::EpiE Ep{E};
              pg8::gemm_phase(lds, g, S, Ep); }
            asm volatile("s_waitcnt vmcnt(0)" ::: "memory"); __syncthreads();
            scan_chain(args, g_, pm_, tid);
            asm volatile("s_waitcnt vmcnt(0)" ::: "memory"); __syncthreads();
            { pg8::Gemm g{A5, KBT, KS5, KS5, KS5, (size_t)RCH * KS5, 0, WOT}; pg8::ListOrder S; S.n = 2; S.u0.pm = pm_; S.u0.pn = 0; S.u0.g = g_; S.u0.kh = 0; S.u1 = S.u0; S.u1.pn = 1;
              pg8::EpiS5Out Ep{YG};
              pg8::gemm_phase(lds, g, S, Ep); }
        }
        __syncthreads();
        attn_phase(args, lds, MISC, vcu, G, bx < 2 * SG ? 1 : 0, tid);
        SEAM(2);
    }
    if (IN(3)) {
        pg8::Gemm g{YG, WGLU, SW, SW, SW, 0, 0, nullptr}; pg8::StaticOrder S; S.init(M, SW, G, bx);
        for (int t = vcu * 512 + tid; t < M; t += G * 512) { const f32x4* p = (const f32x4*)(ssqa16 + (size_t)t * 16); const f32x4 s0 = p[0], s1 = p[1], s2 = p[2], s3 = p[3];
            const f32x4 sv = (s0 + s1) + (s2 + s3); ssqa[t] = (sv[0] + sv[1]) + (sv[2] + sv[3]); }
        REP(3) { pg8::EpiGlu Ep{YG, args.in[I_BGLU], YAYS, ssqs4, XL}; pg8::gemm_phase(lds, g, S, Ep); }
        SEAM(3);
    }
    if (IN(4)) {
        { const int wave_ = __builtin_amdgcn_readfirstlane(tid >> 6), lane_ = tid & 63; float* sbp = (float*)(ws + WS_SB);
          const int gw_ = vcu * 8 + wave_, ngw_ = G * 8;
          for (int r0 = gw_; r0 < 2 * DFF; r0 += 3 * ngw_) { QRow qr[3];
#pragma unroll
            for (int i = 0; i < 3; ++i) { const int row = r0 + i * ngw_; if (row < 2 * DFF) quant_row_load(qr[i], WGU + (size_t)row * DM, lane_); }
#pragma unroll
            for (int i = 0; i < 3; ++i) { const int row = r0 + i * ngw_; if (row < 2 * DFF) { const float sc = quant_row_finish(qr[i], ws + WS_WQ + (size_t)row * DM, lane_); if (lane_ == 0) sbp[row] = sc; } } } }
        pg8::Gemm g{YAYS, WOUT, DM, DM, AW, 0, 0, nullptr}; pg8::SplitKOrder S; S.so.init(M, DM, G, bx);
        REP(4) { pg8::EpiRes1 Ep{XN, XB, ssqa, ssqs4, ssqx8, XL}; pg8::gemm_phase(lds, g, S, Ep); }
        SEAM(4);
    }
    if (IN(5)) {
        pg8::Gemm g{(const bf16_t*)(ws + WS_YAYS), (const bf16_t*)(ws + WS_WQ), DM / 2, DM / 2, DM / 2, 0, 0, nullptr}; pg8::StaticOrder S; S.init(M, 2 * DFF, G, bx);
        { const int wave_ = __builtin_amdgcn_readfirstlane(tid >> 6), lane_ = tid & 63; float* fax = (float*)(ws + WS_FAX);
          for (int rb = vcu * 64 + wave_ * 8; rb < M; rb += G * 64) {
#pragma unroll 1
            for (int h = 0; h < 2; ++h) { QRow qr[4];
#pragma unroll
                for (int i = 0; i < 4; ++i) quant_row_load(qr[i], XB + (size_t)(rb + 4 * h + i) * DM, lane_);
#pragma unroll
                for (int i = 0; i < 4; ++i) { const int row = rb + 4 * h + i; const float sc = quant_row_finish(qr[i], ws + WS_YAYS + (size_t)row * DM, lane_);
                    float sq = 0.f;
#pragma unroll
                    for (int t = 0; t < 8; ++t) sq += ssqx8[(size_t)t * M + row];
                    if (lane_ == 0) fax[row] = sc * __builtin_amdgcn_rsqf(sq * (1.0f / DM) + RMS_EPS); } } } }
        if (MK_N_LAUNCHES == 1) xcd_barrier(bar);
        { pg8::EpiSwiGLU Ep{HB, (const float*)(ws + WS_FAX), (const float*)(ws + WS_SB), {{0.f, 0.f, 0.f, 0.f}, {0.f, 0.f, 0.f, 0.f}}, -1};
          pg8::gemm_phase(lds, g, S, Ep); }
        SEAM(5);
    }
    if (IN(6)) {
        pg8::Gemm g{HB, WD, DFF, DFF, DFF, 0, 0, nullptr}; pg8::StaticOrder S; S.init(M, DM, G, bx);
        REP(6) { pg8::EpiRes2 Ep{args.out, XB}; pg8::gemm_phase(lds, g, S, Ep); }
    }
#undef IN
#undef SEAM
}

extern "C" void kernel_launch(void* const* d_in, const int* in_sizes, int n_in, void* d_out, int out_size, void* d_ws, size_t ws_size, hipStream_t stream) {
    static int grid = 0;
    if (grid == 0) {
        if (n_in != 23 || in_sizes[0] != M * DM || out_size != M * DM || ws_size < WS_END) { fprintf(stderr, "kernel_launch: unexpected shapes (n_in %d, in0 %d, out %d, ws %zu < %zu)\n", n_in, n_in > 0 ? in_sizes[0] : -1, out_size, ws_size, (size_t)WS_END); grid = -1; return; }
        int dev = 0, cus = 0, per_cu = 0;
        if (hipGetDevice(&dev) != hipSuccess || hipDeviceGetAttribute(&cus, hipDeviceAttributeMultiprocessorCount, dev) != hipSuccess) { grid = -1; return; }
        if (hipFuncSetAttribute((const void*)hymba_fwd, hipFuncAttributeMaxDynamicSharedMemorySize, LDS_BYTES) != hipSuccess) { fprintf(stderr, "kernel_launch: hipFuncSetAttribute failed\n"); grid = -1; return; }
        if (hipOccupancyMaxActiveBlocksPerMultiprocessor(&per_cu, (const void*)hymba_fwd, 512, LDS_BYTES) != hipSuccess || per_cu < 1) { fprintf(stderr, "kernel_launch: occupancy query says %d blocks per CU\n", per_cu); (void)hipGetLastError(); per_cu = 1; }
        grid = cus;
    }
    if (grid < 0) return;
    (void)hipMemsetAsync((char*)d_ws + WS_CTL, 0, CTL_ZERO_BYTES, stream);
    Args a{}; a.dup = DUP_PHASE;
    for (int i = 0; i < 23; ++i) a.in[i] = (const float*)d_in[i];
    a.out = (float*)d_out; a.ws = (unsigned char*)d_ws;
    if (MK_N_LAUNCHES == 1) {
        a.ph_lo = 0; a.ph_hi = NPHASE; a.li = 0;
        void* kargs[] = {&a};
        const hipError_t le = hipLaunchCooperativeKernel((const void*)hymba_fwd, dim3(grid), dim3(512), kargs, LDS_BYTES, stream);
        if (le != hipSuccess) fprintf(stderr, "kernel_launch: cooperative launch failed: %s (grid %d)\n", hipGetErrorString(le), grid);
    } else {
        for (int li = 0; li < NPHASE; ++li) { a.ph_lo = li; a.ph_hi = li + 1; a.li = li; hipLaunchKernelGGL(hymba_fwd, dim3(grid), dim3(512), LDS_BYTES, stream, a); }
    }
}
```
